# Optimizing an MI355X kernel written in HIP

```python
import math
import jax
import jax.numpy as jnp
from jax import lax
import numpy as np

D_MODEL = 1024
BATCH = 8
SEQ = 4096
DEPTH = 4

CHUNK = 64
HEAD_DIM = 64
EPS = 1e-6

ATTN_HEADS = 8
ATTN_WIDTH = ATTN_HEADS * HEAD_DIM
LEFT_CHUNKS = 8
BAND_CHUNKS = LEFT_CHUNKS + 1
BAND_LEN = BAND_CHUNKS * CHUNK
MAX_REL = 128
REL_TABLE = MAX_REL + CHUNK

SSM_WIDTH = D_MODEL // 4
SSM_GROUP = 16
SSM_GROUPS = SSM_WIDTH // SSM_GROUP
SSM_STATE = 64
DT_MIN = 1e-3
DT_MAX = 1e-1

RET_HEADS = 4
RET_WIDTH = RET_HEADS * HEAD_DIM
ROPE_BASE = 10000.0

MIX_WIDTH = ATTN_WIDTH + SSM_WIDTH + RET_WIDTH
IN_WIDTH = 3 * ATTN_WIDTH + SSM_WIDTH + 4 * RET_WIDTH

N_GROUPS = 4
EXPERTS_PER_GROUP = 8
N_EXPERTS = N_GROUPS * EXPERTS_PER_GROUP
TOP_K = 2
EXPERT_FF = 256

kernel_name = "hybrid_streaming_encoder_hmoe"


def _rmsnorm(x, g):
    xf = x.astype(jnp.float32)
    y = xf * lax.rsqrt(jnp.mean(xf * xf, axis=-1, keepdims=True) + EPS)
    return (y * g.astype(jnp.float32)).astype(x.dtype)


def _rotary(x, pos):
    half = x.shape[-1] // 2
    inv_freq = ROPE_BASE ** (-jnp.arange(half, dtype=jnp.float32) / half)
    ang = pos.astype(jnp.float32)[:, None] * inv_freq[None, :]
    cos = jnp.cos(ang)[None, :, None, :]
    sin = jnp.sin(ang)[None, :, None, :]
    x1, x2 = x[..., :half], x[..., half:]
    return jnp.concatenate([x1 * cos - x2 * sin, x1 * sin + x2 * cos], axis=-1)


def _chunk_band_attention(q, k, v, rel_bias):
    b, s, h, dh = q.shape
    nc = s // CHUNK
    f32 = jnp.float32
    qc = q.reshape(b, nc, CHUNK, h, dh)
    pad = ((0, 0), (LEFT_CHUNKS, 0), (0, 0), (0, 0), (0, 0))
    kp = jnp.pad(k.reshape(b, nc, CHUNK, h, dh), pad)
    vp = jnp.pad(v.reshape(b, nc, CHUNK, h, dh), pad)
    band = jnp.arange(nc)[:, None] + jnp.arange(BAND_CHUNKS)[None, :]
    kb = kp[:, band].reshape(b, nc, BAND_LEN, h, dh)
    vb = vp[:, band].reshape(b, nc, BAND_LEN, h, dh)
    valid = jnp.repeat(band >= LEFT_CHUNKS, CHUNK, axis=1)
    key_off = jnp.arange(BAND_LEN) - LEFT_CHUNKS * CHUNK
    rel = key_off[None, :] - jnp.arange(CHUNK)[:, None]
    rel_idx = jnp.clip(rel, -MAX_REL, CHUNK - 1) + MAX_REL
    bias = rel_bias.astype(f32)[:, rel_idx]
    scores = jnp.einsum('bnqhd,bnkhd->bnhqk', qc, kb,
                        preferred_element_type=f32) * (dh ** -0.5) + bias
    scores = jnp.where(valid[None, :, None, None, :], scores, -jnp.inf)
    probs = jax.nn.softmax(scores, axis=-1).astype(v.dtype)
    out = jnp.einsum('bnhqk,bnkhd->bnqhd', probs, vb)
    return out.reshape(b, s, h * dh)


def _linear_recurrence_combine(left, right):
    a_l, b_l = left
    a_r, b_r = right
    return a_r * a_l, a_r * b_l + b_r


def _s5(u, a_re, a_im, log_dt, b_re, b_im, c_re, c_im, d_skip, w_glu, b_glu):
    bsz, s, _ = u.shape
    f32 = jnp.float32
    lam = lax.complex(a_re.astype(f32), a_im.astype(f32))
    dt = jnp.exp(log_dt.astype(f32))[:, None]
    a_bar = jnp.exp(lam * dt)
    b_mat = lax.complex(b_re.astype(f32), b_im.astype(f32))
    b_bar = ((a_bar - 1.0) / lam)[:, :, None] * b_mat
    ug = u.astype(f32).reshape(bsz, s, SSM_GROUPS, SSM_GROUP)
    bu = jnp.einsum('bsgc,gpc->bsgp', ug.astype(jnp.complex64), b_bar)
    a_seq = jnp.broadcast_to(a_bar, bu.shape)
    _, states = lax.associative_scan(_linear_recurrence_combine, (a_seq, bu), axis=1)
    c_mat = lax.complex(c_re.astype(f32), c_im.astype(f32))
    y = jnp.real(jnp.einsum('bsgp,gcp->bsgc', states, c_mat))
    y = y + d_skip.astype(f32).reshape(SSM_GROUPS, SSM_GROUP) * ug
    y = jax.nn.gelu(y.reshape(bsz, s, SSM_WIDTH))
    y = y * jax.nn.sigmoid(y @ w_glu.astype(f32) + b_glu.astype(f32))
    return y.astype(u.dtype)


def _retention(q, k, v, gate, gn_g, pos):
    b, s, h, dh = q.shape
    nc = s // CHUNK
    f32 = jnp.float32
    q = _rotary(q.astype(f32), pos)
    k = _rotary(k.astype(f32), pos) * (dh ** -0.5)
    v = v.astype(f32)
    log_gamma = jnp.log1p(-jnp.exp2(-5.0 - jnp.arange(h, dtype=f32)))
    t = jnp.arange(CHUNK, dtype=f32)
    diff = t[:, None] - t[None, :]
    decay = jnp.where(diff >= 0,
                      jnp.exp(log_gamma[:, None, None] * jnp.maximum(diff, 0.0)), 0.0)
    qc = q.reshape(b, nc, CHUNK, h, dh)
    kc = k.reshape(b, nc, CHUNK, h, dh)
    vc = v.reshape(b, nc, CHUNK, h, dh)
    inner = jnp.einsum('bnihd,bnjhd->bnhij', qc, kc) * decay
    inner = jnp.einsum('bnhij,bnjhe->bnihe', inner, vc)
    zeta = jnp.exp(log_gamma[:, None] * (CHUNK - 1 - t))
    kv = jnp.einsum('bnjhd,hj,bnjhe->nbhde', kc, zeta, vc)
    chunk_decay = jnp.exp(log_gamma * CHUNK)[None, :, None, None]

    def step(state, kv_n):
        return chunk_decay * state + kv_n, state

    _, prev = lax.scan(step, jnp.zeros((b, h, dh, dh), f32), kv)
    xi = jnp.exp(log_gamma[:, None] * (t + 1.0))
    cross = jnp.einsum('bnihd,nbhde,hi->bnihe', qc, prev, xi)
    y = inner + cross
    mu = jnp.mean(y, axis=-1, keepdims=True)
    var = jnp.mean(jnp.square(y - mu), axis=-1, keepdims=True)
    y = ((y - mu) * lax.rsqrt(var + EPS)).reshape(b, s, h * dh) * gn_g.astype(f32)
    return (jax.nn.silu(gate.astype(f32)) * y).astype(gate.dtype)


def _hier_moe(h, w_group, b_group, w_expert, b_expert, w_gate, w_up, w_down):
    bsz, s, d = h.shape
    f32 = jnp.float32
    t = h.reshape(bsz * s, d)
    group_logits = (t @ w_group + b_group).astype(f32)
    group_idx = jnp.argmax(group_logits, axis=-1)
    group_w = jnp.max(jax.nn.softmax(group_logits, axis=-1), axis=-1, keepdims=True)
    expert_logits = (t @ w_expert + b_expert).astype(f32)
    expert_logits = expert_logits.reshape(-1, N_GROUPS, EXPERTS_PER_GROUP)
    in_group = jnp.einsum('ng,nge->ne', jax.nn.one_hot(group_idx, N_GROUPS, dtype=f32), expert_logits)
    top_val, top_idx = lax.top_k(in_group, TOP_K)
    top_w = jax.nn.softmax(top_val, axis=-1) * group_w
    expert_id = group_idx[:, None] * EXPERTS_PER_GROUP + top_idx
    combine = jnp.sum(jax.nn.one_hot(expert_id, N_EXPERTS, dtype=f32) * top_w[..., None], axis=1)
    out = jnp.zeros((t.shape[0], d), f32)
    for gi in range(N_GROUPS):
        e = slice(gi * EXPERTS_PER_GROUP, (gi + 1) * EXPERTS_PER_GROUP)
        hg = jnp.einsum('nd,edf->nef', t, w_gate[e])
        hu = jnp.einsum('nd,edf->nef', t, w_up[e])
        act = jax.nn.silu(hg) * hu * combine[:, e, None].astype(t.dtype)
        out = out + jnp.einsum('nef,efd->nd', act, w_down[e]).astype(f32)
    return out.astype(h.dtype).reshape(bsz, s, d)


def setup_inputs(seed: int = 0) -> dict:
    key = jax.random.key(seed)
    ks = iter(jax.random.split(key, 32))
    f32 = jnp.float32

    def nrm(shape, scale):
        return jax.random.normal(next(ks), shape, f32) * scale

    L, D = DEPTH, D_MODEL
    G, P, Cg = SSM_GROUPS, SSM_STATE, SSM_GROUP
    x = nrm((BATCH, SEQ, D), 1.0)
    c = nrm((BATCH, D), 1.0)
    norm1_g = 1.0 + nrm((L, D), 0.05)
    norm2_g = 1.0 + nrm((L, D), 0.05)
    w_ada = nrm((L, D, 6 * D), 0.5 * D ** -0.5)
    b_ada = nrm((L, 6 * D), 0.01)
    w_in = nrm((L, D, IN_WIDTH), D ** -0.5)
    attn_rel_bias = nrm((L, ATTN_HEADS, REL_TABLE), 0.2)
    ssm_a_re = -0.5 + nrm((L, G, P), 0.01)
    ssm_a_im = jnp.tile(math.pi * jnp.arange(P, dtype=f32), (L, G, 1))
    ssm_log_dt = jax.random.uniform(next(ks), (L, G), f32, math.log(DT_MIN), math.log(DT_MAX))
    ssm_b_re = nrm((L, G, P, Cg), (2 * Cg) ** -0.5)
    ssm_b_im = nrm((L, G, P, Cg), (2 * Cg) ** -0.5)
    ssm_c_re = nrm((L, G, Cg, P), (2 * P) ** -0.5)
    ssm_c_im = nrm((L, G, Cg, P), (2 * P) ** -0.5)
    ssm_d = nrm((L, SSM_WIDTH), 1.0)
    ssm_w_glu = nrm((L, SSM_WIDTH, SSM_WIDTH), SSM_WIDTH ** -0.5)
    ssm_b_glu = nrm((L, SSM_WIDTH), 0.01)
    ret_gn_g = 1.0 + nrm((L, RET_WIDTH), 0.05)
    w_out = nrm((L, MIX_WIDTH, D), MIX_WIDTH ** -0.5)
    moe_w_group = nrm((L, D, N_GROUPS), D ** -0.5)
    moe_b_group = nrm((L, N_GROUPS), 0.01)
    moe_w_expert = nrm((L, D, N_EXPERTS), D ** -0.5)
    moe_b_expert = nrm((L, N_EXPERTS), 0.01)
    moe_w_gate = nrm((L, N_EXPERTS, D, EXPERT_FF), D ** -0.5)
    moe_w_up = nrm((L, N_EXPERTS, D, EXPERT_FF), D ** -0.5)
    moe_w_down = nrm((L, N_EXPERTS, EXPERT_FF, D), EXPERT_FF ** -0.5)
    final_g = 1.0 + nrm((D,), 0.05)
    return {"x": x, "c": c, "norm1_g": norm1_g, "norm2_g": norm2_g,
            "w_ada": w_ada, "b_ada": b_ada, "w_in": w_in, "attn_rel_bias": attn_rel_bias,
            "ssm_a_re": ssm_a_re, "ssm_a_im": ssm_a_im, "ssm_log_dt": ssm_log_dt,
            "ssm_b_re": ssm_b_re, "ssm_b_im": ssm_b_im, "ssm_c_re": ssm_c_re, "ssm_c_im": ssm_c_im,
            "ssm_d": ssm_d, "ssm_w_glu": ssm_w_glu, "ssm_b_glu": ssm_b_glu,
            "ret_gn_g": ret_gn_g, "w_out": w_out,
            "moe_w_group": moe_w_group, "moe_b_group": moe_b_group,
            "moe_w_expert": moe_w_expert, "moe_b_expert": moe_b_expert,
            "moe_w_gate": moe_w_gate, "moe_w_up": moe_w_up, "moe_w_down": moe_w_down,
            "final_g": final_g}


def reference(x, c, norm1_g, norm2_g, w_ada, b_ada, w_in, attn_rel_bias,
              ssm_a_re, ssm_a_im, ssm_log_dt, ssm_b_re, ssm_b_im, ssm_c_re, ssm_c_im,
              ssm_d, ssm_w_glu, ssm_b_glu, ret_gn_g, w_out,
              moe_w_group, moe_b_group, moe_w_expert, moe_b_expert,
              moe_w_gate, moe_w_up, moe_w_down, final_g):
    b, s, _ = x.shape
    pos = jnp.arange(s)
    cond = jax.nn.silu(c)
    split_at = np.cumsum([ATTN_WIDTH] * 3 + [SSM_WIDTH] + [RET_WIDTH] * 3).tolist()
    for i in range(DEPTH):
        mod = (cond @ w_ada[i] + b_ada[i])[:, None, :]
        sh1, sc1, g1, sh2, sc2, g2 = jnp.split(mod, 6, axis=-1)
        h = _rmsnorm(x, norm1_g[i]) * (1.0 + sc1) + sh1
        q_a, k_a, v_a, u_s, q_r, k_r, v_r, g_r = jnp.split(h @ w_in[i], split_at, axis=-1)
        y_a = _chunk_band_attention(q_a.reshape(b, s, ATTN_HEADS, HEAD_DIM),
                                    k_a.reshape(b, s, ATTN_HEADS, HEAD_DIM),
                                    v_a.reshape(b, s, ATTN_HEADS, HEAD_DIM),
                                    attn_rel_bias[i])
        y_s = _s5(u_s, ssm_a_re[i], ssm_a_im[i], ssm_log_dt[i], ssm_b_re[i], ssm_b_im[i],
                  ssm_c_re[i], ssm_c_im[i], ssm_d[i], ssm_w_glu[i], ssm_b_glu[i])
        y_r = _retention(q_r.reshape(b, s, RET_HEADS, HEAD_DIM),
                         k_r.reshape(b, s, RET_HEADS, HEAD_DIM),
                         v_r.reshape(b, s, RET_HEADS, HEAD_DIM),
                         g_r, ret_gn_g[i], pos)
        mixed = jnp.concatenate([y_a.astype(x.dtype), y_s, y_r], axis=-1) @ w_out[i]
        x = x + g1 * mixed
        h = _rmsnorm(x, norm2_g[i]) * (1.0 + sc2) + sh2
        x = x + g2 * _hier_moe(h, moe_w_group[i], moe_b_group[i], moe_w_expert[i], moe_b_expert[i],
                               moe_w_gate[i], moe_w_up[i], moe_w_down[i])
    return _rmsnorm(x, final_g)
```

```cpp
#include <hip/hip_runtime.h>
#include <cstdio>
#include <cstdint>

#define GAS __attribute__((address_space(1)))
#define LAS __attribute__((address_space(3)))
typedef unsigned short bf16;
typedef short bf16x8 __attribute__((ext_vector_type(8)));
typedef float f32x4 __attribute__((ext_vector_type(4)));
typedef float f32x2 __attribute__((ext_vector_type(2)));
typedef unsigned u32x4 __attribute__((ext_vector_type(4)));
typedef unsigned u32x2 __attribute__((ext_vector_type(2)));

#ifndef MK_MULTI
#define MK_MULTI 0
#endif

constexpr int NL = 4, NB = 8, SEQ = 4096, DM = 1024, NT = NB * SEQ, NCH = 64;
constexpr int INW = 2816;
constexpr int C_QA = 0, C_KA = 512, C_VA = 1024, C_US = 1536, C_QR = 1792, C_KR = 2048, C_VR = 2304, C_GR = 2560;
constexpr int NE = 32, FF = 256;
constexpr float EPS = 1e-6f;
constexpr int NWAVES = 8, NTHR = 512;
constexpr int LDS_BYTES = 147456;

constexpr size_t al256(size_t x) { return (x + 255) & ~(size_t)255; }
constexpr size_t WS_CTL = 0, CTL_BYTES = 1u << 20;
constexpr size_t WS_WIN = CTL_BYTES;
constexpr size_t WS_WOUT = WS_WIN + (size_t)NL * INW * DM * 2;
constexpr size_t WS_WGU = WS_WOUT + (size_t)NL * DM * DM * 2;
constexpr size_t WS_WD = WS_WGU + (size_t)NL * NE * 512 * DM * 2;
constexpr size_t WS_WGLU = WS_WD + (size_t)NL * NE * DM * FF * 2;
constexpr size_t WS_WR = WS_WGLU + (size_t)NL * 256 * 256 * 2;
constexpr size_t WS_MOD = WS_WR + (size_t)NL * 36 * DM * 4;
constexpr size_t WS_ABAR = WS_MOD + (size_t)NL * NB * 6144 * 4;
constexpr size_t WS_ABAR64 = WS_ABAR + (size_t)NL * 16 * 64 * 8;
constexpr size_t WS_BBAR = WS_ABAR64 + (size_t)NL * 16 * 64 * 8;
constexpr size_t WS_ROPE = WS_BBAR + (size_t)NL * 16 * 64 * 16 * 8;
constexpr size_t WS_H = al256(WS_ROPE + (size_t)SEQ * 32 * 8);
constexpr size_t WS_QKV = WS_H + (size_t)NT * DM * 2;
constexpr size_t WS_SLOT = WS_QKV;
constexpr size_t WS_ACT = WS_QKV + (size_t)2 * NT * DM * 2;
constexpr int ACT_ROWS = 2 * NT + NE * 256;
static_assert(WS_ACT + (size_t)ACT_ROWS * FF * 2 <= WS_QKV + (size_t)NT * INW * 2, "overlay fits");
constexpr size_t WS_MIX = WS_QKV + (size_t)NT * INW * 2;
constexpr size_t WS_YG = WS_MIX + (size_t)NT * DM * 2;
constexpr size_t WS_SEND = WS_YG + (size_t)NT * 256 * 2;
constexpr size_t WS_XS = WS_SEND + (size_t)NB * NCH * 16 * 64 * 8;
constexpr size_t WS_KV = WS_XS + (size_t)NB * NCH * 16 * 64 * 8;
constexpr size_t WS_RW = WS_KV + (size_t)NB * NCH * 4 * 4096 * 4;
constexpr size_t WS_LIST = WS_RW + (size_t)NT * 2 * 4;
constexpr size_t WS_END = WS_LIST + (size_t)NE * NT * 4;
constexpr int CW_BAR = 4096;
constexpr int CW_CNT = 16384;

__device__ __forceinline__ float bf2f(unsigned v) { return __uint_as_float(v << 16); }
__device__ __forceinline__ unsigned f2bf(float f) { unsigned u = __float_as_uint(f); return (u + 0x7fffu + ((u >> 16) & 1u)) >> 16; }
__device__ __forceinline__ unsigned pk2(float lo, float hi) { return f2bf(lo) | (f2bf(hi) << 16); }
__device__ __forceinline__ float wave_sum(float v) {
#pragma unroll
    for (int o = 1; o < 64; o <<= 1) v += __shfl_xor(v, o);
    return v;
}
__device__ __forceinline__ float silu_f(float x) { return x / (1.0f + __expf(-x)); }
__device__ __forceinline__ float sigmoid_f(float x) { return 1.0f / (1.0f + __expf(-x)); }
__device__ __forceinline__ float gelu_tanh_f(float y) { const float z = 0.7978845608028654f * (y + 0.044715f * y * y * y); const float t = 1.0f - 2.0f / (__expf(2.0f * z) + 1.0f); return 0.5f * y * (1.0f + t); }
#define LDS_WAIT() asm volatile("s_waitcnt lgkmcnt(0)" ::: "memory")

#define XB_TMO      128
#define XB_XCNT(j)  (256  + 64 * (j))
#define XB_XSUB(j)  (1280 + 64 * (j))
#define XB_XGEN(j)  (2304 + 64 * (j))
#define XB_TOP      3328
#define XB_TOPGEN   3392
#define XCD_BAR_WORDS 3456
#define XB_SPIN_CAP (1u << 22)
__device__ __forceinline__ unsigned xb_ld(unsigned* p)              { return __hip_atomic_load(p, __ATOMIC_RELAXED, __HIP_MEMORY_SCOPE_AGENT); }
__device__ __forceinline__ unsigned xb_add(unsigned* p, unsigned v) { return __hip_atomic_fetch_add(p, v, __ATOMIC_RELAXED, __HIP_MEMORY_SCOPE_AGENT); }
__device__ __forceinline__ unsigned xb_xcc_id() { return (unsigned)__builtin_amdgcn_s_getreg((3 << 11) | 20) & 0xFu; }
#define XB_SPIN(cond, bar) do { unsigned _sp = 0; while (cond) { __builtin_amdgcn_s_sleep(1); \
    if ((++_sp & 255u) == 0u) { if (xb_ld(&(bar)[XB_TMO])) break; if (_sp > XB_SPIN_CAP) { atomicAdd(&(bar)[XB_TMO], 1u); break; } } } } while (0)
struct XcdBarrier { unsigned* bar; unsigned x; volatile LAS unsigned* st; };
__device__ __forceinline__ XcdBarrier xcd_barrier_post(unsigned* bar, volatile LAS unsigned* st) {
    XcdBarrier b; b.bar = bar; b.x = xb_xcc_id(); b.st = st;
    if (threadIdx.x == 0) (void)xb_add(&bar[XB_XCNT(b.x)], 1u);
    return b;
}
__device__ __forceinline__ void xcd_barrier_complete(unsigned* bar, unsigned x, unsigned& nloc, unsigned& nx) {
    const unsigned G = gridDim.x * gridDim.y * gridDim.z;
    unsigned sum, cnt, mine, sp = 0u;
    for (;;) {
        sum = 0u; cnt = 0u; mine = 0u;
#pragma unroll
        for (unsigned j = 0; j < 16; ++j) { const unsigned c = xb_ld(&bar[XB_XCNT(j)]); sum += c; cnt += (c > 0u) ? 1u : 0u; mine = (j == x) ? c : mine; }
        if (sum == G) break;
        __builtin_amdgcn_s_sleep(1);
        if ((++sp & 255u) == 0u) { if (xb_ld(&bar[XB_TMO])) break; if (sp > XB_SPIN_CAP) { atomicAdd(&bar[XB_TMO], 1u); break; } }
    }
    nloc = mine > 0u ? mine : 1u; nx = cnt > 0u ? cnt : 1u;
}
__device__ __forceinline__ void xcd_barrier(const XcdBarrier& b) {
    asm volatile("s_waitcnt vmcnt(0)" ::: "memory");
    __syncthreads();
    if (threadIdx.x == 0) {
        unsigned* bar = b.bar;
        __builtin_amdgcn_s_waitcnt(0);
        unsigned nloc = b.st[0], nx = b.st[1];
        if (nloc == 0u) { xcd_barrier_complete(bar, b.x, nloc, nx); b.st[0] = nloc; b.st[1] = nx; }
        const unsigned old = xb_add(&bar[XB_XSUB(b.x)], 1u);
        const unsigned gen = old / nloc;
        if (old + 1u == (gen + 1u) * nloc) {
            __builtin_amdgcn_fence(__ATOMIC_RELEASE, "agent");
            asm volatile("s_waitcnt vmcnt(0)" ::: "memory");
            const unsigned og = xb_add(&bar[XB_TOP], 1u);
            const unsigned tg = og / nx;
            if (og + 1u == (tg + 1u) * nx) xb_add(&bar[XB_TOPGEN], 1u);
            else XB_SPIN(xb_ld(&bar[XB_TOPGEN]) == tg, bar);
            __builtin_amdgcn_fence(__ATOMIC_ACQUIRE, "agent");
            xb_add(&bar[XB_XGEN(b.x)], 1u);
            asm volatile("s_waitcnt vmcnt(0)" ::: "memory");
        } else {
            XB_SPIN(xb_ld(&bar[XB_XGEN(b.x)]) == gen, bar);
            __builtin_amdgcn_fence(__ATOMIC_ACQUIRE, "agent");
            asm volatile("s_waitcnt vmcnt(0)" ::: "memory");
        }
    }
    __syncthreads();
}

struct Frame {
    LAS unsigned char* lds;
    LAS unsigned long long* ptab;
    int tid, lane, wave, blk, G, gw, ngw;
    float* out; unsigned char* ws;
};
#define INP(k) ((const float*)F.ptab[k])
#define F_x INP(0)
#define F_c INP(1)
#define F_norm1_g INP(2)
#define F_norm2_g INP(3)
#define F_w_ada INP(4)
#define F_b_ada INP(5)
#define F_w_in INP(6)
#define F_rel_bias INP(7)
#define F_a_re INP(8)
#define F_a_im INP(9)
#define F_log_dt INP(10)
#define F_b_re INP(11)
#define F_b_im INP(12)
#define F_c_re INP(13)
#define F_c_im INP(14)
#define F_ssm_d INP(15)
#define F_w_glu INP(16)
#define F_b_glu INP(17)
#define F_gn_g INP(18)
#define F_w_out INP(19)
#define F_w_group INP(20)
#define F_b_group INP(21)
#define F_w_expert INP(22)
#define F_b_expert INP(23)
#define F_w_gate INP(24)
#define F_w_up INP(25)
#define F_w_down INP(26)
#define F_final_g INP(27)
#define F_ctl ((unsigned*)(F.ws + WS_CTL))
#define F_WinT ((bf16*)(F.ws + WS_WIN))
#define F_WoutT ((bf16*)(F.ws + WS_WOUT))
#define F_WguT ((bf16*)(F.ws + WS_WGU))
#define F_WdT ((bf16*)(F.ws + WS_WD))
#define F_WgluT ((bf16*)(F.ws + WS_WGLU))
#define F_WrT ((float*)(F.ws + WS_WR))
#define F_MOD ((float*)(F.ws + WS_MOD))
#define F_ABAR ((f32x2*)(F.ws + WS_ABAR))
#define F_ABAR64 ((f32x2*)(F.ws + WS_ABAR64))
#define F_BBAR ((f32x2*)(F.ws + WS_BBAR))
#define F_ROPE ((f32x2*)(F.ws + WS_ROPE))
#define F_H ((bf16*)(F.ws + WS_H))
#define F_QKV ((bf16*)(F.ws + WS_QKV))
#define F_SLOT ((bf16*)(F.ws + WS_SLOT))
#define F_ACT ((bf16*)(F.ws + WS_ACT))
#define F_MIX ((bf16*)(F.ws + WS_MIX))
#define F_YG ((bf16*)(F.ws + WS_YG))
#define F_SEND ((f32x2*)(F.ws + WS_SEND))
#define F_XS ((f32x2*)(F.ws + WS_XS))
#define F_KV ((float*)(F.ws + WS_KV))
#define F_RW ((float*)(F.ws + WS_RW))
#define F_LIST ((int*)(F.ws + WS_LIST))

__device__ __forceinline__ void wave_gemm64(f32x4 (&acc)[4][4], const bf16* const (&arow)[4], const bf16* const (&brow)[4], int K) {
#pragma unroll
    for (int i = 0; i < 4; ++i)
#pragma unroll
        for (int j = 0; j < 4; ++j) acc[i][j] = (f32x4){0.f, 0.f, 0.f, 0.f};
    for (int k0 = 0; k0 < K; k0 += 32) {
        bf16x8 a[4], b[4];
#pragma unroll
        for (int i = 0; i < 4; ++i) { a[i] = *(const bf16x8*)(arow[i] + k0); b[i] = *(const bf16x8*)(brow[i] + k0); }
#pragma unroll
        for (int i = 0; i < 4; ++i)
#pragma unroll
            for (int j = 0; j < 4; ++j) acc[i][j] = __builtin_amdgcn_mfma_f32_16x16x32_bf16(b[j], a[i], acc[i][j], 0, 0, 0);
    }
}

__device__ __forceinline__ void transpose_item(const float* W, int N, int k0, int n0, bf16* dst, int ldk, LAS float* scr, int lane) {
#pragma unroll 8
    for (int i = 0; i < 32; ++i) { const int kk = 2 * i + (lane >> 5); scr[kk * 33 + (lane & 31)] = W[(size_t)(k0 + kk) * N + n0 + (lane & 31)]; }
    LDS_WAIT(); asm volatile("" ::: "memory");
    const int c = lane & 7;
#pragma unroll
    for (int j = 0; j < 4; ++j) { const int n = (lane >> 3) + 8 * j; const LAS float* s = scr + (8 * c) * 33 + n;
        u32x4 o; o.x = pk2(s[0 * 33], s[1 * 33]); o.y = pk2(s[2 * 33], s[3 * 33]); o.z = pk2(s[4 * 33], s[5 * 33]); o.w = pk2(s[6 * 33], s[7 * 33]);
        *(u32x4*)(dst + (size_t)n * ldk + k0 + 8 * c) = o; }
    LDS_WAIT(); asm volatile("" ::: "memory");
}
__device__ __forceinline__ void p0_prologue(Frame& F) {
    LAS float* scr = (LAS float*)(F.lds + F.wave * 16384);
    constexpr int I_IN = NL * 16 * 88, I_OUT = NL * 16 * 32, I_GLU = NL * 4 * 8, I_G = NL * NE * 16 * 8, I_D = NL * NE * 4 * 32;
    constexpr int NITEMS = I_IN + I_OUT + I_GLU + 2 * I_G + I_D;
    for (int it = F.gw; it < NITEMS; it += F.ngw) {
        int r = it;
        if (r < I_IN) { const int l = r / (16 * 88), q = r % (16 * 88), kb = q / 88, nb = q % 88;
            transpose_item(F_w_in + (size_t)l * DM * INW, INW, kb * 64, nb * 32, F_WinT + ((size_t)l * INW + nb * 32) * DM, DM, scr, F.lane); continue; } r -= I_IN;
        if (r < I_OUT) { const int l = r / (16 * 32), q = r % (16 * 32), kb = q / 32, nb = q % 32;
            transpose_item(F_w_out + (size_t)l * DM * DM, DM, kb * 64, nb * 32, F_WoutT + ((size_t)l * DM + nb * 32) * DM, DM, scr, F.lane); continue; } r -= I_OUT;
        if (r < I_GLU) { const int l = r / 32, q = r % 32, kb = q / 8, nb = q % 8;
            transpose_item(F_w_glu + (size_t)l * 256 * 256, 256, kb * 64, nb * 32, F_WgluT + ((size_t)l * 256 + nb * 32) * 256, 256, scr, F.lane); continue; } r -= I_GLU;
        if (r < 2 * I_G) { const int up = r >= I_G; if (up) r -= I_G; const int le = r / 128, q = r % 128, kb = q / 8, nb = q % 8; const int n0 = nb * 32;
            const int drow = (n0 >> 7) * 256 + up * 128 + (n0 & 127);
            transpose_item((up ? F_w_up : F_w_gate) + (size_t)le * DM * FF, FF, kb * 64, n0, F_WguT + ((size_t)le * 512 + drow) * DM, DM, scr, F.lane); continue; } r -= 2 * I_G;
        { const int le = r / 128, q = r % 128, kb = q / 32, nb = q % 32;
            transpose_item(F_w_down + (size_t)le * FF * DM, DM, kb * 64, nb * 32, F_WdT + ((size_t)le * DM + nb * 32) * FF, FF, scr, F.lane); }
    }
    for (int i = F.blk * NTHR + F.tid; i < NL * 36 * DM; i += F.G * NTHR) { const int l = i / (36 * DM), j = (i / DM) % 36, k = i % DM;
        F_WrT[i] = (j < 4) ? F_w_group[((size_t)l * DM + k) * 4 + j] : F_w_expert[((size_t)l * DM + k) * 32 + (j - 4)]; }
    for (int i = F.blk * NTHR + F.tid; i < NL * 16 * 64; i += F.G * NTHR) {
        const int lg = i / 64; const float are = F_a_re[i], aim = F_a_im[i], dt = __expf(F_log_dt[lg]);
        const float mag = expf(are * dt); float sn, cs; sincosf(aim * dt, &sn, &cs);
        const float abr = mag * cs, abi = mag * sn;
        F_ABAR[i] = (f32x2){abr, abi};
        const float mag64 = expf(64.f * are * dt); float sn64, cs64; sincosf(64.f * aim * dt, &sn64, &cs64);
        F_ABAR64[i] = (f32x2){mag64 * cs64, mag64 * sn64};
        const float xr = abr - 1.f, xi = abi, den = are * are + aim * aim;
        const float fr = (xr * are + xi * aim) / den, fi = (xi * are - xr * aim) / den;
#pragma unroll
        for (int cc = 0; cc < 16; ++cc) { const float br = F_b_re[(size_t)i * 16 + cc], bi = F_b_im[(size_t)i * 16 + cc];
            F_BBAR[(size_t)i * 16 + cc] = (f32x2){fr * br - fi * bi, fr * bi + fi * br}; }
    }
    for (int i = F.blk * NTHR + F.tid; i < SEQ * 32; i += F.G * NTHR) { const int pos = i >> 5, j = i & 31;
        const float inv = powf(10000.0f, -(float)j / 32.0f); const float ang = (float)pos * inv; float sn, cs; sincosf(ang, &sn, &cs); F_ROPE[i] = (f32x2){cs, sn}; }
    __syncthreads();
    {
        LAS float* cond = (LAS float*)F.lds;
        LAS float* red = (LAS float*)(F.lds + 32768);
        for (int i = F.tid; i < NB * DM; i += NTHR) cond[i] = silu_f(F_c[i]);
        __syncthreads();
        constexpr int NITM = NL * 6144 / 128;
        for (int it = F.blk; it < NITM; it += F.G) {
            const int col = it * 128 + (F.tid & 127), l = col / 6144, j = col % 6144, ks = F.tid >> 7;
            float acc[8];
#pragma unroll
            for (int b = 0; b < 8; ++b) acc[b] = 0.f;
            const float* wp = F_w_ada + (size_t)l * DM * 6144 + j;
            for (int k = ks * 256; k < ks * 256 + 256; ++k) { const float w = wp[(size_t)k * 6144];
#pragma unroll
                for (int b = 0; b < 8; ++b) acc[b] += cond[b * DM + k] * w; }
#pragma unroll
            for (int b = 0; b < 8; ++b) red[(ks * 128 + (F.tid & 127)) * 8 + b] = acc[b];
            __syncthreads();
            if (F.tid < 128) {
#pragma unroll
                for (int b = 0; b < 8; ++b) { const float s = red[(0 * 128 + F.tid) * 8 + b] + red[(1 * 128 + F.tid) * 8 + b] + red[(2 * 128 + F.tid) * 8 + b] + red[(3 * 128 + F.tid) * 8 + b];
                    F_MOD[((size_t)l * NB + b) * 6144 + j] = s + F_b_ada[(size_t)l * 6144 + j]; }
            }
            __syncthreads();
        }
    }
}

template <int MODE>
__device__ __forceinline__ void norm_phase(Frame& F, int l) {
    LAS int* l_ent = (LAS int*)F.lds;
    LAS int* l_exp = l_ent + 256;
    LAS int* l_cnt = l_exp + 256;
    LAS int* l_base = l_cnt + 32;
    LAS int* l_n = l_base + 32;
    const int rpb = NT / F.G;
    if (MODE == 1) { if (F.tid < 32) l_cnt[F.tid] = 0; if (F.tid == 0) l_n[0] = 0; __syncthreads(); }
    const int nit = (MODE == 1) ? rpb / NWAVES : (NT + F.ngw - 1) / F.ngw;
    for (int it = 0; it < nit; ++it) {
        const int row = (MODE == 1) ? F.blk * rpb + it * NWAVES + F.wave : F.gw + it * F.ngw;
        if (row >= NT) break;
        const int b = row / SEQ;
        const float* xsrc = (MODE == 0 && l == 0) ? F_x : F.out;
        const f32x4* xr = (const f32x4*)(xsrc + (size_t)row * DM) + F.lane;
        f32x4 v[4];
#pragma unroll
        for (int j = 0; j < 4; ++j) v[j] = xr[64 * j];
        if ((MODE == 0 && l > 0) || MODE == 2) {
            const int lp = (MODE == 2) ? NL - 1 : l - 1;
            const f32x4* g2 = (const f32x4*)(F_MOD + ((size_t)lp * NB + b) * 6144 + 5120) + F.lane;
            const u32x2* s0 = (const u32x2*)(F_SLOT + (size_t)row * DM) + F.lane;
            const u32x2* s1 = (const u32x2*)(F_SLOT + (size_t)NT * DM + (size_t)row * DM) + F.lane;
#pragma unroll
            for (int j = 0; j < 4; ++j) { const u32x2 a = s0[64 * j], c = s1[64 * j]; const f32x4 g = g2[64 * j];
                v[j].x += g.x * (bf2f(a.x & 0xffffu) + bf2f(c.x & 0xffffu)); v[j].y += g.y * (bf2f(a.x >> 16) + bf2f(c.x >> 16));
                v[j].z += g.z * (bf2f(a.y & 0xffffu) + bf2f(c.y & 0xffffu)); v[j].w += g.w * (bf2f(a.y >> 16) + bf2f(c.y >> 16)); }
            if (MODE == 0) { f32x4* xo = (f32x4*)(F.out + (size_t)row * DM) + F.lane;
#pragma unroll
                for (int j = 0; j < 4; ++j) xo[64 * j] = v[j]; }
        }
        float ss = 0.f;
#pragma unroll
        for (int j = 0; j < 4; ++j) ss += (v[j].x * v[j].x + v[j].y * v[j].y) + (v[j].z * v[j].z + v[j].w * v[j].w);
        const float rstd = 1.0f / sqrtf(wave_sum(ss) * (1.0f / DM) + EPS);
        if (MODE == 2) {
            const f32x4* g = (const f32x4*)F_final_g + F.lane; f32x4* xo = (f32x4*)(F.out + (size_t)row * DM) + F.lane;
#pragma unroll
            for (int j = 0; j < 4; ++j) xo[64 * j] = v[j] * rstd * g[64 * j];
            continue;
        }
        const f32x4* g = (const f32x4*)((MODE == 0 ? F_norm1_g : F_norm2_g) + (size_t)l * DM) + F.lane;
        const float* modb = F_MOD + ((size_t)l * NB + b) * 6144 + (MODE == 0 ? 0 : 3072);
        const f32x4* sh = (const f32x4*)modb + F.lane; const f32x4* sc = (const f32x4*)(modb + 1024) + F.lane;
        u32x2* ho = (u32x2*)(F_H + (size_t)row * DM) + F.lane;
#pragma unroll
        for (int j = 0; j < 4; ++j) { v[j] = v[j] * rstd * g[64 * j] * (sc[64 * j] + 1.0f) + sh[64 * j]; u32x2 o; o.x = pk2(v[j].x, v[j].y); o.y = pk2(v[j].z, v[j].w); ho[64 * j] = o; }
        if (MODE == 1) {
            LAS float* wl = (LAS float*)(F.lds + 4096 + F.wave * 256);
            const f32x4* wr = (const f32x4*)(F_WrT + (size_t)l * 36 * DM) + F.lane;
#pragma unroll 2
            for (int c = 0; c < 36; ++c) { float p = 0.f;
#pragma unroll
                for (int j = 0; j < 4; ++j) { const f32x4 w = wr[c * 256 + 64 * j]; p += (v[j].x * w.x + v[j].y * w.y) + (v[j].z * w.z + v[j].w * w.w); }
                p = wave_sum(p); if (F.lane == 0) wl[c] = p; }
            LDS_WAIT(); __builtin_amdgcn_wave_barrier();
            float gl[4];
#pragma unroll
            for (int j = 0; j < 4; ++j) gl[j] = wl[j] + F_b_group[l * 4 + j];
            int gi = 0; float gm = gl[0];
#pragma unroll
            for (int j = 1; j < 4; ++j) if (gl[j] > gm) { gm = gl[j]; gi = j; }
            float gs = 0.f;
#pragma unroll
            for (int j = 0; j < 4; ++j) gs += __expf(gl[j] - gm);
            const float gw = 1.0f / gs;
            float ig[8];
#pragma unroll
            for (int j = 0; j < 8; ++j) ig[j] = wl[4 + gi * 8 + j] + F_b_expert[l * 32 + gi * 8 + j];
            __builtin_amdgcn_wave_barrier();
            int i0 = 0; float v0 = ig[0];
#pragma unroll
            for (int j = 1; j < 8; ++j) if (ig[j] > v0) { v0 = ig[j]; i0 = j; }
            int i1 = -1; float v1 = -3.0e38f;
#pragma unroll
            for (int j = 0; j < 8; ++j) if (j != i0 && ig[j] > v1) { v1 = ig[j]; i1 = j; }
            const float e1x = __expf(v1 - v0), w0 = gw / (1.0f + e1x), w1 = gw * e1x / (1.0f + e1x);
            if (F.lane == 0) { F_RW[(size_t)row * 2] = w0; F_RW[(size_t)row * 2 + 1] = w1;
                const int lr = it * NWAVES + F.wave; l_ent[lr * 2] = row * 2; l_ent[lr * 2 + 1] = row * 2 + 1; l_exp[lr * 2] = gi * 8 + i0; l_exp[lr * 2 + 1] = gi * 8 + i1; }
        }
    }
    if (MODE == 1) {
        __syncthreads();
        const int npair = 2 * rpb; int rank = 0, e = 0;
        if (F.tid < npair) { e = l_exp[F.tid]; rank = atomicAdd((int*)&l_cnt[e], 1); }
        __syncthreads();
        if (F.tid < 32) l_base[F.tid] = (int)atomicAdd(F_ctl + CW_CNT + l * 32 + F.tid, (unsigned)l_cnt[F.tid]);
        __syncthreads();
        if (F.tid < npair) F_LIST[(size_t)e * NT + l_base[e] + rank] = l_ent[F.tid];
        __syncthreads();
    }
}

template <int EPI>
__device__ __forceinline__ void gemm_simple(Frame& F, int l, const bf16* A, int lda, const bf16* Bt, int N, int K) {
    const int fr = F.lane & 15, fq = F.lane >> 4, wm = F.wave >> 1, wn = F.wave & 1;
    const int nnt = N / 128, nu = (NT / 256) * nnt;
    for (int u = F.blk; u < nu; u += F.G) {
        const int pm = u / nnt, pn = u % nnt, m0 = pm * 256 + wm * 64, n0 = pn * 128 + wn * 64;
        const bf16* arow[4]; const bf16* brow[4];
#pragma unroll
        for (int i = 0; i < 4; ++i) { arow[i] = A + (size_t)(m0 + i * 16 + fr) * lda + fq * 8; brow[i] = Bt + (size_t)(n0 + i * 16 + fr) * K + fq * 8; }
        f32x4 acc[4][4];
        wave_gemm64(acc, arow, brow, K);
#pragma unroll
        for (int i = 0; i < 4; ++i) { const int row = m0 + i * 16 + fr;
#pragma unroll
            for (int j = 0; j < 4; ++j) { const int col = n0 + j * 16 + 4 * fq; const f32x4 a = acc[i][j];
                if (EPI == 0) { u32x2 o; o.x = pk2(a.x, a.y); o.y = pk2(a.z, a.w); *(u32x2*)(F_QKV + (size_t)row * INW + col) = o; }
                if (EPI == 1) { const float* xb = (l == 0 ? F_x : F.out); const f32x4 xv = *(const f32x4*)(xb + (size_t)row * DM + col);
                    const f32x4 g1 = *(const f32x4*)(F_MOD + ((size_t)l * NB + row / SEQ) * 6144 + 2048 + col); *(f32x4*)(F.out + (size_t)row * DM + col) = xv + g1 * a; }
                if (EPI == 2) { const u32x2 y = *(const u32x2*)(F_YG + (size_t)row * 256 + col); const f32x4 bg = *(const f32x4*)(F_b_glu + l * 256 + col);
                    const float y0 = bf2f(y.x & 0xffffu), y1 = bf2f(y.x >> 16), y2 = bf2f(y.y & 0xffffu), y3 = bf2f(y.y >> 16);
                    u32x2 o; o.x = pk2(y0 * sigmoid_f(a.x + bg.x), y1 * sigmoid_f(a.y + bg.y)); o.y = pk2(y2 * sigmoid_f(a.z + bg.z), y3 * sigmoid_f(a.w + bg.w));
                    *(u32x2*)(F_MIX + (size_t)row * DM + 512 + col) = o; }
            } }
    }
}

__device__ __forceinline__ void moe_tables(Frame& F, int l) {
    LAS int* t_cnt = (LAS int*)F.lds; LAS int* t_toff = t_cnt + 32; LAS int* t_aoff = t_toff + 34;
    __syncthreads();
    if (F.tid == 0) { int to = 0, ao = 0;
        for (int e = 0; e < NE; ++e) { const int c = (int)__hip_atomic_load(F_ctl + CW_CNT + l * 32 + e, __ATOMIC_RELAXED, __HIP_MEMORY_SCOPE_AGENT); t_cnt[e] = c; t_toff[e] = to; t_aoff[e] = ao; to += (c + 63) >> 6; ao += ((c + 255) >> 8) << 8; }
        t_toff[NE] = to; }
    __syncthreads();
}
template <int STAGE>
__device__ __forceinline__ void moe_simple(Frame& F, int l) {
    LAS int* t_cnt = (LAS int*)F.lds; LAS int* t_toff = t_cnt + 32; LAS int* t_aoff = t_toff + 34;
    moe_tables(F, l);
    const int fr = F.lane & 15, fq = F.lane >> 4;
    constexpr int NSUB = (STAGE == 1) ? 8 : 16;
    const int ntask = t_toff[NE] * NSUB;
    for (int task = F.gw; task < ntask; task += F.ngw) {
        const int rtg = task / NSUB, sub = task % NSUB;
        int e = 0;
        for (int q = 1; q < NE; ++q) if (t_toff[q] <= rtg) e = q;
        const int rt = rtg - t_toff[e], cnt = t_cnt[e], arow0 = t_aoff[e] + rt * 64;
        int ent[4];
#pragma unroll
        for (int i = 0; i < 4; ++i) { const int pos = rt * 64 + i * 16 + fr; ent[i] = pos < cnt ? F_LIST[(size_t)e * NT + pos] : -1; }
        const bf16* arow[4]; const bf16* brow[4];
        f32x4 acc[4][4];
        if (STAGE == 1) {
            const bf16* wb = F_WguT + (size_t)(l * NE + e) * 512 * DM;
#pragma unroll
            for (int i = 0; i < 4; ++i) { const int tok = ent[i] >= 0 ? (ent[i] >> 1) : 0; arow[i] = F_H + (size_t)tok * DM + fq * 8;
                const int f = sub * 32 + (i & 1) * 16 + fr; const int br = (f >> 7) * 256 + (i >> 1) * 128 + (f & 127); brow[i] = wb + (size_t)br * DM + fq * 8; }
            wave_gemm64(acc, arow, brow, DM);
#pragma unroll
            for (int i = 0; i < 4; ++i) { const float w = ent[i] >= 0 ? F_RW[ent[i]] : 0.f;
#pragma unroll
                for (int j = 0; j < 2; ++j) { const f32x4 g = acc[i][j], u = acc[i][j + 2];
                    u32x2 o; o.x = pk2(silu_f(g.x) * u.x * w, silu_f(g.y) * u.y * w); o.y = pk2(silu_f(g.z) * u.z * w, silu_f(g.w) * u.w * w);
                    *(u32x2*)(F_ACT + (size_t)(arow0 + i * 16 + fr) * FF + sub * 32 + j * 16 + 4 * fq) = o; } }
        } else {
            const bf16* wb = F_WdT + (size_t)(l * NE + e) * DM * FF;
#pragma unroll
            for (int i = 0; i < 4; ++i) { arow[i] = F_ACT + (size_t)(arow0 + i * 16 + fr) * FF + fq * 8; brow[i] = wb + (size_t)(sub * 64 + i * 16 + fr) * FF + fq * 8; }
            wave_gemm64(acc, arow, brow, FF);
#pragma unroll
            for (int i = 0; i < 4; ++i) { if (ent[i] >= 0) { bf16* orow = F_SLOT + (size_t)(ent[i] & 1) * NT * DM + (size_t)(ent[i] >> 1) * DM + sub * 64 + 4 * fq;
#pragma unroll
                for (int j = 0; j < 4; ++j) { const f32x4 a = acc[i][j]; u32x2 o; o.x = pk2(a.x, a.y); o.y = pk2(a.z, a.w); *(u32x2*)(orow + j * 16) = o; } } }
        }
    }
}

__device__ __forceinline__ float ret_log2gamma(int h) { return log2f(1.0f - exp2f(-5.0f - (float)h)); }

__device__ __forceinline__ void p3_local(Frame& F, int l) {
    {
        LAS float* ks = (LAS float*)F.lds;
        LAS float* vs = ks + 64 * 65;
        for (int u = F.blk; u < NB * NCH * 4; u += F.G) {
            const int h = u & 3, n = (u >> 2) & 63, b = u >> 8; const float lg = ret_log2gamma(h);
            const size_t row0 = (size_t)b * SEQ + n * 64;
            __syncthreads();
#pragma unroll
            for (int q = 0; q < 4; ++q) { const int idx = F.tid + q * NTHR, j = idx >> 5, d = idx & 31;
                const bf16* kp = F_QKV + (row0 + j) * INW + C_KR + h * 64; const float k1 = bf2f(kp[d]), k2 = bf2f(kp[d + 32]);
                const f32x2 cs = F_ROPE[(n * 64 + j) * 32 + d]; const float z = 0.125f * exp2f(lg * (float)(63 - j));
                ks[j * 65 + d] = (k1 * cs.x - k2 * cs.y) * z; ks[j * 65 + d + 32] = (k1 * cs.y + k2 * cs.x) * z; }
#pragma unroll
            for (int q = 0; q < 8; ++q) { const int idx = F.tid + q * NTHR, j = idx >> 6, e = idx & 63; vs[j * 65 + e] = bf2f(F_QKV[(row0 + j) * INW + C_VR + h * 64 + e]); }
            __syncthreads();
            const int d = F.tid >> 3, e0 = (F.tid & 7) * 8; float acc[8];
#pragma unroll
            for (int q = 0; q < 8; ++q) acc[q] = 0.f;
            for (int j = 0; j < 64; ++j) { const float kd = ks[j * 65 + d];
#pragma unroll
                for (int q = 0; q < 8; ++q) acc[q] += kd * vs[j * 65 + e0 + q]; }
            float* o = F_KV + ((size_t)((b * NCH + n) * 4 + h)) * 4096 + d * 64 + e0;
#pragma unroll
            for (int q = 0; q < 8; ++q) o[q] = acc[q];
        }
        __syncthreads();
    }
    for (int u = F.gw; u < NB * NCH * 16; u += F.ngw) {
        const int g = u & 15, n = (u >> 4) & 63, b = u >> 10, p = F.lane;
        const f32x2 ab = F_ABAR[(l * 16 + g) * 64 + p]; f32x2 bb[16];
#pragma unroll
        for (int c = 0; c < 16; ++c) bb[c] = F_BBAR[((size_t)(l * 16 + g) * 64 + p) * 16 + c];
        float xr = 0.f, xi = 0.f;
        const bf16* up = F_QKV + ((size_t)b * SEQ + n * 64) * INW + C_US + g * 16;
        for (int s = 0; s < 64; ++s) { const u32x4 a = *(const u32x4*)(up + (size_t)s * INW), c4 = *(const u32x4*)(up + (size_t)s * INW + 8);
            const unsigned w[8] = {a.x, a.y, a.z, a.w, c4.x, c4.y, c4.z, c4.w}; float br = 0.f, bi = 0.f;
#pragma unroll
            for (int q = 0; q < 8; ++q) { const float u0 = bf2f(w[q] & 0xffffu), u1 = bf2f(w[q] >> 16); br += bb[2 * q].x * u0 + bb[2 * q + 1].x * u1; bi += bb[2 * q].y * u0 + bb[2 * q + 1].y * u1; }
            const float nr = ab.x * xr - ab.y * xi + br, ni = ab.x * xi + ab.y * xr + bi; xr = nr; xi = ni; }
        F_SEND[(size_t)u * 64 + p] = (f32x2){xr, xi};
    }
}

__device__ __forceinline__ void p4_scan_attn(Frame& F, int l) {
    for (int i = F.blk * NTHR + F.tid; i < NB * 16 * 64; i += F.G * NTHR) { const int b = i >> 10, gp = i & 1023; const f32x2 a64 = F_ABAR64[l * 1024 + gp];
        float xr = 0.f, xi = 0.f;
        for (int n = 0; n < NCH; ++n) { const size_t idx = ((size_t)(b * NCH + n)) * 1024 + gp; F_XS[idx] = (f32x2){xr, xi}; const f32x2 s = F_SEND[idx];
            const float nr = a64.x * xr - a64.y * xi + s.x, ni = a64.x * xi + a64.y * xr + s.y; xr = nr; xi = ni; } }
    for (int i = F.blk * NTHR + F.tid; i < NB * 4 * 4096; i += F.G * NTHR) { const int b = i >> 14, h = (i >> 12) & 3, de = i & 4095; const float g64 = exp2f(64.f * ret_log2gamma(h));
        float s = 0.f;
        for (int n = 0; n < NCH; ++n) { float* p = F_KV + ((size_t)((b * NCH + n) * 4 + h)) * 4096 + de; const float t = *p; *p = s; s = g64 * s + t; } }
    for (int u = F.gw; u < NB * NCH * 8; u += F.ngw) {
        const int h = u & 7, n = (u >> 3) & 63, b = u >> 9, qi = F.lane;
        const size_t qrow = (size_t)b * SEQ + n * 64 + qi;
        float q[64], o[64];
        { const u32x4* qp = (const u32x4*)(F_QKV + qrow * INW + C_QA + h * 64);
#pragma unroll
            for (int c = 0; c < 8; ++c) { const u32x4 w = qp[c]; q[8 * c] = 0.125f * bf2f(w.x & 0xffffu); q[8 * c + 1] = 0.125f * bf2f(w.x >> 16); q[8 * c + 2] = 0.125f * bf2f(w.y & 0xffffu); q[8 * c + 3] = 0.125f * bf2f(w.y >> 16);
                q[8 * c + 4] = 0.125f * bf2f(w.z & 0xffffu); q[8 * c + 5] = 0.125f * bf2f(w.z >> 16); q[8 * c + 6] = 0.125f * bf2f(w.w & 0xffffu); q[8 * c + 7] = 0.125f * bf2f(w.w >> 16); } }
#pragma unroll
        for (int d = 0; d < 64; ++d) o[d] = 0.f;
        float m = -1.0e30f, ls = 0.f;
        const float* bias = F_rel_bias + (size_t)(l * 8 + h) * 192;
        const int kc0 = n >= 8 ? n - 8 : 0;
        for (int kk = kc0 * 64; kk < (n + 1) * 64; ++kk) {
            const bf16* kr = F_QKV + ((size_t)b * SEQ + kk) * INW + C_KA + h * 64;
            float dot = 0.f;
#pragma unroll
            for (int c = 0; c < 8; ++c) { const u32x4 w = ((const u32x4*)kr)[c];
                dot += q[8 * c] * bf2f(w.x & 0xffffu) + q[8 * c + 1] * bf2f(w.x >> 16) + q[8 * c + 2] * bf2f(w.y & 0xffffu) + q[8 * c + 3] * bf2f(w.y >> 16)
                     + q[8 * c + 4] * bf2f(w.z & 0xffffu) + q[8 * c + 5] * bf2f(w.z >> 16) + q[8 * c + 6] * bf2f(w.w & 0xffffu) + q[8 * c + 7] * bf2f(w.w >> 16); }
            int rel = kk - (n * 64 + qi); rel = rel < -128 ? -128 : (rel > 63 ? 63 : rel);
            const float s = dot + bias[rel + 128];
            if (s > m) { const float sc = __expf(m - s); ls *= sc;
#pragma unroll
                for (int d = 0; d < 64; ++d) o[d] *= sc;
                m = s; }
            const float p = __expf(s - m); ls += p;
            const bf16* vr = F_QKV + ((size_t)b * SEQ + kk) * INW + C_VA + h * 64;
#pragma unroll
            for (int c = 0; c < 8; ++c) { const u32x4 w = ((const u32x4*)vr)[c];
                o[8 * c] += p * bf2f(w.x & 0xffffu); o[8 * c + 1] += p * bf2f(w.x >> 16); o[8 * c + 2] += p * bf2f(w.y & 0xffffu); o[8 * c + 3] += p * bf2f(w.y >> 16);
                o[8 * c + 4] += p * bf2f(w.z & 0xffffu); o[8 * c + 5] += p * bf2f(w.z >> 16); o[8 * c + 6] += p * bf2f(w.w & 0xffffu); o[8 * c + 7] += p * bf2f(w.w >> 16); }
        }
        const float inv = 1.0f / ls;
        u32x4* op = (u32x4*)(F_MIX + qrow * DM + h * 64);
#pragma unroll
        for (int c = 0; c < 8; ++c) { u32x4 w; w.x = pk2(o[8 * c] * inv, o[8 * c + 1] * inv); w.y = pk2(o[8 * c + 2] * inv, o[8 * c + 3] * inv); w.z = pk2(o[8 * c + 4] * inv, o[8 * c + 5] * inv); w.w = pk2(o[8 * c + 6] * inv, o[8 * c + 7] * inv); op[c] = w; }
    }
}

__device__ __forceinline__ void p5_out(Frame& F, int l) {
    {
        LAS float* qs = (LAS float*)F.lds;
        LAS float* ks = qs + 64 * 65;
        LAS float* vs = ks + 64 * 65;
        LAS float* ps = vs + 64 * 65;
        LAS float* pp = ps + 64 * 65;
        for (int u = F.blk; u < NB * NCH * 4; u += F.G) {
            const int h = u & 3, n = (u >> 2) & 63, b = u >> 8; const float lg = ret_log2gamma(h);
            const size_t row0 = (size_t)b * SEQ + n * 64;
            __syncthreads();
#pragma unroll
            for (int q = 0; q < 4; ++q) { const int idx = F.tid + q * NTHR, j = idx >> 5, d = idx & 31; const f32x2 cs = F_ROPE[(n * 64 + j) * 32 + d];
                const bf16* kp = F_QKV + (row0 + j) * INW + C_KR + h * 64; const float k1 = bf2f(kp[d]), k2 = bf2f(kp[d + 32]);
                ks[j * 65 + d] = (k1 * cs.x - k2 * cs.y) * 0.125f; ks[j * 65 + d + 32] = (k1 * cs.y + k2 * cs.x) * 0.125f;
                const bf16* qp = F_QKV + (row0 + j) * INW + C_QR + h * 64; const float q1 = bf2f(qp[d]), q2 = bf2f(qp[d + 32]);
                qs[j * 65 + d] = q1 * cs.x - q2 * cs.y; qs[j * 65 + d + 32] = q1 * cs.y + q2 * cs.x; }
            const float* prev = F_KV + ((size_t)((b * NCH + n) * 4 + h)) * 4096;
#pragma unroll
            for (int q = 0; q < 8; ++q) { const int idx = F.tid + q * NTHR, j = idx >> 6, e = idx & 63; vs[j * 65 + e] = bf2f(F_QKV[(row0 + j) * INW + C_VR + h * 64 + e]); ps[j * 65 + e] = prev[idx]; }
            __syncthreads();
            const int i = F.tid >> 3, c0 = (F.tid & 7) * 8;
            { float acc[8];
#pragma unroll
                for (int q = 0; q < 8; ++q) acc[q] = 0.f;
                for (int d = 0; d < 64; ++d) { const float qd = qs[i * 65 + d];
#pragma unroll
                    for (int q = 0; q < 8; ++q) acc[q] += qd * ks[(c0 + q) * 65 + d]; }
#pragma unroll
                for (int q = 0; q < 8; ++q) { const int j = c0 + q; pp[i * 65 + j] = (i >= j) ? acc[q] * exp2f(lg * (float)(i - j)) : 0.f; } }
            __syncthreads();
            float y[8], cr[8];
#pragma unroll
            for (int q = 0; q < 8; ++q) { y[q] = 0.f; cr[q] = 0.f; }
            for (int j = 0; j < 64; ++j) { const float pj = pp[i * 65 + j], qd = qs[i * 65 + j];
#pragma unroll
                for (int q = 0; q < 8; ++q) { y[q] += pj * vs[j * 65 + c0 + q]; cr[q] += qd * ps[j * 65 + c0 + q]; } }
            const float xi = exp2f(lg * (float)(i + 1)); float s = 0.f;
#pragma unroll
            for (int q = 0; q < 8; ++q) { y[q] += xi * cr[q]; s += y[q]; }
            s += __shfl_xor(s, 1); s += __shfl_xor(s, 2); s += __shfl_xor(s, 4);
            const float mu = s * (1.0f / 64.0f); float vq = 0.f;
#pragma unroll
            for (int q = 0; q < 8; ++q) { y[q] -= mu; vq += y[q] * y[q]; }
            vq += __shfl_xor(vq, 1); vq += __shfl_xor(vq, 2); vq += __shfl_xor(vq, 4);
            const float rstd = 1.0f / sqrtf(vq * (1.0f / 64.0f) + EPS);
            const bf16* gp = F_QKV + (row0 + i) * INW + C_GR + h * 64 + c0; const u32x4 gw = *(const u32x4*)gp;
            const float gt[8] = {bf2f(gw.x & 0xffffu), bf2f(gw.x >> 16), bf2f(gw.y & 0xffffu), bf2f(gw.y >> 16), bf2f(gw.z & 0xffffu), bf2f(gw.z >> 16), bf2f(gw.w & 0xffffu), bf2f(gw.w >> 16)};
            float r[8];
#pragma unroll
            for (int q = 0; q < 8; ++q) r[q] = silu_f(gt[q]) * (y[q] * rstd * F_gn_g[l * 256 + h * 64 + c0 + q]);
            u32x4 w; w.x = pk2(r[0], r[1]); w.y = pk2(r[2], r[3]); w.z = pk2(r[4], r[5]); w.w = pk2(r[6], r[7]);
            *(u32x4*)(F_MIX + (row0 + i) * DM + 768 + h * 64 + c0) = w;
        }
        __syncthreads();
    }
    {
        LAS f32x2* xs = (LAS f32x2*)(F.lds + F.wave * 16640);
        for (int u = F.gw; u < NB * NCH * 16; u += F.ngw) {
            const int g = u & 15, n = (u >> 4) & 63, b = u >> 10, p = F.lane;
            const f32x2 ab = F_ABAR[(l * 16 + g) * 64 + p]; f32x2 bb[16];
#pragma unroll
            for (int c = 0; c < 16; ++c) bb[c] = F_BBAR[((size_t)(l * 16 + g) * 64 + p) * 16 + c];
            const f32x2 x0 = F_XS[(size_t)u * 64 + p]; float xr = x0.x, xi = x0.y;
            const bf16* up = F_QKV + ((size_t)b * SEQ + n * 64) * INW + C_US + g * 16;
            for (int half = 0; half < 2; ++half) {
                for (int t = 0; t < 32; ++t) { const int s = half * 32 + t;
                    const u32x4 a = *(const u32x4*)(up + (size_t)s * INW), c4 = *(const u32x4*)(up + (size_t)s * INW + 8);
                    const unsigned w[8] = {a.x, a.y, a.z, a.w, c4.x, c4.y, c4.z, c4.w}; float br = 0.f, bi = 0.f;
#pragma unroll
                    for (int q = 0; q < 8; ++q) { const float u0 = bf2f(w[q] & 0xffffu), u1 = bf2f(w[q] >> 16); br += bb[2 * q].x * u0 + bb[2 * q + 1].x * u1; bi += bb[2 * q].y * u0 + bb[2 * q + 1].y * u1; }
                    const float nr = ab.x * xr - ab.y * xi + br, ni = ab.x * xi + ab.y * xr + bi; xr = nr; xi = ni;
                    xs[t * 65 + p] = (f32x2){xr, xi}; }
                LDS_WAIT(); __builtin_amdgcn_wave_barrier();
                const int t = F.lane >> 1, c0 = (F.lane & 1) * 8, s = half * 32 + t;
                float y[8];
#pragma unroll
                for (int q = 0; q < 8; ++q) y[q] = 0.f;
                const float* cre = F_c_re + ((size_t)(l * 16 + g) * 16 + c0) * 64; const float* cim = F_c_im + ((size_t)(l * 16 + g) * 16 + c0) * 64;
                for (int pp = 0; pp < 64; ++pp) { const f32x2 xv = xs[t * 65 + pp];
#pragma unroll
                    for (int q = 0; q < 8; ++q) y[q] += cre[q * 64 + pp] * xv.x - cim[q * 64 + pp] * xv.y; }
                const u32x4 uw = *(const u32x4*)(up + (size_t)s * INW + c0);
                const float uu[8] = {bf2f(uw.x & 0xffffu), bf2f(uw.x >> 16), bf2f(uw.y & 0xffffu), bf2f(uw.y >> 16), bf2f(uw.z & 0xffffu), bf2f(uw.z >> 16), bf2f(uw.w & 0xffffu), bf2f(uw.w >> 16)};
                float r[8];
#pragma unroll
                for (int q = 0; q < 8; ++q) r[q] = gelu_tanh_f(y[q] + F_ssm_d[l * 256 + g * 16 + c0 + q] * uu[q]);
                u32x4 w; w.x = pk2(r[0], r[1]); w.y = pk2(r[2], r[3]); w.z = pk2(r[4], r[5]); w.w = pk2(r[6], r[7]);
                *(u32x4*)(F_YG + ((size_t)b * SEQ + n * 64 + s) * 256 + g * 16 + c0) = w;
                LDS_WAIT(); __builtin_amdgcn_wave_barrier();
            }
        }
    }
}

struct Args { const float* in[28]; float* out; unsigned char* ws; int ph_lo, ph_hi; };
constexpr int NPHASE = 2 + NL * 10;

__global__ void __launch_bounds__(NTHR, 2) fwd_kernel(Args args) {
    extern __shared__ __attribute__((aligned(16))) unsigned char lds[];
    Frame F;
    F.lds = (LAS unsigned char*)lds;
    F.tid = threadIdx.x; F.lane = F.tid & 63; F.wave = __builtin_amdgcn_readfirstlane(F.tid >> 6); F.blk = blockIdx.x; F.G = gridDim.x;
    F.gw = F.blk * NWAVES + F.wave; F.ngw = F.G * NWAVES;
    F.out = args.out; F.ws = args.ws;
    F.ptab = (LAS unsigned long long*)(F.lds + LDS_BYTES - 64 - 256);
    if (F.tid == 0) {
#pragma unroll
        for (int i = 0; i < 28; ++i) F.ptab[i] = (unsigned long long)args.in[i];
    }
    LAS unsigned* misc = (LAS unsigned*)(F.lds + LDS_BYTES - 64);
    if (F.tid < 16) misc[F.tid] = 0u;
    __syncthreads();
    const int lo = args.ph_lo, hi = args.ph_hi;
    XcdBarrier bar; bar.bar = F_ctl + CW_BAR; bar.x = 0; bar.st = nullptr;
    if (hi - lo > 1) bar = xcd_barrier_post(F_ctl + CW_BAR, (volatile LAS unsigned*)misc);
#ifndef PH_ONLY
#define PH_ONLY -1
#endif
#define PSEL(j) (PH_ONLY < 0 || PH_ONLY == (j))
#define IN(k) (lo <= (k) && (k) < hi)
#define SEAM(k) do { if (IN(k) && IN((k) + 1)) xcd_barrier(bar); asm volatile("" : "+v"(F.tid), "+v"(F.lane)); } while (0)

    if (IN(0) && PSEL(10)) { p0_prologue(F); } SEAM(0);
    for (int l = 0; l < NL; ++l) {
        const int p = 1 + 10 * l;
        if (IN(p + 0) && PSEL(0)) { norm_phase<0>(F, l); } SEAM(p + 0);
        if (IN(p + 1) && PSEL(1)) { gemm_simple<0>(F, l, F_H, DM, F_WinT + (size_t)l * INW * DM, INW, DM); } SEAM(p + 1);
        if (IN(p + 2) && PSEL(2)) { p3_local(F, l); } SEAM(p + 2);
        if (IN(p + 3) && PSEL(3)) { p4_scan_attn(F, l); } SEAM(p + 3);
        if (IN(p + 4) && PSEL(4)) { p5_out(F, l); } SEAM(p + 4);
        if (IN(p + 5) && PSEL(5)) { gemm_simple<2>(F, l, F_YG, 256, F_WgluT + (size_t)l * 256 * 256, 256, 256); } SEAM(p + 5);
        if (IN(p + 6) && PSEL(6)) { gemm_simple<1>(F, l, F_MIX, DM, F_WoutT + (size_t)l * DM * DM, DM, DM); } SEAM(p + 6);
        if (IN(p + 7) && PSEL(7)) { norm_phase<1>(F, l); } SEAM(p + 7);
        if (IN(p + 8) && PSEL(8)) { moe_simple<1>(F, l); } SEAM(p + 8);
        if (IN(p + 9) && PSEL(9)) { moe_simple<2>(F, l); } SEAM(p + 9);
    }
    if (IN(NPHASE - 1) && PSEL(11)) { norm_phase<2>(F, 0); }
#undef IN
#undef SEAM
}

extern "C" void kernel_launch(void* const* d_in, const int* in_sizes, int n_in, void* d_out, int out_size, void* d_ws, size_t ws_size, hipStream_t stream) {
    static int grid = 0;
    if (grid == 0) {
        if (n_in != 28 || in_sizes[0] != NT * DM || out_size != NT * DM || ws_size < WS_END) { fprintf(stderr, "kernel_launch: unexpected shapes / workspace (%d inputs, ws %zu < %zu)\n", n_in, ws_size, (size_t)WS_END); grid = -1; return; }
        int dev = 0, cus = 0;
        if (hipGetDevice(&dev) != hipSuccess || hipDeviceGetAttribute(&cus, hipDeviceAttributeMultiprocessorCount, dev) != hipSuccess) { grid = -1; return; }
        if (hipFuncSetAttribute((const void*)fwd_kernel, hipFuncAttributeMaxDynamicSharedMemorySize, LDS_BYTES) != hipSuccess) { fprintf(stderr, "kernel_launch: hipFuncSetAttribute failed\n"); grid = -1; return; }
        int per_cu = 0;
        if (hipOccupancyMaxActiveBlocksPerMultiprocessor(&per_cu, (const void*)fwd_kernel, NTHR, LDS_BYTES) != hipSuccess || per_cu < 1) { fprintf(stderr, "kernel_launch: occupancy query says %d\n", per_cu); }
        (void)hipGetLastError();
        grid = 256;
        if (cus < 256) { fprintf(stderr, "kernel_launch: device has %d CUs, need 256\n", cus); grid = -1; return; }
    }
    if (grid < 0) return;
    (void)hipMemsetAsync((char*)d_ws + WS_CTL, 0, CTL_BYTES, stream);
    Args a{};
    for (int i = 0; i < 28; ++i) a.in[i] = (const float*)d_in[i];
    a.out = (float*)d_out; a.ws = (unsigned char*)d_ws;
#if MK_MULTI
    for (int ph = 0; ph < NPHASE; ++ph) { a.ph_lo = ph; a.ph_hi = ph + 1; hipLaunchKernelGGL(fwd_kernel, dim3(grid), dim3(NTHR), LDS_BYTES, stream, a); }
#else
    a.ph_lo = 0; a.ph_hi = NPHASE; hipLaunchKernelGGL(fwd_kernel, dim3(grid), dim3(NTHR), LDS_BYTES, stream, a);
#endif
}
```

```cpp
#include <hip/hip_runtime.h>
#include <cstdio>
#include <cstdint>

#define GAS __attribute__((address_space(1)))
#define LAS __attribute__((address_space(3)))
typedef unsigned short bf16;
typedef short bf16x8 __attribute__((ext_vector_type(8)));
typedef float f32x4 __attribute__((ext_vector_type(4)));
typedef float f32x2 __attribute__((ext_vector_type(2)));
typedef unsigned u32x4 __attribute__((ext_vector_type(4)));
typedef unsigned u32x2 __attribute__((ext_vector_type(2)));

#ifndef MK_MULTI
#define MK_MULTI 0
#endif

#ifndef ATTN_NQT
#define ATTN_NQT 2
#endif

constexpr int NL = 4, NB = 8, SEQ = 4096, DM = 1024, NT = NB * SEQ, NCH = 64;
constexpr int INW = 2816;
constexpr int C_QA = 0, C_KA = 512, C_VA = 1024, C_US = 1536, C_QR = 1792, C_KR = 2048, C_VR = 2304, C_GR = 2560;
constexpr int NE = 32, FF = 256;
constexpr float EPS = 1e-6f;
constexpr int NWAVES = 8, NTHR = 512;
constexpr int LDS_BYTES = 147456;

constexpr size_t al256(size_t x) { return (x + 255) & ~(size_t)255; }
constexpr size_t WS_CTL = 0, CTL_BYTES = 1u << 20;
constexpr size_t WS_WIN = CTL_BYTES;
constexpr size_t WS_WOUT = WS_WIN + (size_t)NL * INW * DM * 2;
constexpr size_t WS_WGU = WS_WOUT + (size_t)NL * DM * DM * 2;
constexpr size_t WS_WD = WS_WGU + (size_t)NL * NE * 512 * DM * 2;
constexpr size_t WS_WGLU = WS_WD + (size_t)NL * NE * DM * FF * 2;
constexpr size_t WS_WR = WS_WGLU + (size_t)NL * 256 * 256 * 2;
constexpr size_t WS_MOD = WS_WR + (size_t)NL * 36 * DM * 4;
constexpr size_t WS_ABAR = WS_MOD + (size_t)NL * NB * 6144 * 4;
constexpr size_t WS_ABAR64 = WS_ABAR + (size_t)NL * 16 * 64 * 8;
constexpr size_t WS_BBAR = WS_ABAR64 + (size_t)NL * 16 * 64 * 8;
constexpr size_t WS_ROPE = WS_BBAR + (size_t)NL * 16 * 64 * 16 * 8;
constexpr size_t WS_H = al256(WS_ROPE + (size_t)SEQ * 32 * 8);
constexpr size_t WS_QKV = WS_H + (size_t)NT * DM * 2;
constexpr size_t WS_SLOT = WS_QKV;
constexpr size_t WS_ACT = WS_QKV + (size_t)2 * NT * DM * 2;
constexpr int ACT_ROWS = 2 * NT + NE * 256;
static_assert(WS_ACT + (size_t)ACT_ROWS * FF * 2 <= WS_QKV + (size_t)NT * INW * 2, "overlay fits");
constexpr size_t WS_MIX = WS_QKV + (size_t)NT * INW * 2;
constexpr size_t WS_YG = WS_MIX + (size_t)NT * DM * 2;
constexpr size_t WS_SEND = WS_YG + (size_t)NT * 256 * 2;
constexpr size_t WS_XS = WS_SEND + (size_t)NB * NCH * 16 * 64 * 8;
constexpr size_t WS_KV = WS_XS + (size_t)NB * NCH * 16 * 64 * 8;
constexpr size_t WS_RW = WS_KV + (size_t)NB * NCH * 4 * 4096 * 4;
constexpr size_t WS_LIST = WS_RW + (size_t)NT * 2 * 4;
constexpr size_t WS_WRHL = WS_LIST + (size_t)NE * NT * 4;
constexpr size_t WS_END = WS_WRHL + (size_t)NL * 2 * 48 * DM * 2;
constexpr int CW_BAR = 4096;
constexpr int CW_CNT = 16384;

__device__ __forceinline__ float bf2f(unsigned v) { return __uint_as_float(v << 16); }
__device__ __forceinline__ unsigned f2bf(float f) { unsigned u = __float_as_uint(f); return (u + 0x7fffu + ((u >> 16) & 1u)) >> 16; }
__device__ __forceinline__ unsigned pk2(float lo, float hi) { return f2bf(lo) | (f2bf(hi) << 16); }
__device__ __forceinline__ float wave_sum(float v) {
#pragma unroll
    for (int o = 1; o < 64; o <<= 1) v += __shfl_xor(v, o);
    return v;
}
__device__ __forceinline__ float silu_f(float x) { return x / (1.0f + __expf(-x)); }
__device__ __forceinline__ float sigmoid_f(float x) { return 1.0f / (1.0f + __expf(-x)); }
__device__ __forceinline__ float gelu_tanh_f(float y) { const float z = 0.7978845608028654f * (y + 0.044715f * y * y * y); const float t = 1.0f - 2.0f / (__expf(2.0f * z) + 1.0f); return 0.5f * y * (1.0f + t); }
#define LDS_WAIT() asm volatile("s_waitcnt lgkmcnt(0)" ::: "memory")

#define XB_TMO      128
#define XB_XCNT(j)  (256  + 64 * (j))
#define XB_XSUB(j)  (1280 + 64 * (j))
#define XB_XGEN(j)  (2304 + 64 * (j))
#define XB_TOP      3328
#define XB_TOPGEN   3392
#define XCD_BAR_WORDS 3456
#define XB_SPIN_CAP (1u << 22)
__device__ __forceinline__ unsigned xb_ld(unsigned* p)              { return __hip_atomic_load(p, __ATOMIC_RELAXED, __HIP_MEMORY_SCOPE_AGENT); }
__device__ __forceinline__ unsigned xb_add(unsigned* p, unsigned v) { return __hip_atomic_fetch_add(p, v, __ATOMIC_RELAXED, __HIP_MEMORY_SCOPE_AGENT); }
__device__ __forceinline__ unsigned xb_xcc_id() { return (unsigned)__builtin_amdgcn_s_getreg((3 << 11) | 20) & 0xFu; }
#define XB_SPIN(cond, bar) do { unsigned _sp = 0; while (cond) { __builtin_amdgcn_s_sleep(1); \
    if ((++_sp & 255u) == 0u) { if (xb_ld(&(bar)[XB_TMO])) break; if (_sp > XB_SPIN_CAP) { atomicAdd(&(bar)[XB_TMO], 1u); break; } } } } while (0)
struct XcdBarrier { unsigned* bar; unsigned x; volatile LAS unsigned* st; };
__device__ __forceinline__ XcdBarrier xcd_barrier_post(unsigned* bar, volatile LAS unsigned* st) {
    XcdBarrier b; b.bar = bar; b.x = xb_xcc_id(); b.st = st;
    if (threadIdx.x == 0) (void)xb_add(&bar[XB_XCNT(b.x)], 1u);
    return b;
}
__device__ __forceinline__ void xcd_barrier_complete(unsigned* bar, unsigned x, unsigned& nloc, unsigned& nx) {
    const unsigned G = gridDim.x * gridDim.y * gridDim.z;
    unsigned sum, cnt, mine, sp = 0u;
    for (;;) {
        sum = 0u; cnt = 0u; mine = 0u;
#pragma unroll
        for (unsigned j = 0; j < 16; ++j) { const unsigned c = xb_ld(&bar[XB_XCNT(j)]); sum += c; cnt += (c > 0u) ? 1u : 0u; mine = (j == x) ? c : mine; }
        if (sum == G) break;
        __builtin_amdgcn_s_sleep(1);
        if ((++sp & 255u) == 0u) { if (xb_ld(&bar[XB_TMO])) break; if (sp > XB_SPIN_CAP) { atomicAdd(&bar[XB_TMO], 1u); break; } }
    }
    nloc = mine > 0u ? mine : 1u; nx = cnt > 0u ? cnt : 1u;
}
__device__ __forceinline__ void xcd_barrier(const XcdBarrier& b) {
    asm volatile("s_waitcnt vmcnt(0)" ::: "memory");
    __syncthreads();
    if (threadIdx.x == 0) {
        unsigned* bar = b.bar;
        __builtin_amdgcn_s_waitcnt(0);
        unsigned nloc = b.st[0], nx = b.st[1];
        if (nloc == 0u) { xcd_barrier_complete(bar, b.x, nloc, nx); b.st[0] = nloc; b.st[1] = nx; }
        const unsigned old = xb_add(&bar[XB_XSUB(b.x)], 1u);
        const unsigned gen = old / nloc;
        if (old + 1u == (gen + 1u) * nloc) {
            __builtin_amdgcn_fence(__ATOMIC_RELEASE, "agent");
            asm volatile("s_waitcnt vmcnt(0)" ::: "memory");
            const unsigned og = xb_add(&bar[XB_TOP], 1u);
            const unsigned tg = og / nx;
            if (og + 1u == (tg + 1u) * nx) xb_add(&bar[XB_TOPGEN], 1u);
            else XB_SPIN(xb_ld(&bar[XB_TOPGEN]) == tg, bar);
            __builtin_amdgcn_fence(__ATOMIC_ACQUIRE, "agent");
            xb_add(&bar[XB_XGEN(b.x)], 1u);
            asm volatile("s_waitcnt vmcnt(0)" ::: "memory");
        } else {
            XB_SPIN(xb_ld(&bar[XB_XGEN(b.x)]) == gen, bar);
            __builtin_amdgcn_fence(__ATOMIC_ACQUIRE, "agent");
            asm volatile("s_waitcnt vmcnt(0)" ::: "memory");
        }
    }
    __syncthreads();
}

struct Frame {
    LAS unsigned char* lds;
    LAS unsigned long long* ptab;
    int tid, lane, wave, blk, G, gw, ngw;
    float* out; unsigned char* ws;
};
__device__ __forceinline__ const float* inp_ptr(LAS unsigned long long* t, int k) { const unsigned long long v = t[k];
    const unsigned lo = __builtin_amdgcn_readfirstlane((unsigned)v), hi = __builtin_amdgcn_readfirstlane((unsigned)(v >> 32)); return (const float*)(((unsigned long long)hi << 32) | lo); }
#define INP(k) inp_ptr(F.ptab, k)
#define F_x INP(0)
#define F_c INP(1)
#define F_norm1_g INP(2)
#define F_norm2_g INP(3)
#define F_w_ada INP(4)
#define F_b_ada INP(5)
#define F_w_in INP(6)
#define F_rel_bias INP(7)
#define F_a_re INP(8)
#define F_a_im INP(9)
#define F_log_dt INP(10)
#define F_b_re INP(11)
#define F_b_im INP(12)
#define F_c_re INP(13)
#define F_c_im INP(14)
#define F_ssm_d INP(15)
#define F_w_glu INP(16)
#define F_b_glu INP(17)
#define F_gn_g INP(18)
#define F_w_out INP(19)
#define F_w_group INP(20)
#define F_b_group INP(21)
#define F_w_expert INP(22)
#define F_b_expert INP(23)
#define F_w_gate INP(24)
#define F_w_up INP(25)
#define F_w_down INP(26)
#define F_final_g INP(27)
#define F_ctl ((unsigned*)(F.ws + WS_CTL))
#define F_WinT ((bf16*)(F.ws + WS_WIN))
#define F_WoutT ((bf16*)(F.ws + WS_WOUT))
#define F_WguT ((bf16*)(F.ws + WS_WGU))
#define F_WdT ((bf16*)(F.ws + WS_WD))
#define F_WgluT ((bf16*)(F.ws + WS_WGLU))
#define F_WrT ((float*)(F.ws + WS_WR))
#define F_MOD ((float*)(F.ws + WS_MOD))
#define F_ABAR ((f32x2*)(F.ws + WS_ABAR))
#define F_ABAR64 ((f32x2*)(F.ws + WS_ABAR64))
#define F_BBAR ((f32x2*)(F.ws + WS_BBAR))
#define F_ROPE ((f32x2*)(F.ws + WS_ROPE))
#define F_H ((bf16*)(F.ws + WS_H))
#define F_QKV ((bf16*)(F.ws + WS_QKV))
#define F_SLOT ((bf16*)(F.ws + WS_SLOT))
#define F_ACT ((bf16*)(F.ws + WS_ACT))
#define F_MIX ((bf16*)(F.ws + WS_MIX))
#define F_YG ((bf16*)(F.ws + WS_YG))
#define F_SEND ((f32x2*)(F.ws + WS_SEND))
#define F_XS ((f32x2*)(F.ws + WS_XS))
#define F_KV ((float*)(F.ws + WS_KV))
#define F_RW ((float*)(F.ws + WS_RW))
#define F_LIST ((int*)(F.ws + WS_LIST))
#define F_WRHL ((bf16*)(F.ws + WS_WRHL))

__device__ __forceinline__ void wave_gemm64(f32x4 (&acc)[4][4], const bf16* const (&arow)[4], const bf16* const (&brow)[4], int K) {
#pragma unroll
    for (int i = 0; i < 4; ++i)
#pragma unroll
        for (int j = 0; j < 4; ++j) acc[i][j] = (f32x4){0.f, 0.f, 0.f, 0.f};
    for (int k0 = 0; k0 < K; k0 += 32) {
        bf16x8 a[4], b[4];
#pragma unroll
        for (int i = 0; i < 4; ++i) { a[i] = *(const bf16x8*)(arow[i] + k0); b[i] = *(const bf16x8*)(brow[i] + k0); }
#pragma unroll
        for (int i = 0; i < 4; ++i)
#pragma unroll
            for (int j = 0; j < 4; ++j) acc[i][j] = __builtin_amdgcn_mfma_f32_16x16x32_bf16(b[j], a[i], acc[i][j], 0, 0, 0);
    }
}

namespace pg8 {
constexpr int BM = 256, BK = 64, HALF = 128, HTB = HALF * BK * 2, STAGE_BYTES = 8 * HTB, NXCD = 8, WGM = 8;
__host__ __device__ __forceinline__ int lds_byte(int r, int c) { const int st = (r >> 4) * 2 + (c >> 5), rr = r & 15, cc = c & 31, ob = rr * 64 + cc * 2; return st * 1024 + (ob ^ (((ob >> 9) & 1) << 5)); }
__host__ __device__ __forceinline__ void stage_rc(int b, int& R, int& C) { const int st = b / 1024, sb = b % 1024, swz = sb ^ (((sb >> 9) & 1) << 5); R = (st >> 1) * 16 + swz / 64; C = (st & 1) * 32 + (swz % 64) / 2; }
__host__ __device__ __forceinline__ int perm32(int rho) { const int n = rho >> 4, i = rho & 15; return 8 * (i >> 2) + 4 * n + (i & 3); }
struct Unit { int pm, pn, e, i; };
struct StaticOrder {
    int nM, nN, nwg, G, c; const char* A; const char* Bt; size_t tstepA, tstepB;
    __device__ void init(const bf16* A_, int lda, const bf16* Bt_, int ldb, int M, int N, int G_, int c_) { nM = M / BM; nN = N / BM; nwg = nM * nN; G = G_; c = c_; A = (const char*)A_; Bt = (const char*)Bt_; tstepA = (size_t)BM * lda * 2; tstepB = (size_t)BM * ldb * 2; }
    __device__ bool next(int i, Unit& u) const {
        const long L = (long)i * G + c; if (L >= nwg) return false;
        int wgid = (int)L; { const int q = nwg / NXCD, r = nwg % NXCD, xcd = wgid % NXCD, off = wgid / NXCD; wgid = (xcd < r ? xcd * (q + 1) : r * (q + 1) + (xcd - r) * q) + off; }
        const int nig = WGM * nN, gid = wgid / nig, fm = gid * WGM, gsz = (nM - fm) < WGM ? (nM - fm) : WGM;
        u.pm = fm + ((wgid % nig) % gsz); u.pn = (wgid % nig) / gsz; u.e = 0; u.i = i; return true;
    }
    __device__ __forceinline__ const char* a_base(const Unit& u) const { return A + (size_t)u.pm * tstepA; }
    __device__ __forceinline__ const char* b_base(const Unit& u) const { return Bt + (size_t)u.pn * tstepB; }
    __device__ __forceinline__ int row(const Unit&, int r) const { return r; }
};
__device__ __forceinline__ unsigned cvt_pk_bf16(float lo, float hi) { unsigned r; asm volatile("v_cvt_pk_bf16_f32 %0, %1, %2" : "=v"(r) : "v"(lo), "v"(hi)); return r; }

template <class Epi, class Sched, bool GATHER>
__device__ __forceinline__ void gemm_phase(LAS unsigned char* lds, const int K, const int lda, const int ldb, const Sched& S, const Epi& E) {
    int tid_ = threadIdx.x; asm volatile("" : "+v"(tid_));
    const int tid = tid_, wid = __builtin_amdgcn_readfirstlane(tid >> 6), lane = tid & 63, wr = wid >> 2, wc = wid & 3, fr = lane & 15, fq = lane >> 4;
    const int nt = K / BK;
    int Rr[2], Cc[2]; unsigned voffB[2];
#pragma unroll
    for (int i = 0; i < 2; ++i) { stage_rc(tid * 16 + i * 8192, Rr[i], Cc[i]); const int Rb = Epi::PERM ? ((Rr[i] & ~31) + perm32(Rr[i] & 31)) : Rr[i]; voffB[i] = (unsigned)(Rb * ldb + Cc[i]) * 2u; }
    const size_t kstep = (size_t)(BK * 2);
    const size_t hstepB = (size_t)HALF * ldb * 2;
    const unsigned ldsw = (unsigned)wid * 1024u;
    const int aoff = lds_byte(wr * 64 + fr, fq * 8), boff = lds_byte(wc * 32 + fr, fq * 8);
#define PG8_SA(b, h) (((b) * 2 + (h)) * HTB)
#define PG8_SB(b, h) ((4 + (b) * 2 + (h)) * HTB)
#define PG8_STAGE(bufoff, gbase, voff) do { _Pragma("unroll") for (int _i = 0; _i < 2; ++_i) \
        __builtin_amdgcn_global_load_lds((const unsigned*)((const char*)(gbase) + (voff)[_i]), (LAS unsigned*)(lds + (bufoff) + ldsw + _i * 8192), 16, 0, 0); } while (0)
#define PG8_STAGE_SEL(bufoff, gbase, h) do { if (GATHER && last) PG8_STAGE(bufoff, gbase, vN[h]); else PG8_STAGE(bufoff, gbase, vA[h]); } while (0)
#define PG8_LDA(dst, b, h) do { _Pragma("unroll") for (int m = 0; m < 4; ++m) _Pragma("unroll") for (int k = 0; k < 2; ++k) dst[m][k] = *(const LAS bf16x8*)(lds + PG8_SA(b, h) + aoff + m * 2048 + k * 1024); } while (0)
#define PG8_LDB(dst, b, h) do { _Pragma("unroll") for (int n = 0; n < 2; ++n) _Pragma("unroll") for (int k = 0; k < 2; ++k) dst[n][k] = *(const LAS bf16x8*)(lds + PG8_SB(b, h) + boff + n * 2048 + k * 1024); } while (0)
#define PG8_MMA(ai, bj, At, Bt) do { __builtin_amdgcn_s_setprio(1); _Pragma("unroll") for (int m = 0; m < 4; ++m) _Pragma("unroll") for (int n = 0; n < 2; ++n) _Pragma("unroll") for (int k = 0; k < 2; ++k) \
        acc[ai][bj][m][n] = __builtin_amdgcn_mfma_f32_16x16x32_bf16(Bt[n][k], At[m][k], acc[ai][bj][m][n], 0, 0, 0); __builtin_amdgcn_s_setprio(0); } while (0)
#define PG8_WAIT_V(n) asm volatile("s_waitcnt vmcnt(" #n ")" ::: "memory")
#define PG8_WAIT_L(n) asm volatile("s_waitcnt lgkmcnt(" #n ")" ::: "memory")
#define PG8_BAR __builtin_amdgcn_s_barrier()
#define PG8_SCHED __builtin_amdgcn_sched_barrier(0)
#define PG8_VOFF(dst, u) do { int _t = tid; if (GATHER) asm volatile("" : "+v"(_t)); _Pragma("unroll") for (int _i = 0; _i < 2; ++_i) { int _R, _C; stage_rc(_t * 16 + _i * 8192, _R, _C); \
        _Pragma("unroll") for (int _h = 0; _h < 2; ++_h) dst[_h][_i] = (unsigned)(S.row(u, _h * HALF + _R) * lda + _C) * 2u; } } while (0)
    Unit cur, nxt; int ui = 0;
    if (!S.next(0, cur)) return;
    f32x4 acc[2][2][4][2];
#pragma unroll
    for (int a = 0; a < 2; ++a)
#pragma unroll
        for (int b = 0; b < 2; ++b)
#pragma unroll
            for (int m = 0; m < 4; ++m)
#pragma unroll
                for (int n = 0; n < 2; ++n) acc[a][b][m][n] = (f32x4){0.f, 0.f, 0.f, 0.f};
    bf16x8 At[4][2], B0[2][2], B1[2][2];
    unsigned vA[2][2], vN[2][2];
    PG8_VOFF(vA, cur);
    const char* cA = S.a_base(cur); const char* cB = S.b_base(cur);
    PG8_STAGE(PG8_SB(0, 0), cB, voffB); PG8_STAGE(PG8_SB(0, 1), cB + hstepB, voffB); PG8_STAGE(PG8_SA(0, 0), cA, vA[0]); PG8_STAGE(PG8_SA(0, 1), cA, vA[1]);
    if (wr == 1) PG8_BAR;
    PG8_WAIT_V(2); PG8_BAR;
    PG8_STAGE(PG8_SB(1, 0), cB + kstep, voffB); PG8_STAGE(PG8_SA(1, 0), cA + kstep, vA[0]); PG8_STAGE(PG8_SB(1, 1), cB + hstepB + kstep, voffB);
    PG8_WAIT_V(6); PG8_BAR;
    for (;;) {
        const bool has_next = S.next(ui + 1, nxt);
        const char* nA = has_next ? S.a_base(nxt) : cA; const char* nB = has_next ? S.b_base(nxt) : cB;
        if (GATHER) { if (has_next) PG8_VOFF(vN, nxt); else {
#pragma unroll
            for (int h = 0; h < 2; ++h) { vN[h][0] = vA[h][0]; vN[h][1] = vA[h][1]; } } }
#pragma unroll 1
        for (int t = 0; t < nt; t += 2) {
            const bool last = (t == nt - 2);
            const char* a1 = cA + (size_t)(t + 1) * kstep;
            const char* a2 = last ? nA : cA + (size_t)(t + 2) * kstep; const char* b2 = last ? nB : cB + (size_t)(t + 2) * kstep;
            const char* a3 = a2 + kstep; const char* b3 = b2 + kstep;
            unsigned vS[2][2];
#pragma unroll
            for (int h = 0; h < 2; ++h)
#pragma unroll
                for (int i = 0; i < 2; ++i) vS[h][i] = (GATHER && last) ? vN[h][i] : vA[h][i];
            PG8_LDB(B0, 0, 0); PG8_LDB(B1, 0, 1); PG8_SCHED; PG8_LDA(At, 0, 0); PG8_STAGE(PG8_SA(1, 1), a1, vA[1]);
            PG8_WAIT_V(8); PG8_WAIT_L(0); PG8_BAR; PG8_MMA(0, 0, At, B0); PG8_MMA(0, 1, At, B1); PG8_BAR; PG8_SCHED;
            PG8_LDA(At, 0, 1); PG8_STAGE(PG8_SB(0, 0), b2, voffB); PG8_STAGE(PG8_SB(0, 1), b2 + hstepB, voffB); PG8_STAGE(PG8_SA(0, 0), a2, vS[0]);
            PG8_WAIT_V(8); PG8_WAIT_L(0); PG8_BAR; PG8_MMA(1, 0, At, B0); PG8_MMA(1, 1, At, B1); PG8_BAR; PG8_SCHED;
            PG8_LDB(B0, 1, 0); PG8_LDB(B1, 1, 1); PG8_SCHED; PG8_LDA(At, 1, 0); PG8_STAGE(PG8_SA(0, 1), a2, vS[1]);
            PG8_WAIT_V(8); PG8_WAIT_L(0); PG8_BAR; PG8_MMA(0, 0, At, B0); PG8_MMA(0, 1, At, B1); PG8_BAR; PG8_SCHED;
            PG8_LDA(At, 1, 1); PG8_STAGE(PG8_SB(1, 0), b3, voffB); PG8_STAGE(PG8_SB(1, 1), b3 + hstepB, voffB); PG8_STAGE(PG8_SA(1, 0), a3, vS[0]);
            PG8_WAIT_V(8); PG8_WAIT_L(0); PG8_BAR; PG8_MMA(1, 0, At, B0); PG8_MMA(1, 1, At, B1); PG8_BAR; PG8_SCHED;
        }
        if (wr == 0) PG8_BAR;
        E(acc, cur, wr, wc, fr, fq);
        if (!has_next) break;
#pragma unroll
        for (int a = 0; a < 2; ++a)
#pragma unroll
            for (int b = 0; b < 2; ++b)
#pragma unroll
                for (int m = 0; m < 4; ++m)
#pragma unroll
                    for (int n = 0; n < 2; ++n) acc[a][b][m][n] = (f32x4){0.f, 0.f, 0.f, 0.f};
        cur = nxt; cA = nA; cB = nB; ++ui;
        if (GATHER) {
#pragma unroll
            for (int h = 0; h < 2; ++h) { vA[h][0] = vN[h][0]; vA[h][1] = vN[h][1]; } }
        if (wr == 1) PG8_BAR;
    }
    PG8_WAIT_V(0);
    PG8_BAR;
#undef PG8_SA
#undef PG8_SB
#undef PG8_STAGE
#undef PG8_STAGE_SEL
#undef PG8_LDA
#undef PG8_LDB
#undef PG8_MMA
#undef PG8_WAIT_V
#undef PG8_WAIT_L
#undef PG8_BAR
#undef PG8_SCHED
#undef PG8_VOFF
}
}

struct EpiQKV {
    static constexpr bool PERM = true;
    bf16* O;
    __device__ __forceinline__ void operator()(const f32x4 (&acc)[2][2][4][2], const pg8::Unit& u, int wr, int wc, int fr, int fq) const {
        const int row0 = u.pm * 256 + wr * 64 + fr, col0 = u.pn * 256 + wc * 32 + 8 * fq;
#pragma unroll
        for (int ai = 0; ai < 2; ++ai)
#pragma unroll
            for (int m = 0; m < 4; ++m) { bf16* rowp = O + (size_t)(row0 + ai * 128 + m * 16) * INW + col0;
#pragma unroll
                for (int bj = 0; bj < 2; ++bj) { const f32x4 v0 = acc[ai][bj][m][0], v1 = acc[ai][bj][m][1];
                    u32x4 w; w.x = pg8::cvt_pk_bf16(v0[0], v0[1]); w.y = pg8::cvt_pk_bf16(v0[2], v0[3]); w.z = pg8::cvt_pk_bf16(v1[0], v1[1]); w.w = pg8::cvt_pk_bf16(v1[2], v1[3]);
                    *(u32x4*)(rowp + bj * 128) = w; } }
    }
};
struct EpiRes {
    static constexpr bool PERM = false;
    const float* xb; float* out; const float* g1l;
    __device__ __forceinline__ void operator()(const f32x4 (&acc)[2][2][4][2], const pg8::Unit& u, int wr, int wc, int fr, int fq) const {
        const int row0 = u.pm * 256 + wr * 64 + fr, col0 = u.pn * 256 + wc * 32 + 4 * fq;
        const float* g1 = g1l + (size_t)((u.pm * 256) / SEQ) * 6144 + col0;
        f32x4 gv[2][2];
#pragma unroll
        for (int bj = 0; bj < 2; ++bj)
#pragma unroll
            for (int n = 0; n < 2; ++n) gv[bj][n] = *(const f32x4*)(g1 + bj * 128 + n * 16);
#pragma unroll
        for (int ai = 0; ai < 2; ++ai)
#pragma unroll
            for (int m = 0; m < 4; ++m) { const size_t off = (size_t)(row0 + ai * 128 + m * 16) * DM + col0;
#pragma unroll
                for (int bj = 0; bj < 2; ++bj)
#pragma unroll
                    for (int n = 0; n < 2; ++n) { const f32x4 xv = *(const f32x4*)(xb + off + bj * 128 + n * 16); *(f32x4*)(out + off + bj * 128 + n * 16) = xv + gv[bj][n] * acc[ai][bj][m][n]; }
                asm volatile("" ::: "memory"); }
    }
};

__device__ __forceinline__ void transpose_item(const float* W, int N, int k0, int n0, bf16* dst, int ldk, LAS float* scr, int lane) {
#pragma unroll 8
    for (int i = 0; i < 32; ++i) { const int kk = 2 * i + (lane >> 5); scr[kk * 33 + (lane & 31)] = W[(size_t)(k0 + kk) * N + n0 + (lane & 31)]; }
    LDS_WAIT(); asm volatile("" ::: "memory");
    const int c = lane & 7;
#pragma unroll
    for (int j = 0; j < 4; ++j) { const int n = (lane >> 3) + 8 * j; const LAS float* s = scr + (8 * c) * 33 + n;
        u32x4 o; o.x = pk2(s[0 * 33], s[1 * 33]); o.y = pk2(s[2 * 33], s[3 * 33]); o.z = pk2(s[4 * 33], s[5 * 33]); o.w = pk2(s[6 * 33], s[7 * 33]);
        *(u32x4*)(dst + (size_t)n * ldk + k0 + 8 * c) = o; }
    LDS_WAIT(); asm volatile("" ::: "memory");
}
__device__ __forceinline__ void p0_prologue(Frame& F) {
    LAS float* scr = (LAS float*)(F.lds + F.wave * 16384);
    constexpr int I_IN = NL * 16 * 88, I_OUT = NL * 16 * 32, I_GLU = NL * 4 * 8, I_G = NL * NE * 16 * 8, I_D = NL * NE * 4 * 32;
    constexpr int NITEMS = I_IN + I_OUT + I_GLU + 2 * I_G + I_D;
    for (int it = F.gw; it < NITEMS; it += F.ngw) {
        int r = it;
        if (r < I_IN) { const int l = r / (16 * 88), q = r % (16 * 88), kb = q / 88, nb = q % 88;
            transpose_item(F_w_in + (size_t)l * DM * INW, INW, kb * 64, nb * 32, F_WinT + ((size_t)l * INW + nb * 32) * DM, DM, scr, F.lane); continue; } r -= I_IN;
        if (r < I_OUT) { const int l = r / (16 * 32), q = r % (16 * 32), kb = q / 32, nb = q % 32;
            transpose_item(F_w_out + (size_t)l * DM * DM, DM, kb * 64, nb * 32, F_WoutT + ((size_t)l * DM + nb * 32) * DM, DM, scr, F.lane); continue; } r -= I_OUT;
        if (r < I_GLU) { const int l = r / 32, q = r % 32, kb = q / 8, nb = q % 8;
            transpose_item(F_w_glu + (size_t)l * 256 * 256, 256, kb * 64, nb * 32, F_WgluT + ((size_t)l * 256 + nb * 32) * 256, 256, scr, F.lane); continue; } r -= I_GLU;
        if (r < 2 * I_G) { const int up = r >= I_G; if (up) r -= I_G; const int le = r / 128, q = r % 128, kb = q / 8, nb = q % 8; const int n0 = nb * 32;
            const int drow = (n0 >> 7) * 256 + up * 128 + (n0 & 127);
            transpose_item((up ? F_w_up : F_w_gate) + (size_t)le * DM * FF, FF, kb * 64, n0, F_WguT + ((size_t)le * 512 + drow) * DM, DM, scr, F.lane); continue; } r -= 2 * I_G;
        { const int le = r / 128, q = r % 128, kb = q / 32, nb = q % 32;
            transpose_item(F_w_down + (size_t)le * FF * DM, DM, kb * 64, nb * 32, F_WdT + ((size_t)le * DM + nb * 32) * FF, FF, scr, F.lane); }
    }
    for (int i = F.blk * NTHR + F.tid; i < NL * 36 * DM; i += F.G * NTHR) { const int l = i / (36 * DM), j = (i / DM) % 36, k = i % DM;
        F_WrT[i] = (j < 4) ? F_w_group[((size_t)l * DM + k) * 4 + j] : F_w_expert[((size_t)l * DM + k) * 32 + (j - 4)]; }
    for (int i = F.blk * NTHR + F.tid; i < NL * 48 * DM; i += F.G * NTHR) { const int l = i / (48 * DM), j = (i / DM) % 48, k = i % DM;
        const float w = (j < 4) ? F_w_group[((size_t)l * DM + k) * 4 + j] : (j < 36 ? F_w_expert[((size_t)l * DM + k) * 32 + (j - 4)] : 0.f);
        const unsigned hi = f2bf(w); const unsigned lo = f2bf(w - bf2f(hi));
        F_WRHL[((size_t)(l * 2 + 0) * 48 + j) * DM + k] = (bf16)hi; F_WRHL[((size_t)(l * 2 + 1) * 48 + j) * DM + k] = (bf16)lo; }
    for (int i = F.blk * NTHR + F.tid; i < NL * 16 * 64; i += F.G * NTHR) {
        const int lg = i / 64; const float are = F_a_re[i], aim = F_a_im[i], dt = __expf(F_log_dt[lg]);
        const float mag = expf(are * dt); float sn, cs; sincosf(aim * dt, &sn, &cs);
        const float abr = mag * cs, abi = mag * sn;
        F_ABAR[i] = (f32x2){abr, abi};
        const float mag64 = expf(64.f * are * dt); float sn64, cs64; sincosf(64.f * aim * dt, &sn64, &cs64);
        F_ABAR64[i] = (f32x2){mag64 * cs64, mag64 * sn64};
        const float xr = abr - 1.f, xi = abi, den = are * are + aim * aim;
        const float fr = (xr * are + xi * aim) / den, fi = (xi * are - xr * aim) / den;
#pragma unroll
        for (int cc = 0; cc < 16; ++cc) { const float br = F_b_re[(size_t)i * 16 + cc], bi = F_b_im[(size_t)i * 16 + cc];
            F_BBAR[(size_t)i * 16 + cc] = (f32x2){fr * br - fi * bi, fr * bi + fi * br}; }
    }
    for (int i = F.blk * NTHR + F.tid; i < SEQ * 32; i += F.G * NTHR) { const int pos = i >> 5, j = i & 31;
        const float inv = powf(10000.0f, -(float)j / 32.0f); const float ang = (float)pos * inv; float sn, cs; sincosf(ang, &sn, &cs); F_ROPE[i] = (f32x2){cs, sn}; }
    __syncthreads();
    {
        LAS float* cond = (LAS float*)F.lds;
        LAS float* red = (LAS float*)(F.lds + 32768);
        for (int i = F.tid; i < NB * DM; i += NTHR) cond[i] = silu_f(F_c[i]);
        __syncthreads();
        constexpr int NITM = NL * 6144 / 128;
        for (int it = F.blk; it < NITM; it += F.G) {
            const int col = it * 128 + (F.tid & 127), l = col / 6144, j = col % 6144, ks = F.tid >> 7;
            float acc[8];
#pragma unroll
            for (int b = 0; b < 8; ++b) acc[b] = 0.f;
            const float* wp = F_w_ada + (size_t)l * DM * 6144 + j;
            for (int k = ks * 256; k < ks * 256 + 256; ++k) { const float w = wp[(size_t)k * 6144];
#pragma unroll
                for (int b = 0; b < 8; ++b) acc[b] += cond[b * DM + k] * w; }
#pragma unroll
            for (int b = 0; b < 8; ++b) red[(ks * 128 + (F.tid & 127)) * 8 + b] = acc[b];
            __syncthreads();
            if (F.tid < 128) {
#pragma unroll
                for (int b = 0; b < 8; ++b) { const float s = red[(0 * 128 + F.tid) * 8 + b] + red[(1 * 128 + F.tid) * 8 + b] + red[(2 * 128 + F.tid) * 8 + b] + red[(3 * 128 + F.tid) * 8 + b];
                    F_MOD[((size_t)l * NB + b) * 6144 + j] = s + F_b_ada[(size_t)l * 6144 + j]; }
            }
            __syncthreads();
        }
    }
}

template <int MODE>
__device__ __forceinline__ void norm_phase(Frame& F, int l) {
    LAS int* l_ent = (LAS int*)F.lds;
    LAS int* l_exp = l_ent + 256;
    LAS int* l_cnt = l_exp + 256;
    LAS int* l_base = l_cnt + 32;
    LAS int* l_n = l_base + 32;
    const int rpb = NT / F.G;
    if (MODE == 1) { if (F.tid < 32) l_cnt[F.tid] = 0; if (F.tid == 0) l_n[0] = 0; __syncthreads(); }
    const int nit = (MODE == 1) ? rpb / NWAVES : (NT + F.ngw - 1) / F.ngw;
    for (int it = 0; it < nit; ++it) {
        const int row = (MODE == 1) ? F.blk * rpb + it * NWAVES + F.wave : F.gw + it * F.ngw;
        if (row >= NT) break;
        const int b = row / SEQ;
        const float* xsrc = (MODE == 0 && l == 0) ? F_x : F.out;
        const f32x4* xr = (const f32x4*)(xsrc + (size_t)row * DM) + F.lane;
        f32x4 v[4];
#pragma unroll
        for (int j = 0; j < 4; ++j) v[j] = xr[64 * j];
        if ((MODE == 0 && l > 0) || MODE == 2) {
            const int lp = (MODE == 2) ? NL - 1 : l - 1;
            const f32x4* g2 = (const f32x4*)(F_MOD + ((size_t)lp * NB + b) * 6144 + 5120) + F.lane;
            const u32x2* s0 = (const u32x2*)(F_SLOT + (size_t)row * DM) + F.lane;
            const u32x2* s1 = (const u32x2*)(F_SLOT + (size_t)NT * DM + (size_t)row * DM) + F.lane;
#pragma unroll
            for (int j = 0; j < 4; ++j) { const u32x2 a = s0[64 * j], c = s1[64 * j]; const f32x4 g = g2[64 * j];
                v[j].x += g.x * (bf2f(a.x & 0xffffu) + bf2f(c.x & 0xffffu)); v[j].y += g.y * (bf2f(a.x >> 16) + bf2f(c.x >> 16));
                v[j].z += g.z * (bf2f(a.y & 0xffffu) + bf2f(c.y & 0xffffu)); v[j].w += g.w * (bf2f(a.y >> 16) + bf2f(c.y >> 16)); }
            if (MODE == 0) { f32x4* xo = (f32x4*)(F.out + (size_t)row * DM) + F.lane;
#pragma unroll
                for (int j = 0; j < 4; ++j) xo[64 * j] = v[j]; }
        }
        float ss = 0.f;
#pragma unroll
        for (int j = 0; j < 4; ++j) ss += (v[j].x * v[j].x + v[j].y * v[j].y) + (v[j].z * v[j].z + v[j].w * v[j].w);
        const float rstd = 1.0f / sqrtf(wave_sum(ss) * (1.0f / DM) + EPS);
        if (MODE == 2) {
            const f32x4* g = (const f32x4*)F_final_g + F.lane; f32x4* xo = (f32x4*)(F.out + (size_t)row * DM) + F.lane;
#pragma unroll
            for (int j = 0; j < 4; ++j) xo[64 * j] = v[j] * rstd * g[64 * j];
            continue;
        }
        const f32x4* g = (const f32x4*)((MODE == 0 ? F_norm1_g : F_norm2_g) + (size_t)l * DM) + F.lane;
        const float* modb = F_MOD + ((size_t)l * NB + b) * 6144 + (MODE == 0 ? 0 : 3072);
        const f32x4* sh = (const f32x4*)modb + F.lane; const f32x4* sc = (const f32x4*)(modb + 1024) + F.lane;
        u32x2* ho = (u32x2*)(F_H + (size_t)row * DM) + F.lane;
#pragma unroll
        for (int j = 0; j < 4; ++j) { v[j] = v[j] * rstd * g[64 * j] * (sc[64 * j] + 1.0f) + sh[64 * j]; u32x2 o; o.x = pk2(v[j].x, v[j].y); o.y = pk2(v[j].z, v[j].w); ho[64 * j] = o; }
        if (MODE == 1) {
            LAS float* wl = (LAS float*)(F.lds + 4096 + F.wave * 256);
            const f32x4* wr = (const f32x4*)(F_WrT + (size_t)l * 36 * DM) + F.lane;
#pragma unroll 2
            for (int c = 0; c < 36; ++c) { float p = 0.f;
#pragma unroll
                for (int j = 0; j < 4; ++j) { const f32x4 w = wr[c * 256 + 64 * j]; p += (v[j].x * w.x + v[j].y * w.y) + (v[j].z * w.z + v[j].w * w.w); }
                p = wave_sum(p); if (F.lane == 0) wl[c] = p; }
            LDS_WAIT(); __builtin_amdgcn_wave_barrier();
            float gl[4];
#pragma unroll
            for (int j = 0; j < 4; ++j) gl[j] = wl[j] + F_b_group[l * 4 + j];
            int gi = 0; float gm = gl[0];
#pragma unroll
            for (int j = 1; j < 4; ++j) if (gl[j] > gm) { gm = gl[j]; gi = j; }
            float gs = 0.f;
#pragma unroll
            for (int j = 0; j < 4; ++j) gs += __expf(gl[j] - gm);
            const float gw = 1.0f / gs;
            float ig[8];
#pragma unroll
            for (int j = 0; j < 8; ++j) ig[j] = wl[4 + gi * 8 + j] + F_b_expert[l * 32 + gi * 8 + j];
            __builtin_amdgcn_wave_barrier();
            int i0 = 0; float v0 = ig[0];
#pragma unroll
            for (int j = 1; j < 8; ++j) if (ig[j] > v0) { v0 = ig[j]; i0 = j; }
            int i1 = -1; float v1 = -3.0e38f;
#pragma unroll
            for (int j = 0; j < 8; ++j) if (j != i0 && ig[j] > v1) { v1 = ig[j]; i1 = j; }
            const float e1x = __expf(v1 - v0), w0 = gw / (1.0f + e1x), w1 = gw * e1x / (1.0f + e1x);
            if (F.lane == 0) { F_RW[(size_t)row * 2] = w0; F_RW[(size_t)row * 2 + 1] = w1;
                const int lr = it * NWAVES + F.wave; l_ent[lr * 2] = row * 2; l_ent[lr * 2 + 1] = row * 2 + 1; l_exp[lr * 2] = gi * 8 + i0; l_exp[lr * 2 + 1] = gi * 8 + i1; }
        }
    }
    if (MODE == 1) {
        __syncthreads();
        const int npair = 2 * rpb; int rank = 0, e = 0;
        if (F.tid < npair) { e = l_exp[F.tid]; rank = atomicAdd((int*)&l_cnt[e], 1); }
        __syncthreads();
        if (F.tid < 32) l_base[F.tid] = (int)atomicAdd(F_ctl + CW_CNT + l * 32 + F.tid, (unsigned)l_cnt[F.tid]);
        __syncthreads();
        if (F.tid < npair) F_LIST[(size_t)e * NT + l_base[e] + rank] = l_ent[F.tid];
        __syncthreads();
    }
}


__device__ __forceinline__ void norm2_router_phase(Frame& F, int l) {
    LAS int* l_ent = (LAS int*)F.lds;
    LAS int* l_exp = l_ent + 256;
    LAS int* l_cnt = l_exp + 256;
    LAS int* l_base = l_cnt + 32;
    LAS float* lgs = (LAS float*)(F.lds + 4096 + F.wave * 3072);
    if (F.tid < 32) l_cnt[F.tid] = 0;
    __syncthreads();
    const int fr = F.lane & 15, fq = F.lane >> 4;
    const int row = F.blk * 128 + F.wave * 16 + fr, b = (F.blk * 128) / SEQ;
    const float* xr = F.out + (size_t)row * DM + fq * 8;
    float ss = 0.f;
#pragma unroll 4
    for (int ks = 0; ks < 32; ++ks) { const f32x4 a = *(const f32x4*)(xr + ks * 32), c = *(const f32x4*)(xr + ks * 32 + 4);
        ss += (a.x * a.x + a.y * a.y) + (a.z * a.z + a.w * a.w) + (c.x * c.x + c.y * c.y) + (c.z * c.z + c.w * c.w); }
    ss += __shfl_xor(ss, 16); ss += __shfl_xor(ss, 32);
    const float rstd = 1.0f / sqrtf(ss * (1.0f / DM) + EPS);
    const float* gp = F_norm2_g + (size_t)l * DM + fq * 8;
    const float* shp = F_MOD + ((size_t)l * NB + b) * 6144 + 3072 + fq * 8; const float* scp = shp + 1024;
    const bf16* wb = F_WRHL + (size_t)l * 2 * 48 * DM + (size_t)fr * DM + fq * 8;
    bf16* hrow = F_H + (size_t)row * DM + fq * 8;
    f32x4 acc[3];
#pragma unroll
    for (int t = 0; t < 3; ++t) acc[t] = (f32x4){0.f, 0.f, 0.f, 0.f};
#pragma unroll 2
    for (int ks = 0; ks < 32; ++ks) {
        const f32x4 a = *(const f32x4*)(xr + ks * 32), c = *(const f32x4*)(xr + ks * 32 + 4);
        const f32x4 g0 = *(const f32x4*)(gp + ks * 32), g1 = *(const f32x4*)(gp + ks * 32 + 4);
        const f32x4 s0 = *(const f32x4*)(scp + ks * 32), s1 = *(const f32x4*)(scp + ks * 32 + 4);
        const f32x4 h0 = *(const f32x4*)(shp + ks * 32), h1 = *(const f32x4*)(shp + ks * 32 + 4);
        const f32x4 v0 = a * rstd * g0 * (s0 + 1.0f) + h0, v1 = c * rstd * g1 * (s1 + 1.0f) + h1;
        u32x4 hi; hi.x = pk2(v0.x, v0.y); hi.y = pk2(v0.z, v0.w); hi.z = pk2(v1.x, v1.y); hi.w = pk2(v1.z, v1.w);
        *(u32x4*)(hrow + ks * 32) = hi;
        u32x4 lo; lo.x = pk2(v0.x - bf2f(hi.x & 0xffffu), v0.y - bf2f(hi.x >> 16)); lo.y = pk2(v0.z - bf2f(hi.y & 0xffffu), v0.w - bf2f(hi.y >> 16));
        lo.z = pk2(v1.x - bf2f(hi.z & 0xffffu), v1.y - bf2f(hi.z >> 16)); lo.w = pk2(v1.z - bf2f(hi.w & 0xffffu), v1.w - bf2f(hi.w >> 16));
        const bf16x8 ahi = __builtin_bit_cast(bf16x8, hi), alo = __builtin_bit_cast(bf16x8, lo);
#pragma unroll
        for (int t = 0; t < 3; ++t) { const bf16x8 bh = *(const bf16x8*)(wb + (size_t)(t * 16) * DM + ks * 32), bl = *(const bf16x8*)(wb + (size_t)(48 + t * 16) * DM + ks * 32);
            acc[t] = __builtin_amdgcn_mfma_f32_16x16x32_bf16(bh, ahi, acc[t], 0, 0, 0);
            acc[t] = __builtin_amdgcn_mfma_f32_16x16x32_bf16(bh, alo, acc[t], 0, 0, 0);
            acc[t] = __builtin_amdgcn_mfma_f32_16x16x32_bf16(bl, ahi, acc[t], 0, 0, 0); }
    }
#pragma unroll
    for (int t = 0; t < 3; ++t)
#pragma unroll
        for (int r = 0; r < 4; ++r) lgs[fr * 48 + t * 16 + 4 * fq + r] = acc[t][r];
    LDS_WAIT(); __builtin_amdgcn_wave_barrier();
    {
        const LAS float* wl = lgs + fr * 48;
        float gl[4];
#pragma unroll
        for (int j = 0; j < 4; ++j) gl[j] = wl[j] + F_b_group[l * 4 + j];
        int gi = 0; float gm = gl[0];
#pragma unroll
        for (int j = 1; j < 4; ++j) if (gl[j] > gm) { gm = gl[j]; gi = j; }
        float gs = 0.f;
#pragma unroll
        for (int j = 0; j < 4; ++j) gs += __expf(gl[j] - gm);
        const float gw = 1.0f / gs;
        float ig[8];
#pragma unroll
        for (int j = 0; j < 8; ++j) ig[j] = wl[4 + gi * 8 + j] + F_b_expert[l * 32 + gi * 8 + j];
        int i0 = 0; float v0 = ig[0];
#pragma unroll
        for (int j = 1; j < 8; ++j) if (ig[j] > v0) { v0 = ig[j]; i0 = j; }
        int i1 = -1; float v1 = -3.0e38f;
#pragma unroll
        for (int j = 0; j < 8; ++j) if (j != i0 && ig[j] > v1) { v1 = ig[j]; i1 = j; }
        const float e1x = __expf(v1 - v0), w0 = gw / (1.0f + e1x), w1 = gw * e1x / (1.0f + e1x);
        if (fq == 0) { F_RW[(size_t)row * 2] = w0; F_RW[(size_t)row * 2 + 1] = w1;
            const int lr = F.wave * 16 + fr; l_ent[lr * 2] = row * 2; l_ent[lr * 2 + 1] = row * 2 + 1; l_exp[lr * 2] = gi * 8 + i0; l_exp[lr * 2 + 1] = gi * 8 + i1; }
    }
    __syncthreads();
    int rank = 0, e = 0;
    if (F.tid < 256) { e = l_exp[F.tid]; rank = atomicAdd((int*)&l_cnt[e], 1); }
    __syncthreads();
    if (F.tid < 32) l_base[F.tid] = (int)atomicAdd(F_ctl + CW_CNT + l * 32 + F.tid, (unsigned)l_cnt[F.tid]);
    __syncthreads();
    if (F.tid < 256) F_LIST[(size_t)e * NT + l_base[e] + rank] = l_ent[F.tid];
    __syncthreads();
}

template <int EPI>
__device__ __forceinline__ void gemm_simple(Frame& F, int l, const bf16* A, int lda, const bf16* Bt, int N, int K) {
    const int fr = F.lane & 15, fq = F.lane >> 4, wm = F.wave >> 1, wn = F.wave & 1;
    const int nnt = N / 128, nu = (NT / 256) * nnt;
    for (int u = F.blk; u < nu; u += F.G) {
        const int pm = u / nnt, pn = u % nnt, m0 = pm * 256 + wm * 64, n0 = pn * 128 + wn * 64;
        const bf16* arow[4]; const bf16* brow[4];
#pragma unroll
        for (int i = 0; i < 4; ++i) { arow[i] = A + (size_t)(m0 + i * 16 + fr) * lda + fq * 8; brow[i] = Bt + (size_t)(n0 + i * 16 + fr) * K + fq * 8; }
        f32x4 acc[4][4];
        wave_gemm64(acc, arow, brow, K);
#pragma unroll
        for (int i = 0; i < 4; ++i) { const int row = m0 + i * 16 + fr;
#pragma unroll
            for (int j = 0; j < 4; ++j) { const int col = n0 + j * 16 + 4 * fq; const f32x4 a = acc[i][j];
                if (EPI == 0) { u32x2 o; o.x = pk2(a.x, a.y); o.y = pk2(a.z, a.w); *(u32x2*)(F_QKV + (size_t)row * INW + col) = o; }
                if (EPI == 1) { const float* xb = (l == 0 ? F_x : F.out); const f32x4 xv = *(const f32x4*)(xb + (size_t)row * DM + col);
                    const f32x4 g1 = *(const f32x4*)(F_MOD + ((size_t)l * NB + row / SEQ) * 6144 + 2048 + col); *(f32x4*)(F.out + (size_t)row * DM + col) = xv + g1 * a; }
                if (EPI == 2) { const u32x2 y = *(const u32x2*)(F_YG + (size_t)row * 256 + col); const f32x4 bg = *(const f32x4*)(F_b_glu + l * 256 + col);
                    const float y0 = bf2f(y.x & 0xffffu), y1 = bf2f(y.x >> 16), y2 = bf2f(y.y & 0xffffu), y3 = bf2f(y.y >> 16);
                    u32x2 o; o.x = pk2(y0 * sigmoid_f(a.x + bg.x), y1 * sigmoid_f(a.y + bg.y)); o.y = pk2(y2 * sigmoid_f(a.z + bg.z), y3 * sigmoid_f(a.w + bg.w));
                    *(u32x2*)(F_MIX + (size_t)row * DM + 512 + col) = o; }
            } }
    }
}

__device__ __forceinline__ void moe_tables(Frame& F, int l) {
    LAS int* t_cnt = (LAS int*)F.lds; LAS int* t_toff = t_cnt + 32; LAS int* t_aoff = t_toff + 34;
    __syncthreads();
    if (F.tid == 0) { int to = 0, ao = 0;
        for (int e = 0; e < NE; ++e) { const int c = (int)__hip_atomic_load(F_ctl + CW_CNT + l * 32 + e, __ATOMIC_RELAXED, __HIP_MEMORY_SCOPE_AGENT); t_cnt[e] = c; t_toff[e] = to; t_aoff[e] = ao; to += (c + 63) >> 6; ao += ((c + 255) >> 8) << 8; }
        t_toff[NE] = to; }
    __syncthreads();
}
template <int STAGE>
__device__ __forceinline__ void moe_simple(Frame& F, int l) {
    LAS int* t_cnt = (LAS int*)F.lds; LAS int* t_toff = t_cnt + 32; LAS int* t_aoff = t_toff + 34;
    moe_tables(F, l);
    const int fr = F.lane & 15, fq = F.lane >> 4;
    constexpr int NSUB = (STAGE == 1) ? 8 : 16;
    const int ntask = t_toff[NE] * NSUB;
    for (int task = F.gw; task < ntask; task += F.ngw) {
        const int rtg = task / NSUB, sub = task % NSUB;
        int e = 0;
        for (int q = 1; q < NE; ++q) if (t_toff[q] <= rtg) e = q;
        const int rt = rtg - t_toff[e], cnt = t_cnt[e], arow0 = t_aoff[e] + rt * 64;
        int ent[4];
#pragma unroll
        for (int i = 0; i < 4; ++i) { const int pos = rt * 64 + i * 16 + fr; ent[i] = pos < cnt ? F_LIST[(size_t)e * NT + pos] : -1; }
        const bf16* arow[4]; const bf16* brow[4];
        f32x4 acc[4][4];
        if (STAGE == 1) {
            const bf16* wb = F_WguT + (size_t)(l * NE + e) * 512 * DM;
#pragma unroll
            for (int i = 0; i < 4; ++i) { const int tok = ent[i] >= 0 ? (ent[i] >> 1) : 0; arow[i] = F_H + (size_t)tok * DM + fq * 8;
                const int f = sub * 32 + (i & 1) * 16 + fr; const int br = (f >> 7) * 256 + (i >> 1) * 128 + (f & 127); brow[i] = wb + (size_t)br * DM + fq * 8; }
            wave_gemm64(acc, arow, brow, DM);
#pragma unroll
            for (int i = 0; i < 4; ++i) { const float w = ent[i] >= 0 ? F_RW[ent[i]] : 0.f;
#pragma unroll
                for (int j = 0; j < 2; ++j) { const f32x4 g = acc[i][j], u = acc[i][j + 2];
                    u32x2 o; o.x = pk2(silu_f(g.x) * u.x * w, silu_f(g.y) * u.y * w); o.y = pk2(silu_f(g.z) * u.z * w, silu_f(g.w) * u.w * w);
                    *(u32x2*)(F_ACT + (size_t)(arow0 + i * 16 + fr) * FF + sub * 32 + j * 16 + 4 * fq) = o; } }
        } else {
            const bf16* wb = F_WdT + (size_t)(l * NE + e) * DM * FF;
#pragma unroll
            for (int i = 0; i < 4; ++i) { arow[i] = F_ACT + (size_t)(arow0 + i * 16 + fr) * FF + fq * 8; brow[i] = wb + (size_t)(sub * 64 + i * 16 + fr) * FF + fq * 8; }
            wave_gemm64(acc, arow, brow, FF);
#pragma unroll
            for (int i = 0; i < 4; ++i) { if (ent[i] >= 0) { bf16* orow = F_SLOT + (size_t)(ent[i] & 1) * NT * DM + (size_t)(ent[i] >> 1) * DM + sub * 64 + 4 * fq;
#pragma unroll
                for (int j = 0; j < 4; ++j) { const f32x4 a = acc[i][j]; u32x2 o; o.x = pk2(a.x, a.y); o.y = pk2(a.z, a.w); *(u32x2*)(orow + j * 16) = o; } } }
        }
    }
}


constexpr int MOE_LDS = 131072;
constexpr int MOE_MAXU = 8;
struct MoeOrder {
    LAS const int* ud; LAS const int* rows; const char* A; const char* Bt; size_t strideE, tstepA, tstepB; bool gather;
    __device__ __forceinline__ bool next(int i, pg8::Unit& u) const { if (i >= MOE_MAXU || ud[i * 4 + 3] == 0) return false; u.pm = ud[i * 4]; u.pn = ud[i * 4 + 1]; u.e = ud[i * 4 + 2]; u.i = i; return true; }
    __device__ __forceinline__ const char* a_base(const pg8::Unit& u) const { return gather ? A : A + (size_t)u.pm * tstepA; }
    __device__ __forceinline__ const char* b_base(const pg8::Unit& u) const { return Bt + (size_t)u.e * strideE + (size_t)u.pn * tstepB; }
    __device__ __forceinline__ int row(const pg8::Unit& u, int r) const { if (!gather) return r; const int ent = rows[u.i * 256 + r]; return ent >= 0 ? (ent >> 1) : 0; }
};
struct EpiMoe1 {
    static constexpr bool PERM = true;
    bf16* act; const float* rw; LAS const int* rows;
    __device__ __forceinline__ void operator()(const f32x4 (&acc)[2][2][4][2], const pg8::Unit& u, int wr, int wc, int fr, int fq) const {
#pragma unroll
        for (int ai = 0; ai < 2; ++ai)
#pragma unroll
            for (int m = 0; m < 4; ++m) { const int rl = ai * 128 + wr * 64 + m * 16 + fr; const int ent = rows[u.i * 256 + rl]; const float w = ent >= 0 ? rw[ent] : 0.f;
                const f32x4 g0 = acc[ai][0][m][0], g1 = acc[ai][0][m][1], u0 = acc[ai][1][m][0], u1 = acc[ai][1][m][1];
                u32x4 o; o.x = pg8::cvt_pk_bf16(silu_f(g0[0]) * u0[0] * w, silu_f(g0[1]) * u0[1] * w); o.y = pg8::cvt_pk_bf16(silu_f(g0[2]) * u0[2] * w, silu_f(g0[3]) * u0[3] * w);
                o.z = pg8::cvt_pk_bf16(silu_f(g1[0]) * u1[0] * w, silu_f(g1[1]) * u1[1] * w); o.w = pg8::cvt_pk_bf16(silu_f(g1[2]) * u1[2] * w, silu_f(g1[3]) * u1[3] * w);
                *(u32x4*)(act + ((size_t)u.pm * 256 + rl) * FF + u.pn * 128 + wc * 32 + 8 * fq) = o; }
    }
};
struct EpiMoe2 {
    static constexpr bool PERM = true;
    bf16* slot; LAS const int* rows;
    __device__ __forceinline__ void operator()(const f32x4 (&acc)[2][2][4][2], const pg8::Unit& u, int wr, int wc, int fr, int fq) const {
#pragma unroll
        for (int ai = 0; ai < 2; ++ai)
#pragma unroll
            for (int m = 0; m < 4; ++m) { const int rl = ai * 128 + wr * 64 + m * 16 + fr; const int ent = rows[u.i * 256 + rl];
                if (ent >= 0) { bf16* rowp = slot + (size_t)(ent & 1) * NT * DM + (size_t)(ent >> 1) * DM + u.pn * 256 + wc * 32 + 8 * fq;
#pragma unroll
                    for (int bj = 0; bj < 2; ++bj) { const f32x4 v0 = acc[ai][bj][m][0], v1 = acc[ai][bj][m][1];
                        u32x4 w; w.x = pg8::cvt_pk_bf16(v0[0], v0[1]); w.y = pg8::cvt_pk_bf16(v0[2], v0[3]); w.z = pg8::cvt_pk_bf16(v1[0], v1[1]); w.w = pg8::cvt_pk_bf16(v1[2], v1[3]);
                        *(u32x4*)(rowp + bj * 128) = w; } } }
    }
};
template <int STAGE>
__device__ __forceinline__ void moe_pg8(Frame& F, int l) {
    LAS int* t_cnt = (LAS int*)(F.lds + MOE_LDS);
    LAS int* t_toff = t_cnt + 32;
    LAS int* ud = t_toff + 36;
    LAS int* rows = ud + 32;
    constexpr int NPN = (STAGE == 1) ? 2 : 4;
    __syncthreads();
    if (F.tid == 0) { int to = 0;
        for (int e = 0; e < NE; ++e) { const int c = (int)__hip_atomic_load(F_ctl + CW_CNT + l * 32 + e, __ATOMIC_RELAXED, __HIP_MEMORY_SCOPE_AGENT); t_cnt[e] = c; t_toff[e] = to; to += (c + 255) >> 8; }
        t_toff[NE] = to; }
    __syncthreads();
    const int total = t_toff[NE] * NPN;
    for (int i = 0; i < MOE_MAXU; ++i) {
        const int L = i * F.G + F.blk; const bool valid = L < total;
        int rtg = 0, pn = 0, e = 0;
        if (valid) { rtg = L / NPN; pn = L % NPN; for (int q = 1; q < NE; ++q) if (t_toff[q] <= rtg) e = q; }
        if (F.tid == 0) { ud[i * 4] = rtg; ud[i * 4 + 1] = pn; ud[i * 4 + 2] = e; ud[i * 4 + 3] = valid ? 1 : 0; }
        if (F.tid < 256) { int ent = -1; if (valid) { const int pos = (rtg - t_toff[e]) * 256 + F.tid; if (pos < t_cnt[e]) ent = F_LIST[(size_t)e * NT + pos]; } rows[i * 256 + F.tid] = ent; }
    }
    __syncthreads();
    MoeOrder S; S.ud = ud; S.rows = rows;
    if (STAGE == 1) { S.A = (const char*)F_H; S.Bt = (const char*)(F_WguT + (size_t)l * NE * 512 * DM); S.strideE = (size_t)512 * DM * 2; S.tstepA = 0; S.tstepB = (size_t)256 * DM * 2; S.gather = true;
        EpiMoe1 E{F_ACT, F_RW, rows};
        pg8::gemm_phase<EpiMoe1, MoeOrder, true>(F.lds, DM, DM, DM, S, E);
    } else { S.A = (const char*)F_ACT; S.Bt = (const char*)(F_WdT + (size_t)l * NE * DM * FF); S.strideE = (size_t)DM * FF * 2; S.tstepA = (size_t)256 * FF * 2; S.tstepB = (size_t)256 * FF * 2; S.gather = false;
        EpiMoe2 E{F_SLOT, rows};
        pg8::gemm_phase<EpiMoe2, MoeOrder, false>(F.lds, FF, FF, FF, S, E);
    }
}

__device__ __forceinline__ float ret_log2gamma(int h) { return log2f(1.0f - exp2f(-5.0f - (float)h)); }

__device__ __forceinline__ void p3_local(Frame& F, int l) {
    {
        LAS float* ks = (LAS float*)F.lds;
        LAS float* vs = ks + 64 * 65;
        for (int u = F.blk; u < NB * NCH * 4; u += F.G) {
            const int h = u & 3, n = (u >> 2) & 63, b = u >> 8; const float lg = ret_log2gamma(h);
            const size_t row0 = (size_t)b * SEQ + n * 64;
            __syncthreads();
#pragma unroll
            for (int q = 0; q < 4; ++q) { const int idx = F.tid + q * NTHR, j = idx >> 5, d = idx & 31;
                const bf16* kp = F_QKV + (row0 + j) * INW + C_KR + h * 64; const float k1 = bf2f(kp[d]), k2 = bf2f(kp[d + 32]);
                const f32x2 cs = F_ROPE[(n * 64 + j) * 32 + d]; const float z = 0.125f * exp2f(lg * (float)(63 - j));
                ks[j * 65 + d] = (k1 * cs.x - k2 * cs.y) * z; ks[j * 65 + d + 32] = (k1 * cs.y + k2 * cs.x) * z; }
#pragma unroll
            for (int q = 0; q < 8; ++q) { const int idx = F.tid + q * NTHR, j = idx >> 6, e = idx & 63; vs[j * 65 + e] = bf2f(F_QKV[(row0 + j) * INW + C_VR + h * 64 + e]); }
            __syncthreads();
            const int d = F.tid >> 3, e0 = (F.tid & 7) * 8; float acc[8];
#pragma unroll
            for (int q = 0; q < 8; ++q) acc[q] = 0.f;
            for (int j = 0; j < 64; ++j) { const float kd = ks[j * 65 + d];
#pragma unroll
                for (int q = 0; q < 8; ++q) acc[q] += kd * vs[j * 65 + e0 + q]; }
            float* o = F_KV + ((size_t)((b * NCH + n) * 4 + h)) * 4096 + d * 64 + e0;
#pragma unroll
            for (int q = 0; q < 8; ++q) o[q] = acc[q];
        }
        __syncthreads();
    }
    for (int u = F.gw; u < NB * NCH * 16; u += F.ngw) {
        const int g = u & 15, n = (u >> 4) & 63, b = u >> 10, p = F.lane;
        const f32x2 ab = F_ABAR[(l * 16 + g) * 64 + p]; f32x2 bb[16];
#pragma unroll
        for (int c = 0; c < 16; ++c) bb[c] = F_BBAR[((size_t)(l * 16 + g) * 64 + p) * 16 + c];
        float xr = 0.f, xi = 0.f;
        const bf16* up = F_QKV + ((size_t)b * SEQ + n * 64) * INW + C_US + g * 16;
        for (int s = 0; s < 64; ++s) { const u32x4 a = *(const u32x4*)(up + (size_t)s * INW), c4 = *(const u32x4*)(up + (size_t)s * INW + 8);
            const unsigned w[8] = {a.x, a.y, a.z, a.w, c4.x, c4.y, c4.z, c4.w}; float br = 0.f, bi = 0.f;
#pragma unroll
            for (int q = 0; q < 8; ++q) { const float u0 = bf2f(w[q] & 0xffffu), u1 = bf2f(w[q] >> 16); br += bb[2 * q].x * u0 + bb[2 * q + 1].x * u1; bi += bb[2 * q].y * u0 + bb[2 * q + 1].y * u1; }
            const float nr = ab.x * xr - ab.y * xi + br, ni = ab.x * xi + ab.y * xr + bi; xr = nr; xi = ni; }
        F_SEND[(size_t)u * 64 + p] = (f32x2){xr, xi};
    }
}

template <int NQT> __device__ __forceinline__ void attn_mfma(Frame& F, int l);
__device__ __forceinline__ void p4_scan_attn(Frame& F, int l) {
    for (int i = F.blk * NTHR + F.tid; i < NB * 16 * 64; i += F.G * NTHR) { const int b = i >> 10, gp = i & 1023; const f32x2 a64 = F_ABAR64[l * 1024 + gp];
        float xr = 0.f, xi = 0.f;
        for (int n = 0; n < NCH; ++n) { const size_t idx = ((size_t)(b * NCH + n)) * 1024 + gp; F_XS[idx] = (f32x2){xr, xi}; const f32x2 s = F_SEND[idx];
            const float nr = a64.x * xr - a64.y * xi + s.x, ni = a64.x * xi + a64.y * xr + s.y; xr = nr; xi = ni; } }
    for (int i = F.blk * NTHR + F.tid; i < NB * 4 * 4096; i += F.G * NTHR) { const int b = i >> 14, h = (i >> 12) & 3, de = i & 4095; const float g64 = exp2f(64.f * ret_log2gamma(h));
        float s = 0.f;
        for (int n = 0; n < NCH; ++n) { float* p = F_KV + ((size_t)((b * NCH + n) * 4 + h)) * 4096 + de; const float t = *p; *p = s; s = g64 * s + t; } }
#if ATTN_NQT > 0
    attn_mfma<ATTN_NQT>(F, l);
#else
    for (int u = F.gw; u < NB * NCH * 8; u += F.ngw) {
        const int h = u & 7, n = (u >> 3) & 63, b = u >> 9, qi = F.lane;
        const size_t qrow = (size_t)b * SEQ + n * 64 + qi;
        float q[64], o[64];
        { const u32x4* qp = (const u32x4*)(F_QKV + qrow * INW + C_QA + h * 64);
#pragma unroll
            for (int c = 0; c < 8; ++c) { const u32x4 w = qp[c]; q[8 * c] = 0.125f * bf2f(w.x & 0xffffu); q[8 * c + 1] = 0.125f * bf2f(w.x >> 16); q[8 * c + 2] = 0.125f * bf2f(w.y & 0xffffu); q[8 * c + 3] = 0.125f * bf2f(w.y >> 16);
                q[8 * c + 4] = 0.125f * bf2f(w.z & 0xffffu); q[8 * c + 5] = 0.125f * bf2f(w.z >> 16); q[8 * c + 6] = 0.125f * bf2f(w.w & 0xffffu); q[8 * c + 7] = 0.125f * bf2f(w.w >> 16); } }
#pragma unroll
        for (int d = 0; d < 64; ++d) o[d] = 0.f;
        float m = -1.0e30f, ls = 0.f;
        const float* bias = F_rel_bias + (size_t)(l * 8 + h) * 192;
        const int kc0 = n >= 8 ? n - 8 : 0;
        for (int kk = kc0 * 64; kk < (n + 1) * 64; ++kk) {
            const bf16* kr = F_QKV + ((size_t)b * SEQ + kk) * INW + C_KA + h * 64;
            float dot = 0.f;
#pragma unroll
            for (int c = 0; c < 8; ++c) { const u32x4 w = ((const u32x4*)kr)[c];
                dot += q[8 * c] * bf2f(w.x & 0xffffu) + q[8 * c + 1] * bf2f(w.x >> 16) + q[8 * c + 2] * bf2f(w.y & 0xffffu) + q[8 * c + 3] * bf2f(w.y >> 16)
                     + q[8 * c + 4] * bf2f(w.z & 0xffffu) + q[8 * c + 5] * bf2f(w.z >> 16) + q[8 * c + 6] * bf2f(w.w & 0xffffu) + q[8 * c + 7] * bf2f(w.w >> 16); }
            int rel = kk - (n * 64 + qi); rel = rel < -128 ? -128 : (rel > 63 ? 63 : rel);
            const float s = dot + bias[rel + 128];
            if (s > m) { const float sc = __expf(m - s); ls *= sc;
#pragma unroll
                for (int d = 0; d < 64; ++d) o[d] *= sc;
                m = s; }
            const float p = __expf(s - m); ls += p;
            const bf16* vr = F_QKV + ((size_t)b * SEQ + kk) * INW + C_VA + h * 64;
#pragma unroll
            for (int c = 0; c < 8; ++c) { const u32x4 w = ((const u32x4*)vr)[c];
                o[8 * c] += p * bf2f(w.x & 0xffffu); o[8 * c + 1] += p * bf2f(w.x >> 16); o[8 * c + 2] += p * bf2f(w.y & 0xffffu); o[8 * c + 3] += p * bf2f(w.y >> 16);
                o[8 * c + 4] += p * bf2f(w.z & 0xffffu); o[8 * c + 5] += p * bf2f(w.z >> 16); o[8 * c + 6] += p * bf2f(w.w & 0xffffu); o[8 * c + 7] += p * bf2f(w.w >> 16); }
        }
        const float inv = 1.0f / ls;
        u32x4* op = (u32x4*)(F_MIX + qrow * DM + h * 64);
#pragma unroll
        for (int c = 0; c < 8; ++c) { u32x4 w; w.x = pk2(o[8 * c] * inv, o[8 * c + 1] * inv); w.y = pk2(o[8 * c + 2] * inv, o[8 * c + 3] * inv); w.z = pk2(o[8 * c + 4] * inv, o[8 * c + 5] * inv); w.w = pk2(o[8 * c + 6] * inv, o[8 * c + 7] * inv); op[c] = w; }
    }
#endif
}


typedef short v4i16_t __attribute__((ext_vector_type(4)));
template <int NQT>
__device__ __forceinline__ void attn_mfma(Frame& F, int l) {
    const int lane = F.lane, fr = lane & 15, fq = lane >> 4;
    LAS unsigned char* vl = F.lds + F.wave * 10240;
    LAS float* bl = (LAS float*)(vl + 9216);
    constexpr int QPW = NQT * 16, TPC = 64 / QPW;
    constexpr float LOG2E = 1.4426950408889634f, SC = 0.125f * LOG2E;
    const int ntask = NB * NCH * 8 * TPC;
    const unsigned vtr0 = (unsigned)((4 * fq + (fr >> 2)) * 144 + (fr & 3) * 8);
    for (int task = F.gw; task < ntask; task += F.ngw) {
        const int sub = task % TPC, u = task / TPC, h = u & 7, n = (u >> 3) & 63, b = u >> 9;
        const size_t qrow0 = (size_t)b * SEQ + n * 64 + sub * QPW;
        __builtin_amdgcn_wave_barrier();
#pragma unroll
        for (int i = 0; i < 3; ++i) bl[lane + 64 * i] = F_rel_bias[(size_t)(l * 8 + h) * 192 + lane + 64 * i] * LOG2E;
        bf16x8 qf[NQT][2];
#pragma unroll
        for (int qt = 0; qt < NQT; ++qt)
#pragma unroll
            for (int ks = 0; ks < 2; ++ks) qf[qt][ks] = *(const bf16x8*)(F_QKV + (qrow0 + qt * 16 + fr) * INW + C_QA + h * 64 + ks * 32 + fq * 8);
        f32x4 ot[4][NQT]; float mrow[NQT], lp[NQT];
#pragma unroll
        for (int qt = 0; qt < NQT; ++qt) { mrow[qt] = -1.0e30f; lp[qt] = 0.f;
#pragma unroll
            for (int et = 0; et < 4; ++et) ot[et][qt] = (f32x4){0.f, 0.f, 0.f, 0.f}; }
        LDS_WAIT(); __builtin_amdgcn_wave_barrier();
        const float b0 = bl[0];
        const int kc0 = n >= 8 ? n - 8 : 0;
        for (int kc = kc0; kc <= n; ++kc) {
            const size_t krow0 = (size_t)b * SEQ + kc * 64;
            u32x4 vreg[8];
#pragma unroll
            for (int i = 0; i < 8; ++i) vreg[i] = *(const u32x4*)(F_QKV + (krow0 + (lane >> 3) + 8 * i) * INW + C_VA + h * 64 + (lane & 7) * 8);
            f32x4 st[4][NQT];
#pragma unroll
            for (int kt = 0; kt < 4; ++kt) { const bf16* kp = F_QKV + (krow0 + kt * 16 + fr) * INW + C_KA + h * 64 + fq * 8;
                const bf16x8 k0 = *(const bf16x8*)kp, k1 = *(const bf16x8*)(kp + 32);
#pragma unroll
                for (int qt = 0; qt < NQT; ++qt) { f32x4 z = (f32x4){0.f, 0.f, 0.f, 0.f};
                    z = __builtin_amdgcn_mfma_f32_16x16x32_bf16(k0, qf[qt][0], z, 0, 0, 0); st[kt][qt] = __builtin_amdgcn_mfma_f32_16x16x32_bf16(k1, qf[qt][1], z, 0, 0, 0); } }
            const int dc = kc - n;
            if (dc <= -3) {
#pragma unroll
                for (int kt = 0; kt < 4; ++kt)
#pragma unroll
                    for (int qt = 0; qt < NQT; ++qt) st[kt][qt] = st[kt][qt] * SC + b0;
            } else {
                const int ib = 64 * dc + 128 + 4 * fq - fr + sub * (-QPW);
#pragma unroll
                for (int kt = 0; kt < 4; ++kt)
#pragma unroll
                    for (int qt = 0; qt < NQT; ++qt)
#pragma unroll
                        for (int r = 0; r < 4; ++r) { int idx = ib + 16 * (kt - qt) + r; idx = idx < 0 ? 0 : idx; st[kt][qt][r] = st[kt][qt][r] * SC + bl[idx]; }
            }
#pragma unroll
            for (int qt = 0; qt < NQT; ++qt) {
                float mx = st[0][qt][0];
#pragma unroll
                for (int kt = 0; kt < 4; ++kt)
#pragma unroll
                    for (int r = 0; r < 4; ++r) mx = fmaxf(mx, st[kt][qt][r]);
                mx = fmaxf(mx, __shfl_xor(mx, 16)); mx = fmaxf(mx, __shfl_xor(mx, 32));
                const float mnew = fmaxf(mrow[qt], mx), alpha = exp2f(mrow[qt] - mnew); mrow[qt] = mnew;
                float ps = 0.f;
#pragma unroll
                for (int kt = 0; kt < 4; ++kt)
#pragma unroll
                    for (int r = 0; r < 4; ++r) { const float p = exp2f(st[kt][qt][r] - mnew); st[kt][qt][r] = p; ps += p; }
                lp[qt] = lp[qt] * alpha + ps;
#pragma unroll
                for (int et = 0; et < 4; ++et) ot[et][qt] = ot[et][qt] * alpha;
            }
            __builtin_amdgcn_wave_barrier();
#pragma unroll
            for (int i = 0; i < 8; ++i) *(LAS u32x4*)(vl + ((lane >> 3) + 8 * i) * 144 + (lane & 7) * 16) = vreg[i];
            LDS_WAIT(); __builtin_amdgcn_wave_barrier();
#pragma unroll
            for (int s = 0; s < 2; ++s) {
                bf16x8 pf[NQT];
#pragma unroll
                for (int qt = 0; qt < NQT; ++qt) { u32x4 w; w.x = pk2(st[2 * s][qt][0], st[2 * s][qt][1]); w.y = pk2(st[2 * s][qt][2], st[2 * s][qt][3]);
                    w.z = pk2(st[2 * s + 1][qt][0], st[2 * s + 1][qt][1]); w.w = pk2(st[2 * s + 1][qt][2], st[2 * s + 1][qt][3]); pf[qt] = __builtin_bit_cast(bf16x8, w); }
#pragma unroll
                for (int et = 0; et < 4; ++et) {
                    const v4i16_t t0 = __builtin_amdgcn_ds_read_tr16_b64_v4i16((LAS v4i16_t*)(vl + vtr0 + (2 * s) * 16 * 144 + et * 32));
                    const v4i16_t t1 = __builtin_amdgcn_ds_read_tr16_b64_v4i16((LAS v4i16_t*)(vl + vtr0 + (2 * s + 1) * 16 * 144 + et * 32));
                    bf16x8 vf; vf[0] = t0[0]; vf[1] = t0[1]; vf[2] = t0[2]; vf[3] = t0[3]; vf[4] = t1[0]; vf[5] = t1[1]; vf[6] = t1[2]; vf[7] = t1[3];
#pragma unroll
                    for (int qt = 0; qt < NQT; ++qt) ot[et][qt] = __builtin_amdgcn_mfma_f32_16x16x32_bf16(vf, pf[qt], ot[et][qt], 0, 0, 0);
                }
            }
        }
#pragma unroll
        for (int qt = 0; qt < NQT; ++qt) { float ls = lp[qt]; ls += __shfl_xor(ls, 16); ls += __shfl_xor(ls, 32); const float inv = 1.0f / ls;
            bf16* op = F_MIX + (qrow0 + qt * 16 + fr) * DM + h * 64 + 4 * fq;
#pragma unroll
            for (int et = 0; et < 4; ++et) { const f32x4 o = ot[et][qt] * inv; u32x2 w; w.x = pk2(o.x, o.y); w.y = pk2(o.z, o.w); *(u32x2*)(op + et * 16) = w; } }
    }
}

__device__ __forceinline__ void p5_out(Frame& F, int l) {
    {
        LAS float* qs = (LAS float*)F.lds;
        LAS float* ks = qs + 64 * 65;
        LAS float* vs = ks + 64 * 65;
        LAS float* ps = vs + 64 * 65;
        LAS float* pp = ps + 64 * 65;
        for (int u = F.blk; u < NB * NCH * 4; u += F.G) {
            const int h = u & 3, n = (u >> 2) & 63, b = u >> 8; const float lg = ret_log2gamma(h);
            const size_t row0 = (size_t)b * SEQ + n * 64;
            __syncthreads();
#pragma unroll
            for (int q = 0; q < 4; ++q) { const int idx = F.tid + q * NTHR, j = idx >> 5, d = idx & 31; const f32x2 cs = F_ROPE[(n * 64 + j) * 32 + d];
                const bf16* kp = F_QKV + (row0 + j) * INW + C_KR + h * 64; const float k1 = bf2f(kp[d]), k2 = bf2f(kp[d + 32]);
                ks[j * 65 + d] = (k1 * cs.x - k2 * cs.y) * 0.125f; ks[j * 65 + d + 32] = (k1 * cs.y + k2 * cs.x) * 0.125f;
                const bf16* qp = F_QKV + (row0 + j) * INW + C_QR + h * 64; const float q1 = bf2f(qp[d]), q2 = bf2f(qp[d + 32]);
                qs[j * 65 + d] = q1 * cs.x - q2 * cs.y; qs[j * 65 + d + 32] = q1 * cs.y + q2 * cs.x; }
            const float* prev = F_KV + ((size_t)((b * NCH + n) * 4 + h)) * 4096;
#pragma unroll
            for (int q = 0; q < 8; ++q) { const int idx = F.tid + q * NTHR, j = idx >> 6, e = idx & 63; vs[j * 65 + e] = bf2f(F_QKV[(row0 + j) * INW + C_VR + h * 64 + e]); ps[j * 65 + e] = prev[idx]; }
            __syncthreads();
            const int i = F.tid >> 3, c0 = (F.tid & 7) * 8;
            { float acc[8];
#pragma unroll
                for (int q = 0; q < 8; ++q) acc[q] = 0.f;
                for (int d = 0; d < 64; ++d) { const float qd = qs[i * 65 + d];
#pragma unroll
                    for (int q = 0; q < 8; ++q) acc[q] += qd * ks[(c0 + q) * 65 + d]; }
#pragma unroll
                for (int q = 0; q < 8; ++q) { const int j = c0 + q; pp[i * 65 + j] = (i >= j) ? acc[q] * exp2f(lg * (float)(i - j)) : 0.f; } }
            __syncthreads();
            float y[8], cr[8];
#pragma unroll
            for (int q = 0; q < 8; ++q) { y[q] = 0.f; cr[q] = 0.f; }
            for (int j = 0; j < 64; ++j) { const float pj = pp[i * 65 + j], qd = qs[i * 65 + j];
#pragma unroll
                for (int q = 0; q < 8; ++q) { y[q] += pj * vs[j * 65 + c0 + q]; cr[q] += qd * ps[j * 65 + c0 + q]; } }
            const float xi = exp2f(lg * (float)(i + 1)); float s = 0.f;
#pragma unroll
            for (int q = 0; q < 8; ++q) { y[q] += xi * cr[q]; s += y[q]; }
            s += __shfl_xor(s, 1); s += __shfl_xor(s, 2); s += __shfl_xor(s, 4);
            const float mu = s * (1.0f / 64.0f); float vq = 0.f;
#pragma unroll
            for (int q = 0; q < 8; ++q) { y[q] -= mu; vq += y[q] * y[q]; }
            vq += __shfl_xor(vq, 1); vq += __shfl_xor(vq, 2); vq += __shfl_xor(vq, 4);
            const float rstd = 1.0f / sqrtf(vq * (1.0f / 64.0f) + EPS);
            const bf16* gp = F_QKV + (row0 + i) * INW + C_GR + h * 64 + c0; const u32x4 gw = *(const u32x4*)gp;
            const float gt[8] = {bf2f(gw.x & 0xffffu), bf2f(gw.x >> 16), bf2f(gw.y & 0xffffu), bf2f(gw.y >> 16), bf2f(gw.z & 0xffffu), bf2f(gw.z >> 16), bf2f(gw.w & 0xffffu), bf2f(gw.w >> 16)};
            float r[8];
#pragma unroll
            for (int q = 0; q < 8; ++q) r[q] = silu_f(gt[q]) * (y[q] * rstd * F_gn_g[l * 256 + h * 64 + c0 + q]);
            u32x4 w; w.x = pk2(r[0], r[1]); w.y = pk2(r[2], r[3]); w.z = pk2(r[4], r[5]); w.w = pk2(r[6], r[7]);
            *(u32x4*)(F_MIX + (row0 + i) * DM + 768 + h * 64 + c0) = w;
        }
        __syncthreads();
    }
    {
        LAS f32x2* xs = (LAS f32x2*)(F.lds + F.wave * 16640);
        for (int u = F.gw; u < NB * NCH * 16; u += F.ngw) {
            const int g = u & 15, n = (u >> 4) & 63, b = u >> 10, p = F.lane;
            const f32x2 ab = F_ABAR[(l * 16 + g) * 64 + p]; f32x2 bb[16];
#pragma unroll
            for (int c = 0; c < 16; ++c) bb[c] = F_BBAR[((size_t)(l * 16 + g) * 64 + p) * 16 + c];
            const f32x2 x0 = F_XS[(size_t)u * 64 + p]; float xr = x0.x, xi = x0.y;
            const bf16* up = F_QKV + ((size_t)b * SEQ + n * 64) * INW + C_US + g * 16;
            for (int half = 0; half < 2; ++half) {
                for (int t = 0; t < 32; ++t) { const int s = half * 32 + t;
                    const u32x4 a = *(const u32x4*)(up + (size_t)s * INW), c4 = *(const u32x4*)(up + (size_t)s * INW + 8);
                    const unsigned w[8] = {a.x, a.y, a.z, a.w, c4.x, c4.y, c4.z, c4.w}; float br = 0.f, bi = 0.f;
#pragma unroll
                    for (int q = 0; q < 8; ++q) { const float u0 = bf2f(w[q] & 0xffffu), u1 = bf2f(w[q] >> 16); br += bb[2 * q].x * u0 + bb[2 * q + 1].x * u1; bi += bb[2 * q].y * u0 + bb[2 * q + 1].y * u1; }
                    const float nr = ab.x * xr - ab.y * xi + br, ni = ab.x * xi + ab.y * xr + bi; xr = nr; xi = ni;
                    xs[t * 65 + p] = (f32x2){xr, xi}; }
                LDS_WAIT(); __builtin_amdgcn_wave_barrier();
                const int t = F.lane >> 1, c0 = (F.lane & 1) * 8, s = half * 32 + t;
                float y[8];
#pragma unroll
                for (int q = 0; q < 8; ++q) y[q] = 0.f;
                const float* cre = F_c_re + ((size_t)(l * 16 + g) * 16 + c0) * 64; const float* cim = F_c_im + ((size_t)(l * 16 + g) * 16 + c0) * 64;
                for (int pp = 0; pp < 64; ++pp) { const f32x2 xv = xs[t * 65 + pp];
#pragma unroll
                    for (int q = 0; q < 8; ++q) y[q] += cre[q * 64 + pp] * xv.x - cim[q * 64 + pp] * xv.y; }
                const u32x4 uw = *(const u32x4*)(up + (size_t)s * INW + c0);
                const float uu[8] = {bf2f(uw.x & 0xffffu), bf2f(uw.x >> 16), bf2f(uw.y & 0xffffu), bf2f(uw.y >> 16), bf2f(uw.z & 0xffffu), bf2f(uw.z >> 16), bf2f(uw.w & 0xffffu), bf2f(uw.w >> 16)};
                float r[8];
#pragma unroll
                for (int q = 0; q < 8; ++q) r[q] = gelu_tanh_f(y[q] + F_ssm_d[l * 256 + g * 16 + c0 + q] * uu[q]);
                u32x4 w; w.x = pk2(r[0], r[1]); w.y = pk2(r[2], r[3]); w.z = pk2(r[4], r[5]); w.w = pk2(r[6], r[7]);
                *(u32x4*)(F_YG + ((size_t)b * SEQ + n * 64 + s) * 256 + g * 16 + c0) = w;
                LDS_WAIT(); __builtin_amdgcn_wave_barrier();
            }
        }
    }
}

struct Args { const float* in[28]; float* out; unsigned char* ws; int ph_lo, ph_hi; };
constexpr int NPHASE = 2 + NL * 10;

__global__ void __launch_bounds__(NTHR, 2) fwd_kernel(Args args) {
    extern __shared__ __attribute__((aligned(16))) unsigned char lds[];
    Frame F;
    F.lds = (LAS unsigned char*)lds;
    F.tid = threadIdx.x; F.lane = F.tid & 63; F.wave = __builtin_amdgcn_readfirstlane(F.tid >> 6); F.blk = blockIdx.x; F.G = gridDim.x;
    F.gw = F.blk * NWAVES + F.wave; F.ngw = F.G * NWAVES;
    F.out = args.out; F.ws = args.ws;
    F.ptab = (LAS unsigned long long*)(F.lds + LDS_BYTES - 64 - 256);
    if (F.tid == 0) {
#pragma unroll
        for (int i = 0; i < 28; ++i) F.ptab[i] = (unsigned long long)args.in[i];
    }
    LAS unsigned* misc = (LAS unsigned*)(F.lds + LDS_BYTES - 64);
    if (F.tid < 16) misc[F.tid] = 0u;
    __syncthreads();
    const int lo = args.ph_lo, hi = args.ph_hi;
    XcdBarrier bar; bar.bar = F_ctl + CW_BAR; bar.x = 0; bar.st = nullptr;
    if (hi - lo > 1) bar = xcd_barrier_post(F_ctl + CW_BAR, (volatile LAS unsigned*)misc);
#ifndef PH_ONLY
#define PH_ONLY -1
#endif
#define PSEL(j) (PH_ONLY < 0 || PH_ONLY == (j))
#define IN(k) (lo <= (k) && (k) < hi)
#define SEAM(k) do { if (IN(k) && IN((k) + 1)) xcd_barrier(bar); { int _t = threadIdx.x; asm volatile("" : "+v"(_t)); F.tid = _t; F.lane = _t & 63; asm volatile("" : "+s"(F.ws), "+s"(F.out)); asm volatile("" : "+s"(F.gw), "+s"(F.ngw), "+s"(F.blk), "+s"(F.G), "+s"(F.wave)); } } while (0)

    if (IN(0) && PSEL(10)) { p0_prologue(F); } SEAM(0);
    for (int l = 0; l < NL; ++l) {
        const int p = 1 + 10 * l;
        if (IN(p + 0) && PSEL(0)) { norm_phase<0>(F, l); } SEAM(p + 0);
        if (IN(p + 1) && PSEL(1)) { pg8::StaticOrder S; S.init(F_H, DM, F_WinT + (size_t)l * INW * DM, DM, NT, INW, F.G, F.blk); EpiQKV E{F_QKV};
            pg8::gemm_phase<EpiQKV, pg8::StaticOrder, false>(F.lds, DM, DM, DM, S, E); } SEAM(p + 1);
        if (IN(p + 2) && PSEL(2)) { p3_local(F, l); } SEAM(p + 2);
        if (IN(p + 3) && PSEL(3)) { p4_scan_attn(F, l); } SEAM(p + 3);
        if (IN(p + 4) && PSEL(4)) { p5_out(F, l); } SEAM(p + 4);
        if (IN(p + 5) && PSEL(5)) { gemm_simple<2>(F, l, F_YG, 256, F_WgluT + (size_t)l * 256 * 256, 256, 256); } SEAM(p + 5);
        if (IN(p + 6) && PSEL(6)) { pg8::StaticOrder S; S.init(F_MIX, DM, F_WoutT + (size_t)l * DM * DM, DM, NT, DM, F.G, F.blk); EpiRes E{l == 0 ? F_x : F.out, F.out, F_MOD + (size_t)l * NB * 6144 + 2048};
            pg8::gemm_phase<EpiRes, pg8::StaticOrder, false>(F.lds, DM, DM, DM, S, E); } SEAM(p + 6);
        if (IN(p + 7) && PSEL(7)) { norm2_router_phase(F, l); } SEAM(p + 7);
        if (IN(p + 8) && PSEL(8)) { moe_pg8<1>(F, l); } SEAM(p + 8);
        if (IN(p + 9) && PSEL(9)) { moe_pg8<2>(F, l); } SEAM(p + 9);
    }
    if (IN(NPHASE - 1) && PSEL(11)) { norm_phase<2>(F, 0); }
#undef IN
#undef SEAM
}

extern "C" void kernel_launch(void* const* d_in, const int* in_sizes, int n_in, void* d_out, int out_size, void* d_ws, size_t ws_size, hipStream_t stream) {
    static int grid = 0;
    if (grid == 0) {
        if (n_in != 28 || in_sizes[0] != NT * DM || out_size != NT * DM || ws_size < WS_END) { fprintf(stderr, "kernel_launch: unexpected shapes / workspace (%d inputs, ws %zu < %zu)\n", n_in, ws_size, (size_t)WS_END); grid = -1; return; }
        int dev = 0, cus = 0;
        if (hipGetDevice(&dev) != hipSuccess || hipDeviceGetAttribute(&cus, hipDeviceAttributeMultiprocessorCount, dev) != hipSuccess) { grid = -1; return; }
        if (hipFuncSetAttribute((const void*)fwd_kernel, hipFuncAttributeMaxDynamicSharedMemorySize, LDS_BYTES) != hipSuccess) { fprintf(stderr, "kernel_launch: hipFuncSetAttribute failed\n"); grid = -1; return; }
        int per_cu = 0;
        if (hipOccupancyMaxActiveBlocksPerMultiprocessor(&per_cu, (const void*)fwd_kernel, NTHR, LDS_BYTES) != hipSuccess || per_cu < 1) { fprintf(stderr, "kernel_launch: occupancy query says %d\n", per_cu); }
        (void)hipGetLastError();
        grid = 256;
        if (cus < 256) { fprintf(stderr, "kernel_launch: device has %d CUs, need 256\n", cus); grid = -1; return; }
    }
    if (grid < 0) return;
    (void)hipMemsetAsync((char*)d_ws + WS_CTL, 0, CTL_BYTES, stream);
    Args a{};
    for (int i = 0; i < 28; ++i) a.in[i] = (const float*)d_in[i];
    a.out = (float*)d_out; a.ws = (unsigned char*)d_ws;
#if MK_MULTI
    for (int ph = 0; ph < NPHASE; ++ph) { a.ph_lo = ph; a.ph_hi = ph + 1; hipLaunchKernelGGL(fwd_kernel, dim3(grid), dim3(NTHR), LDS_BYTES, stream, a); }
#else
    a.ph_lo = 0; a.ph_hi = NPHASE; hipLaunchKernelGGL(fwd_kernel, dim3(grid), dim3(NTHR), LDS_BYTES, stream, a);
#endif
}
```

```cpp
#include <hip/hip_runtime.h>
#include <cstdio>
#include <cstdint>

#define GAS __attribute__((address_space(1)))
#define LAS __attribute__((address_space(3)))
typedef unsigned short bf16;
typedef short bf16x8 __attribute__((ext_vector_type(8)));
typedef float f32x4 __attribute__((ext_vector_type(4)));
typedef float f32x2 __attribute__((ext_vector_type(2)));
typedef unsigned u32x4 __attribute__((ext_vector_type(4)));
typedef unsigned u32x2 __attribute__((ext_vector_type(2)));

#ifndef MK_MULTI
#define MK_MULTI 0
#endif

#ifndef REP_P3
#define REP_P3 1
#endif
#ifndef REP_P5
#define REP_P5 1
#endif
#ifndef REP_AT
#define REP_AT 1
#endif
#ifndef ATTN_NQT
#define ATTN_NQT 2
#endif

constexpr int NL = 4, NB = 8, SEQ = 4096, DM = 1024, NT = NB * SEQ, NCH = 64;
constexpr int INW = 2816;
constexpr int C_QA = 0, C_KA = 512, C_VA = 1024, C_US = 1536, C_QR = 1792, C_KR = 2048, C_VR = 2304, C_GR = 2560;
constexpr int NE = 32, FF = 256;
constexpr float EPS = 1e-6f;
constexpr int NWAVES = 8, NTHR = 512;
constexpr int LDS_BYTES = 147456;

constexpr size_t al256(size_t x) { return (x + 255) & ~(size_t)255; }
constexpr size_t WS_CTL = 0, CTL_BYTES = 1u << 20;
constexpr size_t WS_WIN = CTL_BYTES;
constexpr size_t WS_WOUT = WS_WIN + (size_t)NL * INW * DM * 2;
constexpr size_t WS_WGU = WS_WOUT + (size_t)NL * DM * DM * 2;
constexpr size_t WS_WD = WS_WGU + (size_t)NL * NE * 512 * DM * 2;
constexpr size_t WS_WGLU = WS_WD + (size_t)NL * NE * DM * FF * 2;
constexpr size_t WS_WR = WS_WGLU + (size_t)NL * 256 * 256 * 2;
constexpr size_t WS_MOD = WS_WR + (size_t)NL * 36 * DM * 4;
constexpr size_t WS_ABAR = WS_MOD + (size_t)NL * NB * 6144 * 4;
constexpr size_t WS_ABAR64 = WS_ABAR + (size_t)NL * 16 * 64 * 8;
constexpr size_t WS_BBAR = WS_ABAR64 + (size_t)NL * 16 * 64 * 8;
constexpr size_t WS_ROPE = WS_BBAR + (size_t)NL * 16 * 64 * 16 * 8;
constexpr size_t WS_H = al256(WS_ROPE + (size_t)SEQ * 32 * 8);
constexpr size_t WS_QKV = WS_H + (size_t)NT * DM * 2;
constexpr size_t WS_SLOT = WS_QKV;
constexpr size_t WS_ACT = WS_QKV + (size_t)2 * NT * DM * 2;
constexpr int ACT_ROWS = 2 * NT + NE * 256;
static_assert(WS_ACT + (size_t)ACT_ROWS * FF * 2 <= WS_QKV + (size_t)NT * INW * 2, "overlay fits");
constexpr size_t WS_MIX = WS_QKV + (size_t)NT * INW * 2;
constexpr size_t WS_YG = WS_MIX + (size_t)NT * DM * 2;
constexpr size_t WS_SEND = WS_YG + (size_t)NT * 256 * 2;
constexpr size_t WS_XS = WS_SEND + (size_t)NB * NCH * 16 * 64 * 8;
constexpr size_t WS_KV = WS_XS + (size_t)NB * NCH * 16 * 64 * 8;
constexpr size_t WS_RW = WS_KV + (size_t)NB * NCH * 4 * 4096 * 4;
constexpr size_t WS_LIST = WS_RW + (size_t)NT * 2 * 4;
constexpr size_t WS_WRHL = WS_LIST + (size_t)NE * NT * 4;
constexpr size_t WS_KERN = WS_WRHL + (size_t)NL * 2 * 48 * DM * 2;
constexpr size_t WS_U2X = WS_KERN + (size_t)NL * 16 * 64 * 256 * 4;
constexpr int U2K = 1152, U2LD = 16 * U2K;
constexpr size_t WS_TMAT = WS_U2X + (size_t)512 * U2LD * 2;
constexpr size_t WS_BT1 = WS_TMAT + (size_t)16 * 1024 * U2K * 2;
constexpr size_t WS_END = WS_BT1 + (size_t)16 * 256 * 1024 * 2;
constexpr int CW_BAR = 4096;
constexpr int CW_CNT = 16384;

__device__ __forceinline__ float bf2f(unsigned v) { return __uint_as_float(v << 16); }
__device__ __forceinline__ unsigned f2bf(float f) { unsigned u = __float_as_uint(f); return (u + 0x7fffu + ((u >> 16) & 1u)) >> 16; }
__device__ __forceinline__ unsigned pk2(float lo, float hi) { return f2bf(lo) | (f2bf(hi) << 16); }
__device__ __forceinline__ float wave_sum(float v) {
#pragma unroll
    for (int o = 1; o < 64; o <<= 1) v += __shfl_xor(v, o);
    return v;
}
__device__ __forceinline__ float silu_f(float x) { return x / (1.0f + __expf(-x)); }
__device__ __forceinline__ float sigmoid_f(float x) { return 1.0f / (1.0f + __expf(-x)); }
__device__ __forceinline__ float gelu_tanh_f(float y) { const float z = 0.7978845608028654f * (y + 0.044715f * y * y * y); const float t = 1.0f - 2.0f / (__expf(2.0f * z) + 1.0f); return 0.5f * y * (1.0f + t); }
#define LDS_WAIT() asm volatile("s_waitcnt lgkmcnt(0)" ::: "memory")

#define XB_TMO      128
#define XB_XCNT(j)  (256  + 64 * (j))
#define XB_XSUB(j)  (1280 + 64 * (j))
#define XB_XGEN(j)  (2304 + 64 * (j))
#define XB_TOP      3328
#define XB_TOPGEN   3392
#define XCD_BAR_WORDS 3456
#define XB_SPIN_CAP (1u << 22)
__device__ __forceinline__ unsigned xb_ld(unsigned* p)              { return __hip_atomic_load(p, __ATOMIC_RELAXED, __HIP_MEMORY_SCOPE_AGENT); }
__device__ __forceinline__ unsigned xb_add(unsigned* p, unsigned v) { return __hip_atomic_fetch_add(p, v, __ATOMIC_RELAXED, __HIP_MEMORY_SCOPE_AGENT); }
__device__ __forceinline__ unsigned xb_xcc_id() { return (unsigned)__builtin_amdgcn_s_getreg((3 << 11) | 20) & 0xFu; }
#define XB_SPIN(cond, bar) do { unsigned _sp = 0; while (cond) { __builtin_amdgcn_s_sleep(1); \
    if ((++_sp & 255u) == 0u) { if (xb_ld(&(bar)[XB_TMO])) break; if (_sp > XB_SPIN_CAP) { atomicAdd(&(bar)[XB_TMO], 1u); break; } } } } while (0)
struct XcdBarrier { unsigned* bar; unsigned x; volatile LAS unsigned* st; };
__device__ __forceinline__ XcdBarrier xcd_barrier_post(unsigned* bar, volatile LAS unsigned* st) {
    XcdBarrier b; b.bar = bar; b.x = xb_xcc_id(); b.st = st;
    if (threadIdx.x == 0) (void)xb_add(&bar[XB_XCNT(b.x)], 1u);
    return b;
}
__device__ __forceinline__ void xcd_barrier_complete(unsigned* bar, unsigned x, unsigned& nloc, unsigned& nx) {
    const unsigned G = gridDim.x * gridDim.y * gridDim.z;
    unsigned sum, cnt, mine, sp = 0u;
    for (;;) {
        sum = 0u; cnt = 0u; mine = 0u;
#pragma unroll
        for (unsigned j = 0; j < 16; ++j) { const unsigned c = xb_ld(&bar[XB_XCNT(j)]); sum += c; cnt += (c > 0u) ? 1u : 0u; mine = (j == x) ? c : mine; }
        if (sum == G) break;
        __builtin_amdgcn_s_sleep(1);
        if ((++sp & 255u) == 0u) { if (xb_ld(&bar[XB_TMO])) break; if (sp > XB_SPIN_CAP) { atomicAdd(&bar[XB_TMO], 1u); break; } }
    }
    nloc = mine > 0u ? mine : 1u; nx = cnt > 0u ? cnt : 1u;
}
__device__ __forceinline__ void xcd_barrier(const XcdBarrier& b) {
    asm volatile("s_waitcnt vmcnt(0)" ::: "memory");
    __syncthreads();
    if (threadIdx.x == 0) {
        unsigned* bar = b.bar;
        __builtin_amdgcn_s_waitcnt(0);
        unsigned nloc = b.st[0], nx = b.st[1];
        if (nloc == 0u) { xcd_barrier_complete(bar, b.x, nloc, nx); b.st[0] = nloc; b.st[1] = nx; }
        const unsigned old = xb_add(&bar[XB_XSUB(b.x)], 1u);
        const unsigned gen = old / nloc;
        if (old + 1u == (gen + 1u) * nloc) {
            __builtin_amdgcn_fence(__ATOMIC_RELEASE, "agent");
            asm volatile("s_waitcnt vmcnt(0)" ::: "memory");
            const unsigned og = xb_add(&bar[XB_TOP], 1u);
            const unsigned tg = og / nx;
            if (og + 1u == (tg + 1u) * nx) xb_add(&bar[XB_TOPGEN], 1u);
            else XB_SPIN(xb_ld(&bar[XB_TOPGEN]) == tg, bar);
            __builtin_amdgcn_fence(__ATOMIC_ACQUIRE, "agent");
            xb_add(&bar[XB_XGEN(b.x)], 1u);
            asm volatile("s_waitcnt vmcnt(0)" ::: "memory");
        } else {
            XB_SPIN(xb_ld(&bar[XB_XGEN(b.x)]) == gen, bar);
            __builtin_amdgcn_fence(__ATOMIC_ACQUIRE, "agent");
            asm volatile("s_waitcnt vmcnt(0)" ::: "memory");
        }
    }
    __syncthreads();
}

struct Frame {
    LAS unsigned char* lds;
    LAS unsigned long long* ptab;
    int tid, lane, wave, blk, G, gw, ngw;
    float* out; unsigned char* ws;
};
__device__ __forceinline__ const float* inp_ptr(LAS unsigned long long* t, int k) { const unsigned long long v = t[k];
    const unsigned lo = __builtin_amdgcn_readfirstlane((unsigned)v), hi = __builtin_amdgcn_readfirstlane((unsigned)(v >> 32)); return (const float*)(((unsigned long long)hi << 32) | lo); }
#define INP(k) inp_ptr(F.ptab, k)
#define F_x INP(0)
#define F_c INP(1)
#define F_norm1_g INP(2)
#define F_norm2_g INP(3)
#define F_w_ada INP(4)
#define F_b_ada INP(5)
#define F_w_in INP(6)
#define F_rel_bias INP(7)
#define F_a_re INP(8)
#define F_a_im INP(9)
#define F_log_dt INP(10)
#define F_b_re INP(11)
#define F_b_im INP(12)
#define F_c_re INP(13)
#define F_c_im INP(14)
#define F_ssm_d INP(15)
#define F_w_glu INP(16)
#define F_b_glu INP(17)
#define F_gn_g INP(18)
#define F_w_out INP(19)
#define F_w_group INP(20)
#define F_b_group INP(21)
#define F_w_expert INP(22)
#define F_b_expert INP(23)
#define F_w_gate INP(24)
#define F_w_up INP(25)
#define F_w_down INP(26)
#define F_final_g INP(27)
#define F_ctl ((unsigned*)(F.ws + WS_CTL))
#define F_WinT ((bf16*)(F.ws + WS_WIN))
#define F_WoutT ((bf16*)(F.ws + WS_WOUT))
#define F_WguT ((bf16*)(F.ws + WS_WGU))
#define F_WdT ((bf16*)(F.ws + WS_WD))
#define F_WgluT ((bf16*)(F.ws + WS_WGLU))
#define F_WrT ((float*)(F.ws + WS_WR))
#define F_MOD ((float*)(F.ws + WS_MOD))
#define F_ABAR ((f32x2*)(F.ws + WS_ABAR))
#define F_ABAR64 ((f32x2*)(F.ws + WS_ABAR64))
#define F_BBAR ((f32x2*)(F.ws + WS_BBAR))
#define F_ROPE ((f32x2*)(F.ws + WS_ROPE))
#define F_H ((bf16*)(F.ws + WS_H))
#define F_QKV ((bf16*)(F.ws + WS_QKV))
#define F_SLOT ((bf16*)(F.ws + WS_SLOT))
#define F_ACT ((bf16*)(F.ws + WS_ACT))
#define F_MIX ((bf16*)(F.ws + WS_MIX))
#define F_YG ((bf16*)(F.ws + WS_YG))
#define F_SEND ((f32x2*)(F.ws + WS_SEND))
#define F_XS ((f32x2*)(F.ws + WS_XS))
#define F_KV ((float*)(F.ws + WS_KV))
#define F_RW ((float*)(F.ws + WS_RW))
#define F_LIST ((int*)(F.ws + WS_LIST))
#define F_WRHL ((bf16*)(F.ws + WS_WRHL))
#define F_KERN ((float*)(F.ws + WS_KERN))
#define F_U2X ((bf16*)(F.ws + WS_U2X))
#define F_TMAT ((bf16*)(F.ws + WS_TMAT))
#define F_BT1 ((bf16*)(F.ws + WS_BT1))
#define F_SENDP ((float*)(F.ws + WS_SEND))

__device__ __forceinline__ void wave_gemm64(f32x4 (&acc)[4][4], const bf16* const (&arow)[4], const bf16* const (&brow)[4], int K) {
#pragma unroll
    for (int i = 0; i < 4; ++i)
#pragma unroll
        for (int j = 0; j < 4; ++j) acc[i][j] = (f32x4){0.f, 0.f, 0.f, 0.f};
    for (int k0 = 0; k0 < K; k0 += 32) {
        bf16x8 a[4], b[4];
#pragma unroll
        for (int i = 0; i < 4; ++i) { a[i] = *(const bf16x8*)(arow[i] + k0); b[i] = *(const bf16x8*)(brow[i] + k0); }
#pragma unroll
        for (int i = 0; i < 4; ++i)
#pragma unroll
            for (int j = 0; j < 4; ++j) acc[i][j] = __builtin_amdgcn_mfma_f32_16x16x32_bf16(b[j], a[i], acc[i][j], 0, 0, 0);
    }
}

namespace pg8 {
constexpr int BM = 256, BK = 64, HALF = 128, HTB = HALF * BK * 2, STAGE_BYTES = 8 * HTB, NXCD = 8, WGM = 8;
__host__ __device__ __forceinline__ int lds_byte(int r, int c) { const int st = (r >> 4) * 2 + (c >> 5), rr = r & 15, cc = c & 31, ob = rr * 64 + cc * 2; return st * 1024 + (ob ^ (((ob >> 9) & 1) << 5)); }
__host__ __device__ __forceinline__ void stage_rc(int b, int& R, int& C) { const int st = b / 1024, sb = b % 1024, swz = sb ^ (((sb >> 9) & 1) << 5); R = (st >> 1) * 16 + swz / 64; C = (st & 1) * 32 + (swz % 64) / 2; }
__host__ __device__ __forceinline__ int perm32(int rho) { const int n = rho >> 4, i = rho & 15; return 8 * (i >> 2) + 4 * n + (i & 3); }
struct Unit { int pm, pn, e, i; };
struct StaticOrder {
    int nM, nN, nwg, G, c; const char* A; const char* Bt; size_t tstepA, tstepB;
    __device__ void init(const bf16* A_, int lda, const bf16* Bt_, int ldb, int M, int N, int G_, int c_) { nM = M / BM; nN = N / BM; nwg = nM * nN; G = G_; c = c_; A = (const char*)A_; Bt = (const char*)Bt_; tstepA = (size_t)BM * lda * 2; tstepB = (size_t)BM * ldb * 2; }
    __device__ bool next(int i, Unit& u) const {
        const long L = (long)i * G + c; if (L >= nwg) return false;
        int wgid = (int)L; { const int q = nwg / NXCD, r = nwg % NXCD, xcd = wgid % NXCD, off = wgid / NXCD; wgid = (xcd < r ? xcd * (q + 1) : r * (q + 1) + (xcd - r) * q) + off; }
        const int nig = WGM * nN, gid = wgid / nig, fm = gid * WGM, gsz = (nM - fm) < WGM ? (nM - fm) : WGM;
        u.pm = fm + ((wgid % nig) % gsz); u.pn = (wgid % nig) / gsz; u.e = 0; u.i = i; return true;
    }
    __device__ __forceinline__ const char* a_base(const Unit& u) const { return A + (size_t)u.pm * tstepA; }
    __device__ __forceinline__ const char* b_base(const Unit& u) const { return Bt + (size_t)u.pn * tstepB; }
    __device__ __forceinline__ int row(const Unit&, int r) const { return r; }
};
__device__ __forceinline__ unsigned cvt_pk_bf16(float lo, float hi) { unsigned r; asm volatile("v_cvt_pk_bf16_f32 %0, %1, %2" : "=v"(r) : "v"(lo), "v"(hi)); return r; }

template <class Epi, class Sched, bool GATHER>
__device__ __forceinline__ void gemm_phase(LAS unsigned char* lds, const int K, const int lda, const int ldb, const Sched& S, const Epi& E) {
    int tid_ = threadIdx.x; asm volatile("" : "+v"(tid_));
    const int tid = tid_, wid = __builtin_amdgcn_readfirstlane(tid >> 6), lane = tid & 63, wr = wid >> 2, wc = wid & 3, fr = lane & 15, fq = lane >> 4;
    const int nt = K / BK;
    int Rr[2], Cc[2]; unsigned voffB[2];
#pragma unroll
    for (int i = 0; i < 2; ++i) { stage_rc(tid * 16 + i * 8192, Rr[i], Cc[i]); const int Rb = Epi::PERM ? ((Rr[i] & ~31) + perm32(Rr[i] & 31)) : Rr[i]; voffB[i] = (unsigned)(Rb * ldb + Cc[i]) * 2u; }
    const size_t kstep = (size_t)(BK * 2);
    const size_t hstepB = (size_t)HALF * ldb * 2;
    const unsigned ldsw = (unsigned)wid * 1024u;
    const int aoff = lds_byte(wr * 64 + fr, fq * 8), boff = lds_byte(wc * 32 + fr, fq * 8);
#define PG8_SA(b, h) (((b) * 2 + (h)) * HTB)
#define PG8_SB(b, h) ((4 + (b) * 2 + (h)) * HTB)
#define PG8_STAGE(bufoff, gbase, voff) do { _Pragma("unroll") for (int _i = 0; _i < 2; ++_i) \
        __builtin_amdgcn_global_load_lds((const unsigned*)((const char*)(gbase) + (voff)[_i]), (LAS unsigned*)(lds + (bufoff) + ldsw + _i * 8192), 16, 0, 0); } while (0)
#define PG8_STAGE_SEL(bufoff, gbase, h) do { if (GATHER && last) PG8_STAGE(bufoff, gbase, vN[h]); else PG8_STAGE(bufoff, gbase, vA[h]); } while (0)
#define PG8_LDA(dst, b, h) do { _Pragma("unroll") for (int m = 0; m < 4; ++m) _Pragma("unroll") for (int k = 0; k < 2; ++k) dst[m][k] = *(const LAS bf16x8*)(lds + PG8_SA(b, h) + aoff + m * 2048 + k * 1024); } while (0)
#define PG8_LDB(dst, b, h) do { _Pragma("unroll") for (int n = 0; n < 2; ++n) _Pragma("unroll") for (int k = 0; k < 2; ++k) dst[n][k] = *(const LAS bf16x8*)(lds + PG8_SB(b, h) + boff + n * 2048 + k * 1024); } while (0)
#define PG8_MMA(ai, bj, At, Bt) do { __builtin_amdgcn_s_setprio(1); _Pragma("unroll") for (int m = 0; m < 4; ++m) _Pragma("unroll") for (int n = 0; n < 2; ++n) _Pragma("unroll") for (int k = 0; k < 2; ++k) \
        acc[ai][bj][m][n] = __builtin_amdgcn_mfma_f32_16x16x32_bf16(Bt[n][k], At[m][k], acc[ai][bj][m][n], 0, 0, 0); __builtin_amdgcn_s_setprio(0); } while (0)
#define PG8_WAIT_V(n) asm volatile("s_waitcnt vmcnt(" #n ")" ::: "memory")
#define PG8_WAIT_L(n) asm volatile("s_waitcnt lgkmcnt(" #n ")" ::: "memory")
#define PG8_BAR __builtin_amdgcn_s_barrier()
#define PG8_SCHED __builtin_amdgcn_sched_barrier(0)
#define PG8_VOFF(dst, u) do { int _t = tid; if (GATHER) asm volatile("" : "+v"(_t)); _Pragma("unroll") for (int _i = 0; _i < 2; ++_i) { int _R, _C; stage_rc(_t * 16 + _i * 8192, _R, _C); \
        _Pragma("unroll") for (int _h = 0; _h < 2; ++_h) dst[_h][_i] = (unsigned)(S.row(u, _h * HALF + _R) * lda + _C) * 2u; } } while (0)
    Unit cur, nxt; int ui = 0;
    if (!S.next(0, cur)) return;
    f32x4 acc[2][2][4][2];
#pragma unroll
    for (int a = 0; a < 2; ++a)
#pragma unroll
        for (int b = 0; b < 2; ++b)
#pragma unroll
            for (int m = 0; m < 4; ++m)
#pragma unroll
                for (int n = 0; n < 2; ++n) acc[a][b][m][n] = (f32x4){0.f, 0.f, 0.f, 0.f};
    bf16x8 At[4][2], B0[2][2], B1[2][2];
    unsigned vA[2][2];
    PG8_VOFF(vA, cur);
    const char* cA = S.a_base(cur); const char* cB = S.b_base(cur);
    PG8_STAGE(PG8_SB(0, 0), cB, voffB); PG8_STAGE(PG8_SB(0, 1), cB + hstepB, voffB); PG8_STAGE(PG8_SA(0, 0), cA, vA[0]); PG8_STAGE(PG8_SA(0, 1), cA, vA[1]);
    if (wr == 1) PG8_BAR;
    PG8_WAIT_V(2); PG8_BAR;
    PG8_STAGE(PG8_SB(1, 0), cB + kstep, voffB); PG8_STAGE(PG8_SA(1, 0), cA + kstep, vA[0]); PG8_STAGE(PG8_SB(1, 1), cB + hstepB + kstep, voffB);
    PG8_WAIT_V(6); PG8_BAR;
    for (;;) {
        const bool has_next = S.next(ui + 1, nxt);
        const char* nA = has_next ? S.a_base(nxt) : cA; const char* nB = has_next ? S.b_base(nxt) : cB;
#pragma unroll 1
        for (int t = 0; t < nt; t += 2) {
            const bool last = (t == nt - 2);
            const char* a1 = cA + (size_t)(t + 1) * kstep;
            const char* a2 = last ? nA : cA + (size_t)(t + 2) * kstep; const char* b2 = last ? nB : cB + (size_t)(t + 2) * kstep;
            const char* a3 = a2 + kstep; const char* b3 = b2 + kstep;
            PG8_LDB(B0, 0, 0); PG8_LDB(B1, 0, 1); PG8_SCHED; PG8_LDA(At, 0, 0); PG8_STAGE(PG8_SA(1, 1), a1, vA[1]);
            PG8_WAIT_V(8); PG8_WAIT_L(0); PG8_BAR; PG8_MMA(0, 0, At, B0); PG8_MMA(0, 1, At, B1); PG8_BAR; PG8_SCHED;
            if (GATHER && last && has_next) { PG8_VOFF(vA, nxt); }
            PG8_LDA(At, 0, 1); PG8_STAGE(PG8_SB(0, 0), b2, voffB); PG8_STAGE(PG8_SB(0, 1), b2 + hstepB, voffB); PG8_STAGE(PG8_SA(0, 0), a2, vA[0]);
            PG8_WAIT_V(8); PG8_WAIT_L(0); PG8_BAR; PG8_MMA(1, 0, At, B0); PG8_MMA(1, 1, At, B1); PG8_BAR; PG8_SCHED;
            PG8_LDB(B0, 1, 0); PG8_LDB(B1, 1, 1); PG8_SCHED; PG8_LDA(At, 1, 0); PG8_STAGE(PG8_SA(0, 1), a2, vA[1]);
            PG8_WAIT_V(8); PG8_WAIT_L(0); PG8_BAR; PG8_MMA(0, 0, At, B0); PG8_MMA(0, 1, At, B1); PG8_BAR; PG8_SCHED;
            PG8_LDA(At, 1, 1); PG8_STAGE(PG8_SB(1, 0), b3, voffB); PG8_STAGE(PG8_SB(1, 1), b3 + hstepB, voffB); PG8_STAGE(PG8_SA(1, 0), a3, vA[0]);
            PG8_WAIT_V(8); PG8_WAIT_L(0); PG8_BAR; PG8_MMA(1, 0, At, B0); PG8_MMA(1, 1, At, B1); PG8_BAR; PG8_SCHED;
        }
        if (wr == 0) PG8_BAR;
        { int fr_e = fr, fq_e = fq; asm volatile("" : "+v"(fr_e), "+v"(fq_e)); E(acc, cur, wr, wc, fr_e, fq_e); }
        if (!has_next) break;
#pragma unroll
        for (int a = 0; a < 2; ++a)
#pragma unroll
            for (int b = 0; b < 2; ++b)
#pragma unroll
                for (int m = 0; m < 4; ++m)
#pragma unroll
                    for (int n = 0; n < 2; ++n) acc[a][b][m][n] = (f32x4){0.f, 0.f, 0.f, 0.f};
        cur = nxt; cA = nA; cB = nB; ++ui;
        if (wr == 1) PG8_BAR;
    }
    PG8_WAIT_V(0);
    PG8_BAR;
#undef PG8_SA
#undef PG8_SB
#undef PG8_STAGE
#undef PG8_STAGE_SEL
#undef PG8_LDA
#undef PG8_LDB
#undef PG8_MMA
#undef PG8_WAIT_V
#undef PG8_WAIT_L
#undef PG8_BAR
#undef PG8_SCHED
#undef PG8_VOFF
}
}

struct EpiQKV {
    static constexpr bool PERM = true;
    bf16* O; bf16* U2;
    __device__ __forceinline__ void operator()(const f32x4 (&acc)[2][2][4][2], const pg8::Unit& u, int wr, int wc, int fr, int fq) const {
        const int row0 = u.pm * 256 + wr * 64 + fr, col0 = u.pn * 256 + wc * 32 + 8 * fq;
#pragma unroll
        for (int ai = 0; ai < 2; ++ai)
#pragma unroll
            for (int m = 0; m < 4; ++m) { const int row = row0 + ai * 128 + m * 16; bf16* rowp = O + (size_t)row * INW + col0;
#pragma unroll
                for (int bj = 0; bj < 2; ++bj) { const f32x4 v0 = acc[ai][bj][m][0], v1 = acc[ai][bj][m][1];
                    u32x4 w; w.x = pg8::cvt_pk_bf16(v0[0], v0[1]); w.y = pg8::cvt_pk_bf16(v0[2], v0[3]); w.z = pg8::cvt_pk_bf16(v1[0], v1[1]); w.w = pg8::cvt_pk_bf16(v1[2], v1[3]);
                    if (u.pn == 6) { const int cu = bj * 128 + wc * 32 + 8 * fq;
                        *(u32x4*)(U2 + ((size_t)(row >> 6) * 16 + (cu >> 4)) * U2K + 128 + (row & 63) * 16 + (cu & 15)) = w; }
                    else *(u32x4*)(rowp + bj * 128) = w; } }
    }
};
struct EpiRes {
    static constexpr bool PERM = false;
    const float* xb; float* out; const float* g1l;
    __device__ __forceinline__ void operator()(const f32x4 (&acc)[2][2][4][2], const pg8::Unit& u, int wr, int wc, int fr, int fq) const {
        const int row0 = u.pm * 256 + wr * 64 + fr, col0 = u.pn * 256 + wc * 32 + 4 * fq;
        const float* g1 = g1l + (size_t)((u.pm * 256) / SEQ) * 6144 + col0;
        f32x4 gv[2][2];
#pragma unroll
        for (int bj = 0; bj < 2; ++bj)
#pragma unroll
            for (int n = 0; n < 2; ++n) gv[bj][n] = *(const f32x4*)(g1 + bj * 128 + n * 16);
#pragma unroll
        for (int ai = 0; ai < 2; ++ai)
#pragma unroll
            for (int m = 0; m < 4; ++m) { const size_t off = (size_t)(row0 + ai * 128 + m * 16) * DM + col0;
#pragma unroll
                for (int bj = 0; bj < 2; ++bj)
#pragma unroll
                    for (int n = 0; n < 2; ++n) { const f32x4 xv = *(const f32x4*)(xb + off + bj * 128 + n * 16); *(f32x4*)(out + off + bj * 128 + n * 16) = xv + gv[bj][n] * acc[ai][bj][m][n]; }
                asm volatile("" ::: "memory"); }
    }
};

__device__ __forceinline__ void transpose_item(const float* W, int N, int k0, int n0, bf16* dst, int ldk, LAS float* scr, int lane) {
#pragma unroll 8
    for (int i = 0; i < 32; ++i) { const int kk = 2 * i + (lane >> 5); scr[kk * 33 + (lane & 31)] = W[(size_t)(k0 + kk) * N + n0 + (lane & 31)]; }
    LDS_WAIT(); asm volatile("" ::: "memory");
    const int c = lane & 7;
#pragma unroll
    for (int j = 0; j < 4; ++j) { const int n = (lane >> 3) + 8 * j; const LAS float* s = scr + (8 * c) * 33 + n;
        u32x4 o; o.x = pk2(s[0 * 33], s[1 * 33]); o.y = pk2(s[2 * 33], s[3 * 33]); o.z = pk2(s[4 * 33], s[5 * 33]); o.w = pk2(s[6 * 33], s[7 * 33]);
        *(u32x4*)(dst + (size_t)n * ldk + k0 + 8 * c) = o; }
    LDS_WAIT(); asm volatile("" ::: "memory");
}
__device__ __forceinline__ void p0_prologue(Frame& F) {
    LAS float* scr = (LAS float*)(F.lds + F.wave * 16384);
    constexpr int I_IN = NL * 16 * 88, I_OUT = NL * 16 * 32, I_GLU = NL * 4 * 8, I_G = NL * NE * 16 * 8, I_D = NL * NE * 4 * 32;
    constexpr int NITEMS = I_IN + I_OUT + I_GLU + 2 * I_G + I_D;
    for (int it = F.gw; it < NITEMS; it += F.ngw) {
        int r = it;
        if (r < I_IN) { const int l = r / (16 * 88), q = r % (16 * 88), kb = q / 88, nb = q % 88;
            transpose_item(F_w_in + (size_t)l * DM * INW, INW, kb * 64, nb * 32, F_WinT + ((size_t)l * INW + nb * 32) * DM, DM, scr, F.lane); continue; } r -= I_IN;
        if (r < I_OUT) { const int l = r / (16 * 32), q = r % (16 * 32), kb = q / 32, nb = q % 32;
            transpose_item(F_w_out + (size_t)l * DM * DM, DM, kb * 64, nb * 32, F_WoutT + ((size_t)l * DM + nb * 32) * DM, DM, scr, F.lane); continue; } r -= I_OUT;
        if (r < I_GLU) { const int l = r / 32, q = r % 32, kb = q / 8, nb = q % 8;
            transpose_item(F_w_glu + (size_t)l * 256 * 256, 256, kb * 64, nb * 32, F_WgluT + ((size_t)l * 256 + nb * 32) * 256, 256, scr, F.lane); continue; } r -= I_GLU;
        if (r < 2 * I_G) { const int up = r >= I_G; if (up) r -= I_G; const int le = r / 128, q = r % 128, kb = q / 8, nb = q % 8; const int n0 = nb * 32;
            const int drow = (n0 >> 7) * 256 + up * 128 + (n0 & 127);
            transpose_item((up ? F_w_up : F_w_gate) + (size_t)le * DM * FF, FF, kb * 64, n0, F_WguT + ((size_t)le * 512 + drow) * DM, DM, scr, F.lane); continue; } r -= 2 * I_G;
        { const int le = r / 128, q = r % 128, kb = q / 32, nb = q % 32;
            transpose_item(F_w_down + (size_t)le * FF * DM, DM, kb * 64, nb * 32, F_WdT + ((size_t)le * DM + nb * 32) * FF, FF, scr, F.lane); }
    }
    for (int i = F.blk * NTHR + F.tid; i < NL * 36 * DM; i += F.G * NTHR) { const int l = i / (36 * DM), j = (i / DM) % 36, k = i % DM;
        F_WrT[i] = (j < 4) ? F_w_group[((size_t)l * DM + k) * 4 + j] : F_w_expert[((size_t)l * DM + k) * 32 + (j - 4)]; }
    for (int i = F.blk * NTHR + F.tid; i < NL * 48 * DM; i += F.G * NTHR) { const int l = i / (48 * DM), j = (i / DM) % 48, k = i % DM;
        const float w = (j < 4) ? F_w_group[((size_t)l * DM + k) * 4 + j] : (j < 36 ? F_w_expert[((size_t)l * DM + k) * 32 + (j - 4)] : 0.f);
        const unsigned hi = f2bf(w); const unsigned lo = f2bf(w - bf2f(hi));
        F_WRHL[((size_t)(l * 2 + 0) * 48 + j) * DM + k] = (bf16)hi; F_WRHL[((size_t)(l * 2 + 1) * 48 + j) * DM + k] = (bf16)lo; }
    for (int i = F.blk * NTHR + F.tid; i < NL * 16 * 64; i += F.G * NTHR) {
        const int lg = i / 64; const float are = F_a_re[i], aim = F_a_im[i], dt = __expf(F_log_dt[lg]);
        const float mag = expf(are * dt); float sn, cs; sincosf(aim * dt, &sn, &cs);
        const float abr = mag * cs, abi = mag * sn;
        F_ABAR[i] = (f32x2){abr, abi};
        const float mag64 = expf(64.f * are * dt); float sn64, cs64; sincosf(64.f * aim * dt, &sn64, &cs64);
        F_ABAR64[i] = (f32x2){mag64 * cs64, mag64 * sn64};
        const float xr = abr - 1.f, xi = abi, den = are * are + aim * aim;
        const float fr = (xr * are + xi * aim) / den, fi = (xi * are - xr * aim) / den;
#pragma unroll
        for (int cc = 0; cc < 16; ++cc) { const float br = F_b_re[(size_t)i * 16 + cc], bi = F_b_im[(size_t)i * 16 + cc];
            F_BBAR[(size_t)i * 16 + cc] = (f32x2){fr * br - fi * bi, fr * bi + fi * br}; }
    }
    for (int i = F.blk * NTHR + F.tid; i < NL * 16 * 64 * 16; i += F.G * NTHR) {
        const int c = i & 15, lag = (i >> 4) & 63, lg = i >> 10; const float dt = __expf(F_log_dt[lg]);
        float acc[16];
#pragma unroll
        for (int q = 0; q < 16; ++q) acc[q] = 0.f;
        for (int p = 0; p < 64; ++p) { const float are = F_a_re[lg * 64 + p], aim = F_a_im[lg * 64 + p];
            const float mag = expf(are * dt), xr0 = mag * cosf(aim * dt) - 1.f, xi0 = mag * sinf(aim * dt), den = are * are + aim * aim;
            const float fr_ = (xr0 * are + xi0 * aim) / den, fi_ = (xi0 * are - xr0 * aim) / den;
            const float pm = expf((float)lag * are * dt); float sn, cs; sincosf((float)lag * aim * dt, &sn, &cs);
            const float cr = F_c_re[((size_t)lg * 16 + c) * 64 + p], ci = F_c_im[((size_t)lg * 16 + c) * 64 + p];
            const float pr = pm * cs, pi = pm * sn, zr0 = cr * pr - ci * pi, zi0 = cr * pi + ci * pr;
            const float zr = zr0 * fr_ - zi0 * fi_, zi = zr0 * fi_ + zi0 * fr_;
#pragma unroll
            for (int q = 0; q < 16; ++q) acc[q] += zr * F_b_re[((size_t)lg * 64 + p) * 16 + q] - zi * F_b_im[((size_t)lg * 64 + p) * 16 + q]; }
        if (lag == 0) {
#pragma unroll
            for (int q = 0; q < 16; ++q) if (q == c) acc[q] += F_ssm_d[lg * 16 + c]; }
#pragma unroll
        for (int q = 0; q < 16; ++q) F_KERN[(size_t)i * 16 + q] = acc[q];
    }
    for (int i = F.blk * NTHR + F.tid; i < SEQ * 32; i += F.G * NTHR) { const int pos = i >> 5, j = i & 31;
        const float inv = powf(10000.0f, -(float)j / 32.0f); const float ang = (float)pos * inv; float sn, cs; sincosf(ang, &sn, &cs); F_ROPE[i] = (f32x2){cs, sn}; }
    __syncthreads();
    {
        LAS float* cond = (LAS float*)F.lds;
        LAS float* red = (LAS float*)(F.lds + 32768);
        for (int i = F.tid; i < NB * DM; i += NTHR) cond[i] = silu_f(F_c[i]);
        __syncthreads();
        constexpr int NITM = NL * 6144 / 128;
        for (int it = F.blk; it < NITM; it += F.G) {
            const int col = it * 128 + (F.tid & 127), l = col / 6144, j = col % 6144, ks = F.tid >> 7;
            float acc[8];
#pragma unroll
            for (int b = 0; b < 8; ++b) acc[b] = 0.f;
            const float* wp = F_w_ada + (size_t)l * DM * 6144 + j;
            for (int k = ks * 256; k < ks * 256 + 256; ++k) { const float w = wp[(size_t)k * 6144];
#pragma unroll
                for (int b = 0; b < 8; ++b) acc[b] += cond[b * DM + k] * w; }
#pragma unroll
            for (int b = 0; b < 8; ++b) red[(ks * 128 + (F.tid & 127)) * 8 + b] = acc[b];
            __syncthreads();
            if (F.tid < 128) {
#pragma unroll
                for (int b = 0; b < 8; ++b) { const float s = red[(0 * 128 + F.tid) * 8 + b] + red[(1 * 128 + F.tid) * 8 + b] + red[(2 * 128 + F.tid) * 8 + b] + red[(3 * 128 + F.tid) * 8 + b];
                    F_MOD[((size_t)l * NB + b) * 6144 + j] = s + F_b_ada[(size_t)l * 6144 + j]; }
            }
            __syncthreads();
        }
    }
}

template <int MODE>
__device__ __forceinline__ void norm_phase(Frame& F, int l) {
    LAS int* l_ent = (LAS int*)F.lds;
    LAS int* l_exp = l_ent + 256;
    LAS int* l_cnt = l_exp + 256;
    LAS int* l_base = l_cnt + 32;
    LAS int* l_n = l_base + 32;
    const int rpb = NT / F.G;
    if (MODE == 1) { if (F.tid < 32) l_cnt[F.tid] = 0; if (F.tid == 0) l_n[0] = 0; __syncthreads(); }
    const int nit = (MODE == 1) ? rpb / NWAVES : (NT + F.ngw - 1) / F.ngw;
    for (int it = 0; it < nit; ++it) {
        const int row = (MODE == 1) ? F.blk * rpb + it * NWAVES + F.wave : F.gw + it * F.ngw;
        if (row >= NT) break;
        const int b = row / SEQ;
        const float* xsrc = (MODE == 0 && l == 0) ? F_x : F.out;
        const f32x4* xr = (const f32x4*)(xsrc + (size_t)row * DM) + F.lane;
        f32x4 v[4];
#pragma unroll
        for (int j = 0; j < 4; ++j) v[j] = xr[64 * j];
        if ((MODE == 0 && l > 0) || MODE == 2) {
            const int lp = (MODE == 2) ? NL - 1 : l - 1;
            const f32x4* g2 = (const f32x4*)(F_MOD + ((size_t)lp * NB + b) * 6144 + 5120) + F.lane;
            const u32x2* s0 = (const u32x2*)(F_SLOT + (size_t)row * DM) + F.lane;
            const u32x2* s1 = (const u32x2*)(F_SLOT + (size_t)NT * DM + (size_t)row * DM) + F.lane;
#pragma unroll
            for (int j = 0; j < 4; ++j) { const u32x2 a = s0[64 * j], c = s1[64 * j]; const f32x4 g = g2[64 * j];
                v[j].x += g.x * (bf2f(a.x & 0xffffu) + bf2f(c.x & 0xffffu)); v[j].y += g.y * (bf2f(a.x >> 16) + bf2f(c.x >> 16));
                v[j].z += g.z * (bf2f(a.y & 0xffffu) + bf2f(c.y & 0xffffu)); v[j].w += g.w * (bf2f(a.y >> 16) + bf2f(c.y >> 16)); }
            if (MODE == 0) { f32x4* xo = (f32x4*)(F.out + (size_t)row * DM) + F.lane;
#pragma unroll
                for (int j = 0; j < 4; ++j) xo[64 * j] = v[j]; }
        }
        float ss = 0.f;
#pragma unroll
        for (int j = 0; j < 4; ++j) ss += (v[j].x * v[j].x + v[j].y * v[j].y) + (v[j].z * v[j].z + v[j].w * v[j].w);
        const float rstd = 1.0f / sqrtf(wave_sum(ss) * (1.0f / DM) + EPS);
        if (MODE == 2) {
            const f32x4* g = (const f32x4*)F_final_g + F.lane; f32x4* xo = (f32x4*)(F.out + (size_t)row * DM) + F.lane;
#pragma unroll
            for (int j = 0; j < 4; ++j) xo[64 * j] = v[j] * rstd * g[64 * j];
            continue;
        }
        const f32x4* g = (const f32x4*)((MODE == 0 ? F_norm1_g : F_norm2_g) + (size_t)l * DM) + F.lane;
        const float* modb = F_MOD + ((size_t)l * NB + b) * 6144 + (MODE == 0 ? 0 : 3072);
        const f32x4* sh = (const f32x4*)modb + F.lane; const f32x4* sc = (const f32x4*)(modb + 1024) + F.lane;
        u32x2* ho = (u32x2*)(F_H + (size_t)row * DM) + F.lane;
#pragma unroll
        for (int j = 0; j < 4; ++j) { v[j] = v[j] * rstd * g[64 * j] * (sc[64 * j] + 1.0f) + sh[64 * j]; u32x2 o; o.x = pk2(v[j].x, v[j].y); o.y = pk2(v[j].z, v[j].w); ho[64 * j] = o; }
        if (MODE == 1) {
            LAS float* wl = (LAS float*)(F.lds + 4096 + F.wave * 256);
            const f32x4* wr = (const f32x4*)(F_WrT + (size_t)l * 36 * DM) + F.lane;
#pragma unroll 2
            for (int c = 0; c < 36; ++c) { float p = 0.f;
#pragma unroll
                for (int j = 0; j < 4; ++j) { const f32x4 w = wr[c * 256 + 64 * j]; p += (v[j].x * w.x + v[j].y * w.y) + (v[j].z * w.z + v[j].w * w.w); }
                p = wave_sum(p); if (F.lane == 0) wl[c] = p; }
            LDS_WAIT(); __builtin_amdgcn_wave_barrier();
            float gl[4];
#pragma unroll
            for (int j = 0; j < 4; ++j) gl[j] = wl[j] + F_b_group[l * 4 + j];
            int gi = 0; float gm = gl[0];
#pragma unroll
            for (int j = 1; j < 4; ++j) if (gl[j] > gm) { gm = gl[j]; gi = j; }
            float gs = 0.f;
#pragma unroll
            for (int j = 0; j < 4; ++j) gs += __expf(gl[j] - gm);
            const float gw = 1.0f / gs;
            float ig[8];
#pragma unroll
            for (int j = 0; j < 8; ++j) ig[j] = wl[4 + gi * 8 + j] + F_b_expert[l * 32 + gi * 8 + j];
            __builtin_amdgcn_wave_barrier();
            int i0 = 0; float v0 = ig[0];
#pragma unroll
            for (int j = 1; j < 8; ++j) if (ig[j] > v0) { v0 = ig[j]; i0 = j; }
            int i1 = -1; float v1 = -3.0e38f;
#pragma unroll
            for (int j = 0; j < 8; ++j) if (j != i0 && ig[j] > v1) { v1 = ig[j]; i1 = j; }
            const float e1x = __expf(v1 - v0), w0 = gw / (1.0f + e1x), w1 = gw * e1x / (1.0f + e1x);
            if (F.lane == 0) { F_RW[(size_t)row * 2] = w0; F_RW[(size_t)row * 2 + 1] = w1;
                const int lr = it * NWAVES + F.wave; l_ent[lr * 2] = row * 2; l_ent[lr * 2 + 1] = row * 2 + 1; l_exp[lr * 2] = gi * 8 + i0; l_exp[lr * 2 + 1] = gi * 8 + i1; }
        }
    }
    if (MODE == 1) {
        __syncthreads();
        const int npair = 2 * rpb; int rank = 0, e = 0;
        if (F.tid < npair) { e = l_exp[F.tid]; rank = atomicAdd((int*)&l_cnt[e], 1); }
        __syncthreads();
        if (F.tid < 32) l_base[F.tid] = (int)atomicAdd(F_ctl + CW_CNT + l * 32 + F.tid, (unsigned)l_cnt[F.tid]);
        __syncthreads();
        if (F.tid < npair) F_LIST[(size_t)e * NT + l_base[e] + rank] = l_ent[F.tid];
        __syncthreads();
    }
}


__device__ __forceinline__ void norm2_router_phase(Frame& F, int l) {
    LAS int* l_ent = (LAS int*)F.lds;
    LAS int* l_exp = l_ent + 256;
    LAS int* l_cnt = l_exp + 256;
    LAS int* l_base = l_cnt + 32;
    LAS float* lgs = (LAS float*)(F.lds + 4096 + F.wave * 3072);
    if (F.tid < 32) l_cnt[F.tid] = 0;
    __syncthreads();
    const int fr = F.lane & 15, fq = F.lane >> 4;
    const int row = F.blk * 128 + F.wave * 16 + fr, b = (F.blk * 128) / SEQ;
    const float* xr = F.out + (size_t)row * DM + fq * 8;
    float ss = 0.f;
#pragma unroll 4
    for (int ks = 0; ks < 32; ++ks) { const f32x4 a = *(const f32x4*)(xr + ks * 32), c = *(const f32x4*)(xr + ks * 32 + 4);
        ss += (a.x * a.x + a.y * a.y) + (a.z * a.z + a.w * a.w) + (c.x * c.x + c.y * c.y) + (c.z * c.z + c.w * c.w); }
    ss += __shfl_xor(ss, 16); ss += __shfl_xor(ss, 32);
    const float rstd = 1.0f / sqrtf(ss * (1.0f / DM) + EPS);
    const float* gp = F_norm2_g + (size_t)l * DM + fq * 8;
    const float* shp = F_MOD + ((size_t)l * NB + b) * 6144 + 3072 + fq * 8; const float* scp = shp + 1024;
    const bf16* wb = F_WRHL + (size_t)l * 2 * 48 * DM + (size_t)fr * DM + fq * 8;
    bf16* hrow = F_H + (size_t)row * DM + fq * 8;
    f32x4 acc[3];
#pragma unroll
    for (int t = 0; t < 3; ++t) acc[t] = (f32x4){0.f, 0.f, 0.f, 0.f};
#pragma unroll 2
    for (int ks = 0; ks < 32; ++ks) {
        const f32x4 a = *(const f32x4*)(xr + ks * 32), c = *(const f32x4*)(xr + ks * 32 + 4);
        const f32x4 g0 = *(const f32x4*)(gp + ks * 32), g1 = *(const f32x4*)(gp + ks * 32 + 4);
        const f32x4 s0 = *(const f32x4*)(scp + ks * 32), s1 = *(const f32x4*)(scp + ks * 32 + 4);
        const f32x4 h0 = *(const f32x4*)(shp + ks * 32), h1 = *(const f32x4*)(shp + ks * 32 + 4);
        const f32x4 v0 = a * rstd * g0 * (s0 + 1.0f) + h0, v1 = c * rstd * g1 * (s1 + 1.0f) + h1;
        u32x4 hi; hi.x = pk2(v0.x, v0.y); hi.y = pk2(v0.z, v0.w); hi.z = pk2(v1.x, v1.y); hi.w = pk2(v1.z, v1.w);
        *(u32x4*)(hrow + ks * 32) = hi;
        u32x4 lo; lo.x = pk2(v0.x - bf2f(hi.x & 0xffffu), v0.y - bf2f(hi.x >> 16)); lo.y = pk2(v0.z - bf2f(hi.y & 0xffffu), v0.w - bf2f(hi.y >> 16));
        lo.z = pk2(v1.x - bf2f(hi.z & 0xffffu), v1.y - bf2f(hi.z >> 16)); lo.w = pk2(v1.z - bf2f(hi.w & 0xffffu), v1.w - bf2f(hi.w >> 16));
        const bf16x8 ahi = __builtin_bit_cast(bf16x8, hi), alo = __builtin_bit_cast(bf16x8, lo);
#pragma unroll
        for (int t = 0; t < 3; ++t) { const bf16x8 bh = *(const bf16x8*)(wb + (size_t)(t * 16) * DM + ks * 32), bl = *(const bf16x8*)(wb + (size_t)(48 + t * 16) * DM + ks * 32);
            acc[t] = __builtin_amdgcn_mfma_f32_16x16x32_bf16(bh, ahi, acc[t], 0, 0, 0);
            acc[t] = __builtin_amdgcn_mfma_f32_16x16x32_bf16(bh, alo, acc[t], 0, 0, 0);
            acc[t] = __builtin_amdgcn_mfma_f32_16x16x32_bf16(bl, ahi, acc[t], 0, 0, 0); }
    }
#pragma unroll
    for (int t = 0; t < 3; ++t)
#pragma unroll
        for (int r = 0; r < 4; ++r) lgs[fr * 48 + t * 16 + 4 * fq + r] = acc[t][r];
    LDS_WAIT(); __builtin_amdgcn_wave_barrier();
    {
        const LAS float* wl = lgs + fr * 48;
        float gl[4];
#pragma unroll
        for (int j = 0; j < 4; ++j) gl[j] = wl[j] + F_b_group[l * 4 + j];
        int gi = 0; float gm = gl[0];
#pragma unroll
        for (int j = 1; j < 4; ++j) if (gl[j] > gm) { gm = gl[j]; gi = j; }
        float gs = 0.f;
#pragma unroll
        for (int j = 0; j < 4; ++j) gs += __expf(gl[j] - gm);
        const float gw = 1.0f / gs;
        float ig[8];
#pragma unroll
        for (int j = 0; j < 8; ++j) ig[j] = wl[4 + gi * 8 + j] + F_b_expert[l * 32 + gi * 8 + j];
        int i0 = 0; float v0 = ig[0];
#pragma unroll
        for (int j = 1; j < 8; ++j) if (ig[j] > v0) { v0 = ig[j]; i0 = j; }
        int i1 = -1; float v1 = -3.0e38f;
#pragma unroll
        for (int j = 0; j < 8; ++j) if (j != i0 && ig[j] > v1) { v1 = ig[j]; i1 = j; }
        const float e1x = __expf(v1 - v0), w0 = gw / (1.0f + e1x), w1 = gw * e1x / (1.0f + e1x);
        if (fq == 0) { F_RW[(size_t)row * 2] = w0; F_RW[(size_t)row * 2 + 1] = w1;
            const int lr = F.wave * 16 + fr; l_ent[lr * 2] = row * 2; l_ent[lr * 2 + 1] = row * 2 + 1; l_exp[lr * 2] = gi * 8 + i0; l_exp[lr * 2 + 1] = gi * 8 + i1; }
    }
    __syncthreads();
    int rank = 0, e = 0;
    if (F.tid < 256) { e = l_exp[F.tid]; rank = atomicAdd((int*)&l_cnt[e], 1); }
    __syncthreads();
    if (F.tid < 32) l_base[F.tid] = (int)atomicAdd(F_ctl + CW_CNT + l * 32 + F.tid, (unsigned)l_cnt[F.tid]);
    __syncthreads();
    if (F.tid < 256) F_LIST[(size_t)e * NT + l_base[e] + rank] = l_ent[F.tid];
    __syncthreads();
}

template <int EPI>
__device__ __forceinline__ void gemm_simple(Frame& F, int l, const bf16* A, int lda, const bf16* Bt, int N, int K) {
    const int fr = F.lane & 15, fq = F.lane >> 4, wm = F.wave >> 1, wn = F.wave & 1;
    const int nnt = N / 128, nu = (NT / 256) * nnt;
    for (int u = F.blk; u < nu; u += F.G) {
        const int pm = u / nnt, pn = u % nnt, m0 = pm * 256 + wm * 64, n0 = pn * 128 + wn * 64;
        const bf16* arow[4]; const bf16* brow[4];
#pragma unroll
        for (int i = 0; i < 4; ++i) { arow[i] = A + (size_t)(m0 + i * 16 + fr) * lda + fq * 8; brow[i] = Bt + (size_t)(n0 + i * 16 + fr) * K + fq * 8; }
        f32x4 acc[4][4];
        wave_gemm64(acc, arow, brow, K);
#pragma unroll
        for (int i = 0; i < 4; ++i) { const int row = m0 + i * 16 + fr;
#pragma unroll
            for (int j = 0; j < 4; ++j) { const int col = n0 + j * 16 + 4 * fq; const f32x4 a = acc[i][j];
                if (EPI == 0) { u32x2 o; o.x = pk2(a.x, a.y); o.y = pk2(a.z, a.w); *(u32x2*)(F_QKV + (size_t)row * INW + col) = o; }
                if (EPI == 1) { const float* xb = (l == 0 ? F_x : F.out); const f32x4 xv = *(const f32x4*)(xb + (size_t)row * DM + col);
                    const f32x4 g1 = *(const f32x4*)(F_MOD + ((size_t)l * NB + row / SEQ) * 6144 + 2048 + col); *(f32x4*)(F.out + (size_t)row * DM + col) = xv + g1 * a; }
                if (EPI == 2) { const u32x2 y = *(const u32x2*)(F_YG + (size_t)row * 256 + col); const f32x4 bg = *(const f32x4*)(F_b_glu + l * 256 + col);
                    const float y0 = bf2f(y.x & 0xffffu), y1 = bf2f(y.x >> 16), y2 = bf2f(y.y & 0xffffu), y3 = bf2f(y.y >> 16);
                    u32x2 o; o.x = pk2(y0 * sigmoid_f(a.x + bg.x), y1 * sigmoid_f(a.y + bg.y)); o.y = pk2(y2 * sigmoid_f(a.z + bg.z), y3 * sigmoid_f(a.w + bg.w));
                    *(u32x2*)(F_MIX + (size_t)row * DM + 512 + col) = o; }
            } }
    }
}

__device__ __forceinline__ void moe_tables(Frame& F, int l) {
    LAS int* t_cnt = (LAS int*)F.lds; LAS int* t_toff = t_cnt + 32; LAS int* t_aoff = t_toff + 34;
    __syncthreads();
    if (F.tid == 0) { int to = 0, ao = 0;
        for (int e = 0; e < NE; ++e) { const int c = (int)__hip_atomic_load(F_ctl + CW_CNT + l * 32 + e, __ATOMIC_RELAXED, __HIP_MEMORY_SCOPE_AGENT); t_cnt[e] = c; t_toff[e] = to; t_aoff[e] = ao; to += (c + 63) >> 6; ao += ((c + 255) >> 8) << 8; }
        t_toff[NE] = to; }
    __syncthreads();
}
template <int STAGE>
__device__ __forceinline__ void moe_simple(Frame& F, int l) {
    LAS int* t_cnt = (LAS int*)F.lds; LAS int* t_toff = t_cnt + 32; LAS int* t_aoff = t_toff + 34;
    moe_tables(F, l);
    const int fr = F.lane & 15, fq = F.lane >> 4;
    constexpr int NSUB = (STAGE == 1) ? 8 : 16;
    const int ntask = t_toff[NE] * NSUB;
    for (int task = F.gw; task < ntask; task += F.ngw) {
        const int rtg = task / NSUB, sub = task % NSUB;
        int e = 0;
        for (int q = 1; q < NE; ++q) if (t_toff[q] <= rtg) e = q;
        const int rt = rtg - t_toff[e], cnt = t_cnt[e], arow0 = t_aoff[e] + rt * 64;
        int ent[4];
#pragma unroll
        for (int i = 0; i < 4; ++i) { const int pos = rt * 64 + i * 16 + fr; ent[i] = pos < cnt ? F_LIST[(size_t)e * NT + pos] : -1; }
        const bf16* arow[4]; const bf16* brow[4];
        f32x4 acc[4][4];
        if (STAGE == 1) {
            const bf16* wb = F_WguT + (size_t)(l * NE + e) * 512 * DM;
#pragma unroll
            for (int i = 0; i < 4; ++i) { const int tok = ent[i] >= 0 ? (ent[i] >> 1) : 0; arow[i] = F_H + (size_t)tok * DM + fq * 8;
                const int f = sub * 32 + (i & 1) * 16 + fr; const int br = (f >> 7) * 256 + (i >> 1) * 128 + (f & 127); brow[i] = wb + (size_t)br * DM + fq * 8; }
            wave_gemm64(acc, arow, brow, DM);
#pragma unroll
            for (int i = 0; i < 4; ++i) { const float w = ent[i] >= 0 ? F_RW[ent[i]] : 0.f;
#pragma unroll
                for (int j = 0; j < 2; ++j) { const f32x4 g = acc[i][j], u = acc[i][j + 2];
                    u32x2 o; o.x = pk2(silu_f(g.x) * u.x * w, silu_f(g.y) * u.y * w); o.y = pk2(silu_f(g.z) * u.z * w, silu_f(g.w) * u.w * w);
                    *(u32x2*)(F_ACT + (size_t)(arow0 + i * 16 + fr) * FF + sub * 32 + j * 16 + 4 * fq) = o; } }
        } else {
            const bf16* wb = F_WdT + (size_t)(l * NE + e) * DM * FF;
#pragma unroll
            for (int i = 0; i < 4; ++i) { arow[i] = F_ACT + (size_t)(arow0 + i * 16 + fr) * FF + fq * 8; brow[i] = wb + (size_t)(sub * 64 + i * 16 + fr) * FF + fq * 8; }
            wave_gemm64(acc, arow, brow, FF);
#pragma unroll
            for (int i = 0; i < 4; ++i) { if (ent[i] >= 0) { bf16* orow = F_SLOT + (size_t)(ent[i] & 1) * NT * DM + (size_t)(ent[i] >> 1) * DM + sub * 64 + 4 * fq;
#pragma unroll
                for (int j = 0; j < 4; ++j) { const f32x4 a = acc[i][j]; u32x2 o; o.x = pk2(a.x, a.y); o.y = pk2(a.z, a.w); *(u32x2*)(orow + j * 16) = o; } } }
        }
    }
}


constexpr int MOE_LDS = 131072;
constexpr int MOE_MAXU = 8;
struct MoeOrder {
    LAS const int* ud; LAS const int* rows; const char* A; const char* Bt; size_t strideE, tstepA, tstepB; bool gather;
    __device__ __forceinline__ bool next(int i, pg8::Unit& u) const { if (i >= MOE_MAXU || ud[i * 4 + 3] == 0) return false; u.pm = ud[i * 4]; u.pn = ud[i * 4 + 1]; u.e = ud[i * 4 + 2]; u.i = i; return true; }
    __device__ __forceinline__ const char* a_base(const pg8::Unit& u) const { return gather ? A : A + (size_t)u.pm * tstepA; }
    __device__ __forceinline__ const char* b_base(const pg8::Unit& u) const { return Bt + (size_t)u.e * strideE + (size_t)u.pn * tstepB; }
    __device__ __forceinline__ int row(const pg8::Unit& u, int r) const { if (!gather) return r; const int ent = rows[u.i * 256 + r]; return ent >= 0 ? (ent >> 1) : 0; }
};
struct EpiMoe1 {
    static constexpr bool PERM = true;
    bf16* act; const float* rw; LAS const int* rows;
    __device__ __forceinline__ void operator()(const f32x4 (&acc)[2][2][4][2], const pg8::Unit& u, int wr, int wc, int fr, int fq) const {
#pragma unroll
        for (int ai = 0; ai < 2; ++ai)
#pragma unroll
            for (int m = 0; m < 4; ++m) { const int rl = ai * 128 + wr * 64 + m * 16 + fr; const int ent = rows[u.i * 256 + rl]; const float w = ent >= 0 ? rw[ent] : 0.f;
                const f32x4 g0 = acc[ai][0][m][0], g1 = acc[ai][0][m][1], u0 = acc[ai][1][m][0], u1 = acc[ai][1][m][1];
                u32x4 o; o.x = pg8::cvt_pk_bf16(silu_f(g0[0]) * u0[0] * w, silu_f(g0[1]) * u0[1] * w); o.y = pg8::cvt_pk_bf16(silu_f(g0[2]) * u0[2] * w, silu_f(g0[3]) * u0[3] * w);
                o.z = pg8::cvt_pk_bf16(silu_f(g1[0]) * u1[0] * w, silu_f(g1[1]) * u1[1] * w); o.w = pg8::cvt_pk_bf16(silu_f(g1[2]) * u1[2] * w, silu_f(g1[3]) * u1[3] * w);
                *(u32x4*)(act + ((size_t)u.pm * 256 + rl) * FF + u.pn * 128 + wc * 32 + 8 * fq) = o; }
    }
};
struct EpiMoe2 {
    static constexpr bool PERM = true;
    bf16* slot; LAS const int* rows;
    __device__ __forceinline__ void operator()(const f32x4 (&acc)[2][2][4][2], const pg8::Unit& u, int wr, int wc, int fr, int fq) const {
#pragma unroll
        for (int ai = 0; ai < 2; ++ai)
#pragma unroll
            for (int m = 0; m < 4; ++m) { const int rl = ai * 128 + wr * 64 + m * 16 + fr; const int ent = rows[u.i * 256 + rl];
                if (ent >= 0) { bf16* rowp = slot + (size_t)(ent & 1) * NT * DM + (size_t)(ent >> 1) * DM + u.pn * 256 + wc * 32 + 8 * fq;
#pragma unroll
                    for (int bj = 0; bj < 2; ++bj) { const f32x4 v0 = acc[ai][bj][m][0], v1 = acc[ai][bj][m][1];
                        u32x4 w; w.x = pg8::cvt_pk_bf16(v0[0], v0[1]); w.y = pg8::cvt_pk_bf16(v0[2], v0[3]); w.z = pg8::cvt_pk_bf16(v1[0], v1[1]); w.w = pg8::cvt_pk_bf16(v1[2], v1[3]);
                        *(u32x4*)(rowp + bj * 128) = w; } } }
    }
};
template <int STAGE>
__device__ __forceinline__ void moe_pg8(Frame& F, int l) {
    LAS int* t_cnt = (LAS int*)(F.lds + MOE_LDS);
    LAS int* t_toff = t_cnt + 32;
    LAS int* ud = t_toff + 36;
    LAS int* rows = ud + 32;
    constexpr int NPN = (STAGE == 1) ? 2 : 4;
    __syncthreads();
    if (F.tid == 0) { int to = 0;
        for (int e = 0; e < NE; ++e) { const int c = (int)__hip_atomic_load(F_ctl + CW_CNT + l * 32 + e, __ATOMIC_RELAXED, __HIP_MEMORY_SCOPE_AGENT); t_cnt[e] = c; t_toff[e] = to; to += (c + 255) >> 8; }
        t_toff[NE] = to; }
    __syncthreads();
    const int total = t_toff[NE] * NPN;
    for (int i = 0; i < MOE_MAXU; ++i) {
        const int L = i * F.G + F.blk; const bool valid = L < total;
        int rtg = 0, pn = 0, e = 0;
        if (valid) { rtg = L / NPN; pn = L % NPN; for (int q = 1; q < NE; ++q) if (t_toff[q] <= rtg) e = q; }
        if (F.tid == 0) { ud[i * 4] = rtg; ud[i * 4 + 1] = pn; ud[i * 4 + 2] = e; ud[i * 4 + 3] = valid ? 1 : 0; }
        if (F.tid < 256) { int ent = -1; if (valid) { const int pos = (rtg - t_toff[e]) * 256 + F.tid; if (pos < t_cnt[e]) ent = F_LIST[(size_t)e * NT + pos]; } rows[i * 256 + F.tid] = ent; }
    }
    __syncthreads();
    MoeOrder S; S.ud = ud; S.rows = rows;
    if (STAGE == 1) { S.A = (const char*)F_H; S.Bt = (const char*)(F_WguT + (size_t)l * NE * 512 * DM); S.strideE = (size_t)512 * DM * 2; S.tstepA = 0; S.tstepB = (size_t)256 * DM * 2; S.gather = true;
        EpiMoe1 E{F_ACT, F_RW, rows};
        pg8::gemm_phase<EpiMoe1, MoeOrder, true>(F.lds, DM, DM, DM, S, E);
    } else { S.A = (const char*)F_ACT; S.Bt = (const char*)(F_WdT + (size_t)l * NE * DM * FF); S.strideE = (size_t)DM * FF * 2; S.tstepA = (size_t)256 * FF * 2; S.tstepB = (size_t)256 * FF * 2; S.gather = false;
        EpiMoe2 E{F_SLOT, rows};
        pg8::gemm_phase<EpiMoe2, MoeOrder, false>(F.lds, FF, FF, FF, S, E);
    }
}


__device__ __forceinline__ void s5_build_operands(Frame& F, int l) {
    const int gt = F.blk * NTHR + F.tid, ngt = F.G * NTHR;
    for (int i = gt; i < 16 * 1024 * (U2K / 8); i += ngt) {
        const int kv = i % (U2K / 8), row = (i / (U2K / 8)) & 1023, g = i / ((U2K / 8) * 1024), t = row >> 4, c = row & 15, k0 = kv * 8;
        float v[8];
        if (k0 < 128) {
            const int lg = l * 16 + g; const float dt = __expf(F_log_dt[lg]);
#pragma unroll
            for (int q = 0; q < 8; ++q) { const int p = (k0 + q) & 63; const float are = F_a_re[lg * 64 + p], aim = F_a_im[lg * 64 + p];
                const float pm = expf((float)(t + 1) * are * dt); float sn, cs; sincosf((float)(t + 1) * aim * dt, &sn, &cs);
                const float cr = F_c_re[((size_t)lg * 16 + c) * 64 + p], ci = F_c_im[((size_t)lg * 16 + c) * 64 + p];
                v[q] = (k0 < 64) ? (cr * pm * cs - ci * pm * sn) : -(cr * pm * sn + ci * pm * cs); }
        } else {
            const int s = (k0 - 128) >> 4, c1 = (k0 - 128) & 15;
            if (t >= s) { const float* kp = F_KERN + ((((size_t)(l * 16 + g) * 64 + (t - s)) * 16 + c) * 16 + c1); const f32x4 a = *(const f32x4*)kp, b = *(const f32x4*)(kp + 4);
                v[0] = a.x; v[1] = a.y; v[2] = a.z; v[3] = a.w; v[4] = b.x; v[5] = b.y; v[6] = b.z; v[7] = b.w; }
            else {
#pragma unroll
                for (int q = 0; q < 8; ++q) v[q] = 0.f; }
        }
        u32x4 o; o.x = pk2(v[0], v[1]); o.y = pk2(v[2], v[3]); o.z = pk2(v[4], v[5]); o.w = pk2(v[6], v[7]);
        *(u32x4*)(F_TMAT + ((size_t)(g * 1024 + row)) * U2K + k0) = o;
    }
    for (int i = gt; i < 16 * 256 * 128; i += ngt) {
        const int kv = i & 127, n = (i >> 7) & 255, g = i >> 15, s = kv >> 1, c0 = (kv & 1) * 8;
        float v[8];
#pragma unroll
        for (int q = 0; q < 8; ++q) v[q] = 0.f;
        if (n < 128) { const int p = n & 63, lg = l * 16 + g; const float dt = __expf(F_log_dt[lg]), are = F_a_re[lg * 64 + p], aim = F_a_im[lg * 64 + p];
            const float pm = expf((float)(63 - s) * are * dt); float sn, cs; sincosf((float)(63 - s) * aim * dt, &sn, &cs); const float pr = pm * cs, pi = pm * sn;
#pragma unroll
            for (int q = 0; q < 8; ++q) { const f32x2 bb = F_BBAR[((size_t)lg * 64 + p) * 16 + c0 + q]; v[q] = (n < 64) ? (pr * bb.x - pi * bb.y) : (pr * bb.y + pi * bb.x); } }
        u32x4 o; o.x = pk2(v[0], v[1]); o.y = pk2(v[2], v[3]); o.z = pk2(v[4], v[5]); o.w = pk2(v[6], v[7]);
        *(u32x4*)(F_BT1 + ((size_t)(g * 256 + n)) * 1024 + s * 16 + c0) = o;
    }
}
struct GroupOrder {
    int G, c, npn, nunit; const char* A; const char* Bt; size_t strideB, tstepA, tstepB;
    __device__ __forceinline__ bool next(int i, pg8::Unit& u) const { const int L = i * G + c; if (L >= nunit) return false; u.pn = L % npn; u.pm = (L / npn) & 1; u.e = L / (npn * 2); u.i = i; return true; }
    __device__ __forceinline__ const char* a_base(const pg8::Unit& u) const { return A + (size_t)u.e * (U2K * 2) + (size_t)u.pm * tstepA; }
    __device__ __forceinline__ const char* b_base(const pg8::Unit& u) const { return Bt + (size_t)u.e * strideB + (size_t)u.pn * tstepB; }
    __device__ __forceinline__ int row(const pg8::Unit&, int r) const { return r; }
};
struct EpiS5a {
    static constexpr bool PERM = false;
    float* sendp;
    __device__ __forceinline__ void operator()(const f32x4 (&acc)[2][2][4][2], const pg8::Unit& u, int wr, int wc, int fr, int fq) const {
#pragma unroll
        for (int ai = 0; ai < 2; ++ai)
#pragma unroll
            for (int m = 0; m < 4; ++m) { const int R = u.pm * 256 + ai * 128 + wr * 64 + m * 16 + fr; float* rowp = sendp + ((size_t)R * 16 + u.e) * 128 + wc * 32 + 4 * fq;
#pragma unroll
                for (int n = 0; n < 2; ++n) *(f32x4*)(rowp + n * 16) = acc[ai][0][m][n]; }
    }
};
struct EpiS5b {
    static constexpr bool PERM = true;
    bf16* yg;
    __device__ __forceinline__ void operator()(const f32x4 (&acc)[2][2][4][2], const pg8::Unit& u, int wr, int wc, int fr, int fq) const {
#pragma unroll
        for (int ai = 0; ai < 2; ++ai)
#pragma unroll
            for (int m = 0; m < 4; ++m) { const int R = u.pm * 256 + ai * 128 + wr * 64 + m * 16 + fr;
#pragma unroll
                for (int bj = 0; bj < 2; ++bj) { const int col0 = u.pn * 256 + bj * 128 + wc * 32 + 8 * fq, t = col0 >> 4, c0 = col0 & 15; const f32x4 v0 = acc[ai][bj][m][0], v1 = acc[ai][bj][m][1];
                    u32x4 w; w.x = pg8::cvt_pk_bf16(gelu_tanh_f(v0[0]), gelu_tanh_f(v0[1])); w.y = pg8::cvt_pk_bf16(gelu_tanh_f(v0[2]), gelu_tanh_f(v0[3]));
                    w.z = pg8::cvt_pk_bf16(gelu_tanh_f(v1[0]), gelu_tanh_f(v1[1])); w.w = pg8::cvt_pk_bf16(gelu_tanh_f(v1[2]), gelu_tanh_f(v1[3]));
                    *(u32x4*)(yg + ((size_t)R * 64 + t) * 256 + u.e * 16 + c0) = w; } }
    }
};
struct EpiGlu {
    static constexpr bool PERM = true;
    const bf16* yg; bf16* mix; const float* bglu;
    __device__ __forceinline__ void operator()(const f32x4 (&acc)[2][2][4][2], const pg8::Unit& u, int wr, int wc, int fr, int fq) const {
#pragma unroll
        for (int ai = 0; ai < 2; ++ai)
#pragma unroll
            for (int m = 0; m < 4; ++m) { const size_t row = (size_t)u.pm * 256 + ai * 128 + wr * 64 + m * 16 + fr;
#pragma unroll
                for (int bj = 0; bj < 2; ++bj) { const int col0 = bj * 128 + wc * 32 + 8 * fq; const u32x4 y = *(const u32x4*)(yg + row * 256 + col0);
                    const f32x4 b0 = *(const f32x4*)(bglu + col0), b1 = *(const f32x4*)(bglu + col0 + 4); const f32x4 v0 = acc[ai][bj][m][0] + b0, v1 = acc[ai][bj][m][1] + b1;
                    u32x4 w; w.x = pg8::cvt_pk_bf16(bf2f(y.x & 0xffffu) * sigmoid_f(v0[0]), bf2f(y.x >> 16) * sigmoid_f(v0[1])); w.y = pg8::cvt_pk_bf16(bf2f(y.y & 0xffffu) * sigmoid_f(v0[2]), bf2f(y.y >> 16) * sigmoid_f(v0[3]));
                    w.z = pg8::cvt_pk_bf16(bf2f(y.z & 0xffffu) * sigmoid_f(v1[0]), bf2f(y.z >> 16) * sigmoid_f(v1[1])); w.w = pg8::cvt_pk_bf16(bf2f(y.w & 0xffffu) * sigmoid_f(v1[2]), bf2f(y.w >> 16) * sigmoid_f(v1[3]));
                    *(u32x4*)(mix + row * DM + 512 + col0) = w; } }
    }
};

__device__ __forceinline__ float ret_log2gamma(int h) { return log2f(1.0f - exp2f(-5.0f - (float)h)); }

__device__ __forceinline__ void p3_local(Frame& F, int l) {
    {
        LAS float* ks = (LAS float*)F.lds;
        LAS float* vs = ks + 64 * 65;
        for (int u = F.blk; u < NB * NCH * 4; u += F.G) {
            const int h = u & 3, n = (u >> 2) & 63, b = u >> 8; const float lg = ret_log2gamma(h);
            const size_t row0 = (size_t)b * SEQ + n * 64;
            __syncthreads();
#pragma unroll
            for (int q = 0; q < 4; ++q) { const int idx = F.tid + q * NTHR, j = idx >> 5, d = idx & 31;
                const bf16* kp = F_QKV + (row0 + j) * INW + C_KR + h * 64; const float k1 = bf2f(kp[d]), k2 = bf2f(kp[d + 32]);
                const f32x2 cs = F_ROPE[(n * 64 + j) * 32 + d]; const float z = 0.125f * exp2f(lg * (float)(63 - j));
                ks[j * 65 + d] = (k1 * cs.x - k2 * cs.y) * z; ks[j * 65 + d + 32] = (k1 * cs.y + k2 * cs.x) * z; }
#pragma unroll
            for (int q = 0; q < 8; ++q) { const int idx = F.tid + q * NTHR, j = idx >> 6, e = idx & 63; vs[j * 65 + e] = bf2f(F_QKV[(row0 + j) * INW + C_VR + h * 64 + e]); }
            __syncthreads();
            const int d = F.tid >> 3, e0 = (F.tid & 7) * 8; float acc[8];
#pragma unroll
            for (int q = 0; q < 8; ++q) acc[q] = 0.f;
            for (int j = 0; j < 64; ++j) { const float kd = ks[j * 65 + d];
#pragma unroll
                for (int q = 0; q < 8; ++q) acc[q] += kd * vs[j * 65 + e0 + q]; }
            float* o = F_KV + ((size_t)((b * NCH + n) * 4 + h)) * 4096 + d * 64 + e0;
#pragma unroll
            for (int q = 0; q < 8; ++q) o[q] = acc[q];
        }
        __syncthreads();
    }
}

template <int NQT> __device__ __forceinline__ void attn_mfma(Frame& F, int l);
__device__ __forceinline__ void p4_scan_attn(Frame& F, int l) {
    for (int i = F.blk * NTHR + F.tid; i < NB * 16 * 64; i += F.G * NTHR) { const int b = i >> 10, g = (i >> 6) & 15, p = i & 63; const f32x2 a64 = F_ABAR64[l * 1024 + (i & 1023)];
        float xr = 0.f, xi = 0.f;
        for (int n = 0; n < NCH; ++n) { const size_t r = (size_t)(b * NCH + n) * 16 + g; bf16* cp = F_U2X + r * U2K; cp[p] = (bf16)f2bf(xr); cp[64 + p] = (bf16)f2bf(xi);
            const float sr = F_SENDP[r * 128 + p], si = F_SENDP[r * 128 + 64 + p];
            const float nr = a64.x * xr - a64.y * xi + sr, ni = a64.x * xi + a64.y * xr + si; xr = nr; xi = ni; } }
    for (int i = F.blk * NTHR + F.tid; i < NB * 4 * 4096; i += F.G * NTHR) { const int b = i >> 14, h = (i >> 12) & 3, de = i & 4095; const float g64 = exp2f(64.f * ret_log2gamma(h));
        float s = 0.f;
        for (int n = 0; n < NCH; ++n) { float* p = F_KV + ((size_t)((b * NCH + n) * 4 + h)) * 4096 + de; const float t = *p; *p = s; s = g64 * s + t; } }
#if ATTN_NQT > 0
    for (int rep = 0; rep < REP_AT; ++rep) attn_mfma<ATTN_NQT>(F, l);
#else
    for (int u = F.gw; u < NB * NCH * 8; u += F.ngw) {
        const int h = u & 7, n = (u >> 3) & 63, b = u >> 9, qi = F.lane;
        const size_t qrow = (size_t)b * SEQ + n * 64 + qi;
        float q[64], o[64];
        { const u32x4* qp = (const u32x4*)(F_QKV + qrow * INW + C_QA + h * 64);
#pragma unroll
            for (int c = 0; c < 8; ++c) { const u32x4 w = qp[c]; q[8 * c] = 0.125f * bf2f(w.x & 0xffffu); q[8 * c + 1] = 0.125f * bf2f(w.x >> 16); q[8 * c + 2] = 0.125f * bf2f(w.y & 0xffffu); q[8 * c + 3] = 0.125f * bf2f(w.y >> 16);
                q[8 * c + 4] = 0.125f * bf2f(w.z & 0xffffu); q[8 * c + 5] = 0.125f * bf2f(w.z >> 16); q[8 * c + 6] = 0.125f * bf2f(w.w & 0xffffu); q[8 * c + 7] = 0.125f * bf2f(w.w >> 16); } }
#pragma unroll
        for (int d = 0; d < 64; ++d) o[d] = 0.f;
        float m = -1.0e30f, ls = 0.f;
        const float* bias = F_rel_bias + (size_t)(l * 8 + h) * 192;
        const int kc0 = n >= 8 ? n - 8 : 0;
        for (int kk = kc0 * 64; kk < (n + 1) * 64; ++kk) {
            const bf16* kr = F_QKV + ((size_t)b * SEQ + kk) * INW + C_KA + h * 64;
            float dot = 0.f;
#pragma unroll
            for (int c = 0; c < 8; ++c) { const u32x4 w = ((const u32x4*)kr)[c];
                dot += q[8 * c] * bf2f(w.x & 0xffffu) + q[8 * c + 1] * bf2f(w.x >> 16) + q[8 * c + 2] * bf2f(w.y & 0xffffu) + q[8 * c + 3] * bf2f(w.y >> 16)
                     + q[8 * c + 4] * bf2f(w.z & 0xffffu) + q[8 * c + 5] * bf2f(w.z >> 16) + q[8 * c + 6] * bf2f(w.w & 0xffffu) + q[8 * c + 7] * bf2f(w.w >> 16); }
            int rel = kk - (n * 64 + qi); rel = rel < -128 ? -128 : (rel > 63 ? 63 : rel);
            const float s = dot + bias[rel + 128];
            if (s > m) { const float sc = __expf(m - s); ls *= sc;
#pragma unroll
                for (int d = 0; d < 64; ++d) o[d] *= sc;
                m = s; }
            const float p = __expf(s - m); ls += p;
            const bf16* vr = F_QKV + ((size_t)b * SEQ + kk) * INW + C_VA + h * 64;
#pragma unroll
            for (int c = 0; c < 8; ++c) { const u32x4 w = ((const u32x4*)vr)[c];
                o[8 * c] += p * bf2f(w.x & 0xffffu); o[8 * c + 1] += p * bf2f(w.x >> 16); o[8 * c + 2] += p * bf2f(w.y & 0xffffu); o[8 * c + 3] += p * bf2f(w.y >> 16);
                o[8 * c + 4] += p * bf2f(w.z & 0xffffu); o[8 * c + 5] += p * bf2f(w.z >> 16); o[8 * c + 6] += p * bf2f(w.w & 0xffffu); o[8 * c + 7] += p * bf2f(w.w >> 16); }
        }
        const float inv = 1.0f / ls;
        u32x4* op = (u32x4*)(F_MIX + qrow * DM + h * 64);
#pragma unroll
        for (int c = 0; c < 8; ++c) { u32x4 w; w.x = pk2(o[8 * c] * inv, o[8 * c + 1] * inv); w.y = pk2(o[8 * c + 2] * inv, o[8 * c + 3] * inv); w.z = pk2(o[8 * c + 4] * inv, o[8 * c + 5] * inv); w.w = pk2(o[8 * c + 6] * inv, o[8 * c + 7] * inv); op[c] = w; }
    }
#endif
}


typedef short v4i16_t __attribute__((ext_vector_type(4)));
template <int NQT>
__device__ __forceinline__ void attn_mfma(Frame& F, int l) {
    const int lane = F.lane, fr = lane & 15, fq = lane >> 4;
    LAS unsigned char* vl = F.lds + F.wave * 10240;
    LAS float* bl = (LAS float*)(vl + 9216);
    constexpr int QPW = NQT * 16, TPC = 64 / QPW;
    constexpr float LOG2E = 1.4426950408889634f, SC = 0.125f * LOG2E;
    const int ntask = NB * NCH * 8 * TPC;
    const unsigned vtr0 = (unsigned)((4 * fq + (fr >> 2)) * 144 + (fr & 3) * 8);
    for (int task = F.gw; task < ntask; task += F.ngw) {
        const int sub = task % TPC, u = task / TPC, h = u & 7, n = (u >> 3) & 63, b = u >> 9;
        const size_t qrow0 = (size_t)b * SEQ + n * 64 + sub * QPW;
        __builtin_amdgcn_wave_barrier();
#pragma unroll
        for (int i = 0; i < 3; ++i) bl[lane + 64 * i] = F_rel_bias[(size_t)(l * 8 + h) * 192 + lane + 64 * i] * LOG2E;
        bf16x8 qf[NQT][2];
#pragma unroll
        for (int qt = 0; qt < NQT; ++qt)
#pragma unroll
            for (int ks = 0; ks < 2; ++ks) qf[qt][ks] = *(const bf16x8*)(F_QKV + (qrow0 + qt * 16 + fr) * INW + C_QA + h * 64 + ks * 32 + fq * 8);
        f32x4 ot[4][NQT]; float mrow[NQT], lp[NQT];
#pragma unroll
        for (int qt = 0; qt < NQT; ++qt) { mrow[qt] = -1.0e30f; lp[qt] = 0.f;
#pragma unroll
            for (int et = 0; et < 4; ++et) ot[et][qt] = (f32x4){0.f, 0.f, 0.f, 0.f}; }
        LDS_WAIT(); __builtin_amdgcn_wave_barrier();
        const float b0 = bl[0];
        const int kc0 = n >= 8 ? n - 8 : 0;
        for (int kc = kc0; kc <= n; ++kc) {
            const size_t krow0 = (size_t)b * SEQ + kc * 64;
            u32x4 vreg[8];
#pragma unroll
            for (int i = 0; i < 8; ++i) vreg[i] = *(const u32x4*)(F_QKV + (krow0 + (lane >> 3) + 8 * i) * INW + C_VA + h * 64 + (lane & 7) * 8);
            f32x4 st[4][NQT];
#pragma unroll
            for (int kt = 0; kt < 4; ++kt) { const bf16* kp = F_QKV + (krow0 + kt * 16 + fr) * INW + C_KA + h * 64 + fq * 8;
                const bf16x8 k0 = *(const bf16x8*)kp, k1 = *(const bf16x8*)(kp + 32);
#pragma unroll
                for (int qt = 0; qt < NQT; ++qt) { f32x4 z = (f32x4){0.f, 0.f, 0.f, 0.f};
                    z = __builtin_amdgcn_mfma_f32_16x16x32_bf16(k0, qf[qt][0], z, 0, 0, 0); st[kt][qt] = __builtin_amdgcn_mfma_f32_16x16x32_bf16(k1, qf[qt][1], z, 0, 0, 0); } }
            const int dc = kc - n;
            if (dc <= -3) {
#pragma unroll
                for (int kt = 0; kt < 4; ++kt)
#pragma unroll
                    for (int qt = 0; qt < NQT; ++qt) st[kt][qt] = st[kt][qt] * SC + b0;
            } else {
                const int ib = 64 * dc + 128 + 4 * fq - fr + sub * (-QPW);
#pragma unroll
                for (int kt = 0; kt < 4; ++kt)
#pragma unroll
                    for (int qt = 0; qt < NQT; ++qt)
#pragma unroll
                        for (int r = 0; r < 4; ++r) { int idx = ib + 16 * (kt - qt) + r; idx = idx < 0 ? 0 : idx; st[kt][qt][r] = st[kt][qt][r] * SC + bl[idx]; }
            }
#pragma unroll
            for (int qt = 0; qt < NQT; ++qt) {
                float mx = st[0][qt][0];
#pragma unroll
                for (int kt = 0; kt < 4; ++kt)
#pragma unroll
                    for (int r = 0; r < 4; ++r) mx = fmaxf(mx, st[kt][qt][r]);
                mx = fmaxf(mx, __shfl_xor(mx, 16)); mx = fmaxf(mx, __shfl_xor(mx, 32));
                const float mnew = fmaxf(mrow[qt], mx), alpha = exp2f(mrow[qt] - mnew); mrow[qt] = mnew;
                float ps = 0.f;
#pragma unroll
                for (int kt = 0; kt < 4; ++kt)
#pragma unroll
                    for (int r = 0; r < 4; ++r) { const float p = exp2f(st[kt][qt][r] - mnew); st[kt][qt][r] = p; ps += p; }
                lp[qt] = lp[qt] * alpha + ps;
#pragma unroll
                for (int et = 0; et < 4; ++et) ot[et][qt] = ot[et][qt] * alpha;
            }
            __builtin_amdgcn_wave_barrier();
#pragma unroll
            for (int i = 0; i < 8; ++i) *(LAS u32x4*)(vl + ((lane >> 3) + 8 * i) * 144 + (lane & 7) * 16) = vreg[i];
            LDS_WAIT(); __builtin_amdgcn_wave_barrier();
#pragma unroll
            for (int s = 0; s < 2; ++s) {
                bf16x8 pf[NQT];
#pragma unroll
                for (int qt = 0; qt < NQT; ++qt) { u32x4 w; w.x = pk2(st[2 * s][qt][0], st[2 * s][qt][1]); w.y = pk2(st[2 * s][qt][2], st[2 * s][qt][3]);
                    w.z = pk2(st[2 * s + 1][qt][0], st[2 * s + 1][qt][1]); w.w = pk2(st[2 * s + 1][qt][2], st[2 * s + 1][qt][3]); pf[qt] = __builtin_bit_cast(bf16x8, w); }
#pragma unroll
                for (int et = 0; et < 4; ++et) {
                    const v4i16_t t0 = __builtin_amdgcn_ds_read_tr16_b64_v4i16((LAS v4i16_t*)(vl + vtr0 + (2 * s) * 16 * 144 + et * 32));
                    const v4i16_t t1 = __builtin_amdgcn_ds_read_tr16_b64_v4i16((LAS v4i16_t*)(vl + vtr0 + (2 * s + 1) * 16 * 144 + et * 32));
                    bf16x8 vf; vf[0] = t0[0]; vf[1] = t0[1]; vf[2] = t0[2]; vf[3] = t0[3]; vf[4] = t1[0]; vf[5] = t1[1]; vf[6] = t1[2]; vf[7] = t1[3];
#pragma unroll
                    for (int qt = 0; qt < NQT; ++qt) ot[et][qt] = __builtin_amdgcn_mfma_f32_16x16x32_bf16(vf, pf[qt], ot[et][qt], 0, 0, 0);
                }
            }
        }
#pragma unroll
        for (int qt = 0; qt < NQT; ++qt) { float ls = lp[qt]; ls += __shfl_xor(ls, 16); ls += __shfl_xor(ls, 32); const float inv = 1.0f / ls;
            bf16* op = F_MIX + (qrow0 + qt * 16 + fr) * DM + h * 64 + 4 * fq;
#pragma unroll
            for (int et = 0; et < 4; ++et) { const f32x4 o = ot[et][qt] * inv; u32x2 w; w.x = pk2(o.x, o.y); w.y = pk2(o.z, o.w); *(u32x2*)(op + et * 16) = w; } }
    }
}


__device__ __forceinline__ void unpack8(const u32x4 w, float (&x)[8]) { x[0] = bf2f(w.x & 0xffffu); x[1] = bf2f(w.x >> 16); x[2] = bf2f(w.y & 0xffffu); x[3] = bf2f(w.y >> 16); x[4] = bf2f(w.z & 0xffffu); x[5] = bf2f(w.z >> 16); x[6] = bf2f(w.w & 0xffffu); x[7] = bf2f(w.w >> 16); }
__device__ __forceinline__ u32x4 pack8(const float (&x)[8]) { u32x4 w; w.x = pk2(x[0], x[1]); w.y = pk2(x[2], x[3]); w.z = pk2(x[4], x[5]); w.w = pk2(x[6], x[7]); return w; }
__device__ __forceinline__ void rope8(const u32x4 a, const u32x4 b, const f32x2* cs, float scale, u32x4& o1, u32x4& o2) {
    float x1[8], x2[8], r1[8], r2[8]; unpack8(a, x1); unpack8(b, x2);
    const f32x4* c4 = (const f32x4*)cs;
#pragma unroll
    for (int q = 0; q < 4; ++q) { const f32x4 t = c4[q];
        r1[2 * q] = (x1[2 * q] * t.x - x2[2 * q] * t.y) * scale; r2[2 * q] = (x1[2 * q] * t.y + x2[2 * q] * t.x) * scale;
        r1[2 * q + 1] = (x1[2 * q + 1] * t.z - x2[2 * q + 1] * t.w) * scale; r2[2 * q + 1] = (x1[2 * q + 1] * t.w + x2[2 * q + 1] * t.z) * scale; }
    o1 = pack8(r1); o2 = pack8(r2);
}
__device__ __forceinline__ bf16x8 tr_frag(LAS unsigned char* p0, LAS unsigned char* p1) {
    const v4i16_t t0 = __builtin_amdgcn_ds_read_tr16_b64_v4i16((LAS v4i16_t*)p0), t1 = __builtin_amdgcn_ds_read_tr16_b64_v4i16((LAS v4i16_t*)p1);
    bf16x8 f; f[0] = t0[0]; f[1] = t0[1]; f[2] = t0[2]; f[3] = t0[3]; f[4] = t1[0]; f[5] = t1[1]; f[6] = t1[2]; f[7] = t1[3]; return f;
}
__device__ __forceinline__ void ret_kv_mfma(Frame& F, int l) {
    const int lane = F.lane, fr = lane & 15, fq = lane >> 4;
    constexpr int PIT = 136;
    LAS unsigned char* kt = F.lds + F.wave * (2 * 64 * PIT);
    LAS unsigned char* vt = kt + 64 * PIT;
    const unsigned tr0 = (unsigned)((4 * fq + (fr >> 2)) * PIT + (fr & 3) * 8);
    for (int u = F.gw; u < NB * NCH * 4; u += F.ngw) {
        const int h = u & 3, n = (u >> 2) & 63, b = u >> 8; const float lg = ret_log2gamma(h);
        const size_t row = (size_t)b * SEQ + n * 64 + lane;
        const bf16* kp = F_QKV + row * INW + C_KR + h * 64; const bf16* vp = F_QKV + row * INW + C_VR + h * 64;
        const f32x2* rp = F_ROPE + (size_t)(n * 64 + lane) * 32;
        const float zs = 0.125f * exp2f(lg * (float)(63 - lane));
        __builtin_amdgcn_wave_barrier();
#pragma unroll
        for (int dq = 0; dq < 4; ++dq) { u32x4 o1, o2; rope8(*(const u32x4*)(kp + dq * 8), *(const u32x4*)(kp + 32 + dq * 8), rp + dq * 8, zs, o1, o2);
            LAS u32x2* w1 = (LAS u32x2*)(kt + lane * PIT + dq * 16); LAS u32x2* w2 = (LAS u32x2*)(kt + lane * PIT + 64 + dq * 16);
            w1[0] = (u32x2){o1.x, o1.y}; w1[1] = (u32x2){o1.z, o1.w}; w2[0] = (u32x2){o2.x, o2.y}; w2[1] = (u32x2){o2.z, o2.w}; }
#pragma unroll
        for (int c = 0; c < 8; ++c) { const u32x4 v = *(const u32x4*)(vp + c * 8); LAS u32x2* w = (LAS u32x2*)(vt + lane * PIT + c * 16); w[0] = (u32x2){v.x, v.y}; w[1] = (u32x2){v.z, v.w}; }
        LDS_WAIT(); __builtin_amdgcn_wave_barrier();
        f32x4 acc[4][4];
#pragma unroll
        for (int i = 0; i < 4; ++i)
#pragma unroll
            for (int j = 0; j < 4; ++j) acc[i][j] = (f32x4){0.f, 0.f, 0.f, 0.f};
#pragma unroll
        for (int s = 0; s < 2; ++s) {
            bf16x8 kf[4];
#pragma unroll
            for (int dt = 0; dt < 4; ++dt) kf[dt] = tr_frag(kt + tr0 + (2 * s) * 16 * PIT + dt * 32, kt + tr0 + (2 * s + 1) * 16 * PIT + dt * 32);
#pragma unroll
            for (int et = 0; et < 4; ++et) { const bf16x8 vf = tr_frag(vt + tr0 + (2 * s) * 16 * PIT + et * 32, vt + tr0 + (2 * s + 1) * 16 * PIT + et * 32);
#pragma unroll
                for (int dt = 0; dt < 4; ++dt) acc[et][dt] = __builtin_amdgcn_mfma_f32_16x16x32_bf16(vf, kf[dt], acc[et][dt], 0, 0, 0); }
        }
        float* o = F_KV + (size_t)u * 4096;
#pragma unroll
        for (int et = 0; et < 4; ++et)
#pragma unroll
            for (int dt = 0; dt < 4; ++dt)
#pragma unroll
                for (int r = 0; r < 4; ++r) o[(et * 16 + 4 * fq + r) * 64 + dt * 16 + fr] = acc[et][dt][r];
    }
}
__device__ __forceinline__ void ret_out_mfma(Frame& F, int l) {
    const int lane = F.lane, fr = lane & 15, fq = lane >> 4;
    constexpr int PIT = 144;
    LAS unsigned char* vt = F.lds + F.wave * (64 * PIT);
    const unsigned tr0 = (unsigned)((4 * fq + (fr >> 2)) * PIT + (fr & 3) * 8);
    for (int u = F.gw; u < NB * NCH * 4; u += F.ngw) {
        const int h = u & 3, n = (u >> 2) & 63, b = u >> 8; const float lg = ret_log2gamma(h);
        const size_t row0 = (size_t)b * SEQ + n * 64;
        __builtin_amdgcn_wave_barrier();
#pragma unroll
        for (int i = 0; i < 8; ++i) { const u32x4 v = *(const u32x4*)(F_QKV + (row0 + (lane >> 3) + 8 * i) * INW + C_VR + h * 64 + (lane & 7) * 8); *(LAS u32x4*)(vt + ((lane >> 3) + 8 * i) * PIT + (lane & 7) * 16) = v; }
        bf16x8 kf[4][2];
#pragma unroll
        for (int jt = 0; jt < 4; ++jt) { const int j = jt * 16 + fr; u32x4 o1, o2;
            const bf16* kp = F_QKV + (row0 + j) * INW + C_KR + h * 64 + fq * 8; rope8(*(const u32x4*)kp, *(const u32x4*)(kp + 32), F_ROPE + (size_t)(n * 64 + j) * 32 + fq * 8, 0.125f, o1, o2);
            kf[jt][0] = __builtin_bit_cast(bf16x8, o1); kf[jt][1] = __builtin_bit_cast(bf16x8, o2); }
        LDS_WAIT(); __builtin_amdgcn_wave_barrier();
        const float* prev = F_KV + (size_t)u * 4096;
#pragma unroll 1
        for (int hq = 0; hq < 2; ++hq) {
            bf16x8 qf[2][2];
#pragma unroll
            for (int it = 0; it < 2; ++it) { const int i = (2 * hq + it) * 16 + fr; u32x4 o1, o2;
                const bf16* qp = F_QKV + (row0 + i) * INW + C_QR + h * 64 + fq * 8; rope8(*(const u32x4*)qp, *(const u32x4*)(qp + 32), F_ROPE + (size_t)(n * 64 + i) * 32 + fq * 8, 1.0f, o1, o2);
                qf[it][0] = __builtin_bit_cast(bf16x8, o1); qf[it][1] = __builtin_bit_cast(bf16x8, o2); }
            f32x4 st[4][2];
#pragma unroll
            for (int jt = 0; jt < 4; ++jt)
#pragma unroll
                for (int it = 0; it < 2; ++it) { f32x4 z = (f32x4){0.f, 0.f, 0.f, 0.f}; z = __builtin_amdgcn_mfma_f32_16x16x32_bf16(kf[jt][0], qf[it][0], z, 0, 0, 0); st[jt][it] = __builtin_amdgcn_mfma_f32_16x16x32_bf16(kf[jt][1], qf[it][1], z, 0, 0, 0); }
#pragma unroll
            for (int jt = 0; jt < 4; ++jt)
#pragma unroll
                for (int it = 0; it < 2; ++it)
#pragma unroll
                    for (int r = 0; r < 4; ++r) { const int dd = ((2 * hq + it) * 16 + fr) - (jt * 16 + 4 * fq + r); st[jt][it][r] = dd >= 0 ? st[jt][it][r] * exp2f(lg * (float)dd) : 0.f; }
            f32x4 yi[4][2], yc[4][2];
#pragma unroll
            for (int et = 0; et < 4; ++et)
#pragma unroll
                for (int it = 0; it < 2; ++it) { yi[et][it] = (f32x4){0.f, 0.f, 0.f, 0.f}; yc[et][it] = (f32x4){0.f, 0.f, 0.f, 0.f}; }
#pragma unroll
            for (int s = 0; s < 2; ++s) {
                bf16x8 pf[2];
#pragma unroll
                for (int it = 0; it < 2; ++it) { u32x4 w; w.x = pk2(st[2 * s][it][0], st[2 * s][it][1]); w.y = pk2(st[2 * s][it][2], st[2 * s][it][3]); w.z = pk2(st[2 * s + 1][it][0], st[2 * s + 1][it][1]); w.w = pk2(st[2 * s + 1][it][2], st[2 * s + 1][it][3]); pf[it] = __builtin_bit_cast(bf16x8, w); }
#pragma unroll
                for (int et = 0; et < 4; ++et) { const bf16x8 vf = tr_frag(vt + tr0 + (2 * s) * 16 * PIT + et * 32, vt + tr0 + (2 * s + 1) * 16 * PIT + et * 32);
#pragma unroll
                    for (int it = 0; it < 2; ++it) yi[et][it] = __builtin_amdgcn_mfma_f32_16x16x32_bf16(vf, pf[it], yi[et][it], 0, 0, 0); }
            }
#pragma unroll
            for (int et = 0; et < 4; ++et)
#pragma unroll
                for (int ks = 0; ks < 2; ++ks) { const float* pp = prev + (et * 16 + fr) * 64 + ks * 32 + fq * 8; const f32x4 a = *(const f32x4*)pp, c = *(const f32x4*)(pp + 4);
                    u32x4 w; w.x = pk2(a.x, a.y); w.y = pk2(a.z, a.w); w.z = pk2(c.x, c.y); w.w = pk2(c.z, c.w); const bf16x8 pvf = __builtin_bit_cast(bf16x8, w);
#pragma unroll
                    for (int it = 0; it < 2; ++it) yc[et][it] = __builtin_amdgcn_mfma_f32_16x16x32_bf16(pvf, qf[it][ks], yc[et][it], 0, 0, 0); }
#pragma unroll
            for (int it = 0; it < 2; ++it) { const int i = (2 * hq + it) * 16 + fr; const float xi = exp2f(lg * (float)(i + 1)); float s1 = 0.f;
#pragma unroll
                for (int et = 0; et < 4; ++et) { yi[et][it] = yi[et][it] + yc[et][it] * xi; s1 += (yi[et][it].x + yi[et][it].y) + (yi[et][it].z + yi[et][it].w); }
                s1 += __shfl_xor(s1, 16); s1 += __shfl_xor(s1, 32); const float mu = s1 * (1.0f / 64.0f); float s2 = 0.f;
#pragma unroll
                for (int et = 0; et < 4; ++et) { yi[et][it] = yi[et][it] - mu; s2 += (yi[et][it].x * yi[et][it].x + yi[et][it].y * yi[et][it].y) + (yi[et][it].z * yi[et][it].z + yi[et][it].w * yi[et][it].w); }
                s2 += __shfl_xor(s2, 16); s2 += __shfl_xor(s2, 32); const float rstd = 1.0f / sqrtf(s2 * (1.0f / 64.0f) + EPS);
#pragma unroll
                for (int et = 0; et < 4; ++et) { const int e0 = et * 16 + 4 * fq; const u32x2 gw = *(const u32x2*)(F_QKV + (row0 + i) * INW + C_GR + h * 64 + e0); const f32x4 gn = *(const f32x4*)(F_gn_g + l * 256 + h * 64 + e0);
                    const f32x4 y = yi[et][it] * rstd * gn; u32x2 w; w.x = pk2(silu_f(bf2f(gw.x & 0xffffu)) * y.x, silu_f(bf2f(gw.x >> 16)) * y.y); w.y = pk2(silu_f(bf2f(gw.y & 0xffffu)) * y.z, silu_f(bf2f(gw.y >> 16)) * y.w);
                    *(u32x2*)(F_MIX + (row0 + i) * DM + 768 + h * 64 + e0) = w; }
            }
        }
    }
}

__device__ __forceinline__ void p5_out(Frame& F, int l) {
    {
        LAS float* qs = (LAS float*)F.lds;
        LAS float* ks = qs + 64 * 65;
        LAS float* vs = ks + 64 * 65;
        LAS float* ps = vs + 64 * 65;
        LAS float* pp = ps + 64 * 65;
        for (int u = F.blk; u < NB * NCH * 4; u += F.G) {
            const int h = u & 3, n = (u >> 2) & 63, b = u >> 8; const float lg = ret_log2gamma(h);
            const size_t row0 = (size_t)b * SEQ + n * 64;
            __syncthreads();
#pragma unroll
            for (int q = 0; q < 4; ++q) { const int idx = F.tid + q * NTHR, j = idx >> 5, d = idx & 31; const f32x2 cs = F_ROPE[(n * 64 + j) * 32 + d];
                const bf16* kp = F_QKV + (row0 + j) * INW + C_KR + h * 64; const float k1 = bf2f(kp[d]), k2 = bf2f(kp[d + 32]);
                ks[j * 65 + d] = (k1 * cs.x - k2 * cs.y) * 0.125f; ks[j * 65 + d + 32] = (k1 * cs.y + k2 * cs.x) * 0.125f;
                const bf16* qp = F_QKV + (row0 + j) * INW + C_QR + h * 64; const float q1 = bf2f(qp[d]), q2 = bf2f(qp[d + 32]);
                qs[j * 65 + d] = q1 * cs.x - q2 * cs.y; qs[j * 65 + d + 32] = q1 * cs.y + q2 * cs.x; }
            const float* prev = F_KV + ((size_t)((b * NCH + n) * 4 + h)) * 4096;
#pragma unroll
            for (int q = 0; q < 8; ++q) { const int idx = F.tid + q * NTHR, j = idx >> 6, e = idx & 63; vs[j * 65 + e] = bf2f(F_QKV[(row0 + j) * INW + C_VR + h * 64 + e]); ps[j * 65 + e] = prev[idx]; }
            __syncthreads();
            const int i = F.tid >> 3, c0 = (F.tid & 7) * 8;
            { float acc[8];
#pragma unroll
                for (int q = 0; q < 8; ++q) acc[q] = 0.f;
                for (int d = 0; d < 64; ++d) { const float qd = qs[i * 65 + d];
#pragma unroll
                    for (int q = 0; q < 8; ++q) acc[q] += qd * ks[(c0 + q) * 65 + d]; }
#pragma unroll
                for (int q = 0; q < 8; ++q) { const int j = c0 + q; pp[i * 65 + j] = (i >= j) ? acc[q] * exp2f(lg * (float)(i - j)) : 0.f; } }
            __syncthreads();
            float y[8], cr[8];
#pragma unroll
            for (int q = 0; q < 8; ++q) { y[q] = 0.f; cr[q] = 0.f; }
            for (int j = 0; j < 64; ++j) { const float pj = pp[i * 65 + j], qd = qs[i * 65 + j];
#pragma unroll
                for (int q = 0; q < 8; ++q) { y[q] += pj * vs[j * 65 + c0 + q]; cr[q] += qd * ps[j * 65 + c0 + q]; } }
            const float xi = exp2f(lg * (float)(i + 1)); float s = 0.f;
#pragma unroll
            for (int q = 0; q < 8; ++q) { y[q] += xi * cr[q]; s += y[q]; }
            s += __shfl_xor(s, 1); s += __shfl_xor(s, 2); s += __shfl_xor(s, 4);
            const float mu = s * (1.0f / 64.0f); float vq = 0.f;
#pragma unroll
            for (int q = 0; q < 8; ++q) { y[q] -= mu; vq += y[q] * y[q]; }
            vq += __shfl_xor(vq, 1); vq += __shfl_xor(vq, 2); vq += __shfl_xor(vq, 4);
            const float rstd = 1.0f / sqrtf(vq * (1.0f / 64.0f) + EPS);
            const bf16* gp = F_QKV + (row0 + i) * INW + C_GR + h * 64 + c0; const u32x4 gw = *(const u32x4*)gp;
            const float gt[8] = {bf2f(gw.x & 0xffffu), bf2f(gw.x >> 16), bf2f(gw.y & 0xffffu), bf2f(gw.y >> 16), bf2f(gw.z & 0xffffu), bf2f(gw.z >> 16), bf2f(gw.w & 0xffffu), bf2f(gw.w >> 16)};
            float r[8];
#pragma unroll
            for (int q = 0; q < 8; ++q) r[q] = silu_f(gt[q]) * (y[q] * rstd * F_gn_g[l * 256 + h * 64 + c0 + q]);
            u32x4 w; w.x = pk2(r[0], r[1]); w.y = pk2(r[2], r[3]); w.z = pk2(r[4], r[5]); w.w = pk2(r[6], r[7]);
            *(u32x4*)(F_MIX + (row0 + i) * DM + 768 + h * 64 + c0) = w;
        }
        __syncthreads();
    }
}

struct Args { const float* in[28]; float* out; unsigned char* ws; int ph_lo, ph_hi; };
constexpr int NPHASE = 2 + NL * 10;

__global__ void __launch_bounds__(NTHR, 2) fwd_kernel(Args args) {
    extern __shared__ __attribute__((aligned(16))) unsigned char lds[];
    Frame F;
    F.lds = (LAS unsigned char*)lds;
    F.tid = threadIdx.x; F.lane = F.tid & 63; F.wave = __builtin_amdgcn_readfirstlane(F.tid >> 6); F.blk = blockIdx.x; F.G = gridDim.x;
    F.gw = F.blk * NWAVES + F.wave; F.ngw = F.G * NWAVES;
    F.out = args.out; F.ws = args.ws;
    F.ptab = (LAS unsigned long long*)(F.lds + LDS_BYTES - 64 - 256);
    if (F.tid == 0) {
#pragma unroll
        for (int i = 0; i < 28; ++i) F.ptab[i] = (unsigned long long)args.in[i];
    }
    LAS unsigned* misc = (LAS unsigned*)(F.lds + LDS_BYTES - 64);
    if (F.tid < 16) misc[F.tid] = 0u;
    __syncthreads();
    const int lo = args.ph_lo, hi = args.ph_hi;
    XcdBarrier bar; bar.bar = F_ctl + CW_BAR; bar.x = 0; bar.st = nullptr;
    if (hi - lo > 1) bar = xcd_barrier_post(F_ctl + CW_BAR, (volatile LAS unsigned*)misc);
#ifndef PH_ONLY
#define PH_ONLY -1
#endif
#define PSEL(j) (PH_ONLY < 0 || PH_ONLY == (j))
#define IN(k) (lo <= (k) && (k) < hi)
#define SEAM(k) do { if (IN(k) && IN((k) + 1)) xcd_barrier(bar); { int _t = threadIdx.x; asm volatile("" : "+v"(_t)); F.tid = _t; F.lane = _t & 63; asm volatile("" : "+s"(F.ws), "+s"(F.out)); asm volatile("" : "+s"(F.gw), "+s"(F.ngw), "+s"(F.blk), "+s"(F.G), "+s"(F.wave)); } } while (0)

    if (IN(0) && PSEL(10)) { p0_prologue(F); } SEAM(0);
    for (int l = 0; l < NL; ++l) {
        const int p = 1 + 10 * l;
        if (IN(p + 0) && PSEL(0)) { norm_phase<0>(F, l); s5_build_operands(F, l); } SEAM(p + 0);
        if (IN(p + 1) && PSEL(1)) { pg8::StaticOrder S; S.init(F_H, DM, F_WinT + (size_t)l * INW * DM, DM, NT, INW, F.G, F.blk); EpiQKV E{F_QKV, F_U2X};
            pg8::gemm_phase<EpiQKV, pg8::StaticOrder, false>(F.lds, DM, DM, DM, S, E); } SEAM(p + 1);
        if (IN(p + 2) && PSEL(2)) { ret_kv_mfma(F, l); __syncthreads();
            GroupOrder S; S.G = F.G; S.c = F.blk; S.npn = 1; S.nunit = 32; S.A = (const char*)(F_U2X + 128); S.Bt = (const char*)F_BT1; S.strideB = (size_t)256 * 1024 * 2; S.tstepA = (size_t)256 * U2LD * 2; S.tstepB = 0;
            EpiS5a E{F_SENDP}; pg8::gemm_phase<EpiS5a, GroupOrder, false>(F.lds, 1024, U2LD, 1024, S, E); } SEAM(p + 2);
        if (IN(p + 3) && PSEL(3)) { p4_scan_attn(F, l); } SEAM(p + 3);
        if (IN(p + 4) && PSEL(4)) { ret_out_mfma(F, l); __syncthreads();
            GroupOrder S; S.G = F.G; S.c = F.blk; S.npn = 4; S.nunit = 128; S.A = (const char*)F_U2X; S.Bt = (const char*)F_TMAT; S.strideB = (size_t)1024 * U2K * 2; S.tstepA = (size_t)256 * U2LD * 2; S.tstepB = (size_t)256 * U2K * 2;
            EpiS5b E{F_YG}; pg8::gemm_phase<EpiS5b, GroupOrder, false>(F.lds, U2K, U2LD, U2K, S, E); } SEAM(p + 4);
        if (IN(p + 5) && PSEL(5)) { pg8::StaticOrder S; S.init(F_YG, 256, F_WgluT + (size_t)l * 256 * 256, 256, NT, 256, F.G, F.blk); EpiGlu E{F_YG, F_MIX, F_b_glu + l * 256};
            pg8::gemm_phase<EpiGlu, pg8::StaticOrder, false>(F.lds, 256, 256, 256, S, E); } SEAM(p + 5);
        if (IN(p + 6) && PSEL(6)) { pg8::StaticOrder S; S.init(F_MIX, DM, F_WoutT + (size_t)l * DM * DM, DM, NT, DM, F.G, F.blk); EpiRes E{l == 0 ? F_x : F.out, F.out, F_MOD + (size_t)l * NB * 6144 + 2048};
            pg8::gemm_phase<EpiRes, pg8::StaticOrder, false>(F.lds, DM, DM, DM, S, E); } SEAM(p + 6);
        if (IN(p + 7) && PSEL(7)) { norm2_router_phase(F, l); } SEAM(p + 7);
        if (IN(p + 8) && PSEL(8)) { moe_pg8<1>(F, l); } SEAM(p + 8);
        if (IN(p + 9) && PSEL(9)) { moe_pg8<2>(F, l); } SEAM(p + 9);
    }
    if (IN(NPHASE - 1) && PSEL(11)) { norm_phase<2>(F, 0); }
#undef IN
#undef SEAM
}

extern "C" void kernel_launch(void* const* d_in, const int* in_sizes, int n_in, void* d_out, int out_size, void* d_ws, size_t ws_size, hipStream_t stream) {
    static int grid = 0;
    if (grid == 0) {
        if (n_in != 28 || in_sizes[0] != NT * DM || out_size != NT * DM || ws_size < WS_END) { fprintf(stderr, "kernel_launch: unexpected shapes / workspace (%d inputs, ws %zu < %zu)\n", n_in, ws_size, (size_t)WS_END); grid = -1; return; }
        int dev = 0, cus = 0;
        if (hipGetDevice(&dev) != hipSuccess || hipDeviceGetAttribute(&cus, hipDeviceAttributeMultiprocessorCount, dev) != hipSuccess) { grid = -1; return; }
        if (hipFuncSetAttribute((const void*)fwd_kernel, hipFuncAttributeMaxDynamicSharedMemorySize, LDS_BYTES) != hipSuccess) { fprintf(stderr, "kernel_launch: hipFuncSetAttribute failed\n"); grid = -1; return; }
        int per_cu = 0;
        if (hipOccupancyMaxActiveBlocksPerMultiprocessor(&per_cu, (const void*)fwd_kernel, NTHR, LDS_BYTES) != hipSuccess || per_cu < 1) { fprintf(stderr, "kernel_launch: occupancy query says %d\n", per_cu); }
        (void)hipGetLastError();
        grid = 256;
        if (cus < 256) { fprintf(stderr, "kernel_launch: device has %d CUs, need 256\n", cus); grid = -1; return; }
    }
    if (grid < 0) return;
    (void)hipMemsetAsync((char*)d_ws + WS_CTL, 0, CTL_BYTES, stream);
    Args a{};
    for (int i = 0; i < 28; ++i) a.in[i] = (const float*)d_in[i];
    a.out = (float*)d_out; a.ws = (unsigned char*)d_ws;
#if MK_MULTI
    for (int ph = 0; ph < NPHASE; ++ph) { a.ph_lo = ph; a.ph_hi = ph + 1; hipLaunchKernelGGL(fwd_kernel, dim3(grid), dim3(NTHR), LDS_BYTES, stream, a); }
#else
    a.ph_lo = 0; a.ph_hi = NPHASE; hipLaunchKernelGGL(fwd_kernel, dim3(grid), dim3(NTHR), LDS_BYTES, stream, a);
#endif
}
```

```cpp
#include <hip/hip_runtime.h>
#include <cstdio>
#include <cstdint>

#define GAS __attribute__((address_space(1)))
#define LAS __attribute__((address_space(3)))
typedef unsigned short bf16;
typedef short bf16x8 __attribute__((ext_vector_type(8)));
typedef float f32x4 __attribute__((ext_vector_type(4)));
typedef float f32x2 __attribute__((ext_vector_type(2)));
typedef unsigned u32x4 __attribute__((ext_vector_type(4)));
typedef unsigned u32x2 __attribute__((ext_vector_type(2)));

#ifndef MK_MULTI
#define MK_MULTI 0
#endif

#ifndef REP_P3
#define REP_P3 1
#endif
#ifndef REP_P5
#define REP_P5 1
#endif
#ifndef REP_AT
#define REP_AT 1
#endif
#ifndef ATTN_NQT
#define ATTN_NQT 2
#endif

constexpr int NL = 4, NB = 8, SEQ = 4096, DM = 1024, NT = NB * SEQ, NCH = 64;
constexpr int INW = 2816;
constexpr int C_QA = 0, C_KA = 512, C_VA = 1024, C_US = 1536, C_QR = 1792, C_KR = 2048, C_VR = 2304, C_GR = 2560;
constexpr int NE = 32, FF = 256;
constexpr float EPS = 1e-6f;
constexpr int NWAVES = 8, NTHR = 512;
constexpr int LDS_BYTES = 147456;

constexpr size_t al256(size_t x) { return (x + 255) & ~(size_t)255; }
constexpr size_t WS_CTL = 0, CTL_BYTES = 1u << 20;
constexpr size_t WS_WIN = CTL_BYTES;
constexpr size_t WS_WOUT = WS_WIN + (size_t)NL * INW * DM * 2;
constexpr size_t WS_WGU = WS_WOUT + (size_t)NL * DM * DM * 2;
constexpr size_t WS_WD = WS_WGU + (size_t)NL * NE * 512 * DM * 2;
constexpr size_t WS_WGLU = WS_WD + (size_t)NL * NE * DM * FF * 2;
constexpr size_t WS_WR = WS_WGLU + (size_t)NL * 256 * 256 * 2;
constexpr size_t WS_MOD = WS_WR + (size_t)NL * 36 * DM * 4;
constexpr size_t WS_ABAR = WS_MOD + (size_t)NL * NB * 6144 * 4;
constexpr size_t WS_ABAR64 = WS_ABAR + (size_t)NL * 16 * 64 * 8;
constexpr size_t WS_BBAR = WS_ABAR64 + (size_t)NL * 16 * 64 * 8;
constexpr size_t WS_ROPE = WS_BBAR + (size_t)NL * 16 * 64 * 16 * 8;
constexpr size_t WS_H = al256(WS_ROPE + (size_t)SEQ * 32 * 8);
constexpr size_t WS_QKV = WS_H + (size_t)NT * DM * 2;
constexpr size_t WS_SLOT = WS_QKV;
constexpr size_t WS_ACT = WS_QKV + (size_t)2 * NT * DM * 2;
constexpr int ACT_ROWS = 2 * NT + NE * 256;
static_assert(WS_ACT + (size_t)ACT_ROWS * FF * 2 <= WS_QKV + (size_t)NT * INW * 2, "overlay fits");
constexpr size_t WS_XB = WS_QKV + (size_t)NT * INW * 2;
constexpr size_t WS_MIX = WS_H;
constexpr size_t WS_YG = WS_XB + (size_t)NT * DM * 2;
constexpr size_t WS_SEND = WS_YG + (size_t)NT * 256 * 2;
constexpr size_t WS_XS = WS_SEND + (size_t)NB * NCH * 16 * 64 * 8;
constexpr size_t WS_KV = WS_XS + (size_t)NB * NCH * 16 * 64 * 8;
constexpr size_t WS_RW = WS_KV + (size_t)NB * NCH * 4 * 4096 * 4;
constexpr size_t WS_LIST = WS_RW + (size_t)NT * 2 * 4;
constexpr size_t WS_WRHL = WS_LIST + (size_t)NE * NT * 4;
constexpr size_t WS_KERN = WS_WRHL + (size_t)NL * 2 * 48 * DM * 2;
constexpr size_t WS_U2X = WS_KERN + (size_t)NL * 16 * 64 * 256 * 4;
constexpr int U2K = 1152, U2LD = 16 * U2K;
constexpr size_t WS_TMAT = WS_U2X + (size_t)512 * U2LD * 2;
constexpr size_t WS_BT1 = WS_TMAT + (size_t)16 * 1024 * U2K * 2;
constexpr size_t WS_SSQ = WS_BT1 + (size_t)16 * 256 * 1024 * 2;
constexpr size_t WS_PW = WS_SSQ + (size_t)NT * 16 * 4;
constexpr size_t WS_END = WS_PW + (size_t)NL * 16 * 65 * 64 * 8;
constexpr int CW_BAR = 4096;
constexpr int CW_CNT = 16384;

__device__ __forceinline__ float bf2f(unsigned v) { return __uint_as_float(v << 16); }
__device__ __forceinline__ unsigned f2bf(float f) { unsigned u = __float_as_uint(f); return (u + 0x7fffu + ((u >> 16) & 1u)) >> 16; }
__device__ __forceinline__ unsigned pk2(float lo, float hi) { return f2bf(lo) | (f2bf(hi) << 16); }
__device__ __forceinline__ float wave_sum(float v) {
#pragma unroll
    for (int o = 1; o < 64; o <<= 1) v += __shfl_xor(v, o);
    return v;
}
__device__ __forceinline__ float silu_f(float x) { return x / (1.0f + __expf(-x)); }
__device__ __forceinline__ float sigmoid_f(float x) { return 1.0f / (1.0f + __expf(-x)); }
__device__ __forceinline__ float gelu_tanh_f(float y) { const float z = 0.7978845608028654f * (y + 0.044715f * y * y * y); const float t = 1.0f - 2.0f / (__expf(2.0f * z) + 1.0f); return 0.5f * y * (1.0f + t); }
#define LDS_WAIT() asm volatile("s_waitcnt lgkmcnt(0)" ::: "memory")

#define XB_TMO      128
#define XB_XCNT(j)  (256  + 64 * (j))
#define XB_XSUB(j)  (1280 + 64 * (j))
#define XB_XGEN(j)  (2304 + 64 * (j))
#define XB_TOP      3328
#define XB_TOPGEN   3392
#define XCD_BAR_WORDS 3456
#define XB_SPIN_CAP (1u << 22)
__device__ __forceinline__ unsigned xb_ld(unsigned* p)              { return __hip_atomic_load(p, __ATOMIC_RELAXED, __HIP_MEMORY_SCOPE_AGENT); }
__device__ __forceinline__ unsigned xb_add(unsigned* p, unsigned v) { return __hip_atomic_fetch_add(p, v, __ATOMIC_RELAXED, __HIP_MEMORY_SCOPE_AGENT); }
__device__ __forceinline__ unsigned xb_xcc_id() { return (unsigned)__builtin_amdgcn_s_getreg((3 << 11) | 20) & 0xFu; }
#define XB_SPIN(cond, bar) do { unsigned _sp = 0; while (cond) { __builtin_amdgcn_s_sleep(1); \
    if ((++_sp & 255u) == 0u) { if (xb_ld(&(bar)[XB_TMO])) break; if (_sp > XB_SPIN_CAP) { atomicAdd(&(bar)[XB_TMO], 1u); break; } } } } while (0)
struct XcdBarrier { unsigned* bar; unsigned x; volatile LAS unsigned* st; };
__device__ __forceinline__ XcdBarrier xcd_barrier_post(unsigned* bar, volatile LAS unsigned* st) {
    XcdBarrier b; b.bar = bar; b.x = xb_xcc_id(); b.st = st;
    if (threadIdx.x == 0) (void)xb_add(&bar[XB_XCNT(b.x)], 1u);
    return b;
}
__device__ __forceinline__ void xcd_barrier_complete(unsigned* bar, unsigned x, unsigned& nloc, unsigned& nx) {
    const unsigned G = gridDim.x * gridDim.y * gridDim.z;
    unsigned sum, cnt, mine, sp = 0u;
    for (;;) {
        sum = 0u; cnt = 0u; mine = 0u;
#pragma unroll
        for (unsigned j = 0; j < 16; ++j) { const unsigned c = xb_ld(&bar[XB_XCNT(j)]); sum += c; cnt += (c > 0u) ? 1u : 0u; mine = (j == x) ? c : mine; }
        if (sum == G) break;
        __builtin_amdgcn_s_sleep(1);
        if ((++sp & 255u) == 0u) { if (xb_ld(&bar[XB_TMO])) break; if (sp > XB_SPIN_CAP) { atomicAdd(&bar[XB_TMO], 1u); break; } }
    }
    nloc = mine > 0u ? mine : 1u; nx = cnt > 0u ? cnt : 1u;
}
__device__ __forceinline__ void xcd_barrier(const XcdBarrier& b) {
    asm volatile("s_waitcnt vmcnt(0)" ::: "memory");
    __syncthreads();
    if (threadIdx.x == 0) {
        unsigned* bar = b.bar;
        __builtin_amdgcn_s_waitcnt(0);
        unsigned nloc = b.st[0], nx = b.st[1];
        if (nloc == 0u) { xcd_barrier_complete(bar, b.x, nloc, nx); b.st[0] = nloc; b.st[1] = nx; }
        const unsigned old = xb_add(&bar[XB_XSUB(b.x)], 1u);
        const unsigned gen = old / nloc;
        if (old + 1u == (gen + 1u) * nloc) {
            __builtin_amdgcn_fence(__ATOMIC_RELEASE, "agent");
            asm volatile("s_waitcnt vmcnt(0)" ::: "memory");
            const unsigned og = xb_add(&bar[XB_TOP], 1u);
            const unsigned tg = og / nx;
            if (og + 1u == (tg + 1u) * nx) xb_add(&bar[XB_TOPGEN], 1u);
            else XB_SPIN(xb_ld(&bar[XB_TOPGEN]) == tg, bar);
            __builtin_amdgcn_fence(__ATOMIC_ACQUIRE, "agent");
            xb_add(&bar[XB_XGEN(b.x)], 1u);
            asm volatile("s_waitcnt vmcnt(0)" ::: "memory");
        } else {
            XB_SPIN(xb_ld(&bar[XB_XGEN(b.x)]) == gen, bar);
            __builtin_amdgcn_fence(__ATOMIC_ACQUIRE, "agent");
            asm volatile("s_waitcnt vmcnt(0)" ::: "memory");
        }
    }
    __syncthreads();
}

struct Frame {
    LAS unsigned char* lds;
    LAS unsigned long long* ptab;
    int tid, lane, wave, blk, G, gw, ngw;
    float* out0; unsigned char* ws0; size_t wz;
};
#define F_OUT (F.out0 + F.wz)
__device__ __forceinline__ const float* inp_ptr(LAS unsigned long long* t, int k) { const unsigned long long v = t[k];
    const unsigned lo = __builtin_amdgcn_readfirstlane((unsigned)v), hi = __builtin_amdgcn_readfirstlane((unsigned)(v >> 32)); return (const float*)(const GAS float*)(((unsigned long long)hi << 32) | lo); }
#define INP(k) inp_ptr(F.ptab, k)
#define F_x INP(0)
#define F_c INP(1)
#define F_norm1_g INP(2)
#define F_norm2_g INP(3)
#define F_w_ada INP(4)
#define F_b_ada INP(5)
#define F_w_in INP(6)
#define F_rel_bias INP(7)
#define F_a_re INP(8)
#define F_a_im INP(9)
#define F_log_dt INP(10)
#define F_b_re INP(11)
#define F_b_im INP(12)
#define F_c_re INP(13)
#define F_c_im INP(14)
#define F_ssm_d INP(15)
#define F_w_glu INP(16)
#define F_b_glu INP(17)
#define F_gn_g INP(18)
#define F_w_out INP(19)
#define F_w_group INP(20)
#define F_b_group INP(21)
#define F_w_expert INP(22)
#define F_b_expert INP(23)
#define F_w_gate INP(24)
#define F_w_up INP(25)
#define F_w_down INP(26)
#define F_final_g INP(27)
#define F_ctl ((unsigned*)(F.ws0 + F.wz + WS_CTL))
#define F_WinT ((bf16*)(F.ws0 + F.wz + WS_WIN))
#define F_WoutT ((bf16*)(F.ws0 + F.wz + WS_WOUT))
#define F_WguT ((bf16*)(F.ws0 + F.wz + WS_WGU))
#define F_WdT ((bf16*)(F.ws0 + F.wz + WS_WD))
#define F_WgluT ((bf16*)(F.ws0 + F.wz + WS_WGLU))
#define F_WrT ((float*)(F.ws0 + F.wz + WS_WR))
#define F_MOD ((float*)(F.ws0 + F.wz + WS_MOD))
#define F_ABAR ((f32x2*)(F.ws0 + F.wz + WS_ABAR))
#define F_ABAR64 ((f32x2*)(F.ws0 + F.wz + WS_ABAR64))
#define F_BBAR ((f32x2*)(F.ws0 + F.wz + WS_BBAR))
#define F_ROPE ((f32x2*)(F.ws0 + F.wz + WS_ROPE))
#define F_H ((bf16*)(F.ws0 + F.wz + WS_H))
#define F_QKV ((bf16*)(F.ws0 + F.wz + WS_QKV))
#define F_SLOT ((bf16*)(F.ws0 + F.wz + WS_SLOT))
#define F_ACT ((bf16*)(F.ws0 + F.wz + WS_ACT))
#define F_MIX ((bf16*)(F.ws0 + F.wz + WS_MIX))
#define F_YG ((bf16*)(F.ws0 + F.wz + WS_YG))
#define F_SEND ((f32x2*)(F.ws0 + F.wz + WS_SEND))
#define F_XS ((f32x2*)(F.ws0 + F.wz + WS_XS))
#define F_KV ((float*)(F.ws0 + F.wz + WS_KV))
#define F_KVB ((bf16*)(F.ws0 + F.wz + WS_KV))
#define F_RW ((float*)(F.ws0 + F.wz + WS_RW))
#define F_LIST ((int*)(F.ws0 + F.wz + WS_LIST))
#define F_WRHL ((bf16*)(F.ws0 + F.wz + WS_WRHL))
#define F_KERNB ((bf16*)(F.ws0 + F.wz + WS_KERN))
#define F_U2X ((bf16*)(F.ws0 + F.wz + WS_U2X))
#define F_TMAT ((bf16*)(F.ws0 + F.wz + WS_TMAT))
#define F_BT1 ((bf16*)(F.ws0 + F.wz + WS_BT1))
#define F_SENDP ((float*)(F.ws0 + F.wz + WS_SEND))
#define F_SSQ ((float*)(F.ws0 + F.wz + WS_SSQ))
#define F_PW ((f32x2*)(F.ws0 + F.wz + WS_PW))
#define F_XB ((bf16*)(F.ws0 + F.wz + WS_XB))

namespace pg8 {
constexpr int BM = 256, BK = 64, HALF = 128, HTB = HALF * BK * 2, STAGE_BYTES = 8 * HTB, NXCD = 8, WGM = 8;
__host__ __device__ __forceinline__ int lds_byte(int r, int c) { const int st = (r >> 4) * 2 + (c >> 5), rr = r & 15, cc = c & 31, ob = rr * 64 + cc * 2; return st * 1024 + (ob ^ (((ob >> 9) & 1) << 5)); }
__host__ __device__ __forceinline__ void stage_rc(int b, int& R, int& C) { const int st = b / 1024, sb = b % 1024, swz = sb ^ (((sb >> 9) & 1) << 5); R = (st >> 1) * 16 + swz / 64; C = (st & 1) * 32 + (swz % 64) / 2; }
__host__ __device__ __forceinline__ int perm32(int rho) { const int n = rho >> 4, i = rho & 15; return 8 * (i >> 2) + 4 * n + (i & 3); }
struct Unit { int pm, pn, e, i; };
struct StaticOrder {
    int nM, nN, nwg, G, c; const char* A; const char* Bt; size_t tstepA, tstepB;
    __device__ void init(const bf16* A_, int lda, const bf16* Bt_, int ldb, int M, int N, int G_, int c_) { nM = M / BM; nN = N / BM; nwg = nM * nN; G = G_; c = c_; A = (const char*)A_; Bt = (const char*)Bt_; tstepA = (size_t)BM * lda * 2; tstepB = (size_t)BM * ldb * 2; }
    __device__ bool next(int i, Unit& u) const {
        const long L = (long)i * G + c; if (L >= nwg) return false;
        int wgid = (int)L; { const int q = nwg / NXCD, r = nwg % NXCD, xcd = wgid % NXCD, off = wgid / NXCD; wgid = (xcd < r ? xcd * (q + 1) : r * (q + 1) + (xcd - r) * q) + off; }
        const int nig = WGM * nN, gid = wgid / nig, fm = gid * WGM, gsz = (nM - fm) < WGM ? (nM - fm) : WGM;
        u.pm = fm + ((wgid % nig) % gsz); u.pn = (wgid % nig) / gsz; u.e = 0; u.i = i; return true;
    }
    __device__ __forceinline__ const char* a_base(const Unit& u) const { return A + (size_t)u.pm * tstepA; }
    __device__ __forceinline__ const char* b_base(const Unit& u) const { return Bt + (size_t)u.pn * tstepB; }
    __device__ __forceinline__ int row(const Unit&, int r) const { return r; }
};
__device__ __forceinline__ unsigned cvt_pk_bf16(float lo, float hi) { unsigned r; asm volatile("v_cvt_pk_bf16_f32 %0, %1, %2" : "=v"(r) : "v"(lo), "v"(hi)); return r; }

template <class Epi, class Sched, bool GATHER, bool TOEP = false>
__device__ __forceinline__ void gemm_phase(LAS unsigned char* lds, const int K, const int lda, const int ldb, const Sched& S, const Epi& E) {
    int tid_ = threadIdx.x; asm volatile("" : "+v"(tid_));
    const int tid = tid_, wid = __builtin_amdgcn_readfirstlane(tid >> 6), lane = tid & 63, wr = wid >> 2, wc = wid & 3, fr = lane & 15, fq = lane >> 4;
    const int nt = K / BK;
    int Rr[2], Cc[2]; unsigned voffB[2], voffC[2];
#pragma unroll
    for (int i = 0; i < 2; ++i) { stage_rc(tid * 16 + i * 8192, Rr[i], Cc[i]); const int Rb = Epi::PERM ? ((Rr[i] & ~31) + perm32(Rr[i] & 31)) : Rr[i]; voffC[i] = (unsigned)(Rb * ldb + Cc[i]) * 2u;
        voffB[i] = TOEP ? (unsigned)(((Rb >> 4) - (Cc[i] >> 4) + 3) * 512 + (Rb & 15) * 32 + (Cc[i] & 15) * 2) : voffC[i]; }
    const size_t kstep = (size_t)(BK * 2);
    const long kstepB = TOEP ? -2048l : (long)(BK * 2);
    const size_t hstepC = (size_t)HALF * ldb * 2;
    const size_t hstepB = TOEP ? (size_t)4096 : hstepC;
    const unsigned ldsw = (unsigned)wid * 1024u;
    const int aoff = lds_byte(wr * 64 + fr, fq * 8), boff = lds_byte(wc * 32 + fr, fq * 8);
#define PG8_SA(b, h) (((b) * 2 + (h)) * HTB)
#define PG8_SB(b, h) ((4 + (b) * 2 + (h)) * HTB)
#define PG8_STAGE(bufoff, gbase, voff) do { _Pragma("unroll") for (int _i = 0; _i < 2; ++_i) \
        __builtin_amdgcn_global_load_lds((const unsigned*)((const char*)(gbase) + (voff)[_i]), (LAS unsigned*)(lds + (bufoff) + ldsw + _i * 8192), 16, 0, 0); } while (0)
#define PG8_STAGE_SEL(bufoff, gbase, h) do { if (GATHER && last) PG8_STAGE(bufoff, gbase, vN[h]); else PG8_STAGE(bufoff, gbase, vA[h]); } while (0)
#define PG8_LDA(dst, b, h) do { _Pragma("unroll") for (int m = 0; m < 4; ++m) _Pragma("unroll") for (int k = 0; k < 2; ++k) dst[m][k] = *(const LAS bf16x8*)(lds + PG8_SA(b, h) + aoff + m * 2048 + k * 1024); } while (0)
#define PG8_LDB(dst, b, h) do { _Pragma("unroll") for (int n = 0; n < 2; ++n) _Pragma("unroll") for (int k = 0; k < 2; ++k) dst[n][k] = *(const LAS bf16x8*)(lds + PG8_SB(b, h) + boff + n * 2048 + k * 1024); } while (0)
#define PG8_MMA(ai, bj, At, Bt) do { __builtin_amdgcn_s_setprio(1); _Pragma("unroll") for (int m = 0; m < 4; ++m) _Pragma("unroll") for (int n = 0; n < 2; ++n) _Pragma("unroll") for (int k = 0; k < 2; ++k) \
        acc[ai][bj][m][n] = __builtin_amdgcn_mfma_f32_16x16x32_bf16(Bt[n][k], At[m][k], acc[ai][bj][m][n], 0, 0, 0); __builtin_amdgcn_s_setprio(0); } while (0)
#define PG8_WAIT_V(n) asm volatile("s_waitcnt vmcnt(" #n ")" ::: "memory")
#define PG8_WAIT_L(n) asm volatile("s_waitcnt lgkmcnt(" #n ")" ::: "memory")
#define PG8_BAR __builtin_amdgcn_s_barrier()
#define PG8_SCHED __builtin_amdgcn_sched_barrier(0)
#define PG8_VOFF(dst, u) do { int _t = tid; if (GATHER) asm volatile("" : "+v"(_t)); _Pragma("unroll") for (int _i = 0; _i < 2; ++_i) { int _R, _C; stage_rc(_t * 16 + _i * 8192, _R, _C); \
        _Pragma("unroll") for (int _h = 0; _h < 2; ++_h) dst[_h][_i] = (unsigned)(S.row(u, _h * HALF + _R) * lda + _C) * 2u; } } while (0)
    Unit cur, nxt; int ui = 0;
    if (!S.next(0, cur)) return;
    f32x4 acc[2][2][4][2];
#pragma unroll
    for (int a = 0; a < 2; ++a)
#pragma unroll
        for (int b = 0; b < 2; ++b)
#pragma unroll
            for (int m = 0; m < 4; ++m)
#pragma unroll
                for (int n = 0; n < 2; ++n) acc[a][b][m][n] = (f32x4){0.f, 0.f, 0.f, 0.f};
    bf16x8 At[4][2], B0[2][2], B1[2][2];
    unsigned vA[2][2];
    PG8_VOFF(vA, cur);
    const char* cA = S.a_base(cur); const char* cB = S.b_base(cur);
    const char* cC = cB; if constexpr (TOEP) cC = S.c_base(cur);
    PG8_STAGE(PG8_SB(0, 0), cC, voffC); PG8_STAGE(PG8_SB(0, 1), cC + hstepC, voffC); PG8_STAGE(PG8_SA(0, 0), cA, vA[0]); PG8_STAGE(PG8_SA(0, 1), cA, vA[1]);
    if (wr == 1) PG8_BAR;
    PG8_WAIT_V(2); PG8_BAR;
    PG8_STAGE(PG8_SB(1, 0), cC + kstep, voffC); PG8_STAGE(PG8_SA(1, 0), cA + kstep, vA[0]); PG8_STAGE(PG8_SB(1, 1), cC + hstepC + kstep, voffC);
    PG8_WAIT_V(6); PG8_BAR;
    for (;;) {
        const bool has_next = S.next(ui + 1, nxt);
        const char* nA = has_next ? S.a_base(nxt) : cA; const char* nB = has_next ? S.b_base(nxt) : cB;
        const char* nC = nB; if constexpr (TOEP) nC = has_next ? S.c_base(nxt) : cC;
        asm volatile(".p2align 8\n\t.fill 8, 4, 0xBF800000" ::: "memory");
#pragma unroll 1
        for (int t = 0; t < nt; t += 2) {
            const bool last = (t == nt - 2);
            const char* a1 = cA + (size_t)(t + 1) * kstep;
            const char* a2 = last ? nA : cA + (size_t)(t + 2) * kstep; const char* b2 = last ? nC : cB + (long)(t + 2) * kstepB;
            const char* a3 = a2 + kstep; const char* b3 = (TOEP && last) ? b2 + kstep : b2 + kstepB;
            PG8_LDB(B0, 0, 0); PG8_LDB(B1, 0, 1); PG8_SCHED; PG8_LDA(At, 0, 0); PG8_STAGE(PG8_SA(1, 1), a1, vA[1]);
            PG8_WAIT_V(8); PG8_WAIT_L(0); PG8_BAR; PG8_MMA(0, 0, At, B0); PG8_MMA(0, 1, At, B1); PG8_BAR; PG8_SCHED;
            if (GATHER && last && has_next) { PG8_VOFF(vA, nxt); }
            PG8_LDA(At, 0, 1);
            if (TOEP && last) { PG8_STAGE(PG8_SB(0, 0), b2, voffC); PG8_STAGE(PG8_SB(0, 1), b2 + hstepC, voffC); } else { PG8_STAGE(PG8_SB(0, 0), b2, voffB); PG8_STAGE(PG8_SB(0, 1), b2 + hstepB, voffB); }
            PG8_STAGE(PG8_SA(0, 0), a2, vA[0]);
            PG8_WAIT_V(8); PG8_WAIT_L(0); PG8_BAR; PG8_MMA(1, 0, At, B0); PG8_MMA(1, 1, At, B1); PG8_BAR; PG8_SCHED;
            PG8_LDB(B0, 1, 0); PG8_LDB(B1, 1, 1); PG8_SCHED; PG8_LDA(At, 1, 0); PG8_STAGE(PG8_SA(0, 1), a2, vA[1]);
            PG8_WAIT_V(8); PG8_WAIT_L(0); PG8_BAR; PG8_MMA(0, 0, At, B0); PG8_MMA(0, 1, At, B1); PG8_BAR; PG8_SCHED;
            PG8_LDA(At, 1, 1);
            if (TOEP && last) { PG8_STAGE(PG8_SB(1, 0), b3, voffC); PG8_STAGE(PG8_SB(1, 1), b3 + hstepC, voffC); } else { PG8_STAGE(PG8_SB(1, 0), b3, voffB); PG8_STAGE(PG8_SB(1, 1), b3 + hstepB, voffB); }
            PG8_STAGE(PG8_SA(1, 0), a3, vA[0]);
            PG8_WAIT_V(8); PG8_WAIT_L(0); PG8_BAR; PG8_MMA(1, 0, At, B0); PG8_MMA(1, 1, At, B1); PG8_BAR; PG8_SCHED;
        }
        if (wr == 0) PG8_BAR;
        { int fr_e = fr, fq_e = fq; asm volatile("" : "+v"(fr_e), "+v"(fq_e)); E(acc, cur, wr, wc, fr_e, fq_e); }
        if (!has_next) break;
#pragma unroll
        for (int a = 0; a < 2; ++a)
#pragma unroll
            for (int b = 0; b < 2; ++b)
#pragma unroll
                for (int m = 0; m < 4; ++m)
#pragma unroll
                    for (int n = 0; n < 2; ++n) acc[a][b][m][n] = (f32x4){0.f, 0.f, 0.f, 0.f};
        cur = nxt; cA = nA; cB = nB; cC = nC; ++ui;
        if (wr == 1) PG8_BAR;
    }
    PG8_WAIT_V(0);
    PG8_BAR;
#undef PG8_SA
#undef PG8_SB
#undef PG8_STAGE
#undef PG8_STAGE_SEL
#undef PG8_LDA
#undef PG8_LDB
#undef PG8_MMA
#undef PG8_WAIT_V
#undef PG8_WAIT_L
#undef PG8_BAR
#undef PG8_SCHED
#undef PG8_VOFF
}
}

struct EpiQKV {
    static constexpr bool PERM = true;
    bf16* O; bf16* U2;
    __device__ __forceinline__ void operator()(const f32x4 (&acc)[2][2][4][2], const pg8::Unit& u, int wr, int wc, int fr, int fq) const {
        const int row0 = u.pm * 256 + wr * 64 + fr, col0 = u.pn * 256 + wc * 32 + 8 * fq;
#pragma unroll
        for (int ai = 0; ai < 2; ++ai)
#pragma unroll
            for (int m = 0; m < 4; ++m) { const int row = row0 + ai * 128 + m * 16; bf16* rowp = O + (size_t)row * INW + col0;
#pragma unroll
                for (int bj = 0; bj < 2; ++bj) { const f32x4 v0 = acc[ai][bj][m][0], v1 = acc[ai][bj][m][1];
                    u32x4 w; w.x = pg8::cvt_pk_bf16(v0[0], v0[1]); w.y = pg8::cvt_pk_bf16(v0[2], v0[3]); w.z = pg8::cvt_pk_bf16(v1[0], v1[1]); w.w = pg8::cvt_pk_bf16(v1[2], v1[3]);
                    if (u.pn == 6) { const int cu = bj * 128 + wc * 32 + 8 * fq;
                        *(u32x4*)(U2 + ((size_t)(row >> 6) * 16 + (cu >> 4)) * U2K + 128 + (row & 63) * 16 + (cu & 15)) = w; }
                    else *(u32x4*)(rowp + bj * 128) = w; } }
    }
};
struct EpiRes {
    static constexpr bool PERM = true;
    const float* x0; bf16* xb; const float* g1l; float* ssq; int first;
    __device__ __forceinline__ void operator()(const f32x4 (&acc)[2][2][4][2], const pg8::Unit& u, int wr, int wc, int fr, int fq) const {
        const int row0 = u.pm * 256 + wr * 64 + fr, col0 = u.pn * 256 + wc * 32 + 8 * fq;
        const float* g1 = g1l + (size_t)((u.pm * 256) / SEQ) * 6144 + col0;
        f32x4 gv[2][2];
#pragma unroll
        for (int bj = 0; bj < 2; ++bj)
#pragma unroll
            for (int n = 0; n < 2; ++n) gv[bj][n] = *(const f32x4*)(g1 + bj * 128 + n * 4);
#pragma unroll
        for (int ai = 0; ai < 2; ++ai)
#pragma unroll
            for (int m = 0; m < 4; ++m) { const int row = row0 + ai * 128 + m * 16; const size_t off = (size_t)row * DM + col0; float sq = 0.f;
#pragma unroll
                for (int bj = 0; bj < 2; ++bj) { f32x4 x0v, x1v;
                    if (first) { x0v = *(const f32x4*)(x0 + off + bj * 128); x1v = *(const f32x4*)(x0 + off + bj * 128 + 4); }
                    else { const u32x4 w = *(const u32x4*)(xb + off + bj * 128); x0v = (f32x4){bf2f(w.x & 0xffffu), bf2f(w.x >> 16), bf2f(w.y & 0xffffu), bf2f(w.y >> 16)}; x1v = (f32x4){bf2f(w.z & 0xffffu), bf2f(w.z >> 16), bf2f(w.w & 0xffffu), bf2f(w.w >> 16)}; }
                    const f32x4 o0 = x0v + gv[bj][0] * acc[ai][bj][m][0], o1 = x1v + gv[bj][1] * acc[ai][bj][m][1];
                    u32x4 w; w.x = pg8::cvt_pk_bf16(o0[0], o0[1]); w.y = pg8::cvt_pk_bf16(o0[2], o0[3]); w.z = pg8::cvt_pk_bf16(o1[0], o1[1]); w.w = pg8::cvt_pk_bf16(o1[2], o1[3]);
                    *(u32x4*)(xb + off + bj * 128) = w;
                    sq += (o0.x * o0.x + o0.y * o0.y) + (o0.z * o0.z + o0.w * o0.w) + (o1.x * o1.x + o1.y * o1.y) + (o1.z * o1.z + o1.w * o1.w); }
                sq += __shfl_xor(sq, 16); sq += __shfl_xor(sq, 32);
                if (fq == 0) ssq[(size_t)row * 16 + u.pn * 4 + wc] = sq;
                asm volatile("" ::: "memory"); }
    }
};

__device__ __forceinline__ void p0_prologue(Frame& F) {
    LAS float* scr = (LAS float*)(F.lds + F.wave * 16384);
    constexpr int I_IN = NL * 16 * 88, I_OUT = NL * 16 * 32, I_GLU = NL * 4 * 8, I_G = NL * NE * 16 * 8, I_D = NL * NE * 4 * 32;
    constexpr int NITEMS = I_IN + I_OUT + I_GLU + 2 * I_G + I_D;
    struct TItem { const float* src; bf16* dst; int N, ldk; };
#define TR_DECODE(itv, T) do { int r = (itv); \
        if (r < I_IN) { const int l = r / (16 * 88), q = r % (16 * 88), kb = q / 88, nb = q % 88; T.N = INW; T.ldk = DM; \
            T.src = F_w_in + (size_t)l * DM * INW + (size_t)(kb * 64) * INW + nb * 32; T.dst = F_WinT + ((size_t)l * INW + nb * 32) * DM + kb * 64; break; } r -= I_IN; \
        if (r < I_OUT) { const int l = r / (16 * 32), q = r % (16 * 32), kb = q / 32, nb = q % 32; T.N = DM; T.ldk = DM; \
            T.src = F_w_out + (size_t)l * DM * DM + (size_t)(kb * 64) * DM + nb * 32; T.dst = F_WoutT + ((size_t)l * DM + nb * 32) * DM + kb * 64; break; } r -= I_OUT; \
        if (r < I_GLU) { const int l = r / 32, q = r % 32, kb = q / 8, nb = q % 8; T.N = 256; T.ldk = 256; \
            T.src = F_w_glu + (size_t)l * 256 * 256 + (size_t)(kb * 64) * 256 + nb * 32; T.dst = F_WgluT + ((size_t)l * 256 + nb * 32) * 256 + kb * 64; break; } r -= I_GLU; \
        if (r < 2 * I_G) { const int up = r >= I_G; if (up) r -= I_G; const int le = r / 128, q = r % 128, kb = q / 8, nb = q % 8; const int n0 = nb * 32; \
            const int drow = (n0 >> 7) * 256 + up * 128 + (n0 & 127); T.N = FF; T.ldk = DM; \
            T.src = (up ? F_w_up : F_w_gate) + (size_t)le * DM * FF + (size_t)(kb * 64) * FF + n0; T.dst = F_WguT + ((size_t)le * 512 + drow) * DM + kb * 64; break; } r -= 2 * I_G; \
        { const int le = r / 128, q = r % 128, kb = q / 32, nb = q % 32; T.N = DM; T.ldk = FF; \
            T.src = F_w_down + (size_t)le * FF * DM + (size_t)(kb * 64) * DM + nb * 32; T.dst = F_WdT + ((size_t)le * DM + nb * 32) * FF + kb * 64; } } while (0)
#define TR_LOAD(T, tv) do { _Pragma("unroll") for (int i = 0; i < 32; ++i) { const int kk = 2 * i + (F.lane >> 5); tv[i] = __builtin_nontemporal_load(T.src + (size_t)kk * T.N + (F.lane & 31)); } } while (0)
#define TR_STORE(T, tv) do { _Pragma("unroll") for (int i = 0; i < 32; ++i) { const int kk = 2 * i + (F.lane >> 5); scr[kk * 33 + (F.lane & 31)] = tv[i]; } \
        LDS_WAIT(); asm volatile("" ::: "memory"); const int c = F.lane & 7; \
        _Pragma("unroll") for (int j = 0; j < 4; ++j) { const int n = (F.lane >> 3) + 8 * j; const LAS float* s = scr + (8 * c) * 33 + n; \
            u32x4 o; o.x = pk2(s[0 * 33], s[1 * 33]); o.y = pk2(s[2 * 33], s[3 * 33]); o.z = pk2(s[4 * 33], s[5 * 33]); o.w = pk2(s[6 * 33], s[7 * 33]); \
            *(u32x4*)(T.dst + (size_t)n * T.ldk + 8 * c) = o; } \
        LDS_WAIT(); asm volatile("" ::: "memory"); } while (0)
    {
        float tva[32], tvb[32]; TItem Ta, Tb; Ta.src = nullptr; Ta.dst = nullptr; Ta.N = 0; Ta.ldk = 0; Tb = Ta;
        int it = F.gw;
        if (it < NITEMS) { TR_DECODE(it, Ta); TR_LOAD(Ta, tva); }
        while (it < NITEMS) {
            const int it1 = it + F.ngw; if (it1 < NITEMS) { TR_DECODE(it1, Tb); TR_LOAD(Tb, tvb); }
            TR_STORE(Ta, tva);
            if (it1 >= NITEMS) break;
            const int it2 = it1 + F.ngw; if (it2 < NITEMS) { TR_DECODE(it2, Ta); TR_LOAD(Ta, tva); }
            TR_STORE(Tb, tvb);
            it = it2;
        }
    }
#undef TR_DECODE
#undef TR_LOAD
#undef TR_STORE
    for (int i = F.blk * NTHR + F.tid; i < NL * 48 * DM; i += F.G * NTHR) { const int l = i / (48 * DM), j = (i / DM) % 48, k = i % DM;
        const float w = (j < 4) ? F_w_group[((size_t)l * DM + k) * 4 + j] : (j < 36 ? F_w_expert[((size_t)l * DM + k) * 32 + (j - 4)] : 0.f);
        const unsigned hi = f2bf(w); const unsigned lo = f2bf(w - bf2f(hi));
        F_WRHL[((size_t)(l * 2 + 0) * 48 + j) * DM + k] = (bf16)hi; F_WRHL[((size_t)(l * 2 + 1) * 48 + j) * DM + k] = (bf16)lo; }
    for (int i = F.blk * 16 + F.tid; F.tid < 16 && i < NL * 16 * 64; i += F.G * 16) {
        const int lg = i / 64; const float are = F_a_re[i], aim = F_a_im[i], dt = __expf(F_log_dt[lg]);
        const float mag = expf(are * dt); float sn, cs; sincosf(aim * dt, &sn, &cs);
        const float abr = mag * cs, abi = mag * sn;
        F_ABAR[i] = (f32x2){abr, abi};
        const float mag64 = expf(64.f * are * dt); float sn64, cs64; sincosf(64.f * aim * dt, &sn64, &cs64);
        F_ABAR64[i] = (f32x2){mag64 * cs64, mag64 * sn64};
        F_PW[((size_t)lg * 65 + 64) * 64 + (i & 63)] = (f32x2){mag64 * cs64, mag64 * sn64};
        const float xr = abr - 1.f, xi = abi, den = are * are + aim * aim;
        const float fr = (xr * are + xi * aim) / den, fi = (xi * are - xr * aim) / den;
        f32x4 brv[4], biv[4];
#pragma unroll
        for (int q4 = 0; q4 < 4; ++q4) { brv[q4] = *(const f32x4*)(F_b_re + (size_t)i * 16 + 4 * q4); biv[q4] = *(const f32x4*)(F_b_im + (size_t)i * 16 + 4 * q4); }
#pragma unroll
        for (int q4 = 0; q4 < 4; ++q4)
#pragma unroll
            for (int r = 0; r < 4; ++r) { const float br = brv[q4][r], bi = biv[q4][r]; F_BBAR[(size_t)i * 16 + 4 * q4 + r] = (f32x2){fr * br - fi * bi, fr * bi + fi * br}; }
    }
    __syncthreads();
    for (int wu = F.blk; wu < NL * 16 * 4; wu += F.G) {
        const int lg = wu >> 2, lag0 = (wu & 3) * 16; const float dt = __expf(F_log_dt[lg]);
        LAS f32x2* pw = (LAS f32x2*)F.lds;
        LAS f32x2* ff = pw + 1024;
        LAS f32x2* cc = ff + 64;
        LAS float* bbr = (LAS float*)(cc + 1024);
        LAS float* bbi = bbr + 1024;
        for (int idx = F.tid; idx < 1024 + 64; idx += NTHR) { const int p = idx & 63; const float are = F_a_re[lg * 64 + p], aim = F_a_im[lg * 64 + p];
            if (idx < 1024) { const float lag = (float)(lag0 + (idx >> 6)); const float pm = expf(lag * are * dt); float sn, cs; sincosf(lag * aim * dt, &sn, &cs); const f32x2 pv = (f32x2){pm * cs, pm * sn}; pw[idx] = pv; F_PW[((size_t)lg * 65 + lag0 + (idx >> 6)) * 64 + p] = pv; }
            else { const float mag = expf(are * dt); float sn, cs; sincosf(aim * dt, &sn, &cs); const float xr0 = mag * cs - 1.f, xi0 = mag * sn, den = are * are + aim * aim;
                ff[p] = (f32x2){(xr0 * are + xi0 * aim) / den, (xi0 * are - xr0 * aim) / den}; } }
        for (int idx = F.tid; idx < 1024; idx += NTHR) cc[idx] = (f32x2){F_c_re[(size_t)lg * 1024 + idx], F_c_im[(size_t)lg * 1024 + idx]};
        __syncthreads();
        for (int idx = F.tid; idx < 1024; idx += NTHR) { const f32x2 fv = ff[idx >> 4]; const float br = F_b_re[(size_t)lg * 1024 + idx], bi = F_b_im[(size_t)lg * 1024 + idx];
            bbr[idx] = fv.x * br - fv.y * bi; bbi[idx] = fv.x * bi + fv.y * br; }
        __syncthreads();
        if (F.tid < 256) { const int c = F.tid & 15, lagi = F.tid >> 4, lag = lag0 + lagi;
            float acc[16];
#pragma unroll
            for (int q = 0; q < 16; ++q) acc[q] = 0.f;
#pragma unroll 4
            for (int p = 0; p < 64; ++p) { const f32x2 pv = pw[lagi * 64 + p], cv = cc[c * 64 + p];
                const float zr = cv.x * pv.x - cv.y * pv.y, zi = cv.x * pv.y + cv.y * pv.x;
                const LAS f32x4* br = (const LAS f32x4*)(bbr + p * 16); const LAS f32x4* bi = (const LAS f32x4*)(bbi + p * 16);
#pragma unroll
                for (int q4 = 0; q4 < 4; ++q4) { const f32x4 r4 = br[q4], i4 = bi[q4];
                    acc[4 * q4] += zr * r4.x - zi * i4.x; acc[4 * q4 + 1] += zr * r4.y - zi * i4.y; acc[4 * q4 + 2] += zr * r4.z - zi * i4.z; acc[4 * q4 + 3] += zr * r4.w - zi * i4.w; } }
            if (lag == 0) {
#pragma unroll
                for (int q = 0; q < 16; ++q) if (q == c) acc[q] += F_ssm_d[lg * 16 + c]; }
            bf16* kp = F_KERNB + (((size_t)lg * 128 + 64 + lag) * 16 + c) * 16;
#pragma unroll
            for (int q8 = 0; q8 < 2; ++q8) { u32x4 o; o.x = pk2(acc[8 * q8], acc[8 * q8 + 1]); o.y = pk2(acc[8 * q8 + 2], acc[8 * q8 + 3]); o.z = pk2(acc[8 * q8 + 4], acc[8 * q8 + 5]); o.w = pk2(acc[8 * q8 + 6], acc[8 * q8 + 7]);
                *(u32x4*)(kp + 8 * q8) = o; }
        } else { bf16* zp = F_KERNB + ((size_t)lg * 128 + lag0) * 256 + (F.tid - 256) * 16;
            *(u32x4*)zp = (u32x4){0u, 0u, 0u, 0u}; *(u32x4*)(zp + 8) = (u32x4){0u, 0u, 0u, 0u}; }
        __syncthreads();
    }
    for (int i = F.blk * NTHR + F.tid; i < SEQ * 32; i += F.G * NTHR) { const int pos = i >> 5, j = i & 31;
        const float inv = powf(10000.0f, -(float)j / 32.0f); const float ang = (float)pos * inv; float sn, cs; sincosf(ang, &sn, &cs); F_ROPE[i] = (f32x2){cs, sn}; }
    __syncthreads();
    {
        LAS float* cond = (LAS float*)F.lds;
        LAS float* red = (LAS float*)(F.lds + 32768);
        for (int i = F.tid; i < NB * DM; i += NTHR) cond[i] = silu_f(F_c[i]);
        __syncthreads();
        constexpr int NITM = NL * 6144 / 96;
        for (int it = F.blk; it < NITM; it += F.G) {
            const int cl = F.tid % 96, ks = F.tid / 96, col = it * 96 + cl, l = col / 6144, j = col % 6144;
            if (ks < 4) {
                float acc[8];
#pragma unroll
                for (int b = 0; b < 8; ++b) acc[b] = 0.f;
                const float* wp = F_w_ada + (size_t)l * DM * 6144 + j + (size_t)(ks * 256) * 6144;
                for (int k0 = 0; k0 < 256; k0 += 16) { float w[16];
#pragma unroll
                    for (int q = 0; q < 16; ++q) w[q] = __builtin_nontemporal_load(wp + (size_t)(k0 + q) * 6144);
#pragma unroll
                    for (int q = 0; q < 16; ++q)
#pragma unroll
                        for (int b = 0; b < 8; ++b) acc[b] += cond[b * DM + ks * 256 + k0 + q] * w[q]; }
#pragma unroll
                for (int b = 0; b < 8; ++b) red[(ks * 96 + cl) * 8 + b] = acc[b];
            }
            __syncthreads();
            if (F.tid < 96) {
#pragma unroll
                for (int b = 0; b < 8; ++b) { const float s = red[(0 * 96 + F.tid) * 8 + b] + red[(1 * 96 + F.tid) * 8 + b] + red[(2 * 96 + F.tid) * 8 + b] + red[(3 * 96 + F.tid) * 8 + b];
                    F_MOD[((size_t)l * NB + b) * 6144 + j] = s + F_b_ada[(size_t)l * 6144 + j]; }
            }
            __syncthreads();
        }
    }
}


template <bool FINAL>
__device__ __forceinline__ void norm1_phase(Frame& F, int l) {
    const bool addmoe = FINAL || l > 0;
    const int lp = FINAL ? NL - 1 : l - 1;
    const int rpw = (NT + F.ngw - 1) / F.ngw;
    for (int j = 0; j < rpw; j += 2) {
        const int rowA = F.gw * rpw + j;
        if (rowA >= NT) break;
        f32x4 v[2][4];
#pragma unroll
        for (int q = 0; q < 2; ++q) { const int row = rowA + q;
            if (!FINAL && l == 0) { const f32x4* xr = (const f32x4*)(F_x + (size_t)row * DM) + F.lane;
#pragma unroll
                for (int i = 0; i < 4; ++i) v[q][i] = xr[64 * i]; }
            else { const u32x2* xr = (const u32x2*)(F_XB + (size_t)row * DM) + F.lane;
#pragma unroll
                for (int i = 0; i < 4; ++i) { const u32x2 w = xr[64 * i]; v[q][i] = (f32x4){bf2f(w.x & 0xffffu), bf2f(w.x >> 16), bf2f(w.y & 0xffffu), bf2f(w.y >> 16)}; } } }
        if (addmoe) {
#pragma unroll
            for (int q = 0; q < 2; ++q) { const int row = rowA + q, b = row / SEQ;
                const f32x4* g2 = (const f32x4*)(F_MOD + ((size_t)lp * NB + b) * 6144 + 5120) + F.lane;
                const u32x2* s0 = (const u32x2*)(F_SLOT + (size_t)row * DM) + F.lane; const u32x2* s1 = (const u32x2*)(F_SLOT + (size_t)NT * DM + (size_t)row * DM) + F.lane;
#pragma unroll
                for (int i = 0; i < 4; ++i) { const u32x2 a = s0[64 * i], c = s1[64 * i]; const f32x4 g = g2[64 * i];
                    v[q][i].x += g.x * (bf2f(a.x & 0xffffu) + bf2f(c.x & 0xffffu)); v[q][i].y += g.y * (bf2f(a.x >> 16) + bf2f(c.x >> 16));
                    v[q][i].z += g.z * (bf2f(a.y & 0xffffu) + bf2f(c.y & 0xffffu)); v[q][i].w += g.w * (bf2f(a.y >> 16) + bf2f(c.y >> 16)); }
                if (!FINAL) { u32x2* xo = (u32x2*)(F_XB + (size_t)row * DM) + F.lane;
#pragma unroll
                    for (int i = 0; i < 4; ++i) { u32x2 w; w.x = pk2(v[q][i].x, v[q][i].y); w.y = pk2(v[q][i].z, v[q][i].w); xo[64 * i] = w; } } }
        }
        float ss[2];
#pragma unroll
        for (int q = 0; q < 2; ++q) { ss[q] = 0.f;
#pragma unroll
            for (int i = 0; i < 4; ++i) ss[q] += (v[q][i].x * v[q][i].x + v[q][i].y * v[q][i].y) + (v[q][i].z * v[q][i].z + v[q][i].w * v[q][i].w); }
#pragma unroll
        for (int o = 1; o < 64; o <<= 1) { ss[0] += __shfl_xor(ss[0], o); ss[1] += __shfl_xor(ss[1], o); }
#pragma unroll
        for (int q = 0; q < 2; ++q) { const int row = rowA + q, b = row / SEQ; const float rstd = 1.0f / sqrtf(ss[q] * (1.0f / DM) + EPS);
            if (FINAL) { const f32x4* g = (const f32x4*)F_final_g + F.lane; f32x4* xo = (f32x4*)(F_OUT + (size_t)row * DM) + F.lane;
#pragma unroll
                for (int i = 0; i < 4; ++i) xo[64 * i] = v[q][i] * rstd * g[64 * i];
            } else { const f32x4* g = (const f32x4*)(F_norm1_g + (size_t)l * DM) + F.lane; const float* modb = F_MOD + ((size_t)l * NB + b) * 6144;
                const f32x4* sh = (const f32x4*)modb + F.lane; const f32x4* sc = (const f32x4*)(modb + 1024) + F.lane; u32x2* ho = (u32x2*)(F_H + (size_t)row * DM) + F.lane;
#pragma unroll
                for (int i = 0; i < 4; ++i) { const f32x4 hv = v[q][i] * rstd * g[64 * i] * (sc[64 * i] + 1.0f) + sh[64 * i]; u32x2 o; o.x = pk2(hv.x, hv.y); o.y = pk2(hv.z, hv.w); ho[64 * i] = o; } } }
    }
}

__device__ __forceinline__ void norm2_router_phase(Frame& F, int l) {
    LAS int* l_ent = (LAS int*)F.lds;
    LAS int* l_exp = l_ent + 256;
    LAS int* l_cnt = l_exp + 256;
    LAS int* l_base = l_cnt + 32;
    LAS float* lgs = (LAS float*)(F.lds + 4096 + F.wave * 3072);
    if (F.tid < 32) l_cnt[F.tid] = 0;
    __syncthreads();
    const int fr = F.lane & 15, fq = F.lane >> 4;
    const int row = F.blk * 128 + F.wave * 16 + fr, b = (F.blk * 128) / SEQ;
    const bf16* xr = F_XB + (size_t)row * DM + fq * 8;
    float ss; { const f32x4 q = *(const f32x4*)(F_SSQ + (size_t)row * 16 + fq * 4); ss = (q.x + q.y) + (q.z + q.w); }
    ss += __shfl_xor(ss, 16); ss += __shfl_xor(ss, 32);
    const float rstd = 1.0f / sqrtf(ss * (1.0f / DM) + EPS);
    const float* gp = F_norm2_g + (size_t)l * DM + fq * 8;
    const float* shp = F_MOD + ((size_t)l * NB + b) * 6144 + 3072 + fq * 8; const float* scp = shp + 1024;
    const bf16* wb = F_WRHL + (size_t)l * 2 * 48 * DM + (size_t)fr * DM + fq * 8;
    bf16* hrow = F_H + (size_t)row * DM + fq * 8;
    f32x4 acc[3];
#pragma unroll
    for (int t = 0; t < 3; ++t) acc[t] = (f32x4){0.f, 0.f, 0.f, 0.f};
    struct RStep { u32x4 xw; f32x4 g0, g1, s0, s1, h0, h1; bf16x8 bh[3], bl[3]; };
#define R_LOAD(S, ks) do { S.xw = xall[ks]; S.g0 = *(const f32x4*)(gp + (ks) * 32); S.g1 = *(const f32x4*)(gp + (ks) * 32 + 4); \
        S.s0 = *(const f32x4*)(scp + (ks) * 32); S.s1 = *(const f32x4*)(scp + (ks) * 32 + 4); S.h0 = *(const f32x4*)(shp + (ks) * 32); S.h1 = *(const f32x4*)(shp + (ks) * 32 + 4); \
        _Pragma("unroll") for (int t = 0; t < 3; ++t) { S.bh[t] = *(const bf16x8*)(wb + (size_t)(t * 16) * DM + (ks) * 32); S.bl[t] = *(const bf16x8*)(wb + (size_t)(48 + t * 16) * DM + (ks) * 32); } } while (0)
#define R_COMP(S, ks) do { \
        const f32x4 a = (f32x4){bf2f(S.xw.x & 0xffffu), bf2f(S.xw.x >> 16), bf2f(S.xw.y & 0xffffu), bf2f(S.xw.y >> 16)}, c = (f32x4){bf2f(S.xw.z & 0xffffu), bf2f(S.xw.z >> 16), bf2f(S.xw.w & 0xffffu), bf2f(S.xw.w >> 16)}; \
        const f32x4 v0 = a * rstd * S.g0 * (S.s0 + 1.0f) + S.h0, v1 = c * rstd * S.g1 * (S.s1 + 1.0f) + S.h1; \
        u32x4 hi; hi.x = pk2(v0.x, v0.y); hi.y = pk2(v0.z, v0.w); hi.z = pk2(v1.x, v1.y); hi.w = pk2(v1.z, v1.w); \
        *(u32x4*)(hrow + (ks) * 32) = hi; \
        u32x4 lo; lo.x = pk2(v0.x - bf2f(hi.x & 0xffffu), v0.y - bf2f(hi.x >> 16)); lo.y = pk2(v0.z - bf2f(hi.y & 0xffffu), v0.w - bf2f(hi.y >> 16)); \
        lo.z = pk2(v1.x - bf2f(hi.z & 0xffffu), v1.y - bf2f(hi.z >> 16)); lo.w = pk2(v1.z - bf2f(hi.w & 0xffffu), v1.w - bf2f(hi.w >> 16)); \
        const bf16x8 ahi = __builtin_bit_cast(bf16x8, hi), alo = __builtin_bit_cast(bf16x8, lo); \
        _Pragma("unroll") for (int t = 0; t < 3; ++t) { \
            acc[t] = __builtin_amdgcn_mfma_f32_16x16x32_bf16(S.bh[t], ahi, acc[t], 0, 0, 0); \
            acc[t] = __builtin_amdgcn_mfma_f32_16x16x32_bf16(S.bh[t], alo, acc[t], 0, 0, 0); \
            acc[t] = __builtin_amdgcn_mfma_f32_16x16x32_bf16(S.bl[t], ahi, acc[t], 0, 0, 0); } } while (0)
    {
        u32x4 xall[32];
#pragma unroll
        for (int ks = 0; ks < 32; ++ks) xall[ks] = *(const u32x4*)(xr + ks * 32);
        RStep SA, SB;
        R_LOAD(SA, 0);
#pragma unroll
        for (int ks = 0; ks < 32; ks += 2) {
            R_LOAD(SB, ks + 1);
            R_COMP(SA, ks);
            if (ks + 2 < 32) R_LOAD(SA, ks + 2);
            R_COMP(SB, ks + 1);
        }
    }
#undef R_LOAD
#undef R_COMP
#pragma unroll
    for (int t = 0; t < 3; ++t)
#pragma unroll
        for (int r = 0; r < 4; ++r) lgs[fr * 48 + t * 16 + 4 * fq + r] = acc[t][r];
    LDS_WAIT(); __builtin_amdgcn_wave_barrier();
    {
        const LAS float* wl = lgs + fr * 48;
        float gl[4];
#pragma unroll
        for (int j = 0; j < 4; ++j) gl[j] = wl[j] + F_b_group[l * 4 + j];
        int gi = 0; float gm = gl[0];
#pragma unroll
        for (int j = 1; j < 4; ++j) if (gl[j] > gm) { gm = gl[j]; gi = j; }
        float gs = 0.f;
#pragma unroll
        for (int j = 0; j < 4; ++j) gs += __expf(gl[j] - gm);
        const float gw = 1.0f / gs;
        float ig[8];
#pragma unroll
        for (int j = 0; j < 8; ++j) ig[j] = wl[4 + gi * 8 + j] + F_b_expert[l * 32 + gi * 8 + j];
        int i0 = 0; float v0 = ig[0];
#pragma unroll
        for (int j = 1; j < 8; ++j) if (ig[j] > v0) { v0 = ig[j]; i0 = j; }
        int i1 = -1; float v1 = -3.0e38f;
#pragma unroll
        for (int j = 0; j < 8; ++j) if (j != i0 && ig[j] > v1) { v1 = ig[j]; i1 = j; }
        const float e1x = __expf(v1 - v0), w0 = gw / (1.0f + e1x), w1 = gw * e1x / (1.0f + e1x);
        if (fq == 0) { F_RW[(size_t)row * 2] = w0; F_RW[(size_t)row * 2 + 1] = w1;
            const int lr = F.wave * 16 + fr; l_ent[lr * 2] = row * 2; l_ent[lr * 2 + 1] = row * 2 + 1; l_exp[lr * 2] = gi * 8 + i0; l_exp[lr * 2 + 1] = gi * 8 + i1; }
    }
    __syncthreads();
    int rank = 0, e = 0;
    if (F.tid < 256) { e = l_exp[F.tid]; rank = atomicAdd((int*)&l_cnt[e], 1); }
    __syncthreads();
    if (F.tid < 32) l_base[F.tid] = (int)atomicAdd(F_ctl + CW_CNT + l * 32 + F.tid, (unsigned)l_cnt[F.tid]);
    __syncthreads();
    if (F.tid < 256) F_LIST[(size_t)e * NT + l_base[e] + rank] = l_ent[F.tid];
    __syncthreads();
}


struct GateOrder {
    int blk; const char* A; const char* Bt;
    __device__ __forceinline__ bool next(int i, pg8::Unit& u) const { if (i != 0 || blk < 64 || blk >= 192) return false; u.pm = blk - 64; u.pn = 10; u.e = 0; u.i = 0; return true; }
    __device__ __forceinline__ const char* a_base(const pg8::Unit& u) const { return A + (size_t)u.pm * (256 * DM * 2); }
    __device__ __forceinline__ const char* b_base(const pg8::Unit& u) const { return Bt + (size_t)u.pn * (256 * DM * 2); }
    __device__ __forceinline__ int row(const pg8::Unit&, int r) const { return r; }
};

constexpr int MOE_LDS = 131072;
constexpr int MOE_MAXU = 8;
struct MoeOrder {
    LAS const int* ud; LAS const int* rows; const char* A; const char* Bt; size_t strideE, tstepA, tstepB; bool gather;
    __device__ __forceinline__ bool next(int i, pg8::Unit& u) const { if (i >= MOE_MAXU || ud[i * 4 + 3] == 0) return false; u.pm = ud[i * 4]; u.pn = ud[i * 4 + 1]; u.e = ud[i * 4 + 2]; u.i = i; return true; }
    __device__ __forceinline__ const char* a_base(const pg8::Unit& u) const { return gather ? A : A + (size_t)u.pm * tstepA; }
    __device__ __forceinline__ const char* b_base(const pg8::Unit& u) const { return Bt + (size_t)u.e * strideE + (size_t)u.pn * tstepB; }
    __device__ __forceinline__ int row(const pg8::Unit& u, int r) const { if (!gather) return r; const int ent = rows[u.i * 256 + r]; return ent >= 0 ? (ent >> 1) : 0; }
};
struct EpiMoe1 {
    static constexpr bool PERM = true;
    bf16* act; const float* rw; LAS const int* rows;
    __device__ __forceinline__ void operator()(const f32x4 (&acc)[2][2][4][2], const pg8::Unit& u, int wr, int wc, int fr, int fq) const {
#pragma unroll
        for (int ai = 0; ai < 2; ++ai)
#pragma unroll
            for (int m = 0; m < 4; ++m) { const int rl = ai * 128 + wr * 64 + m * 16 + fr; const int ent = rows[u.i * 256 + rl]; const float w = ent >= 0 ? rw[ent] : 0.f;
                const f32x4 g0 = acc[ai][0][m][0], g1 = acc[ai][0][m][1], u0 = acc[ai][1][m][0], u1 = acc[ai][1][m][1];
                u32x4 o; o.x = pg8::cvt_pk_bf16(silu_f(g0[0]) * u0[0] * w, silu_f(g0[1]) * u0[1] * w); o.y = pg8::cvt_pk_bf16(silu_f(g0[2]) * u0[2] * w, silu_f(g0[3]) * u0[3] * w);
                o.z = pg8::cvt_pk_bf16(silu_f(g1[0]) * u1[0] * w, silu_f(g1[1]) * u1[1] * w); o.w = pg8::cvt_pk_bf16(silu_f(g1[2]) * u1[2] * w, silu_f(g1[3]) * u1[3] * w);
                *(u32x4*)(act + ((size_t)u.pm * 256 + rl) * FF + u.pn * 128 + wc * 32 + 8 * fq) = o; }
    }
};
struct EpiMoe2 {
    static constexpr bool PERM = true;
    bf16* slot; LAS const int* rows;
    __device__ __forceinline__ void operator()(const f32x4 (&acc)[2][2][4][2], const pg8::Unit& u, int wr, int wc, int fr, int fq) const {
#pragma unroll
        for (int ai = 0; ai < 2; ++ai)
#pragma unroll
            for (int m = 0; m < 4; ++m) { const int rl = ai * 128 + wr * 64 + m * 16 + fr; const int ent = rows[u.i * 256 + rl];
                if (ent >= 0) { bf16* rowp = slot + (size_t)(ent & 1) * NT * DM + (size_t)(ent >> 1) * DM + u.pn * 256 + wc * 32 + 8 * fq;
#pragma unroll
                    for (int bj = 0; bj < 2; ++bj) { const f32x4 v0 = acc[ai][bj][m][0], v1 = acc[ai][bj][m][1];
                        u32x4 w; w.x = pg8::cvt_pk_bf16(v0[0], v0[1]); w.y = pg8::cvt_pk_bf16(v0[2], v0[3]); w.z = pg8::cvt_pk_bf16(v1[0], v1[1]); w.w = pg8::cvt_pk_bf16(v1[2], v1[3]);
                        *(u32x4*)(rowp + bj * 128) = w; } } }
    }
};
struct MoeDeal { int nA, nB, NL, q, ls, nAfull; bool defer; };
__device__ __forceinline__ MoeDeal moe_deal(int tiles, int G) {
    MoeDeal d; d.nA = tiles * 2; d.nB = tiles * 4; d.nAfull = (d.nA / G) * G; d.NL = d.nA - d.nAfull; d.q = (d.nB + 2 * d.NL + G - 1) / G; d.ls = d.q - 3 < 2 ? 2 : d.q - 3;
    d.defer = (G == 256) && d.NL > 0 && d.NL <= 64 && d.q >= 4 && d.nAfull > 0 && d.ls <= MOE_MAXU && d.NL * d.ls <= d.nB && (d.nB - d.NL * d.ls + (G - d.NL) - 1) / (G - d.NL) <= MOE_MAXU; return d;
}
constexpr int CW_MB = 28672;
template <int STAGE>
__device__ __forceinline__ void moe_pg8(Frame& F, int l) {
    LAS int* t_cnt = (LAS int*)(F.lds + MOE_LDS);
    LAS int* t_toff = t_cnt + 32;
    LAS int* ud = t_toff + 36;
    LAS int* rows = ud + 32;
    int tid_m = threadIdx.x; asm volatile("" : "+v"(tid_m));
    __syncthreads();
    if (tid_m == 0) { int to = 0;
        for (int e = 0; e < NE; ++e) { const int c = (int)__hip_atomic_load(F_ctl + CW_CNT + l * 32 + e, __ATOMIC_RELAXED, __HIP_MEMORY_SCOPE_AGENT); t_cnt[e] = c; t_toff[e] = to; to += (c + 255) >> 8; }
        t_toff[NE] = to; }
    __syncthreads();
    const MoeDeal D = moe_deal(t_toff[NE], F.G);
#define MOE_SLOT(i, L, valid, NPN_) do { int rtg = 0, pn = 0, e = 0; \
        if (valid) { rtg = (L) / (NPN_); pn = (L) % (NPN_); for (int q_ = 1; q_ < NE; ++q_) if (t_toff[q_] <= rtg) e = q_; } \
        if (tid_m == 0) { ud[(i) * 4] = rtg; ud[(i) * 4 + 1] = pn; ud[(i) * 4 + 2] = e; ud[(i) * 4 + 3] = (valid) ? 1 : 0; } \
        if (tid_m < 256) { int ent = -1; if (valid) { const int pos = (rtg - t_toff[e]) * 256 + tid_m; if (pos < t_cnt[e]) ent = F_LIST[(size_t)e * NT + pos]; } rows[(i) * 256 + tid_m] = ent; } } while (0)
    MoeOrder S; S.ud = ud; S.rows = rows;
    if (STAGE == 1 || (D.defer && F.blk < D.NL)) {
        const int nlim = D.defer ? D.nAfull : D.nA;
        for (int i = 0; i < MOE_MAXU; ++i) { int L; bool valid;
            if (STAGE == 1) { L = i * F.G + F.blk; valid = L < nlim; } else { L = D.nAfull + F.blk; valid = (i == 0); }
            MOE_SLOT(i, L, valid, 2); }
        __syncthreads();
        S.A = (const char*)F_H; S.Bt = (const char*)(F_WguT + (size_t)l * NE * 512 * DM); S.strideE = (size_t)512 * DM * 2; S.tstepA = 0; S.tstepB = (size_t)256 * DM * 2; S.gather = true;
        EpiMoe1 E{F_ACT, F_RW, rows};
        pg8::gemm_phase<EpiMoe1, MoeOrder, true>(F.lds, DM, DM, DM, S, E);
        if (STAGE == 2) {
            asm volatile("s_waitcnt vmcnt(0)" ::: "memory"); __syncthreads();
            if (tid_m == 0) { unsigned* mb = F_ctl + CW_MB + l * 64;
                __builtin_amdgcn_fence(__ATOMIC_RELEASE, "agent"); asm volatile("s_waitcnt vmcnt(0)" ::: "memory");
                (void)__hip_atomic_fetch_add(mb, 1u, __ATOMIC_RELAXED, __HIP_MEMORY_SCOPE_AGENT);
                unsigned sp = 0; while (__hip_atomic_load(mb, __ATOMIC_RELAXED, __HIP_MEMORY_SCOPE_AGENT) < (unsigned)D.NL) { __builtin_amdgcn_s_sleep(1); if (++sp > (1u << 22)) break; }
                __builtin_amdgcn_fence(__ATOMIC_ACQUIRE, "agent"); asm volatile("s_waitcnt vmcnt(0)" ::: "memory"); }
            __syncthreads();
        }
    }
    if (STAGE == 2) {
        for (int i = 0; i < MOE_MAXU; ++i) { int L; bool valid;
            if (!D.defer) { L = i * F.G + F.blk; valid = L < D.nB; }
            else if (F.blk < D.NL) { L = D.nB - (F.blk + 1) * D.ls + i; valid = i < D.ls; }
            else { L = (F.blk - D.NL) + (F.G - D.NL) * i; valid = L < D.nB - D.NL * D.ls; }
            MOE_SLOT(i, L, valid, 4); }
        __syncthreads();
        S.A = (const char*)F_ACT; S.Bt = (const char*)(F_WdT + (size_t)l * NE * DM * FF); S.strideE = (size_t)DM * FF * 2; S.tstepA = (size_t)256 * FF * 2; S.tstepB = (size_t)256 * FF * 2; S.gather = false;
        EpiMoe2 E{F_SLOT, rows};
        pg8::gemm_phase<EpiMoe2, MoeOrder, false>(F.lds, FF, FF, FF, S, E);
    }
#undef MOE_SLOT
}

__device__ __forceinline__ void s5_build_operands(Frame& F, int l) {
    const int gt = F.blk * NTHR + F.tid, ngt = F.G * NTHR;
    for (int i = gt; i < 16 * 1024 * 16; i += ngt) {
        const int kv = i & 15, row = (i >> 4) & 1023, g = i >> 14, t = row >> 4, c = row & 15, k0 = kv * 8;
        const int lg = l * 16 + g, p0 = k0 & 63;
        const f32x4* pwp = (const f32x4*)(F_PW + ((size_t)lg * 65 + t + 1) * 64 + p0);
        const f32x4* crp = (const f32x4*)(F_c_re + ((size_t)lg * 16 + c) * 64 + p0); const f32x4* cip = (const f32x4*)(F_c_im + ((size_t)lg * 16 + c) * 64 + p0);
        const f32x4 w0 = pwp[0], w1 = pwp[1], w2 = pwp[2], w3 = pwp[3], cr0 = crp[0], cr1 = crp[1], ci0 = cip[0], ci1 = cip[1];
        const float pr[8] = {w0.x, w0.z, w1.x, w1.z, w2.x, w2.z, w3.x, w3.z}, pi[8] = {w0.y, w0.w, w1.y, w1.w, w2.y, w2.w, w3.y, w3.w};
        const float cr[8] = {cr0.x, cr0.y, cr0.z, cr0.w, cr1.x, cr1.y, cr1.z, cr1.w}, ci[8] = {ci0.x, ci0.y, ci0.z, ci0.w, ci1.x, ci1.y, ci1.z, ci1.w};
        float v[8];
#pragma unroll
        for (int q = 0; q < 8; ++q) v[q] = (k0 < 64) ? (cr[q] * pr[q] - ci[q] * pi[q]) : -(cr[q] * pi[q] + ci[q] * pr[q]);
        u32x4 o; o.x = pk2(v[0], v[1]); o.y = pk2(v[2], v[3]); o.z = pk2(v[4], v[5]); o.w = pk2(v[6], v[7]);
        *(u32x4*)(F_TMAT + ((size_t)(g * 1024 + row)) * 128 + k0) = o;
    }
    for (int i = gt; i < 16 * 256 * 128; i += ngt) {
        const int kv = i & 127, n = (i >> 7) & 255, g = i >> 15, s = kv >> 1, c0 = (kv & 1) * 8;
        float v[8];
#pragma unroll
        for (int q = 0; q < 8; ++q) v[q] = 0.f;
        if (n < 128) { const int p = n & 63, lg = l * 16 + g; const f32x2 pv = F_PW[((size_t)lg * 65 + (63 - s)) * 64 + p]; const float pr = pv.x, pi = pv.y;
#pragma unroll
            for (int q = 0; q < 8; ++q) { const f32x2 bb = F_BBAR[((size_t)lg * 64 + p) * 16 + c0 + q]; v[q] = (n < 64) ? (pr * bb.x - pi * bb.y) : (pr * bb.y + pi * bb.x); } }
        u32x4 o; o.x = pk2(v[0], v[1]); o.y = pk2(v[2], v[3]); o.z = pk2(v[4], v[5]); o.w = pk2(v[6], v[7]);
        *(u32x4*)(F_BT1 + ((size_t)(g * 256 + n)) * 1024 + s * 16 + c0) = o;
    }
}
struct GroupOrder {
    int G, c, npn, nunit; const char* A; const char* Bt; size_t strideB, tstepA, tstepB;
    __device__ __forceinline__ bool next(int i, pg8::Unit& u) const { const int L = i * G + c; if (L >= nunit) return false; u.pn = L % npn; u.pm = (L / npn) & 1; u.e = L / (npn * 2); u.i = i; return true; }
    __device__ __forceinline__ const char* a_base(const pg8::Unit& u) const { return A + (size_t)u.e * (U2K * 2) + (size_t)u.pm * tstepA; }
    __device__ __forceinline__ const char* b_base(const pg8::Unit& u) const { return Bt + (size_t)u.e * strideB + (size_t)u.pn * tstepB; }
    __device__ __forceinline__ int row(const pg8::Unit&, int r) const { return r; }
};
struct SplitKOrder {
    int G, c; const char* A; const char* Bt;
    __device__ __forceinline__ bool next(int i, pg8::Unit& u) const { const int L = i * G + c; if (L >= 64) return false; u.pn = L & 1; u.pm = (L >> 1) & 1; u.e = L >> 2; u.i = i; return true; }
    __device__ __forceinline__ const char* a_base(const pg8::Unit& u) const { return A + (size_t)u.e * (U2K * 2) + (size_t)u.pm * ((size_t)256 * U2LD * 2) + (size_t)u.pn * 1024; }
    __device__ __forceinline__ const char* b_base(const pg8::Unit& u) const { return Bt + (size_t)u.e * ((size_t)256 * 1024 * 2) + (size_t)u.pn * 1024; }
    __device__ __forceinline__ int row(const pg8::Unit&, int r) const { return r; }
};
struct ToepOrder {
    int G, c, npn, nunit; const char* A; const char* Kb; const char* Ct; size_t tstepA;
    __device__ __forceinline__ bool next(int i, pg8::Unit& u) const { const int L = i * G + c; if (L >= nunit) return false; u.pn = L % npn; u.pm = (L / npn) & 1; u.e = L / (npn * 2); u.i = i; return true; }
    __device__ __forceinline__ const char* a_base(const pg8::Unit& u) const { return A + (size_t)u.e * (U2K * 2) + (size_t)u.pm * tstepA; }
    __device__ __forceinline__ const char* b_base(const pg8::Unit& u) const { return Kb + (size_t)u.e * (128 * 512) + (size_t)(u.pn * 16 + 61) * 512 + 4096; }
    __device__ __forceinline__ const char* c_base(const pg8::Unit& u) const { return Ct + (size_t)u.e * (1024 * 256) + (size_t)u.pn * (256 * 256); }
    __device__ __forceinline__ int row(const pg8::Unit&, int r) const { return r; }
};
struct EpiS5a {
    static constexpr bool PERM = false;
    float* sendp;
    __device__ __forceinline__ void operator()(const f32x4 (&acc)[2][2][4][2], const pg8::Unit& u, int wr, int wc, int fr, int fq) const {
#pragma unroll
        for (int ai = 0; ai < 2; ++ai)
#pragma unroll
            for (int m = 0; m < 4; ++m) { const int R = u.pm * 256 + ai * 128 + wr * 64 + m * 16 + fr; float* rowp = sendp + (size_t)u.pn * (512 * 16 * 128) + ((size_t)R * 16 + u.e) * 128 + wc * 32 + 4 * fq;
#pragma unroll
                for (int n = 0; n < 2; ++n) *(f32x4*)(rowp + n * 16) = acc[ai][0][m][n]; }
    }
};
struct EpiS5b {
    static constexpr bool PERM = true;
    bf16* yg;
    __device__ __forceinline__ void operator()(const f32x4 (&acc)[2][2][4][2], const pg8::Unit& u, int wr, int wc, int fr, int fq) const {
#pragma unroll
        for (int ai = 0; ai < 2; ++ai)
#pragma unroll
            for (int m = 0; m < 4; ++m) { const int R = u.pm * 256 + ai * 128 + wr * 64 + m * 16 + fr;
#pragma unroll
                for (int bj = 0; bj < 2; ++bj) { const int col0 = u.pn * 256 + bj * 128 + wc * 32 + 8 * fq, t = col0 >> 4, c0 = col0 & 15; const f32x4 v0 = acc[ai][bj][m][0], v1 = acc[ai][bj][m][1];
                    u32x4 w; w.x = pg8::cvt_pk_bf16(gelu_tanh_f(v0[0]), gelu_tanh_f(v0[1])); w.y = pg8::cvt_pk_bf16(gelu_tanh_f(v0[2]), gelu_tanh_f(v0[3]));
                    w.z = pg8::cvt_pk_bf16(gelu_tanh_f(v1[0]), gelu_tanh_f(v1[1])); w.w = pg8::cvt_pk_bf16(gelu_tanh_f(v1[2]), gelu_tanh_f(v1[3]));
                    *(u32x4*)(yg + ((size_t)R * 64 + t) * 256 + u.e * 16 + c0) = w; } }
    }
};
struct EpiGlu {
    static constexpr bool PERM = true;
    const bf16* yg; bf16* mix; const float* bglu;
    __device__ __forceinline__ void operator()(const f32x4 (&acc)[2][2][4][2], const pg8::Unit& u, int wr, int wc, int fr, int fq) const {
#pragma unroll
        for (int ai = 0; ai < 2; ++ai)
#pragma unroll
            for (int m = 0; m < 4; ++m) { const size_t row = (size_t)u.pm * 256 + ai * 128 + wr * 64 + m * 16 + fr;
#pragma unroll
                for (int bj = 0; bj < 2; ++bj) { const int col0 = bj * 128 + wc * 32 + 8 * fq; const u32x4 y = *(const u32x4*)(yg + row * 256 + col0);
                    const f32x4 b0 = *(const f32x4*)(bglu + col0), b1 = *(const f32x4*)(bglu + col0 + 4); const f32x4 v0 = acc[ai][bj][m][0] + b0, v1 = acc[ai][bj][m][1] + b1;
                    u32x4 w; w.x = pg8::cvt_pk_bf16(bf2f(y.x & 0xffffu) * sigmoid_f(v0[0]), bf2f(y.x >> 16) * sigmoid_f(v0[1])); w.y = pg8::cvt_pk_bf16(bf2f(y.y & 0xffffu) * sigmoid_f(v0[2]), bf2f(y.y >> 16) * sigmoid_f(v0[3]));
                    w.z = pg8::cvt_pk_bf16(bf2f(y.z & 0xffffu) * sigmoid_f(v1[0]), bf2f(y.z >> 16) * sigmoid_f(v1[1])); w.w = pg8::cvt_pk_bf16(bf2f(y.w & 0xffffu) * sigmoid_f(v1[2]), bf2f(y.w >> 16) * sigmoid_f(v1[3]));
                    *(u32x4*)(mix + row * DM + 512 + col0) = w; } }
    }
};

__device__ __forceinline__ float ret_log2gamma(int h) { return log2f(1.0f - exp2f(-5.0f - (float)h)); }

template <int NQT> __device__ __forceinline__ void attn_mfma(Frame& F, int l);
__device__ __forceinline__ void attn_coop(Frame& F, int l);
__device__ __forceinline__ void p4_scan_attn(Frame& F, int l) {
    if (F.tid < 32) { const int i = F.blk * 32 + F.tid;
        if (i < NB * 16 * 64) { const int b = i >> 10, g = (i >> 6) & 15, p = i & 63; const f32x2 a64 = F_ABAR64[l * 1024 + (i & 1023)];
            float sr[NCH], si[NCH];
#pragma unroll
            for (int n = 0; n < NCH; ++n) { const size_t r = (size_t)(b * NCH + n) * 16 + g; sr[n] = F_SENDP[r * 128 + p] + F_SENDP[512 * 16 * 128 + r * 128 + p]; si[n] = F_SENDP[r * 128 + 64 + p] + F_SENDP[512 * 16 * 128 + r * 128 + 64 + p]; }
            float xr = 0.f, xi = 0.f;
#pragma unroll
            for (int n = 0; n < NCH; ++n) { const size_t r = (size_t)(b * NCH + n) * 16 + g; bf16* cp = F_U2X + r * U2K; cp[p] = (bf16)f2bf(xr); cp[64 + p] = (bf16)f2bf(xi);
                const float nr = a64.x * xr - a64.y * xi + sr[n], ni = a64.x * xi + a64.y * xr + si[n]; xr = nr; xi = ni; } } }
    for (int i = F.blk * 256 + F.tid; F.tid < 256 && i < NB * 4 * 2048; i += F.G * 256) { const int b = i >> 13, h = (i >> 11) & 3, de2 = i & 2047; const float g64 = exp2f(64.f * ret_log2gamma(h));
        unsigned* p0 = (unsigned*)(F_KVB + ((size_t)(b * NCH * 4 + h)) * 4096) + de2; unsigned t[NCH];
#pragma unroll
        for (int n = 0; n < NCH; ++n) t[n] = p0[(size_t)n * 4 * 2048];
        float s0 = 0.f, s1 = 0.f;
#pragma unroll
        for (int n = 0; n < NCH; ++n) { const float v0 = bf2f(t[n] & 0xffffu), v1 = bf2f(t[n] >> 16); t[n] = pk2(s0, s1); s0 = g64 * s0 + v0; s1 = g64 * s1 + v1; }
#pragma unroll
        for (int n = 0; n < NCH; ++n) p0[(size_t)n * 4 * 2048] = t[n]; }
    if (F.G == 256) attn_coop(F, l); else attn_mfma<ATTN_NQT>(F, l);
}


typedef short v4i16_t __attribute__((ext_vector_type(4)));
template <int NQT>
__device__ __forceinline__ void attn_mfma(Frame& F, int l) {
    const int lane = F.lane, fr = lane & 15, fq = lane >> 4;
    LAS unsigned char* vl = F.lds + F.wave * 10240;
    LAS float* bl = (LAS float*)(vl + 9216);
    constexpr int QPW = NQT * 16, TPC = 64 / QPW;
    constexpr float LOG2E = 1.4426950408889634f, SC = 0.125f * LOG2E;
    const int ntask = NB * NCH * 8 * TPC;
    const unsigned vtr0 = (unsigned)((4 * fq + (fr >> 2)) * 144 + (fr & 3) * 8);
    constexpr int WPC = 8 / TPC;
    const bool deal = (F.G == 256);
    const int nstep = deal ? 16 / WPC : (ntask + F.ngw - 1) / F.ngw;
    for (int step = 0; step < nstep; ++step) {
        int sub, h, n, b;
        if (deal) { const int j = F.blk >> 3; b = F.blk & 7; h = j >> 2; n = (j & 3) * 16 + step * WPC + F.wave / TPC; sub = F.wave % TPC; }
        else { const int task = F.gw + step * F.ngw; if (task >= ntask) break; sub = task % TPC; const int u = task / TPC; h = u & 7; n = (u >> 3) & 63; b = u >> 9; }
        const size_t qrow0 = (size_t)b * SEQ + n * 64 + sub * QPW;
        __builtin_amdgcn_wave_barrier();
#pragma unroll
        for (int i = 0; i < 3; ++i) bl[lane + 64 * i] = F_rel_bias[(size_t)(l * 8 + h) * 192 + lane + 64 * i] * LOG2E;
        bf16x8 qf[NQT][2];
#pragma unroll
        for (int qt = 0; qt < NQT; ++qt)
#pragma unroll
            for (int ks = 0; ks < 2; ++ks) qf[qt][ks] = *(const bf16x8*)(F_QKV + (qrow0 + qt * 16 + fr) * INW + C_QA + h * 64 + ks * 32 + fq * 8);
        f32x4 ot[4][NQT]; float lp[NQT];
#pragma unroll
        for (int qt = 0; qt < NQT; ++qt) { lp[qt] = 0.f;
#pragma unroll
            for (int et = 0; et < 4; ++et) ot[et][qt] = (f32x4){0.f, 0.f, 0.f, 0.f}; }
        LDS_WAIT(); __builtin_amdgcn_wave_barrier();
        const float b0 = bl[0];
        const int kc0 = n >= 8 ? n - 8 : 0;
        bf16x8 kf[4][2];
#pragma unroll
        for (int kt = 0; kt < 4; ++kt) { const bf16* kp = F_QKV + ((size_t)b * SEQ + kc0 * 64 + kt * 16 + fr) * INW + C_KA + h * 64 + fq * 8; kf[kt][0] = *(const bf16x8*)kp; kf[kt][1] = *(const bf16x8*)(kp + 32); }
        for (int kc = kc0; kc <= n; ++kc) {
            const size_t krow0 = (size_t)b * SEQ + kc * 64;
            u32x4 vreg[8];
#pragma unroll
            for (int i = 0; i < 8; ++i) vreg[i] = *(const u32x4*)(F_QKV + (krow0 + (lane >> 3) + 8 * i) * INW + C_VA + h * 64 + (lane & 7) * 8);
            bf16x8 kn[4][2];
            { const size_t krow1 = (size_t)b * SEQ + (kc < n ? kc + 1 : n) * 64;
#pragma unroll
                for (int kt = 0; kt < 4; ++kt) { const bf16* kp = F_QKV + (krow1 + kt * 16 + fr) * INW + C_KA + h * 64 + fq * 8; kn[kt][0] = *(const bf16x8*)kp; kn[kt][1] = *(const bf16x8*)(kp + 32); } }
            f32x4 st[4][NQT];
#pragma unroll
            for (int kt = 0; kt < 4; ++kt) {
#pragma unroll
                for (int qt = 0; qt < NQT; ++qt) { f32x4 z = (f32x4){0.f, 0.f, 0.f, 0.f};
                    z = __builtin_amdgcn_mfma_f32_16x16x32_bf16(kf[kt][0], qf[qt][0], z, 0, 0, 0); st[kt][qt] = __builtin_amdgcn_mfma_f32_16x16x32_bf16(kf[kt][1], qf[qt][1], z, 0, 0, 0); } }
            const int dc = kc - n;
            if (dc <= -3) {
#pragma unroll
                for (int kt = 0; kt < 4; ++kt)
#pragma unroll
                    for (int qt = 0; qt < NQT; ++qt) st[kt][qt] = st[kt][qt] * SC + b0;
            } else {
                const int ib = 64 * dc + 128 + 4 * fq - fr + sub * (-QPW);
#pragma unroll
                for (int kt = 0; kt < 4; ++kt)
#pragma unroll
                    for (int qt = 0; qt < NQT; ++qt)
#pragma unroll
                        for (int r = 0; r < 4; ++r) { int idx = ib + 16 * (kt - qt) + r; idx = idx < 0 ? 0 : idx; st[kt][qt][r] = st[kt][qt][r] * SC + bl[idx]; }
            }
#pragma unroll
            for (int qt = 0; qt < NQT; ++qt) { float ps = 0.f;
#pragma unroll
                for (int kt = 0; kt < 4; ++kt)
#pragma unroll
                    for (int r = 0; r < 4; ++r) { const float p = __builtin_amdgcn_exp2f(st[kt][qt][r]); st[kt][qt][r] = p; ps += p; }
                lp[qt] += ps; }
            __builtin_amdgcn_wave_barrier();
#pragma unroll
            for (int i = 0; i < 8; ++i) *(LAS u32x4*)(vl + ((lane >> 3) + 8 * i) * 144 + (lane & 7) * 16) = vreg[i];
            LDS_WAIT(); __builtin_amdgcn_wave_barrier();
#pragma unroll
            for (int s = 0; s < 2; ++s) {
                bf16x8 pf[NQT];
#pragma unroll
                for (int qt = 0; qt < NQT; ++qt) { u32x4 w; w.x = pg8::cvt_pk_bf16(st[2 * s][qt][0], st[2 * s][qt][1]); w.y = pg8::cvt_pk_bf16(st[2 * s][qt][2], st[2 * s][qt][3]);
                    w.z = pg8::cvt_pk_bf16(st[2 * s + 1][qt][0], st[2 * s + 1][qt][1]); w.w = pg8::cvt_pk_bf16(st[2 * s + 1][qt][2], st[2 * s + 1][qt][3]); pf[qt] = __builtin_bit_cast(bf16x8, w); }
#pragma unroll
                for (int et = 0; et < 4; ++et) {
                    const v4i16_t t0 = __builtin_amdgcn_ds_read_tr16_b64_v4i16((LAS v4i16_t*)(vl + vtr0 + (2 * s) * 16 * 144 + et * 32));
                    const v4i16_t t1 = __builtin_amdgcn_ds_read_tr16_b64_v4i16((LAS v4i16_t*)(vl + vtr0 + (2 * s + 1) * 16 * 144 + et * 32));
                    bf16x8 vf; vf[0] = t0[0]; vf[1] = t0[1]; vf[2] = t0[2]; vf[3] = t0[3]; vf[4] = t1[0]; vf[5] = t1[1]; vf[6] = t1[2]; vf[7] = t1[3];
#pragma unroll
                    for (int qt = 0; qt < NQT; ++qt) ot[et][qt] = __builtin_amdgcn_mfma_f32_16x16x32_bf16(vf, pf[qt], ot[et][qt], 0, 0, 0);
                }
            }
#pragma unroll
            for (int kt = 0; kt < 4; ++kt) { kf[kt][0] = kn[kt][0]; kf[kt][1] = kn[kt][1]; }
        }
#pragma unroll
        for (int qt = 0; qt < NQT; ++qt) { float ls = lp[qt]; ls += __shfl_xor(ls, 16); ls += __shfl_xor(ls, 32); const float inv = 1.0f / ls;
            bf16* op = F_MIX + (qrow0 + qt * 16 + fr) * DM + h * 64 + 4 * fq;
#pragma unroll
            for (int et = 0; et < 4; ++et) { const f32x4 o = ot[et][qt] * inv; u32x2 w; w.x = pk2(o.x, o.y); w.y = pk2(o.z, o.w); *(u32x2*)(op + et * 16) = w; } }
    }
}


__device__ __forceinline__ void attn_coop(Frame& F, int l) {
    const int lane = F.lane, fr = lane & 15, fq = lane >> 4, tid = F.tid, wave = F.wave;
    constexpr int PIT = 144, TILE = 64 * PIT, BUF = 2 * TILE;
    LAS unsigned char* base = F.lds;
    LAS float* bl = (LAS float*)(F.lds + 2 * BUF);
    constexpr float LOG2E = 1.4426950408889634f, SC = 0.125f * LOG2E;
    const unsigned vtr0 = (unsigned)((4 * fq + (fr >> 2)) * PIT + (fr & 3) * 8);
    const unsigned kfa = (unsigned)(fr * PIT + fq * 16);
    const int srow = tid >> 3, sch = tid & 7;
    const int b = F.blk & 7, jq = F.blk >> 3, h = jq >> 2, quarter = jq & 3, sub = wave & 1;
    for (int step = 0; step < 4; ++step) {
        const int n0 = quarter * 16 + step * 4, nw = n0 + (wave >> 1);
        const size_t qrow0 = (size_t)b * SEQ + nw * 64 + sub * 32;
        const int kcmin = n0 >= 8 ? n0 - 8 : 0, nit = n0 + 3 - kcmin + 1;
        __syncthreads();
        if (tid < 192) bl[tid] = F_rel_bias[(size_t)(l * 8 + h) * 192 + tid] * LOG2E;
        { const bf16* gp = F_QKV + ((size_t)b * SEQ + kcmin * 64 + srow) * INW + h * 64 + sch * 8;
            const u32x4 kk = *(const u32x4*)(gp + C_KA), vv = *(const u32x4*)(gp + C_VA);
            *(LAS u32x4*)(base + srow * PIT + sch * 16) = kk; *(LAS u32x4*)(base + TILE + srow * PIT + sch * 16) = vv; }
        bf16x8 qf[2][2];
#pragma unroll
        for (int qt = 0; qt < 2; ++qt)
#pragma unroll
            for (int ks = 0; ks < 2; ++ks) qf[qt][ks] = *(const bf16x8*)(F_QKV + (qrow0 + qt * 16 + fr) * INW + C_QA + h * 64 + ks * 32 + fq * 8);
        f32x4 ot[4][2]; float lp[2];
#pragma unroll
        for (int qt = 0; qt < 2; ++qt) { lp[qt] = 0.f;
#pragma unroll
            for (int et = 0; et < 4; ++et) ot[et][qt] = (f32x4){0.f, 0.f, 0.f, 0.f}; }
        __syncthreads();
        const float b0 = bl[0];
        for (int i = 0; i < nit; ++i) {
            const int kc = kcmin + i; const bool more = (i + 1 < nit);
            u32x4 kk, vv;
            if (more) { const bf16* gp = F_QKV + ((size_t)b * SEQ + (kc + 1) * 64 + srow) * INW + h * 64 + sch * 8; kk = *(const u32x4*)(gp + C_KA); vv = *(const u32x4*)(gp + C_VA); }
            LAS unsigned char* kb = base + (i & 1) * BUF; LAS unsigned char* vb = kb + TILE;
            if (kc >= nw - 8 && kc <= nw) {
                f32x4 st[4][2];
#pragma unroll
                for (int kt = 0; kt < 4; ++kt) { const bf16x8 k0 = *(const LAS bf16x8*)(kb + kfa + kt * 16 * PIT), k1 = *(const LAS bf16x8*)(kb + kfa + kt * 16 * PIT + 64);
#pragma unroll
                    for (int qt = 0; qt < 2; ++qt) { f32x4 z = (f32x4){0.f, 0.f, 0.f, 0.f};
                        z = __builtin_amdgcn_mfma_f32_16x16x32_bf16(k0, qf[qt][0], z, 0, 0, 0); st[kt][qt] = __builtin_amdgcn_mfma_f32_16x16x32_bf16(k1, qf[qt][1], z, 0, 0, 0); } }
                const int dc = kc - nw;
                if (dc <= -3) {
#pragma unroll
                    for (int kt = 0; kt < 4; ++kt)
#pragma unroll
                        for (int qt = 0; qt < 2; ++qt) st[kt][qt] = st[kt][qt] * SC + b0;
                } else {
                    const int ib = 64 * dc + 128 + 4 * fq - fr - sub * 32;
#pragma unroll
                    for (int kt = 0; kt < 4; ++kt)
#pragma unroll
                        for (int qt = 0; qt < 2; ++qt)
#pragma unroll
                            for (int r = 0; r < 4; ++r) { int idx = ib + 16 * (kt - qt) + r; idx = idx < 0 ? 0 : idx; st[kt][qt][r] = st[kt][qt][r] * SC + bl[idx]; }
                }
#pragma unroll
                for (int qt = 0; qt < 2; ++qt) { float ps = 0.f;
#pragma unroll
                    for (int kt = 0; kt < 4; ++kt)
#pragma unroll
                        for (int r = 0; r < 4; ++r) { const float p = __builtin_amdgcn_exp2f(st[kt][qt][r]); st[kt][qt][r] = p; ps += p; }
                    lp[qt] += ps; }
#pragma unroll
                for (int s = 0; s < 2; ++s) {
                    bf16x8 pf[2];
#pragma unroll
                    for (int qt = 0; qt < 2; ++qt) { u32x4 w; w.x = pg8::cvt_pk_bf16(st[2 * s][qt][0], st[2 * s][qt][1]); w.y = pg8::cvt_pk_bf16(st[2 * s][qt][2], st[2 * s][qt][3]);
                        w.z = pg8::cvt_pk_bf16(st[2 * s + 1][qt][0], st[2 * s + 1][qt][1]); w.w = pg8::cvt_pk_bf16(st[2 * s + 1][qt][2], st[2 * s + 1][qt][3]); pf[qt] = __builtin_bit_cast(bf16x8, w); }
#pragma unroll
                    for (int et = 0; et < 4; ++et) {
                        const v4i16_t t0 = __builtin_amdgcn_ds_read_tr16_b64_v4i16((LAS v4i16_t*)(vb + vtr0 + (2 * s) * 16 * PIT + et * 32));
                        const v4i16_t t1 = __builtin_amdgcn_ds_read_tr16_b64_v4i16((LAS v4i16_t*)(vb + vtr0 + (2 * s + 1) * 16 * PIT + et * 32));
                        bf16x8 vf; vf[0] = t0[0]; vf[1] = t0[1]; vf[2] = t0[2]; vf[3] = t0[3]; vf[4] = t1[0]; vf[5] = t1[1]; vf[6] = t1[2]; vf[7] = t1[3];
#pragma unroll
                        for (int qt = 0; qt < 2; ++qt) ot[et][qt] = __builtin_amdgcn_mfma_f32_16x16x32_bf16(vf, pf[qt], ot[et][qt], 0, 0, 0);
                    }
                }
            }
            if (more) { LAS unsigned char* nb = base + ((i + 1) & 1) * BUF; *(LAS u32x4*)(nb + srow * PIT + sch * 16) = kk; *(LAS u32x4*)(nb + TILE + srow * PIT + sch * 16) = vv; }
            __syncthreads();
        }
#pragma unroll
        for (int qt = 0; qt < 2; ++qt) { float ls = lp[qt]; ls += __shfl_xor(ls, 16); ls += __shfl_xor(ls, 32); const float inv = 1.0f / ls;
            bf16* op = F_MIX + (qrow0 + qt * 16 + fr) * DM + h * 64 + 4 * fq;
#pragma unroll
            for (int et = 0; et < 4; ++et) { const f32x4 o = ot[et][qt] * inv; u32x2 w; w.x = pk2(o.x, o.y); w.y = pk2(o.z, o.w); *(u32x2*)(op + et * 16) = w; } }
    }
}

__device__ __forceinline__ void unpack8(const u32x4 w, float (&x)[8]) { x[0] = bf2f(w.x & 0xffffu); x[1] = bf2f(w.x >> 16); x[2] = bf2f(w.y & 0xffffu); x[3] = bf2f(w.y >> 16); x[4] = bf2f(w.z & 0xffffu); x[5] = bf2f(w.z >> 16); x[6] = bf2f(w.w & 0xffffu); x[7] = bf2f(w.w >> 16); }
__device__ __forceinline__ u32x4 pack8(const float (&x)[8]) { u32x4 w; w.x = pk2(x[0], x[1]); w.y = pk2(x[2], x[3]); w.z = pk2(x[4], x[5]); w.w = pk2(x[6], x[7]); return w; }
__device__ __forceinline__ void rope8(const u32x4 a, const u32x4 b, const f32x2* cs, float scale, u32x4& o1, u32x4& o2) {
    float x1[8], x2[8], r1[8], r2[8]; unpack8(a, x1); unpack8(b, x2);
    const f32x4* c4 = (const f32x4*)cs;
#pragma unroll
    for (int q = 0; q < 4; ++q) { const f32x4 t = c4[q];
        r1[2 * q] = (x1[2 * q] * t.x - x2[2 * q] * t.y) * scale; r2[2 * q] = (x1[2 * q] * t.y + x2[2 * q] * t.x) * scale;
        r1[2 * q + 1] = (x1[2 * q + 1] * t.z - x2[2 * q + 1] * t.w) * scale; r2[2 * q + 1] = (x1[2 * q + 1] * t.w + x2[2 * q + 1] * t.z) * scale; }
    o1 = pack8(r1); o2 = pack8(r2);
}
__device__ __forceinline__ bf16x8 tr_frag(LAS unsigned char* p0, LAS unsigned char* p1) {
    const v4i16_t t0 = __builtin_amdgcn_ds_read_tr16_b64_v4i16((LAS v4i16_t*)p0), t1 = __builtin_amdgcn_ds_read_tr16_b64_v4i16((LAS v4i16_t*)p1);
    bf16x8 f; f[0] = t0[0]; f[1] = t0[1]; f[2] = t0[2]; f[3] = t0[3]; f[4] = t1[0]; f[5] = t1[1]; f[6] = t1[2]; f[7] = t1[3]; return f;
}
__device__ __forceinline__ void ret_kv_mfma(Frame& F, int l) {
    const int lane = F.lane, fr = lane & 15, fq = lane >> 4;
    constexpr int PIT = 136;
    LAS unsigned char* kt = F.lds + F.wave * (2 * 64 * PIT);
    LAS unsigned char* vt = kt + 64 * PIT;
    const unsigned tr0 = (unsigned)((4 * fq + (fr >> 2)) * PIT + (fr & 3) * 8);
    int u0, ustride, ucnt;
    if (F.G != 256) { u0 = F.gw; ustride = F.ngw; ucnt = (NB * NCH * 4 - u0 + ustride - 1) / ustride; }
    else if (F.blk < 64) { u0 = F.blk * NWAVES + F.wave; ustride = 0; ucnt = 1; }
    else if (F.blk >= 192) { u0 = 512 + (F.blk - 192) * NWAVES + F.wave; ustride = 512; ucnt = 3; }
    else return;
    for (int ui = 0; ui < ucnt; ++ui) { const int u = u0 + ui * ustride;
        const int h = u & 3, n = (u >> 2) & 63, b = u >> 8; const float lg = ret_log2gamma(h);
        const size_t row = (size_t)b * SEQ + n * 64 + lane;
        const bf16* kp = F_QKV + row * INW + C_KR + h * 64; const bf16* vp = F_QKV + row * INW + C_VR + h * 64;
        const f32x2* rp = F_ROPE + (size_t)(n * 64 + lane) * 32;
        const float zs = 0.125f * exp2f(lg * (float)(63 - lane));
        __builtin_amdgcn_wave_barrier();
#pragma unroll
        for (int dq = 0; dq < 4; ++dq) { u32x4 o1, o2; rope8(*(const u32x4*)(kp + dq * 8), *(const u32x4*)(kp + 32 + dq * 8), rp + dq * 8, zs, o1, o2);
            LAS u32x2* w1 = (LAS u32x2*)(kt + lane * PIT + dq * 16); LAS u32x2* w2 = (LAS u32x2*)(kt + lane * PIT + 64 + dq * 16);
            w1[0] = (u32x2){o1.x, o1.y}; w1[1] = (u32x2){o1.z, o1.w}; w2[0] = (u32x2){o2.x, o2.y}; w2[1] = (u32x2){o2.z, o2.w}; }
#pragma unroll
        for (int c = 0; c < 8; ++c) { const u32x4 v = *(const u32x4*)(vp + c * 8); LAS u32x2* w = (LAS u32x2*)(vt + lane * PIT + c * 16); w[0] = (u32x2){v.x, v.y}; w[1] = (u32x2){v.z, v.w}; }
        LDS_WAIT(); __builtin_amdgcn_wave_barrier();
        f32x4 acc[4][4];
#pragma unroll
        for (int i = 0; i < 4; ++i)
#pragma unroll
            for (int j = 0; j < 4; ++j) acc[i][j] = (f32x4){0.f, 0.f, 0.f, 0.f};
#pragma unroll
        for (int s = 0; s < 2; ++s) {
            bf16x8 kf[4];
#pragma unroll
            for (int dt = 0; dt < 4; ++dt) kf[dt] = tr_frag(kt + tr0 + (2 * s) * 16 * PIT + dt * 32, kt + tr0 + (2 * s + 1) * 16 * PIT + dt * 32);
#pragma unroll
            for (int et = 0; et < 4; ++et) { const bf16x8 vf = tr_frag(vt + tr0 + (2 * s) * 16 * PIT + et * 32, vt + tr0 + (2 * s + 1) * 16 * PIT + et * 32);
#pragma unroll
                for (int dt = 0; dt < 4; ++dt) acc[et][dt] = __builtin_amdgcn_mfma_f32_16x16x32_bf16(kf[dt], vf, acc[et][dt], 0, 0, 0); }
        }
        bf16* o = F_KVB + (size_t)u * 4096;
#pragma unroll
        for (int et = 0; et < 4; ++et)
#pragma unroll
            for (int dt = 0; dt < 4; ++dt) { u32x2 w; w.x = pk2(acc[et][dt][0], acc[et][dt][1]); w.y = pk2(acc[et][dt][2], acc[et][dt][3]); *(u32x2*)(o + (et * 16 + fr) * 64 + dt * 16 + 4 * fq) = w; }
    }
}
__device__ __forceinline__ void ret_out_mfma(Frame& F, int l) {
    const int lane = F.lane, fr = lane & 15, fq = lane >> 4;
    constexpr int PIT = 144;
    LAS unsigned char* vt = F.lds + F.wave * (64 * PIT);
    const unsigned tr0 = (unsigned)((4 * fq + (fr >> 2)) * PIT + (fr & 3) * 8);
    const int skip = (F.G == 256) ? 128 : 0;
    if (F.blk < skip) return;
    for (int u = (F.blk - skip) * NWAVES + F.wave; u < NB * NCH * 4; u += (F.G - skip) * NWAVES) {
        const int h = u & 3, n = (u >> 2) & 63, b = u >> 8; const float lg = ret_log2gamma(h);
        const size_t row0 = (size_t)b * SEQ + n * 64;
        __builtin_amdgcn_wave_barrier();
#pragma unroll
        for (int i = 0; i < 8; ++i) { const u32x4 v = *(const u32x4*)(F_QKV + (row0 + (lane >> 3) + 8 * i) * INW + C_VR + h * 64 + (lane & 7) * 8); *(LAS u32x4*)(vt + ((lane >> 3) + 8 * i) * PIT + (lane & 7) * 16) = v; }
        bf16x8 kf[4][2];
#pragma unroll
        for (int jt = 0; jt < 4; ++jt) { const int j = jt * 16 + fr; u32x4 o1, o2;
            const bf16* kp = F_QKV + (row0 + j) * INW + C_KR + h * 64 + fq * 8; rope8(*(const u32x4*)kp, *(const u32x4*)(kp + 32), F_ROPE + (size_t)(n * 64 + j) * 32 + fq * 8, 0.125f, o1, o2);
            kf[jt][0] = __builtin_bit_cast(bf16x8, o1); kf[jt][1] = __builtin_bit_cast(bf16x8, o2); }
        LDS_WAIT(); __builtin_amdgcn_wave_barrier();
        const bf16* prev = F_KVB + (size_t)u * 4096; const float* gng = F_gn_g + l * 256 + h * 64 + 4 * fq;
        bf16x8 pvf[4][2];
#pragma unroll
        for (int et = 0; et < 4; ++et)
#pragma unroll
            for (int ks = 0; ks < 2; ++ks) pvf[et][ks] = *(const bf16x8*)(prev + (et * 16 + fr) * 64 + ks * 32 + fq * 8);
#pragma unroll 1
        for (int hq = 0; hq < 2; ++hq) {
            bf16x8 qf[2][2];
#pragma unroll
            for (int it = 0; it < 2; ++it) { const int i = (2 * hq + it) * 16 + fr; u32x4 o1, o2;
                const bf16* qp = F_QKV + (row0 + i) * INW + C_QR + h * 64 + fq * 8; rope8(*(const u32x4*)qp, *(const u32x4*)(qp + 32), F_ROPE + (size_t)(n * 64 + i) * 32 + fq * 8, 1.0f, o1, o2);
                qf[it][0] = __builtin_bit_cast(bf16x8, o1); qf[it][1] = __builtin_bit_cast(bf16x8, o2); }
            u32x2 gwv[2][4]; f32x4 gnv[4];
#pragma unroll
            for (int et = 0; et < 4; ++et) { gnv[et] = *(const f32x4*)(gng + et * 16);
#pragma unroll
                for (int it = 0; it < 2; ++it) gwv[it][et] = *(const u32x2*)(F_QKV + (row0 + (2 * hq + it) * 16 + fr) * INW + C_GR + h * 64 + et * 16 + 4 * fq); }
            f32x4 st[4][2];
#pragma unroll
            for (int jt = 0; jt < 4; ++jt)
#pragma unroll
                for (int it = 0; it < 2; ++it) { f32x4 z = (f32x4){0.f, 0.f, 0.f, 0.f}; z = __builtin_amdgcn_mfma_f32_16x16x32_bf16(kf[jt][0], qf[it][0], z, 0, 0, 0); st[jt][it] = __builtin_amdgcn_mfma_f32_16x16x32_bf16(kf[jt][1], qf[it][1], z, 0, 0, 0); }
#pragma unroll
            for (int jt = 0; jt < 4; ++jt)
#pragma unroll
                for (int it = 0; it < 2; ++it)
#pragma unroll
                    for (int r = 0; r < 4; ++r) { const int dd = ((2 * hq + it) * 16 + fr) - (jt * 16 + 4 * fq + r); st[jt][it][r] = dd >= 0 ? st[jt][it][r] * exp2f(lg * (float)dd) : 0.f; }
            f32x4 yi[4][2], yc[4][2];
#pragma unroll
            for (int et = 0; et < 4; ++et)
#pragma unroll
                for (int it = 0; it < 2; ++it) { yi[et][it] = (f32x4){0.f, 0.f, 0.f, 0.f}; yc[et][it] = (f32x4){0.f, 0.f, 0.f, 0.f}; }
#pragma unroll
            for (int s = 0; s < 2; ++s) {
                bf16x8 pf[2];
#pragma unroll
                for (int it = 0; it < 2; ++it) { u32x4 w; w.x = pk2(st[2 * s][it][0], st[2 * s][it][1]); w.y = pk2(st[2 * s][it][2], st[2 * s][it][3]); w.z = pk2(st[2 * s + 1][it][0], st[2 * s + 1][it][1]); w.w = pk2(st[2 * s + 1][it][2], st[2 * s + 1][it][3]); pf[it] = __builtin_bit_cast(bf16x8, w); }
#pragma unroll
                for (int et = 0; et < 4; ++et) { const bf16x8 vf = tr_frag(vt + tr0 + (2 * s) * 16 * PIT + et * 32, vt + tr0 + (2 * s + 1) * 16 * PIT + et * 32);
#pragma unroll
                    for (int it = 0; it < 2; ++it) yi[et][it] = __builtin_amdgcn_mfma_f32_16x16x32_bf16(vf, pf[it], yi[et][it], 0, 0, 0); }
            }
#pragma unroll
            for (int et = 0; et < 4; ++et)
#pragma unroll
                for (int ks = 0; ks < 2; ++ks) {
#pragma unroll
                    for (int it = 0; it < 2; ++it) yc[et][it] = __builtin_amdgcn_mfma_f32_16x16x32_bf16(pvf[et][ks], qf[it][ks], yc[et][it], 0, 0, 0); }
#pragma unroll
            for (int it = 0; it < 2; ++it) { const int i = (2 * hq + it) * 16 + fr; const float xi = exp2f(lg * (float)(i + 1)); float s1 = 0.f;
#pragma unroll
                for (int et = 0; et < 4; ++et) { yi[et][it] = yi[et][it] + yc[et][it] * xi; s1 += (yi[et][it].x + yi[et][it].y) + (yi[et][it].z + yi[et][it].w); }
                s1 += __shfl_xor(s1, 16); s1 += __shfl_xor(s1, 32); const float mu = s1 * (1.0f / 64.0f); float s2 = 0.f;
#pragma unroll
                for (int et = 0; et < 4; ++et) { yi[et][it] = yi[et][it] - mu; s2 += (yi[et][it].x * yi[et][it].x + yi[et][it].y * yi[et][it].y) + (yi[et][it].z * yi[et][it].z + yi[et][it].w * yi[et][it].w); }
                s2 += __shfl_xor(s2, 16); s2 += __shfl_xor(s2, 32); const float rstd = 1.0f / sqrtf(s2 * (1.0f / 64.0f) + EPS);
#pragma unroll
                for (int et = 0; et < 4; ++et) { const int e0 = et * 16 + 4 * fq; const u32x2 gw = gwv[it][et]; const f32x4 gn = gnv[et];
                    const f32x4 y = yi[et][it] * rstd * gn; u32x2 w; w.x = pk2(silu_f(bf2f(gw.x & 0xffffu)) * y.x, silu_f(bf2f(gw.x >> 16)) * y.y); w.y = pk2(silu_f(bf2f(gw.y & 0xffffu)) * y.z, silu_f(bf2f(gw.y >> 16)) * y.w);
                    *(u32x2*)(F_MIX + (row0 + i) * DM + 768 + h * 64 + e0) = w; }
            }
        }
    }
}

struct Args { const float* in[28]; float* out; unsigned char* ws; int ph_lo, ph_hi; };
constexpr int NPHASE = 2 + NL * 10;

__global__ void __launch_bounds__(NTHR, 2) fwd_kernel(Args args) {
    extern __shared__ __attribute__((aligned(16))) unsigned char lds[];
    Frame F;
    F.lds = (LAS unsigned char*)lds;
    F.tid = threadIdx.x; F.lane = F.tid & 63; F.wave = __builtin_amdgcn_readfirstlane(F.tid >> 6); F.blk = blockIdx.x; F.G = gridDim.x;
    F.gw = F.blk * NWAVES + F.wave; F.ngw = F.G * NWAVES;
    F.out0 = args.out; F.ws0 = args.ws; F.wz = 0;
    F.ptab = (LAS unsigned long long*)(F.lds + LDS_BYTES - 64 - 256);
    if (F.tid == 0) {
#pragma unroll
        for (int i = 0; i < 28; ++i) F.ptab[i] = (unsigned long long)args.in[i];
    }
    LAS unsigned* misc = (LAS unsigned*)(F.lds + LDS_BYTES - 64);
    if (F.tid < 16) misc[F.tid] = 0u;
    __syncthreads();
    const int lo = args.ph_lo, hi = args.ph_hi;
    XcdBarrier bar; bar.bar = F_ctl + CW_BAR; bar.x = 0; bar.st = nullptr;
    if (hi - lo > 1) bar = xcd_barrier_post(F_ctl + CW_BAR, (volatile LAS unsigned*)misc);
#ifndef PH_ONLY
#define PH_ONLY -1
#endif
#define PSEL(j) (PH_ONLY < 0 || PH_ONLY == (j))
#define IN(k) (lo <= (k) && (k) < hi)
#define SEAM(k) do { if (IN(k) && IN((k) + 1)) xcd_barrier(bar); { int _t = threadIdx.x; asm volatile("" : "+v"(_t)); F.tid = _t; F.lane = _t & 63; asm volatile("" : "+s"(F.wz)); { unsigned _z = 0; asm volatile("" : "+s"(_z)); F.lds = (LAS unsigned char*)lds + _z; F.ptab = (LAS unsigned long long*)(F.lds + LDS_BYTES - 64 - 256); } asm volatile("" : "+s"(F.gw), "+s"(F.ngw), "+s"(F.blk), "+s"(F.G), "+s"(F.wave)); } } while (0)

#ifndef PROBE_PH
#define PROBE_PH -1
#endif
    volatile LAS unsigned long long* tpw = (volatile LAS unsigned long long*)(F.lds + LDS_BYTES - 32);
#define TPB(j) do { if (PROBE_PH == (j) && F.blk == 0 && F.tid == 0) tpw[1] = __builtin_amdgcn_s_memrealtime(); } while (0)
#define TPE(j) do { if (PROBE_PH == (j) && F.blk == 0 && F.tid == 0) tpw[0] = tpw[0] + (__builtin_amdgcn_s_memrealtime() - tpw[1]); } while (0)
    TPB(10); if (IN(0) && PSEL(10)) { p0_prologue(F); } SEAM(0); TPE(10);
    for (int l = 0; l < NL; ++l) {
        const int p = 1 + 10 * l;
        TPB(0); if (IN(p + 0) && PSEL(0)) { norm1_phase<false>(F, l); s5_build_operands(F, l); } SEAM(p + 0); TPE(0);
        TPB(1); if (IN(p + 1) && PSEL(1)) { pg8::StaticOrder S; S.init(F_H, DM, F_WinT + (size_t)l * INW * DM, DM, NT, (F.G == 256) ? INW - 256 : INW, F.G, F.blk); EpiQKV E{F_QKV, F_U2X};
            pg8::gemm_phase<EpiQKV, pg8::StaticOrder, false>(F.lds, DM, DM, DM, S, E); } SEAM(p + 1); TPE(1);
        TPB(2); if (IN(p + 2) && PSEL(2)) { ret_kv_mfma(F, l); __syncthreads();
            SplitKOrder S; S.G = F.G; S.c = F.blk; S.A = (const char*)(F_U2X + 128); S.Bt = (const char*)F_BT1;
            EpiS5a E{F_SENDP}; pg8::gemm_phase<EpiS5a, SplitKOrder, false>(F.lds, 512, U2LD, 1024, S, E);
            if (F.G == 256) { GateOrder SG; SG.blk = F.blk; SG.A = (const char*)F_H; SG.Bt = (const char*)(F_WinT + (size_t)l * INW * DM); EpiQKV EG{F_QKV, F_U2X};
                pg8::gemm_phase<EpiQKV, GateOrder, false>(F.lds, DM, DM, DM, SG, EG); } } SEAM(p + 2); TPE(2);
        TPB(3); if (IN(p + 3) && PSEL(3)) { p4_scan_attn(F, l); } SEAM(p + 3); TPE(3);
        TPB(4); if (IN(p + 4) && PSEL(4)) { ret_out_mfma(F, l); __syncthreads();
            ToepOrder S; S.G = F.G; S.c = F.blk; S.npn = 4; S.nunit = 128; S.A = (const char*)F_U2X; S.Kb = (const char*)(F_KERNB + (size_t)l * 16 * 128 * 256); S.Ct = (const char*)F_TMAT; S.tstepA = (size_t)256 * U2LD * 2;
            EpiS5b E{F_YG}; const int keff = (F.G == 256) ? 128 + 256 * ((F.blk & 3) + 1) : U2K;
            pg8::gemm_phase<EpiS5b, ToepOrder, false, true>(F.lds, keff, U2LD, 128, S, E); } SEAM(p + 4); TPE(4);
        TPB(5); if (IN(p + 5) && PSEL(5)) { pg8::StaticOrder S; S.init(F_YG, 256, F_WgluT + (size_t)l * 256 * 256, 256, NT, 256, F.G, F.blk); EpiGlu E{F_YG, F_MIX, F_b_glu + l * 256};
            pg8::gemm_phase<EpiGlu, pg8::StaticOrder, false>(F.lds, 256, 256, 256, S, E); } SEAM(p + 5); TPE(5);
        TPB(6); if (IN(p + 6) && PSEL(6)) { pg8::StaticOrder S; S.init(F_MIX, DM, F_WoutT + (size_t)l * DM * DM, DM, NT, DM, F.G, F.blk); EpiRes E{F_x, F_XB, F_MOD + (size_t)l * NB * 6144 + 2048, F_SSQ, l == 0 ? 1 : 0};
            pg8::gemm_phase<EpiRes, pg8::StaticOrder, false>(F.lds, DM, DM, DM, S, E); } SEAM(p + 6); TPE(6);
        TPB(7); if (IN(p + 7) && PSEL(7)) { norm2_router_phase(F, l); } SEAM(p + 7); TPE(7);
        TPB(8); if (IN(p + 8) && PSEL(8)) { moe_pg8<1>(F, l); } SEAM(p + 8); TPE(8);
        TPB(9); if (IN(p + 9) && PSEL(9)) { moe_pg8<2>(F, l); } SEAM(p + 9); TPE(9);
    }
    TPB(11); if (IN(NPHASE - 1) && PSEL(11)) { norm1_phase<true>(F, 0); } TPE(11);
    if (PROBE_PH >= 0 && F.blk == 0 && F.tid == 0) { const unsigned long long t1 = __builtin_amdgcn_s_memrealtime(); const unsigned long long tp_acc = tpw[0]; while (__builtin_amdgcn_s_memrealtime() - t1 < 4ull * tp_acc) __builtin_amdgcn_s_sleep(8); }
#undef IN
#undef SEAM
}

extern "C" void kernel_launch(void* const* d_in, const int* in_sizes, int n_in, void* d_out, int out_size, void* d_ws, size_t ws_size, hipStream_t stream) {
    static int grid = 0;
    if (grid == 0) {
        if (n_in != 28 || in_sizes[0] != NT * DM || out_size != NT * DM || ws_size < WS_END) { fprintf(stderr, "kernel_launch: unexpected shapes / workspace (%d inputs, ws %zu < %zu)\n", n_in, ws_size, (size_t)WS_END); grid = -1; return; }
        int dev = 0, cus = 0;
        if (hipGetDevice(&dev) != hipSuccess || hipDeviceGetAttribute(&cus, hipDeviceAttributeMultiprocessorCount, dev) != hipSuccess) { grid = -1; return; }
        if (hipFuncSetAttribute((const void*)fwd_kernel, hipFuncAttributeMaxDynamicSharedMemorySize, LDS_BYTES) != hipSuccess) { fprintf(stderr, "kernel_launch: hipFuncSetAttribute failed\n"); grid = -1; return; }
        int per_cu = 0;
        if (hipOccupancyMaxActiveBlocksPerMultiprocessor(&per_cu, (const void*)fwd_kernel, NTHR, LDS_BYTES) != hipSuccess || per_cu < 1) { fprintf(stderr, "kernel_launch: occupancy query says %d\n", per_cu); }
        (void)hipGetLastError();
        grid = 256;
        if (cus < 256) { fprintf(stderr, "kernel_launch: device has %d CUs, need 256\n", cus); grid = -1; return; }
    }
    if (grid < 0) return;
    (void)hipMemsetAsync((char*)d_ws + WS_CTL, 0, CTL_BYTES, stream);
    Args a{};
    for (int i = 0; i < 28; ++i) a.in[i] = (const float*)d_in[i];
    a.out = (float*)d_out; a.ws = (unsigned char*)d_ws;
#if MK_MULTI
    for (int ph = 0; ph < NPHASE; ++ph) { a.ph_lo = ph; a.ph_hi = ph + 1; hipLaunchKernelGGL(fwd_kernel, dim3(grid), dim3(NTHR), LDS_BYTES, stream, a); }
#else
    a.ph_lo = 0; a.ph_hi = NPHASE; hipLaunchKernelGGL(fwd_kernel, dim3(grid), dim3(NTHR), LDS_BYTES, stream, a);
#endif
}
```

```cpp
#include <hip/hip_runtime.h>
#include <cstdio>
#include <cstdint>

#define GAS __attribute__((address_space(1)))
#define LAS __attribute__((address_space(3)))
typedef unsigned short bf16;
typedef short bf16x8 __attribute__((ext_vector_type(8)));
typedef float f32x4 __attribute__((ext_vector_type(4)));
typedef float f32x2 __attribute__((ext_vector_type(2)));
typedef unsigned u32x4 __attribute__((ext_vector_type(4)));
typedef unsigned u32x2 __attribute__((ext_vector_type(2)));

#ifndef MK_MULTI
#define MK_MULTI 0
#endif

#ifndef REP_P3
#define REP_P3 1
#endif
#ifndef REP_P5
#define REP_P5 1
#endif
#ifndef REP_AT
#define REP_AT 1
#endif
#ifndef ATTN_NQT
#define ATTN_NQT 2
#endif

constexpr int NL = 4, NB = 8, SEQ = 4096, DM = 1024, NT = NB * SEQ, NCH = 64;
constexpr int INW = 2816;
constexpr int C_QA = 0, C_KA = 512, C_VA = 1024, C_US = 1536, C_QR = 1792, C_KR = 2048, C_VR = 2304, C_GR = 2560;
constexpr int NE = 32, FF = 256;
constexpr float EPS = 1e-6f;
constexpr int NWAVES = 8, NTHR = 512;
constexpr int LDS_BYTES = 147456;

constexpr size_t al256(size_t x) { return (x + 255) & ~(size_t)255; }
constexpr size_t WS_CTL = 0, CTL_BYTES = 1u << 20;
constexpr size_t WS_WIN = CTL_BYTES;
constexpr size_t WS_WOUT = WS_WIN + (size_t)NL * INW * DM * 2;
constexpr size_t WS_WGU = WS_WOUT + (size_t)NL * DM * DM * 2;
constexpr size_t WS_WD = WS_WGU + (size_t)NL * NE * 512 * DM * 2;
constexpr size_t WS_WGLU = WS_WD + (size_t)NL * NE * DM * FF * 2;
constexpr size_t WS_WR = WS_WGLU + (size_t)NL * 256 * 256 * 2;
constexpr size_t WS_MOD = WS_WR + (size_t)NL * 36 * DM * 4;
constexpr size_t WS_ABAR = WS_MOD + (size_t)NL * NB * 6144 * 4;
constexpr size_t WS_ABAR64 = WS_ABAR + (size_t)NL * 16 * 64 * 8;
constexpr size_t WS_BBAR = WS_ABAR64 + (size_t)NL * 16 * 64 * 8;
constexpr size_t WS_ROPE = WS_BBAR + (size_t)NL * 16 * 64 * 16 * 8;
constexpr size_t WS_H = al256(WS_ROPE + (size_t)SEQ * 32 * 8);
constexpr size_t WS_QKV = WS_H + (size_t)NT * DM * 2;
constexpr size_t WS_SLOT = WS_QKV;
constexpr size_t WS_ACT = WS_QKV + (size_t)2 * NT * DM * 2;
constexpr int ACT_ROWS = 2 * NT + NE * 256;
static_assert(WS_ACT + (size_t)ACT_ROWS * FF * 2 <= WS_QKV + (size_t)NT * INW * 2, "overlay fits");
constexpr size_t WS_XB = WS_QKV + (size_t)NT * INW * 2;
constexpr size_t WS_MIX = WS_H;
constexpr size_t WS_YG = WS_XB + (size_t)NT * DM * 2;
constexpr size_t WS_SEND = WS_YG + (size_t)NT * 256 * 2;
constexpr size_t WS_XS = WS_SEND + (size_t)NB * NCH * 16 * 64 * 8;
constexpr size_t WS_KV = WS_XS + (size_t)NB * NCH * 16 * 64 * 8;
constexpr size_t WS_RW = WS_KV + (size_t)NB * NCH * 4 * 4096 * 4;
constexpr size_t WS_LIST = WS_RW + (size_t)NT * 2 * 4;
constexpr size_t WS_WRHL = WS_LIST + (size_t)NE * NT * 4;
constexpr size_t WS_KERN = WS_WRHL + (size_t)NL * 2 * 48 * DM * 2;
constexpr size_t WS_U2X = WS_KERN + (size_t)NL * 16 * 64 * 256 * 4;
constexpr int U2K = 1152, U2LD = 16 * U2K;
constexpr size_t WS_TMAT = WS_U2X + (size_t)512 * U2LD * 2;
constexpr size_t WS_BT1 = WS_TMAT + (size_t)16 * 1024 * U2K * 2;
constexpr size_t WS_SSQ = WS_BT1 + (size_t)16 * 256 * 1024 * 2;
constexpr size_t WS_PW = WS_SSQ + (size_t)NT * 16 * 4;
constexpr size_t WS_END = WS_PW + (size_t)NL * 16 * 65 * 64 * 8;
constexpr int CW_BAR = 4096;
constexpr int CW_CNT = 16384;

__device__ __forceinline__ float bf2f(unsigned v) { return __uint_as_float(v << 16); }
__device__ __forceinline__ unsigned f2bf(float f) { unsigned u = __float_as_uint(f); return (u + 0x7fffu + ((u >> 16) & 1u)) >> 16; }
__device__ __forceinline__ unsigned pk2(float lo, float hi) { return f2bf(lo) | (f2bf(hi) << 16); }
__device__ __forceinline__ float wave_sum(float v) {
#pragma unroll
    for (int o = 1; o < 64; o <<= 1) v += __shfl_xor(v, o);
    return v;
}
__device__ __forceinline__ float silu_f(float x) { return x / (1.0f + __expf(-x)); }
__device__ __forceinline__ float sigmoid_f(float x) { return 1.0f / (1.0f + __expf(-x)); }
__device__ __forceinline__ float gelu_tanh_f(float y) { const float z = 0.7978845608028654f * (y + 0.044715f * y * y * y); const float t = 1.0f - 2.0f / (__expf(2.0f * z) + 1.0f); return 0.5f * y * (1.0f + t); }
#define LDS_WAIT() asm volatile("s_waitcnt lgkmcnt(0)" ::: "memory")

#define XB_TMO      128
#define XB_XCNT(j)  (256  + 64 * (j))
#define XB_XSUB(j)  (1280 + 64 * (j))
#define XB_XGEN(j)  (2304 + 64 * (j))
#define XB_TOP      3328
#define XB_TOPGEN   3392
#define XCD_BAR_WORDS 3456
#define XB_SPIN_CAP (1u << 22)
__device__ __forceinline__ unsigned xb_ld(unsigned* p)              { return __hip_atomic_load(p, __ATOMIC_RELAXED, __HIP_MEMORY_SCOPE_AGENT); }
__device__ __forceinline__ unsigned xb_add(unsigned* p, unsigned v) { return __hip_atomic_fetch_add(p, v, __ATOMIC_RELAXED, __HIP_MEMORY_SCOPE_AGENT); }
__device__ __forceinline__ unsigned xb_xcc_id() { return (unsigned)__builtin_amdgcn_s_getreg((3 << 11) | 20) & 0xFu; }
#define XB_SPIN(cond, bar) do { unsigned _sp = 0; while (cond) { __builtin_amdgcn_s_sleep(1); \
    if ((++_sp & 255u) == 0u) { if (xb_ld(&(bar)[XB_TMO])) break; if (_sp > XB_SPIN_CAP) { atomicAdd(&(bar)[XB_TMO], 1u); break; } } } } while (0)
struct XcdBarrier { unsigned* bar; unsigned x; volatile LAS unsigned* st; };
__device__ __forceinline__ XcdBarrier xcd_barrier_post(unsigned* bar, volatile LAS unsigned* st) {
    XcdBarrier b; b.bar = bar; b.x = xb_xcc_id(); b.st = st;
    if (threadIdx.x == 0) (void)xb_add(&bar[XB_XCNT(b.x)], 1u);
    return b;
}
__device__ __forceinline__ void xcd_barrier_complete(unsigned* bar, unsigned x, unsigned& nloc, unsigned& nx) {
    const unsigned G = gridDim.x * gridDim.y * gridDim.z;
    unsigned sum, cnt, mine, sp = 0u;
    for (;;) {
        sum = 0u; cnt = 0u; mine = 0u;
#pragma unroll
        for (unsigned j = 0; j < 16; ++j) { const unsigned c = xb_ld(&bar[XB_XCNT(j)]); sum += c; cnt += (c > 0u) ? 1u : 0u; mine = (j == x) ? c : mine; }
        if (sum == G) break;
        __builtin_amdgcn_s_sleep(1);
        if ((++sp & 255u) == 0u) { if (xb_ld(&bar[XB_TMO])) break; if (sp > XB_SPIN_CAP) { atomicAdd(&bar[XB_TMO], 1u); break; } }
    }
    nloc = mine > 0u ? mine : 1u; nx = cnt > 0u ? cnt : 1u;
}
__device__ __forceinline__ void xcd_barrier(const XcdBarrier& b) {
    asm volatile("s_waitcnt vmcnt(0)" ::: "memory");
    __syncthreads();
    if (threadIdx.x == 0) {
        unsigned* bar = b.bar;
        __builtin_amdgcn_s_waitcnt(0);
        unsigned nloc = b.st[0], nx = b.st[1];
        if (nloc == 0u) { xcd_barrier_complete(bar, b.x, nloc, nx); b.st[0] = nloc; b.st[1] = nx; }
        const unsigned old = xb_add(&bar[XB_XSUB(b.x)], 1u);
        const unsigned gen = old / nloc;
        if (old + 1u == (gen + 1u) * nloc) {
            __builtin_amdgcn_fence(__ATOMIC_RELEASE, "agent");
            asm volatile("s_waitcnt vmcnt(0)" ::: "memory");
            const unsigned og = xb_add(&bar[XB_TOP], 1u);
            const unsigned tg = og / nx;
            if (og + 1u == (tg + 1u) * nx) xb_add(&bar[XB_TOPGEN], 1u);
            else XB_SPIN(xb_ld(&bar[XB_TOPGEN]) == tg, bar);
            __builtin_amdgcn_fence(__ATOMIC_ACQUIRE, "agent");
            xb_add(&bar[XB_XGEN(b.x)], 1u);
            asm volatile("s_waitcnt vmcnt(0)" ::: "memory");
        } else {
            XB_SPIN(xb_ld(&bar[XB_XGEN(b.x)]) == gen, bar);
            __builtin_amdgcn_fence(__ATOMIC_ACQUIRE, "agent");
            asm volatile("s_waitcnt vmcnt(0)" ::: "memory");
        }
    }
    __syncthreads();
}

struct Frame {
    LAS unsigned char* lds;
    LAS unsigned long long* ptab;
    int tid, lane, wave, blk, G, gw, ngw;
    float* out0; unsigned char* ws0; size_t wz;
};
#define F_OUT (F.out0 + F.wz)
__device__ __forceinline__ const float* inp_ptr(LAS unsigned long long* t, int k) { const unsigned long long v = t[k];
    const unsigned lo = __builtin_amdgcn_readfirstlane((unsigned)v), hi = __builtin_amdgcn_readfirstlane((unsigned)(v >> 32)); return (const float*)(const GAS float*)(((unsigned long long)hi << 32) | lo); }
#define INP(k) inp_ptr(F.ptab, k)
#define F_x INP(0)
#define F_c INP(1)
#define F_norm1_g INP(2)
#define F_norm2_g INP(3)
#define F_w_ada INP(4)
#define F_b_ada INP(5)
#define F_w_in INP(6)
#define F_rel_bias INP(7)
#define F_a_re INP(8)
#define F_a_im INP(9)
#define F_log_dt INP(10)
#define F_b_re INP(11)
#define F_b_im INP(12)
#define F_c_re INP(13)
#define F_c_im INP(14)
#define F_ssm_d INP(15)
#define F_w_glu INP(16)
#define F_b_glu INP(17)
#define F_gn_g INP(18)
#define F_w_out INP(19)
#define F_w_group INP(20)
#define F_b_group INP(21)
#define F_w_expert INP(22)
#define F_b_expert INP(23)
#define F_w_gate INP(24)
#define F_w_up INP(25)
#define F_w_down INP(26)
#define F_final_g INP(27)
#define F_ctl ((unsigned*)(F.ws0 + F.wz + WS_CTL))
#define F_WinT ((bf16*)(F.ws0 + F.wz + WS_WIN))
#define F_WoutT ((bf16*)(F.ws0 + F.wz + WS_WOUT))
#define F_WguT ((bf16*)(F.ws0 + F.wz + WS_WGU))
#define F_WdT ((bf16*)(F.ws0 + F.wz + WS_WD))
#define F_WgluT ((bf16*)(F.ws0 + F.wz + WS_WGLU))
#define F_WrT ((float*)(F.ws0 + F.wz + WS_WR))
#define F_MOD ((float*)(F.ws0 + F.wz + WS_MOD))
#define F_ABAR ((f32x2*)(F.ws0 + F.wz + WS_ABAR))
#define F_ABAR64 ((f32x2*)(F.ws0 + F.wz + WS_ABAR64))
#define F_BBAR ((f32x2*)(F.ws0 + F.wz + WS_BBAR))
#define F_ROPE ((f32x2*)(F.ws0 + F.wz + WS_ROPE))
#define F_H ((bf16*)(F.ws0 + F.wz + WS_H))
#define F_QKV ((bf16*)(F.ws0 + F.wz + WS_QKV))
#define F_SLOT ((bf16*)(F.ws0 + F.wz + WS_SLOT))
#define F_ACT ((bf16*)(F.ws0 + F.wz + WS_ACT))
#define F_MIX ((bf16*)(F.ws0 + F.wz + WS_MIX))
#define F_YG ((bf16*)(F.ws0 + F.wz + WS_YG))
#define F_SEND ((f32x2*)(F.ws0 + F.wz + WS_SEND))
#define F_XS ((f32x2*)(F.ws0 + F.wz + WS_XS))
#define F_KV ((float*)(F.ws0 + F.wz + WS_KV))
#define F_KVB ((bf16*)(F.ws0 + F.wz + WS_KV))
#define F_RW ((float*)(F.ws0 + F.wz + WS_RW))
#define F_LIST ((int*)(F.ws0 + F.wz + WS_LIST))
#define F_WRHL ((bf16*)(F.ws0 + F.wz + WS_WRHL))
#define F_KERNB ((bf16*)(F.ws0 + F.wz + WS_KERN))
#define F_U2X ((bf16*)(F.ws0 + F.wz + WS_U2X))
#define F_TMAT ((bf16*)(F.ws0 + F.wz + WS_TMAT))
#define F_BT1 ((bf16*)(F.ws0 + F.wz + WS_BT1))
#define F_SENDP ((float*)(F.ws0 + F.wz + WS_SEND))
#define F_SSQ ((float*)(F.ws0 + F.wz + WS_SSQ))
#define F_PW ((f32x2*)(F.ws0 + F.wz + WS_PW))
#define F_XB ((bf16*)(F.ws0 + F.wz + WS_XB))

namespace pg8 {
constexpr int BM = 256, BK = 64, HALF = 128, HTB = HALF * BK * 2, STAGE_BYTES = 8 * HTB, NXCD = 8, WGM = 8;
__host__ __device__ __forceinline__ int lds_byte(int r, int c) { const int st = (r >> 4) * 2 + (c >> 5), rr = r & 15, cc = c & 31, ob = rr * 64 + cc * 2; return st * 1024 + (ob ^ (((ob >> 9) & 1) << 5)); }
__host__ __device__ __forceinline__ void stage_rc(int b, int& R, int& C) { const int st = b / 1024, sb = b % 1024, swz = sb ^ (((sb >> 9) & 1) << 5); R = (st >> 1) * 16 + swz / 64; C = (st & 1) * 32 + (swz % 64) / 2; }
__host__ __device__ __forceinline__ int perm32(int rho) { const int n = rho >> 4, i = rho & 15; return 8 * (i >> 2) + 4 * n + (i & 3); }
struct Unit { int pm, pn, e, i; };
struct StaticOrder {
    int nM, nN, nwg, G, c; const char* A; const char* Bt; size_t tstepA, tstepB;
    __device__ void init(const bf16* A_, int lda, const bf16* Bt_, int ldb, int M, int N, int G_, int c_) { nM = M / BM; nN = N / BM; nwg = nM * nN; G = G_; c = c_; A = (const char*)A_; Bt = (const char*)Bt_; tstepA = (size_t)BM * lda * 2; tstepB = (size_t)BM * ldb * 2; }
    __device__ bool next(int i, Unit& u) const {
        const long L = (long)i * G + c; if (L >= nwg) return false;
        int wgid = (int)L; { const int q = nwg / NXCD, r = nwg % NXCD, xcd = wgid % NXCD, off = wgid / NXCD; wgid = (xcd < r ? xcd * (q + 1) : r * (q + 1) + (xcd - r) * q) + off; }
        const int nig = WGM * nN, gid = wgid / nig, fm = gid * WGM, gsz = (nM - fm) < WGM ? (nM - fm) : WGM;
        u.pm = fm + ((wgid % nig) % gsz); u.pn = (wgid % nig) / gsz; u.e = 0; u.i = i; return true;
    }
    __device__ __forceinline__ const char* a_base(const Unit& u) const { return A + (size_t)u.pm * tstepA; }
    __device__ __forceinline__ const char* b_base(const Unit& u) const { return Bt + (size_t)u.pn * tstepB; }
    __device__ __forceinline__ int row(const Unit&, int r) const { return r; }
};
__device__ __forceinline__ unsigned cvt_pk_bf16(float lo, float hi) { unsigned r; asm volatile("v_cvt_pk_bf16_f32 %0, %1, %2" : "=v"(r) : "v"(lo), "v"(hi)); return r; }

template <class Epi, class Sched, bool GATHER, bool TOEP = false>
__device__ __forceinline__ void gemm_phase(LAS unsigned char* lds, const int K, const int lda, const int ldb, const Sched& S, const Epi& E) {
    int tid_ = threadIdx.x; asm volatile("" : "+v"(tid_));
    const int tid = tid_, wid = __builtin_amdgcn_readfirstlane(tid >> 6), lane = tid & 63, wr = wid >> 2, wc = wid & 3, fr = lane & 15, fq = lane >> 4;
    const int nt = K / BK;
    int Rr[2], Cc[2]; unsigned voffB[2], voffC[2];
#pragma unroll
    for (int i = 0; i < 2; ++i) { stage_rc(tid * 16 + i * 8192, Rr[i], Cc[i]); const int Rb = Epi::PERM ? ((Rr[i] & ~31) + perm32(Rr[i] & 31)) : Rr[i]; voffC[i] = (unsigned)(Rb * ldb + Cc[i]) * 2u;
        voffB[i] = TOEP ? (unsigned)(((Rb >> 4) - (Cc[i] >> 4) + 3) * 512 + (Rb & 15) * 32 + (Cc[i] & 15) * 2) : voffC[i]; }
    const size_t kstep = (size_t)(BK * 2);
    const long kstepB = TOEP ? -2048l : (long)(BK * 2);
    const size_t hstepC = (size_t)HALF * ldb * 2;
    const size_t hstepB = TOEP ? (size_t)4096 : hstepC;
    const unsigned ldsw = (unsigned)wid * 1024u;
    const int aoff = lds_byte(wr * 64 + fr, fq * 8), boff = lds_byte(wc * 32 + fr, fq * 8);
#define PG8_SA(b, h) (((b) * 2 + (h)) * HTB)
#define PG8_SB(b, h) ((4 + (b) * 2 + (h)) * HTB)
#define PG8_STAGE(bufoff, gbase, voff) do { _Pragma("unroll") for (int _i = 0; _i < 2; ++_i) \
        __builtin_amdgcn_global_load_lds((const unsigned*)((const char*)(gbase) + (voff)[_i]), (LAS unsigned*)(lds + (bufoff) + ldsw + _i * 8192), 16, 0, 0); } while (0)
#define PG8_STAGE_SEL(bufoff, gbase, h) do { if (GATHER && last) PG8_STAGE(bufoff, gbase, vN[h]); else PG8_STAGE(bufoff, gbase, vA[h]); } while (0)
#define PG8_LDA(dst, b, h) do { _Pragma("unroll") for (int m = 0; m < 4; ++m) _Pragma("unroll") for (int k = 0; k < 2; ++k) dst[m][k] = *(const LAS bf16x8*)(lds + PG8_SA(b, h) + aoff + m * 2048 + k * 1024); } while (0)
#define PG8_LDB(dst, b, h) do { _Pragma("unroll") for (int n = 0; n < 2; ++n) _Pragma("unroll") for (int k = 0; k < 2; ++k) dst[n][k] = *(const LAS bf16x8*)(lds + PG8_SB(b, h) + boff + n * 2048 + k * 1024); } while (0)
#define PG8_MMA(ai, bj, At, Bt) do { __builtin_amdgcn_s_setprio(1); _Pragma("unroll") for (int m = 0; m < 4; ++m) _Pragma("unroll") for (int n = 0; n < 2; ++n) _Pragma("unroll") for (int k = 0; k < 2; ++k) \
        acc[ai][bj][m][n] = __builtin_amdgcn_mfma_f32_16x16x32_bf16(Bt[n][k], At[m][k], acc[ai][bj][m][n], 0, 0, 0); __builtin_amdgcn_s_setprio(0); } while (0)
#define PG8_WAIT_V(n) asm volatile("s_waitcnt vmcnt(" #n ")" ::: "memory")
#define PG8_WAIT_L(n) asm volatile("s_waitcnt lgkmcnt(" #n ")" ::: "memory")
#define PG8_BAR __builtin_amdgcn_s_barrier()
#define PG8_SCHED __builtin_amdgcn_sched_barrier(0)
#define PG8_VOFF(dst, u) do { int _t = tid; if (GATHER) asm volatile("" : "+v"(_t)); _Pragma("unroll") for (int _i = 0; _i < 2; ++_i) { int _R, _C; stage_rc(_t * 16 + _i * 8192, _R, _C); \
        _Pragma("unroll") for (int _h = 0; _h < 2; ++_h) dst[_h][_i] = (unsigned)(S.row(u, _h * HALF + _R) * lda + _C) * 2u; } } while (0)
    Unit cur, nxt; int ui = 0;
    if (!S.next(0, cur)) return;
    f32x4 acc[2][2][4][2];
#pragma unroll
    for (int a = 0; a < 2; ++a)
#pragma unroll
        for (int b = 0; b < 2; ++b)
#pragma unroll
            for (int m = 0; m < 4; ++m)
#pragma unroll
                for (int n = 0; n < 2; ++n) acc[a][b][m][n] = (f32x4){0.f, 0.f, 0.f, 0.f};
    bf16x8 At[4][2], B0[2][2], B1[2][2];
    unsigned vA[2][2];
    PG8_VOFF(vA, cur);
    const char* cA = S.a_base(cur); const char* cB = S.b_base(cur);
    const char* cC = cB; if constexpr (TOEP) cC = S.c_base(cur);
    PG8_STAGE(PG8_SB(0, 0), cC, voffC); PG8_STAGE(PG8_SB(0, 1), cC + hstepC, voffC); PG8_STAGE(PG8_SA(0, 0), cA, vA[0]); PG8_STAGE(PG8_SA(0, 1), cA, vA[1]);
    if (wr == 1) PG8_BAR;
    PG8_WAIT_V(2); PG8_BAR;
    PG8_STAGE(PG8_SB(1, 0), cC + kstep, voffC); PG8_STAGE(PG8_SA(1, 0), cA + kstep, vA[0]); PG8_STAGE(PG8_SB(1, 1), cC + hstepC + kstep, voffC);
    PG8_WAIT_V(6); PG8_BAR;
    for (;;) {
        const bool has_next = S.next(ui + 1, nxt);
        const char* nA = has_next ? S.a_base(nxt) : cA; const char* nB = has_next ? S.b_base(nxt) : cB;
        const char* nC = nB; if constexpr (TOEP) nC = has_next ? S.c_base(nxt) : cC;
        asm volatile(".p2align 8\n\t.fill 8, 4, 0xBF800000" ::: "memory");
#pragma unroll 1
        for (int t = 0; t < nt; t += 2) {
            const bool last = (t == nt - 2);
            const char* a1 = cA + (size_t)(t + 1) * kstep;
            const char* a2 = last ? nA : cA + (size_t)(t + 2) * kstep; const char* b2 = last ? nC : cB + (long)(t + 2) * kstepB;
            const char* a3 = a2 + kstep; const char* b3 = (TOEP && last) ? b2 + kstep : b2 + kstepB;
            PG8_LDB(B0, 0, 0); PG8_LDB(B1, 0, 1); PG8_SCHED; PG8_LDA(At, 0, 0); PG8_STAGE(PG8_SA(1, 1), a1, vA[1]);
            PG8_WAIT_V(8); PG8_WAIT_L(0); PG8_BAR; PG8_MMA(0, 0, At, B0); PG8_MMA(0, 1, At, B1); PG8_BAR; PG8_SCHED;
            if (GATHER && last && has_next) { PG8_VOFF(vA, nxt); }
            PG8_LDA(At, 0, 1);
            if (TOEP && last) { PG8_STAGE(PG8_SB(0, 0), b2, voffC); PG8_STAGE(PG8_SB(0, 1), b2 + hstepC, voffC); } else { PG8_STAGE(PG8_SB(0, 0), b2, voffB); PG8_STAGE(PG8_SB(0, 1), b2 + hstepB, voffB); }
            PG8_STAGE(PG8_SA(0, 0), a2, vA[0]);
            PG8_WAIT_V(8); PG8_WAIT_L(0); PG8_BAR; PG8_MMA(1, 0, At, B0); PG8_MMA(1, 1, At, B1); PG8_BAR; PG8_SCHED;
            PG8_LDB(B0, 1, 0); PG8_LDB(B1, 1, 1); PG8_SCHED; PG8_LDA(At, 1, 0); PG8_STAGE(PG8_SA(0, 1), a2, vA[1]);
            PG8_WAIT_V(8); PG8_WAIT_L(0); PG8_BAR; PG8_MMA(0, 0, At, B0); PG8_MMA(0, 1, At, B1); PG8_BAR; PG8_SCHED;
            PG8_LDA(At, 1, 1);
            if (TOEP && last) { PG8_STAGE(PG8_SB(1, 0), b3, voffC); PG8_STAGE(PG8_SB(1, 1), b3 + hstepC, voffC); } else { PG8_STAGE(PG8_SB(1, 0), b3, voffB); PG8_STAGE(PG8_SB(1, 1), b3 + hstepB, voffB); }
            PG8_STAGE(PG8_SA(1, 0), a3, vA[0]);
            PG8_WAIT_V(8); PG8_WAIT_L(0); PG8_BAR; PG8_MMA(1, 0, At, B0); PG8_MMA(1, 1, At, B1); PG8_BAR; PG8_SCHED;
        }
        if (wr == 0) PG8_BAR;
        { int fr_e = fr, fq_e = fq; asm volatile("" : "+v"(fr_e), "+v"(fq_e)); E(acc, cur, wr, wc, fr_e, fq_e); }
        if (!has_next) break;
#pragma unroll
        for (int a = 0; a < 2; ++a)
#pragma unroll
            for (int b = 0; b < 2; ++b)
#pragma unroll
                for (int m = 0; m < 4; ++m)
#pragma unroll
                    for (int n = 0; n < 2; ++n) acc[a][b][m][n] = (f32x4){0.f, 0.f, 0.f, 0.f};
        cur = nxt; cA = nA; cB = nB; cC = nC; ++ui;
        if (wr == 1) PG8_BAR;
    }
    PG8_WAIT_V(0);
    PG8_BAR;
#undef PG8_SA
#undef PG8_SB
#undef PG8_STAGE
#undef PG8_STAGE_SEL
#undef PG8_LDA
#undef PG8_LDB
#undef PG8_MMA
#undef PG8_WAIT_V
#undef PG8_WAIT_L
#undef PG8_BAR
#undef PG8_SCHED
#undef PG8_VOFF
}
}

struct EpiQKV {
    static constexpr bool PERM = true;
    bf16* O; bf16* U2;
    __device__ __forceinline__ void operator()(const f32x4 (&acc)[2][2][4][2], const pg8::Unit& u, int wr, int wc, int fr, int fq) const {
        const int row0 = u.pm * 256 + wr * 64 + fr, col0 = u.pn * 256 + wc * 32 + 8 * fq;
#pragma unroll
        for (int ai = 0; ai < 2; ++ai)
#pragma unroll
            for (int m = 0; m < 4; ++m) { const int row = row0 + ai * 128 + m * 16; bf16* rowp = O + (size_t)row * INW + col0;
#pragma unroll
                for (int bj = 0; bj < 2; ++bj) { const f32x4 v0 = acc[ai][bj][m][0], v1 = acc[ai][bj][m][1];
                    u32x4 w; w.x = pg8::cvt_pk_bf16(v0[0], v0[1]); w.y = pg8::cvt_pk_bf16(v0[2], v0[3]); w.z = pg8::cvt_pk_bf16(v1[0], v1[1]); w.w = pg8::cvt_pk_bf16(v1[2], v1[3]);
                    if (u.pn == 6) { const int cu = bj * 128 + wc * 32 + 8 * fq;
                        *(u32x4*)(U2 + ((size_t)(row >> 6) * 16 + (cu >> 4)) * U2K + 128 + (row & 63) * 16 + (cu & 15)) = w; }
                    else *(u32x4*)(rowp + bj * 128) = w; } }
    }
};
struct EpiRes {
    static constexpr bool PERM = true;
    const float* x0; bf16* xb; const float* g1l; float* ssq; int first;
    __device__ __forceinline__ void operator()(const f32x4 (&acc)[2][2][4][2], const pg8::Unit& u, int wr, int wc, int fr, int fq) const {
        const int row0 = u.pm * 256 + wr * 64 + fr, col0 = u.pn * 256 + wc * 32 + 8 * fq;
        const float* g1 = g1l + (size_t)((u.pm * 256) / SEQ) * 6144 + col0;
        f32x4 gv[2][2];
#pragma unroll
        for (int bj = 0; bj < 2; ++bj)
#pragma unroll
            for (int n = 0; n < 2; ++n) gv[bj][n] = *(const f32x4*)(g1 + bj * 128 + n * 4);
#pragma unroll
        for (int ai = 0; ai < 2; ++ai)
#pragma unroll
            for (int m = 0; m < 4; ++m) { const int row = row0 + ai * 128 + m * 16; const size_t off = (size_t)row * DM + col0; float sq = 0.f;
#pragma unroll
                for (int bj = 0; bj < 2; ++bj) { f32x4 x0v, x1v;
                    if (first) { x0v = *(const f32x4*)(x0 + off + bj * 128); x1v = *(const f32x4*)(x0 + off + bj * 128 + 4); }
                    else { const u32x4 w = *(const u32x4*)(xb + off + bj * 128); x0v = (f32x4){bf2f(w.x & 0xffffu), bf2f(w.x >> 16), bf2f(w.y & 0xffffu), bf2f(w.y >> 16)}; x1v = (f32x4){bf2f(w.z & 0xffffu), bf2f(w.z >> 16), bf2f(w.w & 0xffffu), bf2f(w.w >> 16)}; }
                    const f32x4 o0 = x0v + gv[bj][0] * acc[ai][bj][m][0], o1 = x1v + gv[bj][1] * acc[ai][bj][m][1];
                    u32x4 w; w.x = pg8::cvt_pk_bf16(o0[0], o0[1]); w.y = pg8::cvt_pk_bf16(o0[2], o0[3]); w.z = pg8::cvt_pk_bf16(o1[0], o1[1]); w.w = pg8::cvt_pk_bf16(o1[2], o1[3]);
                    *(u32x4*)(xb + off + bj * 128) = w;
                    sq += (o0.x * o0.x + o0.y * o0.y) + (o0.z * o0.z + o0.w * o0.w) + (o1.x * o1.x + o1.y * o1.y) + (o1.z * o1.z + o1.w * o1.w); }
                sq += __shfl_xor(sq, 16); sq += __shfl_xor(sq, 32);
                if (fq == 0) ssq[(size_t)row * 16 + u.pn * 4 + wc] = sq;
                asm volatile("" ::: "memory"); }
    }
};

__device__ __forceinline__ void p0_prologue(Frame& F) {
    LAS float* scr = (LAS float*)(F.lds + F.wave * 16384);
    constexpr int I_IN = NL * 16 * 88, I_OUT = NL * 16 * 32, I_GLU = NL * 4 * 8, I_G = NL * NE * 16 * 8, I_D = NL * NE * 4 * 32;
    constexpr int NITEMS = I_IN + I_OUT + I_GLU + 2 * I_G + I_D;
    struct TItem { const float* src; bf16* dst; int N, ldk; };
#define TR_DECODE(itv, T) do { int r = (itv); \
        if (r < I_IN) { const int l = r / (16 * 88), q = r % (16 * 88), kb = q / 88, nb = q % 88; T.N = INW; T.ldk = DM; \
            T.src = F_w_in + (size_t)l * DM * INW + (size_t)(kb * 64) * INW + nb * 32; T.dst = F_WinT + ((size_t)l * INW + nb * 32) * DM + kb * 64; break; } r -= I_IN; \
        if (r < I_OUT) { const int l = r / (16 * 32), q = r % (16 * 32), kb = q / 32, nb = q % 32; T.N = DM; T.ldk = DM; \
            T.src = F_w_out + (size_t)l * DM * DM + (size_t)(kb * 64) * DM + nb * 32; T.dst = F_WoutT + ((size_t)l * DM + nb * 32) * DM + kb * 64; break; } r -= I_OUT; \
        if (r < I_GLU) { const int l = r / 32, q = r % 32, kb = q / 8, nb = q % 8; T.N = 256; T.ldk = 256; \
            T.src = F_w_glu + (size_t)l * 256 * 256 + (size_t)(kb * 64) * 256 + nb * 32; T.dst = F_WgluT + ((size_t)l * 256 + nb * 32) * 256 + kb * 64; break; } r -= I_GLU; \
        if (r < 2 * I_G) { const int up = r >= I_G; if (up) r -= I_G; const int le = r / 128, q = r % 128, kb = q / 8, nb = q % 8; const int n0 = nb * 32; \
            const int drow = (n0 >> 7) * 256 + up * 128 + (n0 & 127); T.N = FF; T.ldk = DM; \
            T.src = (up ? F_w_up : F_w_gate) + (size_t)le * DM * FF + (size_t)(kb * 64) * FF + n0; T.dst = F_WguT + ((size_t)le * 512 + drow) * DM + kb * 64; break; } r -= 2 * I_G; \
        { const int le = r / 128, q = r % 128, kb = q / 32, nb = q % 32; T.N = DM; T.ldk = FF; \
            T.src = F_w_down + (size_t)le * FF * DM + (size_t)(kb * 64) * DM + nb * 32; T.dst = F_WdT + ((size_t)le * DM + nb * 32) * FF + kb * 64; } } while (0)
#define TR_LOAD(T, tv) do { _Pragma("unroll") for (int i = 0; i < 32; ++i) { const int kk = 2 * i + (F.lane >> 5); tv[i] = __builtin_nontemporal_load(T.src + (size_t)kk * T.N + (F.lane & 31)); } } while (0)
#define TR_STORE(T, tv) do { _Pragma("unroll") for (int i = 0; i < 32; ++i) { const int kk = 2 * i + (F.lane >> 5); scr[kk * 33 + (F.lane & 31)] = tv[i]; } \
        LDS_WAIT(); asm volatile("" ::: "memory"); const int c = F.lane & 7; \
        _Pragma("unroll") for (int j = 0; j < 4; ++j) { const int n = (F.lane >> 3) + 8 * j; const LAS float* s = scr + (8 * c) * 33 + n; \
            u32x4 o; o.x = pk2(s[0 * 33], s[1 * 33]); o.y = pk2(s[2 * 33], s[3 * 33]); o.z = pk2(s[4 * 33], s[5 * 33]); o.w = pk2(s[6 * 33], s[7 * 33]); \
            *(u32x4*)(T.dst + (size_t)n * T.ldk + 8 * c) = o; } \
        LDS_WAIT(); asm volatile("" ::: "memory"); } while (0)
    {
        float tva[32], tvb[32]; TItem Ta, Tb; Ta.src = nullptr; Ta.dst = nullptr; Ta.N = 0; Ta.ldk = 0; Tb = Ta;
        int it = F.gw;
        if (it < NITEMS) { TR_DECODE(it, Ta); TR_LOAD(Ta, tva); }
        while (it < NITEMS) {
            const int it1 = it + F.ngw; if (it1 < NITEMS) { TR_DECODE(it1, Tb); TR_LOAD(Tb, tvb); }
            TR_STORE(Ta, tva);
            if (it1 >= NITEMS) break;
            const int it2 = it1 + F.ngw; if (it2 < NITEMS) { TR_DECODE(it2, Ta); TR_LOAD(Ta, tva); }
            TR_STORE(Tb, tvb);
            it = it2;
        }
    }
#undef TR_DECODE
#undef TR_LOAD
#undef TR_STORE
    for (int i = F.blk * NTHR + F.tid; i < NL * 48 * DM; i += F.G * NTHR) { const int l = i / (48 * DM), j = (i / DM) % 48, k = i % DM;
        const float w = (j < 4) ? F_w_group[((size_t)l * DM + k) * 4 + j] : (j < 36 ? F_w_expert[((size_t)l * DM + k) * 32 + (j - 4)] : 0.f);
        const unsigned hi = f2bf(w); const unsigned lo = f2bf(w - bf2f(hi));
        F_WRHL[((size_t)(l * 2 + 0) * 48 + j) * DM + k] = (bf16)hi; F_WRHL[((size_t)(l * 2 + 1) * 48 + j) * DM + k] = (bf16)lo; }
    for (int i = F.blk * 16 + F.tid; F.tid < 16 && i < NL * 16 * 64; i += F.G * 16) {
        const int lg = i / 64; const float are = F_a_re[i], aim = F_a_im[i], dt = __expf(F_log_dt[lg]);
        const float mag = expf(are * dt); float sn, cs; sincosf(aim * dt, &sn, &cs);
        const float abr = mag * cs, abi = mag * sn;
        F_ABAR[i] = (f32x2){abr, abi};
        const float mag64 = expf(64.f * are * dt); float sn64, cs64; sincosf(64.f * aim * dt, &sn64, &cs64);
        F_ABAR64[i] = (f32x2){mag64 * cs64, mag64 * sn64};
        F_PW[((size_t)lg * 65 + 64) * 64 + (i & 63)] = (f32x2){mag64 * cs64, mag64 * sn64};
        const float xr = abr - 1.f, xi = abi, den = are * are + aim * aim;
        const float fr = (xr * are + xi * aim) / den, fi = (xi * are - xr * aim) / den;
        f32x4 brv[4], biv[4];
#pragma unroll
        for (int q4 = 0; q4 < 4; ++q4) { brv[q4] = *(const f32x4*)(F_b_re + (size_t)i * 16 + 4 * q4); biv[q4] = *(const f32x4*)(F_b_im + (size_t)i * 16 + 4 * q4); }
#pragma unroll
        for (int q4 = 0; q4 < 4; ++q4)
#pragma unroll
            for (int r = 0; r < 4; ++r) { const float br = brv[q4][r], bi = biv[q4][r]; F_BBAR[(size_t)i * 16 + 4 * q4 + r] = (f32x2){fr * br - fi * bi, fr * bi + fi * br}; }
    }
    __syncthreads();
    for (int wu = F.blk; wu < NL * 16 * 4; wu += F.G) {
        const int lg = wu >> 2, lag0 = (wu & 3) * 16; const float dt = __expf(F_log_dt[lg]);
        LAS f32x2* pw = (LAS f32x2*)F.lds;
        LAS f32x2* ff = pw + 1024;
        LAS f32x2* cc = ff + 64;
        LAS float* bbr = (LAS float*)(cc + 1024);
        LAS float* bbi = bbr + 1024;
        for (int idx = F.tid; idx < 1024 + 64; idx += NTHR) { const int p = idx & 63; const float are = F_a_re[lg * 64 + p], aim = F_a_im[lg * 64 + p];
            if (idx < 1024) { const float lag = (float)(lag0 + (idx >> 6)); const float pm = expf(lag * are * dt); float sn, cs; sincosf(lag * aim * dt, &sn, &cs); const f32x2 pv = (f32x2){pm * cs, pm * sn}; pw[idx] = pv; F_PW[((size_t)lg * 65 + lag0 + (idx >> 6)) * 64 + p] = pv; }
            else { const float mag = expf(are * dt); float sn, cs; sincosf(aim * dt, &sn, &cs); const float xr0 = mag * cs - 1.f, xi0 = mag * sn, den = are * are + aim * aim;
                ff[p] = (f32x2){(xr0 * are + xi0 * aim) / den, (xi0 * are - xr0 * aim) / den}; } }
        for (int idx = F.tid; idx < 1024; idx += NTHR) cc[idx] = (f32x2){F_c_re[(size_t)lg * 1024 + idx], F_c_im[(size_t)lg * 1024 + idx]};
        __syncthreads();
        for (int idx = F.tid; idx < 1024; idx += NTHR) { const f32x2 fv = ff[idx >> 4]; const float br = F_b_re[(size_t)lg * 1024 + idx], bi = F_b_im[(size_t)lg * 1024 + idx];
            bbr[idx] = fv.x * br - fv.y * bi; bbi[idx] = fv.x * bi + fv.y * br; }
        __syncthreads();
        if (F.tid < 256) { const int c = F.tid & 15, lagi = F.tid >> 4, lag = lag0 + lagi;
            float acc[16];
#pragma unroll
            for (int q = 0; q < 16; ++q) acc[q] = 0.f;
#pragma unroll 4
            for (int p = 0; p < 64; ++p) { const f32x2 pv = pw[lagi * 64 + p], cv = cc[c * 64 + p];
                const float zr = cv.x * pv.x - cv.y * pv.y, zi = cv.x * pv.y + cv.y * pv.x;
                const LAS f32x4* br = (const LAS f32x4*)(bbr + p * 16); const LAS f32x4* bi = (const LAS f32x4*)(bbi + p * 16);
#pragma unroll
                for (int q4 = 0; q4 < 4; ++q4) { const f32x4 r4 = br[q4], i4 = bi[q4];
                    acc[4 * q4] += zr * r4.x - zi * i4.x; acc[4 * q4 + 1] += zr * r4.y - zi * i4.y; acc[4 * q4 + 2] += zr * r4.z - zi * i4.z; acc[4 * q4 + 3] += zr * r4.w - zi * i4.w; } }
            if (lag == 0) {
#pragma unroll
                for (int q = 0; q < 16; ++q) if (q == c) acc[q] += F_ssm_d[lg * 16 + c]; }
            bf16* kp = F_KERNB + (((size_t)lg * 128 + 64 + lag) * 16 + c) * 16;
#pragma unroll
            for (int q8 = 0; q8 < 2; ++q8) { u32x4 o; o.x = pk2(acc[8 * q8], acc[8 * q8 + 1]); o.y = pk2(acc[8 * q8 + 2], acc[8 * q8 + 3]); o.z = pk2(acc[8 * q8 + 4], acc[8 * q8 + 5]); o.w = pk2(acc[8 * q8 + 6], acc[8 * q8 + 7]);
                *(u32x4*)(kp + 8 * q8) = o; }
        } else { bf16* zp = F_KERNB + ((size_t)lg * 128 + lag0) * 256 + (F.tid - 256) * 16;
            *(u32x4*)zp = (u32x4){0u, 0u, 0u, 0u}; *(u32x4*)(zp + 8) = (u32x4){0u, 0u, 0u, 0u}; }
        __syncthreads();
    }
    for (int i = F.blk * NTHR + F.tid; i < SEQ * 32; i += F.G * NTHR) { const int pos = i >> 5, j = i & 31;
        const float inv = powf(10000.0f, -(float)j / 32.0f); const float ang = (float)pos * inv; float sn, cs; sincosf(ang, &sn, &cs); F_ROPE[i] = (f32x2){cs, sn}; }
    __syncthreads();
    {
        LAS float* cond = (LAS float*)F.lds;
        LAS float* red = (LAS float*)(F.lds + 32768);
        for (int i = F.tid; i < NB * DM; i += NTHR) cond[i] = silu_f(F_c[i]);
        __syncthreads();
        constexpr int NITM = NL * 6144 / 96;
        for (int it = F.blk; it < NITM; it += F.G) {
            const int cl = F.tid % 96, ks = F.tid / 96, col = it * 96 + cl, l = col / 6144, j = col % 6144;
            if (ks < 4) {
                float acc[8];
#pragma unroll
                for (int b = 0; b < 8; ++b) acc[b] = 0.f;
                const float* wp = F_w_ada + (size_t)l * DM * 6144 + j + (size_t)(ks * 256) * 6144;
                for (int k0 = 0; k0 < 256; k0 += 16) { float w[16];
#pragma unroll
                    for (int q = 0; q < 16; ++q) w[q] = __builtin_nontemporal_load(wp + (size_t)(k0 + q) * 6144);
#pragma unroll
                    for (int q = 0; q < 16; ++q)
#pragma unroll
                        for (int b = 0; b < 8; ++b) acc[b] += cond[b * DM + ks * 256 + k0 + q] * w[q]; }
#pragma unroll
                for (int b = 0; b < 8; ++b) red[(ks * 96 + cl) * 8 + b] = acc[b];
            }
            __syncthreads();
            if (F.tid < 96) {
#pragma unroll
                for (int b = 0; b < 8; ++b) { const float s = red[(0 * 96 + F.tid) * 8 + b] + red[(1 * 96 + F.tid) * 8 + b] + red[(2 * 96 + F.tid) * 8 + b] + red[(3 * 96 + F.tid) * 8 + b];
                    F_MOD[((size_t)l * NB + b) * 6144 + j] = s + F_b_ada[(size_t)l * 6144 + j]; }
            }
            __syncthreads();
        }
    }
}


template <bool FINAL>
__device__ __forceinline__ void norm1_phase(Frame& F, int l) {
    const bool addmoe = FINAL || l > 0;
    const int lp = FINAL ? NL - 1 : l - 1;
    const int rpw = (NT + F.ngw - 1) / F.ngw;
    for (int j = 0; j < rpw; j += 2) {
        const int rowA = F.gw * rpw + j;
        if (rowA >= NT) break;
        f32x4 v[2][4];
#pragma unroll
        for (int q = 0; q < 2; ++q) { const int row = rowA + q;
            if (!FINAL && l == 0) { const f32x4* xr = (const f32x4*)(F_x + (size_t)row * DM) + F.lane;
#pragma unroll
                for (int i = 0; i < 4; ++i) v[q][i] = xr[64 * i]; }
            else { const u32x2* xr = (const u32x2*)(F_XB + (size_t)row * DM) + F.lane;
#pragma unroll
                for (int i = 0; i < 4; ++i) { const u32x2 w = xr[64 * i]; v[q][i] = (f32x4){bf2f(w.x & 0xffffu), bf2f(w.x >> 16), bf2f(w.y & 0xffffu), bf2f(w.y >> 16)}; } } }
        if (addmoe) {
#pragma unroll
            for (int q = 0; q < 2; ++q) { const int row = rowA + q, b = row / SEQ;
                const f32x4* g2 = (const f32x4*)(F_MOD + ((size_t)lp * NB + b) * 6144 + 5120) + F.lane;
                const u32x2* s0 = (const u32x2*)(F_SLOT + (size_t)row * DM) + F.lane; const u32x2* s1 = (const u32x2*)(F_SLOT + (size_t)NT * DM + (size_t)row * DM) + F.lane;
#pragma unroll
                for (int i = 0; i < 4; ++i) { const u32x2 a = s0[64 * i], c = s1[64 * i]; const f32x4 g = g2[64 * i];
                    v[q][i].x += g.x * (bf2f(a.x & 0xffffu) + bf2f(c.x & 0xffffu)); v[q][i].y += g.y * (bf2f(a.x >> 16) + bf2f(c.x >> 16));
                    v[q][i].z += g.z * (bf2f(a.y & 0xffffu) + bf2f(c.y & 0xffffu)); v[q][i].w += g.w * (bf2f(a.y >> 16) + bf2f(c.y >> 16)); }
                if (!FINAL) { u32x2* xo = (u32x2*)(F_XB + (size_t)row * DM) + F.lane;
#pragma unroll
                    for (int i = 0; i < 4; ++i) { u32x2 w; w.x = pk2(v[q][i].x, v[q][i].y); w.y = pk2(v[q][i].z, v[q][i].w); xo[64 * i] = w; } } }
        }
        float ss[2];
#pragma unroll
        for (int q = 0; q < 2; ++q) { ss[q] = 0.f;
#pragma unroll
            for (int i = 0; i < 4; ++i) ss[q] += (v[q][i].x * v[q][i].x + v[q][i].y * v[q][i].y) + (v[q][i].z * v[q][i].z + v[q][i].w * v[q][i].w); }
#pragma unroll
        for (int o = 1; o < 64; o <<= 1) { ss[0] += __shfl_xor(ss[0], o); ss[1] += __shfl_xor(ss[1], o); }
#pragma unroll
        for (int q = 0; q < 2; ++q) { const int row = rowA + q, b = row / SEQ; const float rstd = 1.0f / sqrtf(ss[q] * (1.0f / DM) + EPS);
            if (FINAL) { const f32x4* g = (const f32x4*)F_final_g + F.lane; f32x4* xo = (f32x4*)(F_OUT + (size_t)row * DM) + F.lane;
#pragma unroll
                for (int i = 0; i < 4; ++i) xo[64 * i] = v[q][i] * rstd * g[64 * i];
            } else { const f32x4* g = (const f32x4*)(F_norm1_g + (size_t)l * DM) + F.lane; const float* modb = F_MOD + ((size_t)l * NB + b) * 6144;
                const f32x4* sh = (const f32x4*)modb + F.lane; const f32x4* sc = (const f32x4*)(modb + 1024) + F.lane; u32x2* ho = (u32x2*)(F_H + (size_t)row * DM) + F.lane;
#pragma unroll
                for (int i = 0; i < 4; ++i) { const f32x4 hv = v[q][i] * rstd * g[64 * i] * (sc[64 * i] + 1.0f) + sh[64 * i]; u32x2 o; o.x = pk2(hv.x, hv.y); o.y = pk2(hv.z, hv.w); ho[64 * i] = o; } } }
    }
}

__device__ __forceinline__ void norm2_router_phase(Frame& F, int l) {
    LAS int* l_ent = (LAS int*)F.lds;
    LAS int* l_exp = l_ent + 256;
    LAS int* l_cnt = l_exp + 256;
    LAS int* l_base = l_cnt + 32;
    LAS float* lgs = (LAS float*)(F.lds + 4096 + F.wave * 3072);
    if (F.tid < 32) l_cnt[F.tid] = 0;
    __syncthreads();
    const int fr = F.lane & 15, fq = F.lane >> 4;
    const int row = F.blk * 128 + F.wave * 16 + fr, b = (F.blk * 128) / SEQ;
    const bf16* xr = F_XB + (size_t)row * DM + fq * 8;
    float ss; { const f32x4 q = *(const f32x4*)(F_SSQ + (size_t)row * 16 + fq * 4); ss = (q.x + q.y) + (q.z + q.w); }
    ss += __shfl_xor(ss, 16); ss += __shfl_xor(ss, 32);
    const float rstd = 1.0f / sqrtf(ss * (1.0f / DM) + EPS);
    const float* gp = F_norm2_g + (size_t)l * DM + fq * 8;
    const float* shp = F_MOD + ((size_t)l * NB + b) * 6144 + 3072 + fq * 8; const float* scp = shp + 1024;
    const bf16* wb = F_WRHL + (size_t)l * 2 * 48 * DM + (size_t)fr * DM + fq * 8;
    bf16* hrow = F_H + (size_t)row * DM + fq * 8;
    f32x4 acc[3];
#pragma unroll
    for (int t = 0; t < 3; ++t) acc[t] = (f32x4){0.f, 0.f, 0.f, 0.f};
    struct RStep { u32x4 xw; f32x4 g0, g1, s0, s1, h0, h1; bf16x8 bh[3], bl[3]; };
#define R_LOAD(S, ks) do { S.xw = xall[ks]; S.g0 = *(const f32x4*)(gp + (ks) * 32); S.g1 = *(const f32x4*)(gp + (ks) * 32 + 4); \
        S.s0 = *(const f32x4*)(scp + (ks) * 32); S.s1 = *(const f32x4*)(scp + (ks) * 32 + 4); S.h0 = *(const f32x4*)(shp + (ks) * 32); S.h1 = *(const f32x4*)(shp + (ks) * 32 + 4); \
        _Pragma("unroll") for (int t = 0; t < 3; ++t) { S.bh[t] = *(const bf16x8*)(wb + (size_t)(t * 16) * DM + (ks) * 32); S.bl[t] = *(const bf16x8*)(wb + (size_t)(48 + t * 16) * DM + (ks) * 32); } } while (0)
#define R_COMP(S, ks) do { \
        const f32x4 a = (f32x4){bf2f(S.xw.x & 0xffffu), bf2f(S.xw.x >> 16), bf2f(S.xw.y & 0xffffu), bf2f(S.xw.y >> 16)}, c = (f32x4){bf2f(S.xw.z & 0xffffu), bf2f(S.xw.z >> 16), bf2f(S.xw.w & 0xffffu), bf2f(S.xw.w >> 16)}; \
        const f32x4 v0 = a * rstd * S.g0 * (S.s0 + 1.0f) + S.h0, v1 = c * rstd * S.g1 * (S.s1 + 1.0f) + S.h1; \
        u32x4 hi; hi.x = pk2(v0.x, v0.y); hi.y = pk2(v0.z, v0.w); hi.z = pk2(v1.x, v1.y); hi.w = pk2(v1.z, v1.w); \
        *(u32x4*)(hrow + (ks) * 32) = hi; \
        u32x4 lo; lo.x = pk2(v0.x - bf2f(hi.x & 0xffffu), v0.y - bf2f(hi.x >> 16)); lo.y = pk2(v0.z - bf2f(hi.y & 0xffffu), v0.w - bf2f(hi.y >> 16)); \
        lo.z = pk2(v1.x - bf2f(hi.z & 0xffffu), v1.y - bf2f(hi.z >> 16)); lo.w = pk2(v1.z - bf2f(hi.w & 0xffffu), v1.w - bf2f(hi.w >> 16)); \
        const bf16x8 ahi = __builtin_bit_cast(bf16x8, hi), alo = __builtin_bit_cast(bf16x8, lo); \
        _Pragma("unroll") for (int t = 0; t < 3; ++t) { \
            acc[t] = __builtin_amdgcn_mfma_f32_16x16x32_bf16(S.bh[t], ahi, acc[t], 0, 0, 0); \
            acc[t] = __builtin_amdgcn_mfma_f32_16x16x32_bf16(S.bh[t], alo, acc[t], 0, 0, 0); \
            acc[t] = __builtin_amdgcn_mfma_f32_16x16x32_bf16(S.bl[t], ahi, acc[t], 0, 0, 0); } } while (0)
    {
        u32x4 xall[32];
#pragma unroll
        for (int ks = 0; ks < 32; ++ks) xall[ks] = *(const u32x4*)(xr + ks * 32);
        RStep SA, SB;
        R_LOAD(SA, 0);
#pragma unroll
        for (int ks = 0; ks < 32; ks += 2) {
            R_LOAD(SB, ks + 1);
            R_COMP(SA, ks);
            if (ks + 2 < 32) R_LOAD(SA, ks + 2);
            R_COMP(SB, ks + 1);
        }
    }
#undef R_LOAD
#undef R_COMP
#pragma unroll
    for (int t = 0; t < 3; ++t)
#pragma unroll
        for (int r = 0; r < 4; ++r) lgs[fr * 48 + t * 16 + 4 * fq + r] = acc[t][r];
    LDS_WAIT(); __builtin_amdgcn_wave_barrier();
    {
        const LAS float* wl = lgs + fr * 48;
        float gl[4];
#pragma unroll
        for (int j = 0; j < 4; ++j) gl[j] = wl[j] + F_b_group[l * 4 + j];
        int gi = 0; float gm = gl[0];
#pragma unroll
        for (int j = 1; j < 4; ++j) if (gl[j] > gm) { gm = gl[j]; gi = j; }
        float gs = 0.f;
#pragma unroll
        for (int j = 0; j < 4; ++j) gs += __expf(gl[j] - gm);
        const float gw = 1.0f / gs;
        float ig[8];
#pragma unroll
        for (int j = 0; j < 8; ++j) ig[j] = wl[4 + gi * 8 + j] + F_b_expert[l * 32 + gi * 8 + j];
        int i0 = 0; float v0 = ig[0];
#pragma unroll
        for (int j = 1; j < 8; ++j) if (ig[j] > v0) { v0 = ig[j]; i0 = j; }
        int i1 = -1; float v1 = -3.0e38f;
#pragma unroll
        for (int j = 0; j < 8; ++j) if (j != i0 && ig[j] > v1) { v1 = ig[j]; i1 = j; }
        const float e1x = __expf(v1 - v0), w0 = gw / (1.0f + e1x), w1 = gw * e1x / (1.0f + e1x);
        if (fq == 0) { F_RW[(size_t)row * 2] = w0; F_RW[(size_t)row * 2 + 1] = w1;
            const int lr = F.wave * 16 + fr; l_ent[lr * 2] = row * 2; l_ent[lr * 2 + 1] = row * 2 + 1; l_exp[lr * 2] = gi * 8 + i0; l_exp[lr * 2 + 1] = gi * 8 + i1; }
    }
    __syncthreads();
    int rank = 0, e = 0;
    if (F.tid < 256) { e = l_exp[F.tid]; rank = atomicAdd((int*)&l_cnt[e], 1); }
    __syncthreads();
    if (F.tid < 32) l_base[F.tid] = (int)atomicAdd(F_ctl + CW_CNT + l * 32 + F.tid, (unsigned)l_cnt[F.tid]);
    __syncthreads();
    if (F.tid < 256) F_LIST[(size_t)e * NT + l_base[e] + rank] = l_ent[F.tid];
    __syncthreads();
}


struct GateOrder {
    int blk; const char* A; const char* Bt;
    __device__ __forceinline__ bool next(int i, pg8::Unit& u) const { if (i != 0 || blk < 64 || blk >= 192) return false; u.pm = blk - 64; u.pn = 10; u.e = 0; u.i = 0; return true; }
    __device__ __forceinline__ const char* a_base(const pg8::Unit& u) const { return A + (size_t)u.pm * (256 * DM * 2); }
    __device__ __forceinline__ const char* b_base(const pg8::Unit& u) const { return Bt + (size_t)u.pn * (256 * DM * 2); }
    __device__ __forceinline__ int row(const pg8::Unit&, int r) const { return r; }
};

constexpr int MOE_LDS = 131072;
constexpr int MOE_MAXU = 8;
struct MoeOrder {
    LAS const int* ud; LAS const int* rows; const char* A; const char* Bt; size_t strideE, tstepA, tstepB; bool gather;
    __device__ __forceinline__ bool next(int i, pg8::Unit& u) const { if (i >= MOE_MAXU || ud[i * 4 + 3] == 0) return false; u.pm = ud[i * 4]; u.pn = ud[i * 4 + 1]; u.e = ud[i * 4 + 2]; u.i = i; return true; }
    __device__ __forceinline__ const char* a_base(const pg8::Unit& u) const { return gather ? A : A + (size_t)u.pm * tstepA; }
    __device__ __forceinline__ const char* b_base(const pg8::Unit& u) const { return Bt + (size_t)u.e * strideE + (size_t)u.pn * tstepB; }
    __device__ __forceinline__ int row(const pg8::Unit& u, int r) const { if (!gather) return r; const int ent = rows[u.i * 256 + r]; return ent >= 0 ? (ent >> 1) : 0; }
};
struct EpiMoe1 {
    static constexpr bool PERM = true;
    bf16* act; const float* rw; LAS const int* rows;
    __device__ __forceinline__ void operator()(const f32x4 (&acc)[2][2][4][2], const pg8::Unit& u, int wr, int wc, int fr, int fq) const {
#pragma unroll
        for (int ai = 0; ai < 2; ++ai)
#pragma unroll
            for (int m = 0; m < 4; ++m) { const int rl = ai * 128 + wr * 64 + m * 16 + fr; const int ent = rows[u.i * 256 + rl]; const float w = ent >= 0 ? rw[ent] : 0.f;
                const f32x4 g0 = acc[ai][0][m][0], g1 = acc[ai][0][m][1], u0 = acc[ai][1][m][0], u1 = acc[ai][1][m][1];
                u32x4 o; o.x = pg8::cvt_pk_bf16(silu_f(g0[0]) * u0[0] * w, silu_f(g0[1]) * u0[1] * w); o.y = pg8::cvt_pk_bf16(silu_f(g0[2]) * u0[2] * w, silu_f(g0[3]) * u0[3] * w);
                o.z = pg8::cvt_pk_bf16(silu_f(g1[0]) * u1[0] * w, silu_f(g1[1]) * u1[1] * w); o.w = pg8::cvt_pk_bf16(silu_f(g1[2]) * u1[2] * w, silu_f(g1[3]) * u1[3] * w);
                *(u32x4*)(act + ((size_t)u.pm * 256 + rl) * FF + u.pn * 128 + wc * 32 + 8 * fq) = o; }
    }
};
struct EpiMoe2 {
    static constexpr bool PERM = true;
    bf16* slot; LAS const int* rows;
    __device__ __forceinline__ void operator()(const f32x4 (&acc)[2][2][4][2], const pg8::Unit& u, int wr, int wc, int fr, int fq) const {
#pragma unroll
        for (int ai = 0; ai < 2; ++ai)
#pragma unroll
            for (int m = 0; m < 4; ++m) { const int rl = ai * 128 + wr * 64 + m * 16 + fr; const int ent = rows[u.i * 256 + rl];
                if (ent >= 0) { bf16* rowp = slot + (size_t)(ent & 1) * NT * DM + (size_t)(ent >> 1) * DM + u.pn * 256 + wc * 32 + 8 * fq;
#pragma unroll
                    for (int bj = 0; bj < 2; ++bj) { const f32x4 v0 = acc[ai][bj][m][0], v1 = acc[ai][bj][m][1];
                        u32x4 w; w.x = pg8::cvt_pk_bf16(v0[0], v0[1]); w.y = pg8::cvt_pk_bf16(v0[2], v0[3]); w.z = pg8::cvt_pk_bf16(v1[0], v1[1]); w.w = pg8::cvt_pk_bf16(v1[2], v1[3]);
                        *(u32x4*)(rowp + bj * 128) = w; } } }
    }
};
struct MoeDeal { int nA, nB, NL, q, ls, nAfull; bool defer; };
__device__ __forceinline__ MoeDeal moe_deal(int tiles, int G) {
    MoeDeal d; d.nA = tiles * 2; d.nB = tiles * 4; d.nAfull = (d.nA / G) * G; d.NL = d.nA - d.nAfull; d.q = (d.nB + 2 * d.NL + G - 1) / G; d.ls = d.q - 3 < 2 ? 2 : d.q - 3;
    d.defer = (G == 256) && d.NL > 0 && d.NL <= 64 && d.q >= 4 && d.nAfull > 0 && d.ls <= MOE_MAXU && d.NL * d.ls <= d.nB && (d.nB - d.NL * d.ls + (G - d.NL) - 1) / (G - d.NL) <= MOE_MAXU; return d;
}
constexpr int CW_MB = 28672;
template <int STAGE>
__device__ __forceinline__ void moe_pg8(Frame& F, int l) {
    LAS int* t_cnt = (LAS int*)(F.lds + MOE_LDS);
    LAS int* t_toff = t_cnt + 32;
    LAS int* ud = t_toff + 36;
    LAS int* rows = ud + 32;
    int tid_m = threadIdx.x; asm volatile("" : "+v"(tid_m));
    __syncthreads();
    if (tid_m == 0) { int to = 0;
        for (int e = 0; e < NE; ++e) { const int c = (int)__hip_atomic_load(F_ctl + CW_CNT + l * 32 + e, __ATOMIC_RELAXED, __HIP_MEMORY_SCOPE_AGENT); t_cnt[e] = c; t_toff[e] = to; to += (c + 255) >> 8; }
        t_toff[NE] = to; }
    __syncthreads();
    const MoeDeal D = moe_deal(t_toff[NE], F.G);
#define MOE_SLOT(i, L, valid, NPN_) do { int rtg = 0, pn = 0, e = 0; \
        if (valid) { rtg = (L) / (NPN_); pn = (L) % (NPN_); for (int q_ = 1; q_ < NE; ++q_) if (t_toff[q_] <= rtg) e = q_; } \
        if (tid_m == 0) { ud[(i) * 4] = rtg; ud[(i) * 4 + 1] = pn; ud[(i) * 4 + 2] = e; ud[(i) * 4 + 3] = (valid) ? 1 : 0; } \
        if (tid_m < 256) { int ent = -1; if (valid) { const int pos = (rtg - t_toff[e]) * 256 + tid_m; if (pos < t_cnt[e]) ent = F_LIST[(size_t)e * NT + pos]; } rows[(i) * 256 + tid_m] = ent; } } while (0)
    MoeOrder S; S.ud = ud; S.rows = rows;
    if (STAGE == 1 || (D.defer && F.blk < D.NL)) {
        const int nlim = D.defer ? D.nAfull : D.nA;
        for (int i = 0; i < MOE_MAXU; ++i) { int L; bool valid;
            if (STAGE == 1) { L = i * F.G + F.blk; valid = L < nlim; } else { L = D.nAfull + F.blk; valid = (i == 0); }
            MOE_SLOT(i, L, valid, 2); }
        __syncthreads();
        S.A = (const char*)F_H; S.Bt = (const char*)(F_WguT + (size_t)l * NE * 512 * DM); S.strideE = (size_t)512 * DM * 2; S.tstepA = 0; S.tstepB = (size_t)256 * DM * 2; S.gather = true;
        EpiMoe1 E{F_ACT, F_RW, rows};
        pg8::gemm_phase<EpiMoe1, MoeOrder, true>(F.lds, DM, DM, DM, S, E);
        if (STAGE == 2) {
            asm volatile("s_waitcnt vmcnt(0)" ::: "memory"); __syncthreads();
            if (tid_m == 0) { unsigned* mb = F_ctl + CW_MB + l * 64;
                __builtin_amdgcn_fence(__ATOMIC_RELEASE, "agent"); asm volatile("s_waitcnt vmcnt(0)" ::: "memory");
                (void)__hip_atomic_fetch_add(mb, 1u, __ATOMIC_RELAXED, __HIP_MEMORY_SCOPE_AGENT);
                unsigned sp = 0; while (__hip_atomic_load(mb, __ATOMIC_RELAXED, __HIP_MEMORY_SCOPE_AGENT) < (unsigned)D.NL) { __builtin_amdgcn_s_sleep(1); if (++sp > (1u << 22)) break; }
                __builtin_amdgcn_fence(__ATOMIC_ACQUIRE, "agent"); asm volatile("s_waitcnt vmcnt(0)" ::: "memory"); }
            __syncthreads();
        }
    }
    if (STAGE == 2) {
        for (int i = 0; i < MOE_MAXU; ++i) { int L; bool valid;
            if (!D.defer) { L = i * F.G + F.blk; valid = L < D.nB; }
            else if (F.blk < D.NL) { L = D.nB - (F.blk + 1) * D.ls + i; valid = i < D.ls; }
            else { L = (F.blk - D.NL) + (F.G - D.NL) * i; valid = L < D.nB - D.NL * D.ls; }
            MOE_SLOT(i, L, valid, 4); }
        __syncthreads();
        S.A = (const char*)F_ACT; S.Bt = (const char*)(F_WdT + (size_t)l * NE * DM * FF); S.strideE = (size_t)DM * FF * 2; S.tstepA = (size_t)256 * FF * 2; S.tstepB = (size_t)256 * FF * 2; S.gather = false;
        EpiMoe2 E{F_SLOT, rows};
        pg8::gemm_phase<EpiMoe2, MoeOrder, false>(F.lds, FF, FF, FF, S, E);
    }
#undef MOE_SLOT
}

__device__ __forceinline__ void s5_build_operands(Frame& F, int l) {
    const int gt = F.blk * NTHR + F.tid, ngt = F.G * NTHR;
    for (int i = gt; i < 16 * 1024 * 16; i += ngt) {
        const int kv = i & 15, row = (i >> 4) & 1023, g = i >> 14, t = row >> 4, c = row & 15, k0 = kv * 8;
        const int lg = l * 16 + g, p0 = k0 & 63;
        const f32x4* pwp = (const f32x4*)(F_PW + ((size_t)lg * 65 + t + 1) * 64 + p0);
        const f32x4* crp = (const f32x4*)(F_c_re + ((size_t)lg * 16 + c) * 64 + p0); const f32x4* cip = (const f32x4*)(F_c_im + ((size_t)lg * 16 + c) * 64 + p0);
        const f32x4 w0 = pwp[0], w1 = pwp[1], w2 = pwp[2], w3 = pwp[3], cr0 = crp[0], cr1 = crp[1], ci0 = cip[0], ci1 = cip[1];
        const float pr[8] = {w0.x, w0.z, w1.x, w1.z, w2.x, w2.z, w3.x, w3.z}, pi[8] = {w0.y, w0.w, w1.y, w1.w, w2.y, w2.w, w3.y, w3.w};
        const float cr[8] = {cr0.x, cr0.y, cr0.z, cr0.w, cr1.x, cr1.y, cr1.z, cr1.w}, ci[8] = {ci0.x, ci0.y, ci0.z, ci0.w, ci1.x, ci1.y, ci1.z, ci1.w};
        float v[8];
#pragma unroll
        for (int q = 0; q < 8; ++q) v[q] = (k0 < 64) ? (cr[q] * pr[q] - ci[q] * pi[q]) : -(cr[q] * pi[q] + ci[q] * pr[q]);
        u32x4 o; o.x = pk2(v[0], v[1]); o.y = pk2(v[2], v[3]); o.z = pk2(v[4], v[5]); o.w = pk2(v[6], v[7]);
        *(u32x4*)(F_TMAT + ((size_t)(g * 1024 + row)) * 128 + k0) = o;
    }
    for (int i = gt; i < 16 * 256 * 128; i += ngt) {
        const int kv = i & 127, n = (i >> 7) & 255, g = i >> 15, s = kv >> 1, c0 = (kv & 1) * 8;
        float v[8];
#pragma unroll
        for (int q = 0; q < 8; ++q) v[q] = 0.f;
        if (n < 128) { const int p = n & 63, lg = l * 16 + g; const f32x2 pv = F_PW[((size_t)lg * 65 + (63 - s)) * 64 + p]; const float pr = pv.x, pi = pv.y;
#pragma unroll
            for (int q = 0; q < 8; ++q) { const f32x2 bb = F_BBAR[((size_t)lg * 64 + p) * 16 + c0 + q]; v[q] = (n < 64) ? (pr * bb.x - pi * bb.y) : (pr * bb.y + pi * bb.x); } }
        u32x4 o; o.x = pk2(v[0], v[1]); o.y = pk2(v[2], v[3]); o.z = pk2(v[4], v[5]); o.w = pk2(v[6], v[7]);
        *(u32x4*)(F_BT1 + ((size_t)(g * 256 + n)) * 1024 + s * 16 + c0) = o;
    }
}
struct GroupOrder {
    int G, c, npn, nunit; const char* A; const char* Bt; size_t strideB, tstepA, tstepB;
    __device__ __forceinline__ bool next(int i, pg8::Unit& u) const { const int L = i * G + c; if (L >= nunit) return false; u.pn = L % npn; u.pm = (L / npn) & 1; u.e = L / (npn * 2); u.i = i; return true; }
    __device__ __forceinline__ const char* a_base(const pg8::Unit& u) const { return A + (size_t)u.e * (U2K * 2) + (size_t)u.pm * tstepA; }
    __device__ __forceinline__ const char* b_base(const pg8::Unit& u) const { return Bt + (size_t)u.e * strideB + (size_t)u.pn * tstepB; }
    __device__ __forceinline__ int row(const pg8::Unit&, int r) const { return r; }
};
struct SplitKOrder {
    int G, c; const char* A; const char* Bt;
    __device__ __forceinline__ bool next(int i, pg8::Unit& u) const { const int L = i * G + c; if (L >= 64) return false; u.pn = L & 1; u.pm = (L >> 1) & 1; u.e = L >> 2; u.i = i; return true; }
    __device__ __forceinline__ const char* a_base(const pg8::Unit& u) const { return A + (size_t)u.e * (U2K * 2) + (size_t)u.pm * ((size_t)256 * U2LD * 2) + (size_t)u.pn * 1024; }
    __device__ __forceinline__ const char* b_base(const pg8::Unit& u) const { return Bt + (size_t)u.e * ((size_t)256 * 1024 * 2) + (size_t)u.pn * 1024; }
    __device__ __forceinline__ int row(const pg8::Unit&, int r) const { return r; }
};
struct ToepOrder {
    int G, c, npn, nunit; const char* A; const char* Kb; const char* Ct; size_t tstepA;
    __device__ __forceinline__ bool next(int i, pg8::Unit& u) const { const int L = i * G + c; if (L >= nunit) return false; u.pn = L % npn; u.pm = (L / npn) & 1; u.e = L / (npn * 2); u.i = i; return true; }
    __device__ __forceinline__ const char* a_base(const pg8::Unit& u) const { return A + (size_t)u.e * (U2K * 2) + (size_t)u.pm * tstepA; }
    __device__ __forceinline__ const char* b_base(const pg8::Unit& u) const { return Kb + (size_t)u.e * (128 * 512) + (size_t)(u.pn * 16 + 61) * 512 + 4096; }
    __device__ __forceinline__ const char* c_base(const pg8::Unit& u) const { return Ct + (size_t)u.e * (1024 * 256) + (size_t)u.pn * (256 * 256); }
    __device__ __forceinline__ int row(const pg8::Unit&, int r) const { return r; }
};
struct EpiS5a {
    static constexpr bool PERM = false;
    float* sendp;
    __device__ __forceinline__ void operator()(const f32x4 (&acc)[2][2][4][2], const pg8::Unit& u, int wr, int wc, int fr, int fq) const {
#pragma unroll
        for (int ai = 0; ai < 2; ++ai)
#pragma unroll
            for (int m = 0; m < 4; ++m) { const int R = u.pm * 256 + ai * 128 + wr * 64 + m * 16 + fr; float* rowp = sendp + (size_t)u.pn * (512 * 16 * 128) + ((size_t)R * 16 + u.e) * 128 + wc * 32 + 4 * fq;
#pragma unroll
                for (int n = 0; n < 2; ++n) *(f32x4*)(rowp + n * 16) = acc[ai][0][m][n]; }
    }
};
struct EpiS5b {
    static constexpr bool PERM = true;
    bf16* yg;
    __device__ __forceinline__ void operator()(const f32x4 (&acc)[2][2][4][2], const pg8::Unit& u, int wr, int wc, int fr, int fq) const {
#pragma unroll
        for (int ai = 0; ai < 2; ++ai)
#pragma unroll
            for (int m = 0; m < 4; ++m) { const int R = u.pm * 256 + ai * 128 + wr * 64 + m * 16 + fr;
#pragma unroll
                for (int bj = 0; bj < 2; ++bj) { const int col0 = u.pn * 256 + bj * 128 + wc * 32 + 8 * fq, t = col0 >> 4, c0 = col0 & 15; const f32x4 v0 = acc[ai][bj][m][0], v1 = acc[ai][bj][m][1];
                    u32x4 w; w.x = pg8::cvt_pk_bf16(gelu_tanh_f(v0[0]), gelu_tanh_f(v0[1])); w.y = pg8::cvt_pk_bf16(gelu_tanh_f(v0[2]), gelu_tanh_f(v0[3]));
                    w.z = pg8::cvt_pk_bf16(gelu_tanh_f(v1[0]), gelu_tanh_f(v1[1])); w.w = pg8::cvt_pk_bf16(gelu_tanh_f(v1[2]), gelu_tanh_f(v1[3]));
                    *(u32x4*)(yg + ((size_t)R * 64 + t) * 256 + u.e * 16 + c0) = w; } }
    }
};
struct EpiGlu {
    static constexpr bool PERM = true;
    const bf16* yg; bf16* mix; const float* bglu;
    __device__ __forceinline__ void operator()(const f32x4 (&acc)[2][2][4][2], const pg8::Unit& u, int wr, int wc, int fr, int fq) const {
#pragma unroll
        for (int ai = 0; ai < 2; ++ai)
#pragma unroll
            for (int m = 0; m < 4; ++m) { const size_t row = (size_t)u.pm * 256 + ai * 128 + wr * 64 + m * 16 + fr;
#pragma unroll
                for (int bj = 0; bj < 2; ++bj) { const int col0 = bj * 128 + wc * 32 + 8 * fq; const u32x4 y = *(const u32x4*)(yg + row * 256 + col0);
                    const f32x4 b0 = *(const f32x4*)(bglu + col0), b1 = *(const f32x4*)(bglu + col0 + 4); const f32x4 v0 = acc[ai][bj][m][0] + b0, v1 = acc[ai][bj][m][1] + b1;
                    u32x4 w; w.x = pg8::cvt_pk_bf16(bf2f(y.x & 0xffffu) * sigmoid_f(v0[0]), bf2f(y.x >> 16) * sigmoid_f(v0[1])); w.y = pg8::cvt_pk_bf16(bf2f(y.y & 0xffffu) * sigmoid_f(v0[2]), bf2f(y.y >> 16) * sigmoid_f(v0[3]));
                    w.z = pg8::cvt_pk_bf16(bf2f(y.z & 0xffffu) * sigmoid_f(v1[0]), bf2f(y.z >> 16) * sigmoid_f(v1[1])); w.w = pg8::cvt_pk_bf16(bf2f(y.w & 0xffffu) * sigmoid_f(v1[2]), bf2f(y.w >> 16) * sigmoid_f(v1[3]));
                    *(u32x4*)(mix + row * DM + 512 + col0) = w; } }
    }
};

__device__ __forceinline__ float ret_log2gamma(int h) { return log2f(1.0f - exp2f(-5.0f - (float)h)); }

template <int NQT> __device__ __forceinline__ void attn_mfma(Frame& F, int l);
__device__ __forceinline__ void attn_coop(Frame& F, int l);
__device__ __forceinline__ void p4_scan_attn(Frame& F, int l) {
    LAS float* sst = (LAS float*)F.lds;
    { const int i0 = F.blk * 32, b = (i0 >> 10) & 7, g = (i0 >> 6) & 15, pb = i0 & 63;
#pragma unroll
        for (int j = 0; j < 2; ++j) { const int v = F.tid + j * NTHR, n = v >> 4, part = (v >> 3) & 1, q = v & 7; const size_t r = (size_t)(b * NCH + n) * 16 + g;
            const float* sp = F_SENDP + r * 128 + part * 64 + pb + q * 4; const f32x4 a = *(const f32x4*)sp, c = *(const f32x4*)(sp + 512 * 16 * 128);
            *(LAS f32x4*)(sst + (n * 2 + part) * 32 + q * 4) = a + c; } }
    __syncthreads();
    if (F.tid >= NTHR - 32) { const int tl = F.tid - (NTHR - 32), i = F.blk * 32 + tl;
        if (i < NB * 16 * 64) { const int b = i >> 10, g = (i >> 6) & 15, p = i & 63; const f32x2 a64 = F_ABAR64[l * 1024 + (i & 1023)];
            float xr = 0.f, xi = 0.f;
#pragma unroll 8
            for (int n = 0; n < NCH; ++n) { const size_t r = (size_t)(b * NCH + n) * 16 + g; bf16* cp = F_U2X + r * U2K; cp[p] = (bf16)f2bf(xr); cp[64 + p] = (bf16)f2bf(xi);
                const float sr = sst[(n * 2) * 32 + tl], si = sst[(n * 2 + 1) * 32 + tl];
                const float nr = a64.x * xr - a64.y * xi + sr, ni = a64.x * xi + a64.y * xr + si; xr = nr; xi = ni; } } }
    for (int i = F.blk * 256 + F.tid; F.tid < 256 && i < NB * 4 * 2048; i += F.G * 256) { const int b = i >> 13, h = (i >> 11) & 3, de2 = i & 2047; const float g64 = exp2f(64.f * ret_log2gamma(h));
        unsigned* p0 = (unsigned*)(F_KVB + ((size_t)(b * NCH * 4 + h)) * 4096) + de2; unsigned t[NCH];
#pragma unroll
        for (int n = 0; n < NCH; ++n) t[n] = p0[(size_t)n * 4 * 2048];
        float s0 = 0.f, s1 = 0.f;
#pragma unroll
        for (int n = 0; n < NCH; ++n) { const float v0 = bf2f(t[n] & 0xffffu), v1 = bf2f(t[n] >> 16); t[n] = pk2(s0, s1); s0 = g64 * s0 + v0; s1 = g64 * s1 + v1; }
#pragma unroll
        for (int n = 0; n < NCH; ++n) p0[(size_t)n * 4 * 2048] = t[n]; }
    __syncthreads();
    if (F.G == 256) attn_coop(F, l); else attn_mfma<ATTN_NQT>(F, l);
}


typedef short v4i16_t __attribute__((ext_vector_type(4)));
template <int NQT>
__device__ __forceinline__ void attn_mfma(Frame& F, int l) {
    const int lane = F.lane, fr = lane & 15, fq = lane >> 4;
    LAS unsigned char* vl = F.lds + F.wave * 10240;
    LAS float* bl = (LAS float*)(vl + 9216);
    constexpr int QPW = NQT * 16, TPC = 64 / QPW;
    constexpr float LOG2E = 1.4426950408889634f, SC = 0.125f * LOG2E;
    const int ntask = NB * NCH * 8 * TPC;
    const unsigned vtr0 = (unsigned)((4 * fq + (fr >> 2)) * 144 + (fr & 3) * 8);
    constexpr int WPC = 8 / TPC;
    const bool deal = (F.G == 256);
    const int nstep = deal ? 16 / WPC : (ntask + F.ngw - 1) / F.ngw;
    for (int step = 0; step < nstep; ++step) {
        int sub, h, n, b;
        if (deal) { const int j = F.blk >> 3; b = F.blk & 7; h = j >> 2; n = (j & 3) * 16 + step * WPC + F.wave / TPC; sub = F.wave % TPC; }
        else { const int task = F.gw + step * F.ngw; if (task >= ntask) break; sub = task % TPC; const int u = task / TPC; h = u & 7; n = (u >> 3) & 63; b = u >> 9; }
        const size_t qrow0 = (size_t)b * SEQ + n * 64 + sub * QPW;
        __builtin_amdgcn_wave_barrier();
#pragma unroll
        for (int i = 0; i < 3; ++i) bl[lane + 64 * i] = F_rel_bias[(size_t)(l * 8 + h) * 192 + lane + 64 * i] * LOG2E;
        bf16x8 qf[NQT][2];
#pragma unroll
        for (int qt = 0; qt < NQT; ++qt)
#pragma unroll
            for (int ks = 0; ks < 2; ++ks) qf[qt][ks] = *(const bf16x8*)(F_QKV + (qrow0 + qt * 16 + fr) * INW + C_QA + h * 64 + ks * 32 + fq * 8);
        f32x4 ot[4][NQT]; float lp[NQT];
#pragma unroll
        for (int qt = 0; qt < NQT; ++qt) { lp[qt] = 0.f;
#pragma unroll
            for (int et = 0; et < 4; ++et) ot[et][qt] = (f32x4){0.f, 0.f, 0.f, 0.f}; }
        LDS_WAIT(); __builtin_amdgcn_wave_barrier();
        const float b0 = bl[0];
        const int kc0 = n >= 8 ? n - 8 : 0;
        bf16x8 kf[4][2];
#pragma unroll
        for (int kt = 0; kt < 4; ++kt) { const bf16* kp = F_QKV + ((size_t)b * SEQ + kc0 * 64 + kt * 16 + fr) * INW + C_KA + h * 64 + fq * 8; kf[kt][0] = *(const bf16x8*)kp; kf[kt][1] = *(const bf16x8*)(kp + 32); }
        for (int kc = kc0; kc <= n; ++kc) {
            const size_t krow0 = (size_t)b * SEQ + kc * 64;
            u32x4 vreg[8];
#pragma unroll
            for (int i = 0; i < 8; ++i) vreg[i] = *(const u32x4*)(F_QKV + (krow0 + (lane >> 3) + 8 * i) * INW + C_VA + h * 64 + (lane & 7) * 8);
            bf16x8 kn[4][2];
            { const size_t krow1 = (size_t)b * SEQ + (kc < n ? kc + 1 : n) * 64;
#pragma unroll
                for (int kt = 0; kt < 4; ++kt) { const bf16* kp = F_QKV + (krow1 + kt * 16 + fr) * INW + C_KA + h * 64 + fq * 8; kn[kt][0] = *(const bf16x8*)kp; kn[kt][1] = *(const bf16x8*)(kp + 32); } }
            f32x4 st[4][NQT];
#pragma unroll
            for (int kt = 0; kt < 4; ++kt) {
#pragma unroll
                for (int qt = 0; qt < NQT; ++qt) { f32x4 z = (f32x4){0.f, 0.f, 0.f, 0.f};
                    z = __builtin_amdgcn_mfma_f32_16x16x32_bf16(kf[kt][0], qf[qt][0], z, 0, 0, 0); st[kt][qt] = __builtin_amdgcn_mfma_f32_16x16x32_bf16(kf[kt][1], qf[qt][1], z, 0, 0, 0); } }
            const int dc = kc - n;
            if (dc <= -3) {
#pragma unroll
                for (int kt = 0; kt < 4; ++kt)
#pragma unroll
                    for (int qt = 0; qt < NQT; ++qt) st[kt][qt] = st[kt][qt] * SC + b0;
            } else {
                const int ib = 64 * dc + 128 + 4 * fq - fr + sub * (-QPW);
#pragma unroll
                for (int kt = 0; kt < 4; ++kt)
#pragma unroll
                    for (int qt = 0; qt < NQT; ++qt)
#pragma unroll
                        for (int r = 0; r < 4; ++r) { int idx = ib + 16 * (kt - qt) + r; idx = idx < 0 ? 0 : idx; st[kt][qt][r] = st[kt][qt][r] * SC + bl[idx]; }
            }
#pragma unroll
            for (int qt = 0; qt < NQT; ++qt) { float ps = 0.f;
#pragma unroll
                for (int kt = 0; kt < 4; ++kt)
#pragma unroll
                    for (int r = 0; r < 4; ++r) { const float p = __builtin_amdgcn_exp2f(st[kt][qt][r]); st[kt][qt][r] = p; ps += p; }
                lp[qt] += ps; }
            __builtin_amdgcn_wave_barrier();
#pragma unroll
            for (int i = 0; i < 8; ++i) *(LAS u32x4*)(vl + ((lane >> 3) + 8 * i) * 144 + (lane & 7) * 16) = vreg[i];
            LDS_WAIT(); __builtin_amdgcn_wave_barrier();
#pragma unroll
            for (int s = 0; s < 2; ++s) {
                bf16x8 pf[NQT];
#pragma unroll
                for (int qt = 0; qt < NQT; ++qt) { u32x4 w; w.x = pg8::cvt_pk_bf16(st[2 * s][qt][0], st[2 * s][qt][1]); w.y = pg8::cvt_pk_bf16(st[2 * s][qt][2], st[2 * s][qt][3]);
                    w.z = pg8::cvt_pk_bf16(st[2 * s + 1][qt][0], st[2 * s + 1][qt][1]); w.w = pg8::cvt_pk_bf16(st[2 * s + 1][qt][2], st[2 * s + 1][qt][3]); pf[qt] = __builtin_bit_cast(bf16x8, w); }
#pragma unroll
                for (int et = 0; et < 4; ++et) {
                    const v4i16_t t0 = __builtin_amdgcn_ds_read_tr16_b64_v4i16((LAS v4i16_t*)(vl + vtr0 + (2 * s) * 16 * 144 + et * 32));
                    const v4i16_t t1 = __builtin_amdgcn_ds_read_tr16_b64_v4i16((LAS v4i16_t*)(vl + vtr0 + (2 * s + 1) * 16 * 144 + et * 32));
                    bf16x8 vf; vf[0] = t0[0]; vf[1] = t0[1]; vf[2] = t0[2]; vf[3] = t0[3]; vf[4] = t1[0]; vf[5] = t1[1]; vf[6] = t1[2]; vf[7] = t1[3];
#pragma unroll
                    for (int qt = 0; qt < NQT; ++qt) ot[et][qt] = __builtin_amdgcn_mfma_f32_16x16x32_bf16(vf, pf[qt], ot[et][qt], 0, 0, 0);
                }
            }
#pragma unroll
            for (int kt = 0; kt < 4; ++kt) { kf[kt][0] = kn[kt][0]; kf[kt][1] = kn[kt][1]; }
        }
#pragma unroll
        for (int qt = 0; qt < NQT; ++qt) { float ls = lp[qt]; ls += __shfl_xor(ls, 16); ls += __shfl_xor(ls, 32); const float inv = 1.0f / ls;
            bf16* op = F_MIX + (qrow0 + qt * 16 + fr) * DM + h * 64 + 4 * fq;
#pragma unroll
            for (int et = 0; et < 4; ++et) { const f32x4 o = ot[et][qt] * inv; u32x2 w; w.x = pk2(o.x, o.y); w.y = pk2(o.z, o.w); *(u32x2*)(op + et * 16) = w; } }
    }
}


__device__ __forceinline__ void attn_coop(Frame& F, int l) {
    const int lane = F.lane, fr = lane & 15, fq = lane >> 4, tid = F.tid, wave = F.wave;
    constexpr int PIT = 144, TILE = 64 * PIT, BUF = 2 * TILE;
    LAS unsigned char* base = F.lds;
    LAS float* bl = (LAS float*)(F.lds + 2 * BUF);
    constexpr float LOG2E = 1.4426950408889634f, SC = 0.125f * LOG2E;
    const unsigned vtr0 = (unsigned)((4 * fq + (fr >> 2)) * PIT + (fr & 3) * 8);
    const unsigned kfa = (unsigned)(fr * PIT + fq * 16);
    const int srow = tid >> 3, sch = tid & 7;
    const int b = F.blk & 7, jq = F.blk >> 3, h = jq >> 2, quarter = jq & 3, sub = wave & 1;
    for (int step = 0; step < 4; ++step) {
        const int n0 = quarter * 16 + step * 4, nw = n0 + (wave >> 1);
        const size_t qrow0 = (size_t)b * SEQ + nw * 64 + sub * 32;
        const int kcmin = n0 >= 8 ? n0 - 8 : 0, nit = n0 + 3 - kcmin + 1;
        __syncthreads();
        if (tid < 192) bl[tid] = F_rel_bias[(size_t)(l * 8 + h) * 192 + tid] * LOG2E;
        { const bf16* gp = F_QKV + ((size_t)b * SEQ + kcmin * 64 + srow) * INW + h * 64 + sch * 8;
            const u32x4 kk = *(const u32x4*)(gp + C_KA), vv = *(const u32x4*)(gp + C_VA);
            *(LAS u32x4*)(base + srow * PIT + sch * 16) = kk; *(LAS u32x4*)(base + TILE + srow * PIT + sch * 16) = vv; }
        bf16x8 qf[2][2];
#pragma unroll
        for (int qt = 0; qt < 2; ++qt)
#pragma unroll
            for (int ks = 0; ks < 2; ++ks) qf[qt][ks] = *(const bf16x8*)(F_QKV + (qrow0 + qt * 16 + fr) * INW + C_QA + h * 64 + ks * 32 + fq * 8);
        f32x4 ot[4][2]; float lp[2];
#pragma unroll
        for (int qt = 0; qt < 2; ++qt) { lp[qt] = 0.f;
#pragma unroll
            for (int et = 0; et < 4; ++et) ot[et][qt] = (f32x4){0.f, 0.f, 0.f, 0.f}; }
        __syncthreads();
        const float b0 = bl[0];
        for (int i = 0; i < nit; ++i) {
            const int kc = kcmin + i; const bool more = (i + 1 < nit);
            u32x4 kk, vv;
            if (more) { const bf16* gp = F_QKV + ((size_t)b * SEQ + (kc + 1) * 64 + srow) * INW + h * 64 + sch * 8; kk = *(const u32x4*)(gp + C_KA); vv = *(const u32x4*)(gp + C_VA); }
            LAS unsigned char* kb = base + (i & 1) * BUF; LAS unsigned char* vb = kb + TILE;
            if (kc >= nw - 8 && kc <= nw) {
                f32x4 st[4][2];
#pragma unroll
                for (int kt = 0; kt < 4; ++kt) { const bf16x8 k0 = *(const LAS bf16x8*)(kb + kfa + kt * 16 * PIT), k1 = *(const LAS bf16x8*)(kb + kfa + kt * 16 * PIT + 64);
#pragma unroll
                    for (int qt = 0; qt < 2; ++qt) { f32x4 z = (f32x4){0.f, 0.f, 0.f, 0.f};
                        z = __builtin_amdgcn_mfma_f32_16x16x32_bf16(k0, qf[qt][0], z, 0, 0, 0); st[kt][qt] = __builtin_amdgcn_mfma_f32_16x16x32_bf16(k1, qf[qt][1], z, 0, 0, 0); } }
                const int dc = kc - nw;
                if (dc <= -3) {
#pragma unroll
                    for (int kt = 0; kt < 4; ++kt)
#pragma unroll
                        for (int qt = 0; qt < 2; ++qt) st[kt][qt] = st[kt][qt] * SC + b0;
                } else {
                    const int ib = 64 * dc + 128 + 4 * fq - fr - sub * 32;
#pragma unroll
                    for (int kt = 0; kt < 4; ++kt)
#pragma unroll
                        for (int qt = 0; qt < 2; ++qt)
#pragma unroll
                            for (int r = 0; r < 4; ++r) { int idx = ib + 16 * (kt - qt) + r; idx = idx < 0 ? 0 : idx; st[kt][qt][r] = st[kt][qt][r] * SC + bl[idx]; }
                }
#pragma unroll
                for (int qt = 0; qt < 2; ++qt) { float ps = 0.f;
#pragma unroll
                    for (int kt = 0; kt < 4; ++kt)
#pragma unroll
                        for (int r = 0; r < 4; ++r) { const float p = __builtin_amdgcn_exp2f(st[kt][qt][r]); st[kt][qt][r] = p; ps += p; }
                    lp[qt] += ps; }
#pragma unroll
                for (int s = 0; s < 2; ++s) {
                    bf16x8 pf[2];
#pragma unroll
                    for (int qt = 0; qt < 2; ++qt) { u32x4 w; w.x = pg8::cvt_pk_bf16(st[2 * s][qt][0], st[2 * s][qt][1]); w.y = pg8::cvt_pk_bf16(st[2 * s][qt][2], st[2 * s][qt][3]);
                        w.z = pg8::cvt_pk_bf16(st[2 * s + 1][qt][0], st[2 * s + 1][qt][1]); w.w = pg8::cvt_pk_bf16(st[2 * s + 1][qt][2], st[2 * s + 1][qt][3]); pf[qt] = __builtin_bit_cast(bf16x8, w); }
#pragma unroll
                    for (int et = 0; et < 4; ++et) {
                        const v4i16_t t0 = __builtin_amdgcn_ds_read_tr16_b64_v4i16((LAS v4i16_t*)(vb + vtr0 + (2 * s) * 16 * PIT + et * 32));
                        const v4i16_t t1 = __builtin_amdgcn_ds_read_tr16_b64_v4i16((LAS v4i16_t*)(vb + vtr0 + (2 * s + 1) * 16 * PIT + et * 32));
                        bf16x8 vf; vf[0] = t0[0]; vf[1] = t0[1]; vf[2] = t0[2]; vf[3] = t0[3]; vf[4] = t1[0]; vf[5] = t1[1]; vf[6] = t1[2]; vf[7] = t1[3];
#pragma unroll
                        for (int qt = 0; qt < 2; ++qt) ot[et][qt] = __builtin_amdgcn_mfma_f32_16x16x32_bf16(vf, pf[qt], ot[et][qt], 0, 0, 0);
                    }
                }
            }
            if (more) { LAS unsigned char* nb = base + ((i + 1) & 1) * BUF; *(LAS u32x4*)(nb + srow * PIT + sch * 16) = kk; *(LAS u32x4*)(nb + TILE + srow * PIT + sch * 16) = vv; }
            __syncthreads();
        }
#pragma unroll
        for (int qt = 0; qt < 2; ++qt) { float ls = lp[qt]; ls += __shfl_xor(ls, 16); ls += __shfl_xor(ls, 32); const float inv = 1.0f / ls;
            bf16* op = F_MIX + (qrow0 + qt * 16 + fr) * DM + h * 64 + 4 * fq;
#pragma unroll
            for (int et = 0; et < 4; ++et) { const f32x4 o = ot[et][qt] * inv; u32x2 w; w.x = pk2(o.x, o.y); w.y = pk2(o.z, o.w); *(u32x2*)(op + et * 16) = w; } }
    }
}

__device__ __forceinline__ void unpack8(const u32x4 w, float (&x)[8]) { x[0] = bf2f(w.x & 0xffffu); x[1] = bf2f(w.x >> 16); x[2] = bf2f(w.y & 0xffffu); x[3] = bf2f(w.y >> 16); x[4] = bf2f(w.z & 0xffffu); x[5] = bf2f(w.z >> 16); x[6] = bf2f(w.w & 0xffffu); x[7] = bf2f(w.w >> 16); }
__device__ __forceinline__ u32x4 pack8(const float (&x)[8]) { u32x4 w; w.x = pk2(x[0], x[1]); w.y = pk2(x[2], x[3]); w.z = pk2(x[4], x[5]); w.w = pk2(x[6], x[7]); return w; }
__device__ __forceinline__ void rope8(const u32x4 a, const u32x4 b, const f32x2* cs, float scale, u32x4& o1, u32x4& o2) {
    float x1[8], x2[8], r1[8], r2[8]; unpack8(a, x1); unpack8(b, x2);
    const f32x4* c4 = (const f32x4*)cs;
#pragma unroll
    for (int q = 0; q < 4; ++q) { const f32x4 t = c4[q];
        r1[2 * q] = (x1[2 * q] * t.x - x2[2 * q] * t.y) * scale; r2[2 * q] = (x1[2 * q] * t.y + x2[2 * q] * t.x) * scale;
        r1[2 * q + 1] = (x1[2 * q + 1] * t.z - x2[2 * q + 1] * t.w) * scale; r2[2 * q + 1] = (x1[2 * q + 1] * t.w + x2[2 * q + 1] * t.z) * scale; }
    o1 = pack8(r1); o2 = pack8(r2);
}
__device__ __forceinline__ bf16x8 tr_frag(LAS unsigned char* p0, LAS unsigned char* p1) {
    const v4i16_t t0 = __builtin_amdgcn_ds_read_tr16_b64_v4i16((LAS v4i16_t*)p0), t1 = __builtin_amdgcn_ds_read_tr16_b64_v4i16((LAS v4i16_t*)p1);
    bf16x8 f; f[0] = t0[0]; f[1] = t0[1]; f[2] = t0[2]; f[3] = t0[3]; f[4] = t1[0]; f[5] = t1[1]; f[6] = t1[2]; f[7] = t1[3]; return f;
}
__device__ __forceinline__ void ret_kv_mfma(Frame& F, int l) {
    const int lane = F.lane, fr = lane & 15, fq = lane >> 4;
    constexpr int PIT = 136;
    LAS unsigned char* kt = F.lds + F.wave * (2 * 64 * PIT);
    LAS unsigned char* vt = kt + 64 * PIT;
    const unsigned tr0 = (unsigned)((4 * fq + (fr >> 2)) * PIT + (fr & 3) * 8);
    int u0, ustride, ucnt;
    if (F.G != 256) { u0 = F.gw; ustride = F.ngw; ucnt = (NB * NCH * 4 - u0 + ustride - 1) / ustride; }
    else if (F.blk < 64) { u0 = F.blk * NWAVES + F.wave; ustride = 0; ucnt = 1; }
    else if (F.blk >= 192) { u0 = 512 + (F.blk - 192) * NWAVES + F.wave; ustride = 512; ucnt = 3; }
    else return;
    for (int ui = 0; ui < ucnt; ++ui) { const int u = u0 + ui * ustride;
        const int h = u & 3, n = (u >> 2) & 63, b = u >> 8; const float lg = ret_log2gamma(h);
        const size_t row = (size_t)b * SEQ + n * 64 + lane;
        const bf16* kp = F_QKV + row * INW + C_KR + h * 64; const bf16* vp = F_QKV + row * INW + C_VR + h * 64;
        const f32x2* rp = F_ROPE + (size_t)(n * 64 + lane) * 32;
        const float zs = 0.125f * exp2f(lg * (float)(63 - lane));
        __builtin_amdgcn_wave_barrier();
#pragma unroll
        for (int dq = 0; dq < 4; ++dq) { u32x4 o1, o2; rope8(*(const u32x4*)(kp + dq * 8), *(const u32x4*)(kp + 32 + dq * 8), rp + dq * 8, zs, o1, o2);
            LAS u32x2* w1 = (LAS u32x2*)(kt + lane * PIT + dq * 16); LAS u32x2* w2 = (LAS u32x2*)(kt + lane * PIT + 64 + dq * 16);
            w1[0] = (u32x2){o1.x, o1.y}; w1[1] = (u32x2){o1.z, o1.w}; w2[0] = (u32x2){o2.x, o2.y}; w2[1] = (u32x2){o2.z, o2.w}; }
#pragma unroll
        for (int c = 0; c < 8; ++c) { const u32x4 v = *(const u32x4*)(vp + c * 8); LAS u32x2* w = (LAS u32x2*)(vt + lane * PIT + c * 16); w[0] = (u32x2){v.x, v.y}; w[1] = (u32x2){v.z, v.w}; }
        LDS_WAIT(); __builtin_amdgcn_wave_barrier();
        f32x4 acc[4][4];
#pragma unroll
        for (int i = 0; i < 4; ++i)
#pragma unroll
            for (int j = 0; j < 4; ++j) acc[i][j] = (f32x4){0.f, 0.f, 0.f, 0.f};
#pragma unroll
        for (int s = 0; s < 2; ++s) {
            bf16x8 kf[4];
#pragma unroll
            for (int dt = 0; dt < 4; ++dt) kf[dt] = tr_frag(kt + tr0 + (2 * s) * 16 * PIT + dt * 32, kt + tr0 + (2 * s + 1) * 16 * PIT + dt * 32);
#pragma unroll
            for (int et = 0; et < 4; ++et) { const bf16x8 vf = tr_frag(vt + tr0 + (2 * s) * 16 * PIT + et * 32, vt + tr0 + (2 * s + 1) * 16 * PIT + et * 32);
#pragma unroll
                for (int dt = 0; dt < 4; ++dt) acc[et][dt] = __builtin_amdgcn_mfma_f32_16x16x32_bf16(kf[dt], vf, acc[et][dt], 0, 0, 0); }
        }
        bf16* o = F_KVB + (size_t)u * 4096;
#pragma unroll
        for (int et = 0; et < 4; ++et)
#pragma unroll
            for (int dt = 0; dt < 4; ++dt) { u32x2 w; w.x = pk2(acc[et][dt][0], acc[et][dt][1]); w.y = pk2(acc[et][dt][2], acc[et][dt][3]); *(u32x2*)(o + (et * 16 + fr) * 64 + dt * 16 + 4 * fq) = w; }
    }
}
__device__ __forceinline__ void ret_out_mfma(Frame& F, int l) {
    const int lane = F.lane, fr = lane & 15, fq = lane >> 4;
    constexpr int PIT = 144;
    LAS unsigned char* vt = F.lds + F.wave * (64 * PIT);
    const unsigned tr0 = (unsigned)((4 * fq + (fr >> 2)) * PIT + (fr & 3) * 8);
    const int skip = (F.G == 256) ? 128 : 0;
    if (F.blk < skip) return;
    for (int u = (F.blk - skip) * NWAVES + F.wave; u < NB * NCH * 4; u += (F.G - skip) * NWAVES) {
        const int h = u & 3, n = (u >> 2) & 63, b = u >> 8; const float lg = ret_log2gamma(h);
        const size_t row0 = (size_t)b * SEQ + n * 64;
        __builtin_amdgcn_wave_barrier();
#pragma unroll
        for (int i = 0; i < 8; ++i) { const u32x4 v = *(const u32x4*)(F_QKV + (row0 + (lane >> 3) + 8 * i) * INW + C_VR + h * 64 + (lane & 7) * 8); *(LAS u32x4*)(vt + ((lane >> 3) + 8 * i) * PIT + (lane & 7) * 16) = v; }
        bf16x8 kf[4][2];
#pragma unroll
        for (int jt = 0; jt < 4; ++jt) { const int j = jt * 16 + fr; u32x4 o1, o2;
            const bf16* kp = F_QKV + (row0 + j) * INW + C_KR + h * 64 + fq * 8; rope8(*(const u32x4*)kp, *(const u32x4*)(kp + 32), F_ROPE + (size_t)(n * 64 + j) * 32 + fq * 8, 0.125f, o1, o2);
            kf[jt][0] = __builtin_bit_cast(bf16x8, o1); kf[jt][1] = __builtin_bit_cast(bf16x8, o2); }
        LDS_WAIT(); __builtin_amdgcn_wave_barrier();
        const bf16* prev = F_KVB + (size_t)u * 4096; const float* gng = F_gn_g + l * 256 + h * 64 + 4 * fq;
        bf16x8 pvf[4][2];
#pragma unroll
        for (int et = 0; et < 4; ++et)
#pragma unroll
            for (int ks = 0; ks < 2; ++ks) pvf[et][ks] = *(const bf16x8*)(prev + (et * 16 + fr) * 64 + ks * 32 + fq * 8);
#pragma unroll 1
        for (int hq = 0; hq < 2; ++hq) {
            bf16x8 qf[2][2];
#pragma unroll
            for (int it = 0; it < 2; ++it) { const int i = (2 * hq + it) * 16 + fr; u32x4 o1, o2;
                const bf16* qp = F_QKV + (row0 + i) * INW + C_QR + h * 64 + fq * 8; rope8(*(const u32x4*)qp, *(const u32x4*)(qp + 32), F_ROPE + (size_t)(n * 64 + i) * 32 + fq * 8, 1.0f, o1, o2);
                qf[it][0] = __builtin_bit_cast(bf16x8, o1); qf[it][1] = __builtin_bit_cast(bf16x8, o2); }
            u32x2 gwv[2][4]; f32x4 gnv[4];
#pragma unroll
            for (int et = 0; et < 4; ++et) { gnv[et] = *(const f32x4*)(gng + et * 16);
#pragma unroll
                for (int it = 0; it < 2; ++it) gwv[it][et] = *(const u32x2*)(F_QKV + (row0 + (2 * hq + it) * 16 + fr) * INW + C_GR + h * 64 + et * 16 + 4 * fq); }
            f32x4 st[4][2];
#pragma unroll
            for (int jt = 0; jt < 4; ++jt)
#pragma unroll
                for (int it = 0; it < 2; ++it) { f32x4 z = (f32x4){0.f, 0.f, 0.f, 0.f}; z = __builtin_amdgcn_mfma_f32_16x16x32_bf16(kf[jt][0], qf[it][0], z, 0, 0, 0); st[jt][it] = __builtin_amdgcn_mfma_f32_16x16x32_bf16(kf[jt][1], qf[it][1], z, 0, 0, 0); }
#pragma unroll
            for (int jt = 0; jt < 4; ++jt)
#pragma unroll
                for (int it = 0; it < 2; ++it)
#pragma unroll
                    for (int r = 0; r < 4; ++r) { const int dd = ((2 * hq + it) * 16 + fr) - (jt * 16 + 4 * fq + r); st[jt][it][r] = dd >= 0 ? st[jt][it][r] * exp2f(lg * (float)dd) : 0.f; }
            f32x4 yi[4][2], yc[4][2];
#pragma unroll
            for (int et = 0; et < 4; ++et)
#pragma unroll
                for (int it = 0; it < 2; ++it) { yi[et][it] = (f32x4){0.f, 0.f, 0.f, 0.f}; yc[et][it] = (f32x4){0.f, 0.f, 0.f, 0.f}; }
#pragma unroll
            for (int s = 0; s < 2; ++s) {
                bf16x8 pf[2];
#pragma unroll
                for (int it = 0; it < 2; ++it) { u32x4 w; w.x = pk2(st[2 * s][it][0], st[2 * s][it][1]); w.y = pk2(st[2 * s][it][2], st[2 * s][it][3]); w.z = pk2(st[2 * s + 1][it][0], st[2 * s + 1][it][1]); w.w = pk2(st[2 * s + 1][it][2], st[2 * s + 1][it][3]); pf[it] = __builtin_bit_cast(bf16x8, w); }
#pragma unroll
                for (int et = 0; et < 4; ++et) { const bf16x8 vf = tr_frag(vt + tr0 + (2 * s) * 16 * PIT + et * 32, vt + tr0 + (2 * s + 1) * 16 * PIT + et * 32);
#pragma unroll
                    for (int it = 0; it < 2; ++it) yi[et][it] = __builtin_amdgcn_mfma_f32_16x16x32_bf16(vf, pf[it], yi[et][it], 0, 0, 0); }
            }
#pragma unroll
            for (int et = 0; et < 4; ++et)
#pragma unroll
                for (int ks = 0; ks < 2; ++ks) {
#pragma unroll
                    for (int it = 0; it < 2; ++it) yc[et][it] = __builtin_amdgcn_mfma_f32_16x16x32_bf16(pvf[et][ks], qf[it][ks], yc[et][it], 0, 0, 0); }
#pragma unroll
            for (int it = 0; it < 2; ++it) { const int i = (2 * hq + it) * 16 + fr; const float xi = exp2f(lg * (float)(i + 1)); float s1 = 0.f;
#pragma unroll
                for (int et = 0; et < 4; ++et) { yi[et][it] = yi[et][it] + yc[et][it] * xi; s1 += (yi[et][it].x + yi[et][it].y) + (yi[et][it].z + yi[et][it].w); }
                s1 += __shfl_xor(s1, 16); s1 += __shfl_xor(s1, 32); const float mu = s1 * (1.0f / 64.0f); float s2 = 0.f;
#pragma unroll
                for (int et = 0; et < 4; ++et) { yi[et][it] = yi[et][it] - mu; s2 += (yi[et][it].x * yi[et][it].x + yi[et][it].y * yi[et][it].y) + (yi[et][it].z * yi[et][it].z + yi[et][it].w * yi[et][it].w); }
                s2 += __shfl_xor(s2, 16); s2 += __shfl_xor(s2, 32); const float rstd = 1.0f / sqrtf(s2 * (1.0f / 64.0f) + EPS);
#pragma unroll
                for (int et = 0; et < 4; ++et) { const int e0 = et * 16 + 4 * fq; const u32x2 gw = gwv[it][et]; const f32x4 gn = gnv[et];
                    const f32x4 y = yi[et][it] * rstd * gn; u32x2 w; w.x = pk2(silu_f(bf2f(gw.x & 0xffffu)) * y.x, silu_f(bf2f(gw.x >> 16)) * y.y); w.y = pk2(silu_f(bf2f(gw.y & 0xffffu)) * y.z, silu_f(bf2f(gw.y >> 16)) * y.w);
                    *(u32x2*)(F_MIX + (row0 + i) * DM + 768 + h * 64 + e0) = w; }
            }
        }
    }
}

struct Args { const float* in[28]; float* out; unsigned char* ws; int ph_lo, ph_hi; };
constexpr int NPHASE = 2 + NL * 10;

__global__ void __launch_bounds__(NTHR, 2) fwd_kernel(Args args) {
    extern __shared__ __attribute__((aligned(16))) unsigned char lds[];
    Frame F;
    F.lds = (LAS unsigned char*)lds;
    F.tid = threadIdx.x; F.lane = F.tid & 63; F.wave = __builtin_amdgcn_readfirstlane(F.tid >> 6); F.blk = blockIdx.x; F.G = gridDim.x;
    F.gw = F.blk * NWAVES + F.wave; F.ngw = F.G * NWAVES;
    F.out0 = args.out; F.ws0 = args.ws; F.wz = 0;
    F.ptab = (LAS unsigned long long*)(F.lds + LDS_BYTES - 64 - 256);
    if (F.tid == 0) {
#pragma unroll
        for (int i = 0; i < 28; ++i) F.ptab[i] = (unsigned long long)args.in[i];
    }
    LAS unsigned* misc = (LAS unsigned*)(F.lds + LDS_BYTES - 64);
    if (F.tid < 16) misc[F.tid] = 0u;
    __syncthreads();
    const int lo = args.ph_lo, hi = args.ph_hi;
    XcdBarrier bar; bar.bar = F_ctl + CW_BAR; bar.x = 0; bar.st = nullptr;
    if (hi - lo > 1) bar = xcd_barrier_post(F_ctl + CW_BAR, (volatile LAS unsigned*)misc);
#ifndef PH_ONLY
#define PH_ONLY -1
#endif
#define PSEL(j) (PH_ONLY < 0 || PH_ONLY == (j))
#define IN(k) (lo <= (k) && (k) < hi)
#define SEAM(k) do { if (IN(k) && IN((k) + 1)) xcd_barrier(bar); { int _t = threadIdx.x; asm volatile("" : "+v"(_t)); F.tid = _t; F.lane = _t & 63; asm volatile("" : "+s"(F.wz)); { unsigned _z = 0; asm volatile("" : "+s"(_z)); F.lds = (LAS unsigned char*)lds + _z; F.ptab = (LAS unsigned long long*)(F.lds + LDS_BYTES - 64 - 256); } asm volatile("" : "+s"(F.gw), "+s"(F.ngw), "+s"(F.blk), "+s"(F.G), "+s"(F.wave)); } } while (0)

#ifndef PROBE_PH
#define PROBE_PH -1
#endif
    volatile LAS unsigned long long* tpw = (volatile LAS unsigned long long*)(F.lds + LDS_BYTES - 32);
#define TPB(j) do { if (PROBE_PH == (j) && F.blk == 0 && F.tid == 0) tpw[1] = __builtin_amdgcn_s_memrealtime(); } while (0)
#define TPE(j) do { if (PROBE_PH == (j) && F.blk == 0 && F.tid == 0) tpw[0] = tpw[0] + (__builtin_amdgcn_s_memrealtime() - tpw[1]); } while (0)
    TPB(10); if (IN(0) && PSEL(10)) { p0_prologue(F); } SEAM(0); TPE(10);
    for (int l = 0; l < NL; ++l) {
        const int p = 1 + 10 * l;
        TPB(0); if (IN(p + 0) && PSEL(0)) { norm1_phase<false>(F, l); s5_build_operands(F, l); } SEAM(p + 0); TPE(0);
        TPB(1); if (IN(p + 1) && PSEL(1)) { pg8::StaticOrder S; S.init(F_H, DM, F_WinT + (size_t)l * INW * DM, DM, NT, (F.G == 256) ? INW - 256 : INW, F.G, F.blk); EpiQKV E{F_QKV, F_U2X};
            pg8::gemm_phase<EpiQKV, pg8::StaticOrder, false>(F.lds, DM, DM, DM, S, E); } SEAM(p + 1); TPE(1);
        TPB(2); if (IN(p + 2) && PSEL(2)) { ret_kv_mfma(F, l); __syncthreads();
            SplitKOrder S; S.G = F.G; S.c = F.blk; S.A = (const char*)(F_U2X + 128); S.Bt = (const char*)F_BT1;
            EpiS5a E{F_SENDP}; pg8::gemm_phase<EpiS5a, SplitKOrder, false>(F.lds, 512, U2LD, 1024, S, E);
            if (F.G == 256) { GateOrder SG; SG.blk = F.blk; SG.A = (const char*)F_H; SG.Bt = (const char*)(F_WinT + (size_t)l * INW * DM); EpiQKV EG{F_QKV, F_U2X};
                pg8::gemm_phase<EpiQKV, GateOrder, false>(F.lds, DM, DM, DM, SG, EG); } } SEAM(p + 2); TPE(2);
        TPB(3); if (IN(p + 3) && PSEL(3)) { p4_scan_attn(F, l); } SEAM(p + 3); TPE(3);
        TPB(4); if (IN(p + 4) && PSEL(4)) { ret_out_mfma(F, l); __syncthreads();
            ToepOrder S; S.G = F.G; S.c = F.blk; S.npn = 4; S.nunit = 128; S.A = (const char*)F_U2X; S.Kb = (const char*)(F_KERNB + (size_t)l * 16 * 128 * 256); S.Ct = (const char*)F_TMAT; S.tstepA = (size_t)256 * U2LD * 2;
            EpiS5b E{F_YG}; const int keff = (F.G == 256) ? 128 + 256 * ((F.blk & 3) + 1) : U2K;
            pg8::gemm_phase<EpiS5b, ToepOrder, false, true>(F.lds, keff, U2LD, 128, S, E); } SEAM(p + 4); TPE(4);
        TPB(5); if (IN(p + 5) && PSEL(5)) { pg8::StaticOrder S; S.init(F_YG, 256, F_WgluT + (size_t)l * 256 * 256, 256, NT, 256, F.G, F.blk); EpiGlu E{F_YG, F_MIX, F_b_glu + l * 256};
            pg8::gemm_phase<EpiGlu, pg8::StaticOrder, false>(F.lds, 256, 256, 256, S, E); } SEAM(p + 5); TPE(5);
        TPB(6); if (IN(p + 6) && PSEL(6)) { pg8::StaticOrder S; S.init(F_MIX, DM, F_WoutT + (size_t)l * DM * DM, DM, NT, DM, F.G, F.blk); EpiRes E{F_x, F_XB, F_MOD + (size_t)l * NB * 6144 + 2048, F_SSQ, l == 0 ? 1 : 0};
            pg8::gemm_phase<EpiRes, pg8::StaticOrder, false>(F.lds, DM, DM, DM, S, E); } SEAM(p + 6); TPE(6);
        TPB(7); if (IN(p + 7) && PSEL(7)) { norm2_router_phase(F, l); } SEAM(p + 7); TPE(7);
        TPB(8); if (IN(p + 8) && PSEL(8)) { moe_pg8<1>(F, l); } SEAM(p + 8); TPE(8);
        TPB(9); if (IN(p + 9) && PSEL(9)) { moe_pg8<2>(F, l); } SEAM(p + 9); TPE(9);
    }
    TPB(11); if (IN(NPHASE - 1) && PSEL(11)) { norm1_phase<true>(F, 0); } TPE(11);
    if (PROBE_PH >= 0 && F.blk == 0 && F.tid == 0) { const unsigned long long t1 = __builtin_amdgcn_s_memrealtime(); const unsigned long long tp_acc = tpw[0]; while (__builtin_amdgcn_s_memrealtime() - t1 < 4ull * tp_acc) __builtin_amdgcn_s_sleep(8); }
#undef IN
#undef SEAM
}

extern "C" void kernel_launch(void* const* d_in, const int* in_sizes, int n_in, void* d_out, int out_size, void* d_ws, size_t ws_size, hipStream_t stream) {
    static int grid = 0;
    if (grid == 0) {
        if (n_in != 28 || in_sizes[0] != NT * DM || out_size != NT * DM || ws_size < WS_END) { fprintf(stderr, "kernel_launch: unexpected shapes / workspace (%d inputs, ws %zu < %zu)\n", n_in, ws_size, (size_t)WS_END); grid = -1; return; }
        int dev = 0, cus = 0;
        if (hipGetDevice(&dev) != hipSuccess || hipDeviceGetAttribute(&cus, hipDeviceAttributeMultiprocessorCount, dev) != hipSuccess) { grid = -1; return; }
        if (hipFuncSetAttribute((const void*)fwd_kernel, hipFuncAttributeMaxDynamicSharedMemorySize, LDS_BYTES) != hipSuccess) { fprintf(stderr, "kernel_launch: hipFuncSetAttribute failed\n"); grid = -1; return; }
        int per_cu = 0;
        if (hipOccupancyMaxActiveBlocksPerMultiprocessor(&per_cu, (const void*)fwd_kernel, NTHR, LDS_BYTES) != hipSuccess || per_cu < 1) { fprintf(stderr, "kernel_launch: occupancy query says %d\n", per_cu); }
        (void)hipGetLastError();
        grid = 256;
        if (cus < 256) { fprintf(stderr, "kernel_launch: device has %d CUs, need 256\n", cus); grid = -1; return; }
    }
    if (grid < 0) return;
    (void)hipMemsetAsync((char*)d_ws + WS_CTL, 0, CTL_BYTES, stream);
    Args a{};
    for (int i = 0; i < 28; ++i) a.in[i] = (const float*)d_in[i];
    a.out = (float*)d_out; a.ws = (unsigned char*)d_ws;
#if MK_MULTI
    for (int ph = 0; ph < NPHASE; ++ph) { a.ph_lo = ph; a.ph_hi = ph + 1; hipLaunchKernelGGL(fwd_kernel, dim3(grid), dim3(NTHR), LDS_BYTES, stream, a); }
#else
    a.ph_lo = 0; a.ph_hi = NPHASE; hipLaunchKernelGGL(fwd_kernel, dim3(grid), dim3(NTHR), LDS_BYTES, stream, a);
#endif
}
```

```cpp
#include <hip/hip_runtime.h>
#include <cstdio>
#include <cstdint>

#define GAS __attribute__((address_space(1)))
#define LAS __attribute__((address_space(3)))
typedef unsigned short bf16;
typedef short bf16x8 __attribute__((ext_vector_type(8)));
typedef float f32x4 __attribute__((ext_vector_type(4)));
typedef float f32x2 __attribute__((ext_vector_type(2)));
typedef unsigned u32x4 __attribute__((ext_vector_type(4)));
typedef unsigned u32x2 __attribute__((ext_vector_type(2)));

#ifndef MK_MULTI
#define MK_MULTI 0
#endif

#ifndef REP_P3
#define REP_P3 1
#endif
#ifndef REP_P5
#define REP_P5 1
#endif
#ifndef REP_AT
#define REP_AT 1
#endif
#ifndef ATTN_NQT
#define ATTN_NQT 2
#endif

constexpr int NL = 4, NB = 8, SEQ = 4096, DM = 1024, NT = NB * SEQ, NCH = 64;
constexpr int INW = 2816;
constexpr int C_QA = 0, C_KA = 512, C_VA = 1024, C_US = 1536, C_QR = 1792, C_KR = 2048, C_VR = 2304, C_GR = 2560;
constexpr int NE = 32, FF = 256;
constexpr float EPS = 1e-6f;
constexpr int NWAVES = 8, NTHR = 512;
constexpr int LDS_BYTES = 147456;

constexpr size_t al256(size_t x) { return (x + 255) & ~(size_t)255; }
constexpr size_t WS_CTL = 0, CTL_BYTES = 1u << 20;
constexpr size_t WS_WIN = CTL_BYTES;
constexpr size_t WS_WOUT = WS_WIN + (size_t)NL * INW * DM * 2;
constexpr size_t WS_WGU = WS_WOUT + (size_t)NL * DM * DM * 2;
constexpr size_t WS_WD = WS_WGU + (size_t)NL * NE * 512 * DM * 2;
constexpr size_t WS_WGLU = WS_WD + (size_t)NL * NE * DM * FF * 2;
constexpr size_t WS_WR = WS_WGLU + (size_t)NL * 256 * 256 * 2;
constexpr size_t WS_MOD = WS_WR + (size_t)NL * 36 * DM * 4;
constexpr size_t WS_ABAR = WS_MOD + (size_t)NL * NB * 6144 * 4;
constexpr size_t WS_ABAR64 = WS_ABAR + (size_t)NL * 16 * 64 * 8;
constexpr size_t WS_BBAR = WS_ABAR64 + (size_t)NL * 16 * 64 * 8;
constexpr size_t WS_ROPE = WS_BBAR + (size_t)NL * 16 * 64 * 16 * 8;
constexpr size_t WS_H = al256(WS_ROPE + (size_t)SEQ * 32 * 8);
constexpr size_t WS_QKV = WS_H + (size_t)NT * DM * 2;
constexpr size_t WS_SLOT = WS_QKV;
constexpr size_t WS_ACT = WS_QKV + (size_t)2 * NT * DM * 2;
constexpr int ACT_ROWS = 2 * NT + NE * 256;
static_assert(WS_ACT + (size_t)ACT_ROWS * FF * 2 <= WS_QKV + (size_t)NT * INW * 2, "overlay fits");
constexpr size_t WS_XB = WS_QKV + (size_t)NT * INW * 2;
constexpr size_t WS_MIX = WS_H;
constexpr size_t WS_YG = WS_XB + (size_t)NT * DM * 2;
constexpr size_t WS_SEND = WS_YG + (size_t)NT * 256 * 2;
constexpr size_t WS_XS = WS_SEND + (size_t)NB * NCH * 16 * 64 * 8;
constexpr size_t WS_KV = WS_XS + (size_t)NB * NCH * 16 * 64 * 8;
constexpr size_t WS_RW = WS_KV + (size_t)NB * NCH * 4 * 4096 * 4;
constexpr size_t WS_LIST = WS_RW + (size_t)NT * 2 * 4;
constexpr size_t WS_WRHL = WS_LIST + (size_t)NE * NT * 4;
constexpr size_t WS_KERN = WS_WRHL + (size_t)NL * 2 * 48 * DM * 2;
constexpr size_t WS_U2X = WS_KERN + (size_t)NL * 16 * 64 * 256 * 4;
constexpr int U2K = 1152, U2LD = 16 * U2K;
constexpr size_t WS_TMAT = WS_U2X + (size_t)512 * U2LD * 2;
constexpr size_t WS_BT1 = WS_TMAT + (size_t)16 * 1024 * U2K * 2;
constexpr size_t WS_SSQ = WS_BT1 + (size_t)16 * 256 * 1024 * 2;
constexpr size_t WS_PW = WS_SSQ + (size_t)NT * 16 * 4;
constexpr size_t WS_END = WS_PW + (size_t)NL * 16 * 65 * 64 * 8;
constexpr int CW_BAR = 4096;
constexpr int CW_CNT = 16384;

__device__ __forceinline__ float bf2f(unsigned v) { return __uint_as_float(v << 16); }
__device__ __forceinline__ unsigned f2bf(float f) { unsigned u = __float_as_uint(f); return (u + 0x7fffu + ((u >> 16) & 1u)) >> 16; }
__device__ __forceinline__ unsigned pk2(float lo, float hi) { return f2bf(lo) | (f2bf(hi) << 16); }
__device__ __forceinline__ float wave_sum(float v) {
#pragma unroll
    for (int o = 1; o < 64; o <<= 1) v += __shfl_xor(v, o);
    return v;
}
__device__ __forceinline__ float silu_f(float x) { return x / (1.0f + __expf(-x)); }
__device__ __forceinline__ float sigmoid_f(float x) { return 1.0f / (1.0f + __expf(-x)); }
__device__ __forceinline__ float gelu_tanh_f(float y) { const float z = 0.7978845608028654f * (y + 0.044715f * y * y * y); const float t = 1.0f - 2.0f / (__expf(2.0f * z) + 1.0f); return 0.5f * y * (1.0f + t); }
#define LDS_WAIT() asm volatile("s_waitcnt lgkmcnt(0)" ::: "memory")

#define XB_TMO      128
#define XB_XCNT(j)  (256  + 64 * (j))
#define XB_XSUB(j)  (1280 + 64 * (j))
#define XB_XGEN(j)  (2304 + 64 * (j))
#define XB_TOP      3328
#define XB_TOPGEN   3392
#define XCD_BAR_WORDS 3456
#define XB_SPIN_CAP (1u << 22)
__device__ __forceinline__ unsigned xb_ld(unsigned* p)              { return __hip_atomic_load(p, __ATOMIC_RELAXED, __HIP_MEMORY_SCOPE_AGENT); }
__device__ __forceinline__ unsigned xb_add(unsigned* p, unsigned v) { return __hip_atomic_fetch_add(p, v, __ATOMIC_RELAXED, __HIP_MEMORY_SCOPE_AGENT); }
__device__ __forceinline__ unsigned xb_xcc_id() { return (unsigned)__builtin_amdgcn_s_getreg((3 << 11) | 20) & 0xFu; }
#define XB_SPIN(cond, bar) do { unsigned _sp = 0; while (cond) { __builtin_amdgcn_s_sleep(1); \
    if ((++_sp & 255u) == 0u) { if (xb_ld(&(bar)[XB_TMO])) break; if (_sp > XB_SPIN_CAP) { atomicAdd(&(bar)[XB_TMO], 1u); break; } } } } while (0)
struct XcdBarrier { unsigned* bar; unsigned x; volatile LAS unsigned* st; };
__device__ __forceinline__ XcdBarrier xcd_barrier_post(unsigned* bar, volatile LAS unsigned* st) {
    XcdBarrier b; b.bar = bar; b.x = xb_xcc_id(); b.st = st;
    if (threadIdx.x == 0) (void)xb_add(&bar[XB_XCNT(b.x)], 1u);
    return b;
}
__device__ __forceinline__ void xcd_barrier_complete(unsigned* bar, unsigned x, unsigned& nloc, unsigned& nx) {
    const unsigned G = gridDim.x * gridDim.y * gridDim.z;
    unsigned sum, cnt, mine, sp = 0u;
    for (;;) {
        sum = 0u; cnt = 0u; mine = 0u;
#pragma unroll
        for (unsigned j = 0; j < 16; ++j) { const unsigned c = xb_ld(&bar[XB_XCNT(j)]); sum += c; cnt += (c > 0u) ? 1u : 0u; mine = (j == x) ? c : mine; }
        if (sum == G) break;
        __builtin_amdgcn_s_sleep(1);
        if ((++sp & 255u) == 0u) { if (xb_ld(&bar[XB_TMO])) break; if (sp > XB_SPIN_CAP) { atomicAdd(&bar[XB_TMO], 1u); break; } }
    }
    nloc = mine > 0u ? mine : 1u; nx = cnt > 0u ? cnt : 1u;
}
__device__ __forceinline__ void xcd_barrier(const XcdBarrier& b) {
    asm volatile("s_waitcnt vmcnt(0)" ::: "memory");
    __syncthreads();
    if (threadIdx.x == 0) {
        unsigned* bar = b.bar;
        __builtin_amdgcn_s_waitcnt(0);
        unsigned nloc = b.st[0], nx = b.st[1];
        if (nloc == 0u) { xcd_barrier_complete(bar, b.x, nloc, nx); b.st[0] = nloc; b.st[1] = nx; }
        const unsigned old = xb_add(&bar[XB_XSUB(b.x)], 1u);
        const unsigned gen = old / nloc;
        if (old + 1u == (gen + 1u) * nloc) {
            __builtin_amdgcn_fence(__ATOMIC_RELEASE, "agent");
            asm volatile("s_waitcnt vmcnt(0)" ::: "memory");
            const unsigned og = xb_add(&bar[XB_TOP], 1u);
            const unsigned tg = og / nx;
            if (og + 1u == (tg + 1u) * nx) xb_add(&bar[XB_TOPGEN], 1u);
            else XB_SPIN(xb_ld(&bar[XB_TOPGEN]) == tg, bar);
            __builtin_amdgcn_fence(__ATOMIC_ACQUIRE, "agent");
            xb_add(&bar[XB_XGEN(b.x)], 1u);
            asm volatile("s_waitcnt vmcnt(0)" ::: "memory");
        } else {
            XB_SPIN(xb_ld(&bar[XB_XGEN(b.x)]) == gen, bar);
            __builtin_amdgcn_fence(__ATOMIC_ACQUIRE, "agent");
            asm volatile("s_waitcnt vmcnt(0)" ::: "memory");
        }
    }
    __syncthreads();
}

struct Frame {
    LAS unsigned char* lds;
    LAS unsigned long long* ptab;
    int tid, lane, wave, blk, G, gw, ngw;
    float* out0; unsigned char* ws0; size_t wz;
};
#define F_OUT (F.out0 + F.wz)
__device__ __forceinline__ const float* inp_ptr(LAS unsigned long long* t, int k) { const unsigned long long v = t[k];
    const unsigned lo = __builtin_amdgcn_readfirstlane((unsigned)v), hi = __builtin_amdgcn_readfirstlane((unsigned)(v >> 32)); return (const float*)(const GAS float*)(((unsigned long long)hi << 32) | lo); }
#define INP(k) inp_ptr(F.ptab, k)
#define F_x INP(0)
#define F_c INP(1)
#define F_norm1_g INP(2)
#define F_norm2_g INP(3)
#define F_w_ada INP(4)
#define F_b_ada INP(5)
#define F_w_in INP(6)
#define F_rel_bias INP(7)
#define F_a_re INP(8)
#define F_a_im INP(9)
#define F_log_dt INP(10)
#define F_b_re INP(11)
#define F_b_im INP(12)
#define F_c_re INP(13)
#define F_c_im INP(14)
#define F_ssm_d INP(15)
#define F_w_glu INP(16)
#define F_b_glu INP(17)
#define F_gn_g INP(18)
#define F_w_out INP(19)
#define F_w_group INP(20)
#define F_b_group INP(21)
#define F_w_expert INP(22)
#define F_b_expert INP(23)
#define F_w_gate INP(24)
#define F_w_up INP(25)
#define F_w_down INP(26)
#define F_final_g INP(27)
#define F_ctl ((unsigned*)(F.ws0 + F.wz + WS_CTL))
#define F_WinT ((bf16*)(F.ws0 + F.wz + WS_WIN))
#define F_WoutT ((bf16*)(F.ws0 + F.wz + WS_WOUT))
#define F_WguT ((bf16*)(F.ws0 + F.wz + WS_WGU))
#define F_WdT ((bf16*)(F.ws0 + F.wz + WS_WD))
#define F_WgluT ((bf16*)(F.ws0 + F.wz + WS_WGLU))
#define F_WrT ((float*)(F.ws0 + F.wz + WS_WR))
#define F_MOD ((float*)(F.ws0 + F.wz + WS_MOD))
#define F_ABAR ((f32x2*)(F.ws0 + F.wz + WS_ABAR))
#define F_ABAR64 ((f32x2*)(F.ws0 + F.wz + WS_ABAR64))
#define F_BBAR ((f32x2*)(F.ws0 + F.wz + WS_BBAR))
#define F_ROPE ((f32x2*)(F.ws0 + F.wz + WS_ROPE))
#define F_H ((bf16*)(F.ws0 + F.wz + WS_H))
#define F_QKV ((bf16*)(F.ws0 + F.wz + WS_QKV))
#define F_SLOT ((bf16*)(F.ws0 + F.wz + WS_SLOT))
#define F_ACT ((bf16*)(F.ws0 + F.wz + WS_ACT))
#define F_MIX ((bf16*)(F.ws0 + F.wz + WS_MIX))
#define F_YG ((bf16*)(F.ws0 + F.wz + WS_YG))
#define F_SEND ((f32x2*)(F.ws0 + F.wz + WS_SEND))
#define F_XS ((f32x2*)(F.ws0 + F.wz + WS_XS))
#define F_KV ((float*)(F.ws0 + F.wz + WS_KV))
#define F_KVB ((bf16*)(F.ws0 + F.wz + WS_KV))
constexpr int KVST = 4 * 4096 + 128;
#define F_RW ((float*)(F.ws0 + F.wz + WS_RW))
#define F_LIST ((int*)(F.ws0 + F.wz + WS_LIST))
#define F_WRHL ((bf16*)(F.ws0 + F.wz + WS_WRHL))
#define F_KERNB ((bf16*)(F.ws0 + F.wz + WS_KERN))
#define F_U2X ((bf16*)(F.ws0 + F.wz + WS_U2X))
#define F_TMAT ((bf16*)(F.ws0 + F.wz + WS_TMAT))
#define F_BT1 ((bf16*)(F.ws0 + F.wz + WS_BT1))
#define F_SENDP ((float*)(F.ws0 + F.wz + WS_SEND))
#define F_SSQ ((float*)(F.ws0 + F.wz + WS_SSQ))
#define F_PW ((f32x2*)(F.ws0 + F.wz + WS_PW))
#define F_XB ((bf16*)(F.ws0 + F.wz + WS_XB))

namespace pg8 {
constexpr int BM = 256, BK = 64, HALF = 128, HTB = HALF * BK * 2, STAGE_BYTES = 8 * HTB, NXCD = 8, WGM = 8;
__host__ __device__ __forceinline__ int lds_byte(int r, int c) { const int st = (r >> 4) * 2 + (c >> 5), rr = r & 15, cc = c & 31, ob = rr * 64 + cc * 2; return st * 1024 + (ob ^ (((ob >> 9) & 1) << 5)); }
__host__ __device__ __forceinline__ void stage_rc(int b, int& R, int& C) { const int st = b / 1024, sb = b % 1024, swz = sb ^ (((sb >> 9) & 1) << 5); R = (st >> 1) * 16 + swz / 64; C = (st & 1) * 32 + (swz % 64) / 2; }
__host__ __device__ __forceinline__ int perm32(int rho) { const int n = rho >> 4, i = rho & 15; return 8 * (i >> 2) + 4 * n + (i & 3); }
struct Unit { int pm, pn, e, i; };
struct StaticOrder {
    int nM, nN, nwg, G, c; const char* A; const char* Bt; size_t tstepA, tstepB;
    __device__ void init(const bf16* A_, int lda, const bf16* Bt_, int ldb, int M, int N, int G_, int c_) { nM = M / BM; nN = N / BM; nwg = nM * nN; G = G_; c = c_; A = (const char*)A_; Bt = (const char*)Bt_; tstepA = (size_t)BM * lda * 2; tstepB = (size_t)BM * ldb * 2; }
    __device__ bool next(int i, Unit& u) const {
        const long L = (long)i * G + c; if (L >= nwg) return false;
        int wgid = (int)L; { const int q = nwg / NXCD, r = nwg % NXCD, xcd = wgid % NXCD, off = wgid / NXCD; wgid = (xcd < r ? xcd * (q + 1) : r * (q + 1) + (xcd - r) * q) + off; }
        const int nig = WGM * nN, gid = wgid / nig, fm = gid * WGM, gsz = (nM - fm) < WGM ? (nM - fm) : WGM;
        u.pm = fm + ((wgid % nig) % gsz); u.pn = (wgid % nig) / gsz; u.e = 0; u.i = i; return true;
    }
    __device__ __forceinline__ const char* a_base(const Unit& u) const { return A + (size_t)u.pm * tstepA; }
    __device__ __forceinline__ const char* b_base(const Unit& u) const { return Bt + (size_t)u.pn * tstepB; }
    __device__ __forceinline__ int row(const Unit&, int r) const { return r; }
};
__device__ __forceinline__ unsigned cvt_pk_bf16(float lo, float hi) { unsigned r; asm volatile("v_cvt_pk_bf16_f32 %0, %1, %2" : "=v"(r) : "v"(lo), "v"(hi)); return r; }

template <class Epi, class Sched, bool GATHER, bool TOEP = false>
__device__ __forceinline__ void gemm_phase(LAS unsigned char* lds, const int K, const int lda, const int ldb, const Sched& S, const Epi& E) {
    int tid_ = threadIdx.x; asm volatile("" : "+v"(tid_));
    const int tid = tid_, wid = __builtin_amdgcn_readfirstlane(tid >> 6), lane = tid & 63, wr = wid >> 2, wc = wid & 3, fr = lane & 15, fq = lane >> 4;
    const int nt = K / BK;
    int Rr[2], Cc[2]; unsigned voffB[2], voffC[2];
#pragma unroll
    for (int i = 0; i < 2; ++i) { stage_rc(tid * 16 + i * 8192, Rr[i], Cc[i]); const int Rb = Epi::PERM ? ((Rr[i] & ~31) + perm32(Rr[i] & 31)) : Rr[i]; voffC[i] = (unsigned)(Rb * ldb + Cc[i]) * 2u;
        voffB[i] = TOEP ? (unsigned)(((Rb >> 4) - (Cc[i] >> 4) + 3) * 512 + (Rb & 15) * 32 + (Cc[i] & 15) * 2) : voffC[i]; }
    const size_t kstep = (size_t)(BK * 2);
    const long kstepB = TOEP ? -2048l : (long)(BK * 2);
    const size_t hstepC = (size_t)HALF * ldb * 2;
    const size_t hstepB = TOEP ? (size_t)4096 : hstepC;
    const unsigned ldsw = (unsigned)wid * 1024u;
    const int aoff = lds_byte(wr * 64 + fr, fq * 8), boff = lds_byte(wc * 32 + fr, fq * 8);
#define PG8_SA(b, h) (((b) * 2 + (h)) * HTB)
#define PG8_SB(b, h) ((4 + (b) * 2 + (h)) * HTB)
#define PG8_STAGE(bufoff, gbase, voff) do { _Pragma("unroll") for (int _i = 0; _i < 2; ++_i) \
        __builtin_amdgcn_global_load_lds((const unsigned*)((const char*)(gbase) + (voff)[_i]), (LAS unsigned*)(lds + (bufoff) + ldsw + _i * 8192), 16, 0, 0); } while (0)
#define PG8_STAGE_SEL(bufoff, gbase, h) do { if (GATHER && last) PG8_STAGE(bufoff, gbase, vN[h]); else PG8_STAGE(bufoff, gbase, vA[h]); } while (0)
#define PG8_LDA(dst, b, h) do { _Pragma("unroll") for (int m = 0; m < 4; ++m) _Pragma("unroll") for (int k = 0; k < 2; ++k) dst[m][k] = *(const LAS bf16x8*)(lds + PG8_SA(b, h) + aoff + m * 2048 + k * 1024); } while (0)
#define PG8_LDB(dst, b, h) do { _Pragma("unroll") for (int n = 0; n < 2; ++n) _Pragma("unroll") for (int k = 0; k < 2; ++k) dst[n][k] = *(const LAS bf16x8*)(lds + PG8_SB(b, h) + boff + n * 2048 + k * 1024); } while (0)
#define PG8_MMA(ai, bj, At, Bt) do { __builtin_amdgcn_s_setprio(1); _Pragma("unroll") for (int m = 0; m < 4; ++m) _Pragma("unroll") for (int n = 0; n < 2; ++n) _Pragma("unroll") for (int k = 0; k < 2; ++k) \
        acc[ai][bj][m][n] = __builtin_amdgcn_mfma_f32_16x16x32_bf16(Bt[n][k], At[m][k], acc[ai][bj][m][n], 0, 0, 0); __builtin_amdgcn_s_setprio(0); } while (0)
#define PG8_WAIT_V(n) asm volatile("s_waitcnt vmcnt(" #n ")" ::: "memory")
#define PG8_WAIT_L(n) asm volatile("s_waitcnt lgkmcnt(" #n ")" ::: "memory")
#define PG8_BAR __builtin_amdgcn_s_barrier()
#define PG8_SCHED __builtin_amdgcn_sched_barrier(0)
#define PG8_VOFF(dst, u) do { int _t = tid; if (GATHER) asm volatile("" : "+v"(_t)); _Pragma("unroll") for (int _i = 0; _i < 2; ++_i) { int _R, _C; stage_rc(_t * 16 + _i * 8192, _R, _C); \
        _Pragma("unroll") for (int _h = 0; _h < 2; ++_h) dst[_h][_i] = (unsigned)(S.row(u, _h * HALF + _R) * lda + _C) * 2u; } } while (0)
    Unit cur, nxt; int ui = 0;
    if (!S.next(0, cur)) return;
    f32x4 acc[2][2][4][2];
#pragma unroll
    for (int a = 0; a < 2; ++a)
#pragma unroll
        for (int b = 0; b < 2; ++b)
#pragma unroll
            for (int m = 0; m < 4; ++m)
#pragma unroll
                for (int n = 0; n < 2; ++n) acc[a][b][m][n] = (f32x4){0.f, 0.f, 0.f, 0.f};
    bf16x8 At[4][2], B0[2][2], B1[2][2];
    unsigned vA[2][2];
    PG8_VOFF(vA, cur);
    const char* cA = S.a_base(cur); const char* cB = S.b_base(cur);
    const char* cC = cB; if constexpr (TOEP) cC = S.c_base(cur);
    PG8_STAGE(PG8_SB(0, 0), cC, voffC); PG8_STAGE(PG8_SB(0, 1), cC + hstepC, voffC); PG8_STAGE(PG8_SA(0, 0), cA, vA[0]); PG8_STAGE(PG8_SA(0, 1), cA, vA[1]);
    if (wr == 1) PG8_BAR;
    PG8_WAIT_V(2); PG8_BAR;
    PG8_STAGE(PG8_SB(1, 0), cC + kstep, voffC); PG8_STAGE(PG8_SA(1, 0), cA + kstep, vA[0]); PG8_STAGE(PG8_SB(1, 1), cC + hstepC + kstep, voffC);
    PG8_WAIT_V(6); PG8_BAR;
    for (;;) {
        const bool has_next = S.next(ui + 1, nxt);
        const char* nA = has_next ? S.a_base(nxt) : cA; const char* nB = has_next ? S.b_base(nxt) : cB;
        const char* nC = nB; if constexpr (TOEP) nC = has_next ? S.c_base(nxt) : cC;
        asm volatile(".p2align 8\n\t.fill 8, 4, 0xBF800000" ::: "memory");
#pragma unroll 1
        for (int t = 0; t < nt; t += 2) {
            const bool last = (t == nt - 2);
            const char* a1 = cA + (size_t)(t + 1) * kstep;
            const char* a2 = last ? nA : cA + (size_t)(t + 2) * kstep; const char* b2 = last ? nC : cB + (long)(t + 2) * kstepB;
            const char* a3 = a2 + kstep; const char* b3 = (TOEP && last) ? b2 + kstep : b2 + kstepB;
            PG8_LDB(B0, 0, 0); PG8_LDB(B1, 0, 1); PG8_SCHED; PG8_LDA(At, 0, 0); PG8_STAGE(PG8_SA(1, 1), a1, vA[1]);
            PG8_WAIT_V(8); PG8_WAIT_L(0); PG8_BAR; PG8_MMA(0, 0, At, B0); PG8_MMA(0, 1, At, B1); PG8_BAR; PG8_SCHED;
            if (GATHER && last && has_next) { PG8_VOFF(vA, nxt); }
            PG8_LDA(At, 0, 1);
            if (TOEP && last) { PG8_STAGE(PG8_SB(0, 0), b2, voffC); PG8_STAGE(PG8_SB(0, 1), b2 + hstepC, voffC); } else { PG8_STAGE(PG8_SB(0, 0), b2, voffB); PG8_STAGE(PG8_SB(0, 1), b2 + hstepB, voffB); }
            PG8_STAGE(PG8_SA(0, 0), a2, vA[0]);
            PG8_WAIT_V(8); PG8_WAIT_L(0); PG8_BAR; PG8_MMA(1, 0, At, B0); PG8_MMA(1, 1, At, B1); PG8_BAR; PG8_SCHED;
            PG8_LDB(B0, 1, 0); PG8_LDB(B1, 1, 1); PG8_SCHED; PG8_LDA(At, 1, 0); PG8_STAGE(PG8_SA(0, 1), a2, vA[1]);
            PG8_WAIT_V(8); PG8_WAIT_L(0); PG8_BAR; PG8_MMA(0, 0, At, B0); PG8_MMA(0, 1, At, B1); PG8_BAR; PG8_SCHED;
            PG8_LDA(At, 1, 1);
            if (TOEP && last) { PG8_STAGE(PG8_SB(1, 0), b3, voffC); PG8_STAGE(PG8_SB(1, 1), b3 + hstepC, voffC); } else { PG8_STAGE(PG8_SB(1, 0), b3, voffB); PG8_STAGE(PG8_SB(1, 1), b3 + hstepB, voffB); }
            PG8_STAGE(PG8_SA(1, 0), a3, vA[0]);
            PG8_WAIT_V(8); PG8_WAIT_L(0); PG8_BAR; PG8_MMA(1, 0, At, B0); PG8_MMA(1, 1, At, B1); PG8_BAR; PG8_SCHED;
        }
        if (wr == 0) PG8_BAR;
        { int fr_e = fr, fq_e = fq; asm volatile("" : "+v"(fr_e), "+v"(fq_e)); E(acc, cur, wr, wc, fr_e, fq_e); }
        if (!has_next) break;
#pragma unroll
        for (int a = 0; a < 2; ++a)
#pragma unroll
            for (int b = 0; b < 2; ++b)
#pragma unroll
                for (int m = 0; m < 4; ++m)
#pragma unroll
                    for (int n = 0; n < 2; ++n) acc[a][b][m][n] = (f32x4){0.f, 0.f, 0.f, 0.f};
        cur = nxt; cA = nA; cB = nB; cC = nC; ++ui;
        if (wr == 1) PG8_BAR;
    }
    PG8_WAIT_V(0);
    PG8_BAR;
#undef PG8_SA
#undef PG8_SB
#undef PG8_STAGE
#undef PG8_STAGE_SEL
#undef PG8_LDA
#undef PG8_LDB
#undef PG8_MMA
#undef PG8_WAIT_V
#undef PG8_WAIT_L
#undef PG8_BAR
#undef PG8_SCHED
#undef PG8_VOFF
}
}

struct EpiQKV {
    static constexpr bool PERM = true;
    bf16* O; bf16* U2;
    __device__ __forceinline__ void operator()(const f32x4 (&acc)[2][2][4][2], const pg8::Unit& u, int wr, int wc, int fr, int fq) const {
        const int row0 = u.pm * 256 + wr * 64 + fr, col0 = u.pn * 256 + wc * 32 + 8 * fq;
#pragma unroll
        for (int ai = 0; ai < 2; ++ai)
#pragma unroll
            for (int m = 0; m < 4; ++m) { const int row = row0 + ai * 128 + m * 16; bf16* rowp = O + (size_t)row * INW + col0;
#pragma unroll
                for (int bj = 0; bj < 2; ++bj) { const f32x4 v0 = acc[ai][bj][m][0], v1 = acc[ai][bj][m][1];
                    u32x4 w; w.x = pg8::cvt_pk_bf16(v0[0], v0[1]); w.y = pg8::cvt_pk_bf16(v0[2], v0[3]); w.z = pg8::cvt_pk_bf16(v1[0], v1[1]); w.w = pg8::cvt_pk_bf16(v1[2], v1[3]);
                    if (u.pn == 6) { const int cu = bj * 128 + wc * 32 + 8 * fq;
                        *(u32x4*)(U2 + ((size_t)(row >> 6) * 16 + (cu >> 4)) * U2K + 128 + (row & 63) * 16 + (cu & 15)) = w; }
                    else *(u32x4*)(rowp + bj * 128) = w; } }
    }
};
struct EpiRes {
    static constexpr bool PERM = true;
    const float* x0; bf16* xb; const float* g1l; float* ssq; int first;
    __device__ __forceinline__ void operator()(const f32x4 (&acc)[2][2][4][2], const pg8::Unit& u, int wr, int wc, int fr, int fq) const {
        const int row0 = u.pm * 256 + wr * 64 + fr, col0 = u.pn * 256 + wc * 32 + 8 * fq;
        const float* g1 = g1l + (size_t)((u.pm * 256) / SEQ) * 6144 + col0;
        f32x4 gv[2][2];
#pragma unroll
        for (int bj = 0; bj < 2; ++bj)
#pragma unroll
            for (int n = 0; n < 2; ++n) gv[bj][n] = *(const f32x4*)(g1 + bj * 128 + n * 4);
#pragma unroll
        for (int ai = 0; ai < 2; ++ai)
#pragma unroll
            for (int m = 0; m < 4; ++m) { const int row = row0 + ai * 128 + m * 16; const size_t off = (size_t)row * DM + col0; float sq = 0.f;
#pragma unroll
                for (int bj = 0; bj < 2; ++bj) { f32x4 x0v, x1v;
                    if (first) { x0v = *(const f32x4*)(x0 + off + bj * 128); x1v = *(const f32x4*)(x0 + off + bj * 128 + 4); }
                    else { const u32x4 w = *(const u32x4*)(xb + off + bj * 128); x0v = (f32x4){bf2f(w.x & 0xffffu), bf2f(w.x >> 16), bf2f(w.y & 0xffffu), bf2f(w.y >> 16)}; x1v = (f32x4){bf2f(w.z & 0xffffu), bf2f(w.z >> 16), bf2f(w.w & 0xffffu), bf2f(w.w >> 16)}; }
                    const f32x4 o0 = x0v + gv[bj][0] * acc[ai][bj][m][0], o1 = x1v + gv[bj][1] * acc[ai][bj][m][1];
                    u32x4 w; w.x = pg8::cvt_pk_bf16(o0[0], o0[1]); w.y = pg8::cvt_pk_bf16(o0[2], o0[3]); w.z = pg8::cvt_pk_bf16(o1[0], o1[1]); w.w = pg8::cvt_pk_bf16(o1[2], o1[3]);
                    *(u32x4*)(xb + off + bj * 128) = w;
                    sq += (o0.x * o0.x + o0.y * o0.y) + (o0.z * o0.z + o0.w * o0.w) + (o1.x * o1.x + o1.y * o1.y) + (o1.z * o1.z + o1.w * o1.w); }
                sq += __shfl_xor(sq, 16); sq += __shfl_xor(sq, 32);
                if (fq == 0) ssq[(size_t)row * 16 + u.pn * 4 + wc] = sq;
                asm volatile("" ::: "memory"); }
    }
};

__device__ __forceinline__ void p0_prologue(Frame& F) {
    LAS float* scr = (LAS float*)(F.lds + F.wave * 16384);
    constexpr int I_IN = NL * 16 * 88, I_OUT = NL * 16 * 32, I_GLU = NL * 4 * 8, I_G = NL * NE * 16 * 8, I_D = NL * NE * 4 * 32;
    constexpr int NITEMS = I_IN + I_OUT + I_GLU + 2 * I_G + I_D;
    struct TItem { const float* src; bf16* dst; int N, ldk; };
#define TR_DECODE(itv, T) do { int r = (itv); \
        if (r < I_IN) { const int l = r / (16 * 88), q = r % (16 * 88), kb = q / 88, nb = q % 88; T.N = INW; T.ldk = DM; \
            T.src = F_w_in + (size_t)l * DM * INW + (size_t)(kb * 64) * INW + nb * 32; T.dst = F_WinT + ((size_t)l * INW + nb * 32) * DM + kb * 64; break; } r -= I_IN; \
        if (r < I_OUT) { const int l = r / (16 * 32), q = r % (16 * 32), kb = q / 32, nb = q % 32; T.N = DM; T.ldk = DM; \
            T.src = F_w_out + (size_t)l * DM * DM + (size_t)(kb * 64) * DM + nb * 32; T.dst = F_WoutT + ((size_t)l * DM + nb * 32) * DM + kb * 64; break; } r -= I_OUT; \
        if (r < I_GLU) { const int l = r / 32, q = r % 32, kb = q / 8, nb = q % 8; T.N = 256; T.ldk = 256; \
            T.src = F_w_glu + (size_t)l * 256 * 256 + (size_t)(kb * 64) * 256 + nb * 32; T.dst = F_WgluT + ((size_t)l * 256 + nb * 32) * 256 + kb * 64; break; } r -= I_GLU; \
        if (r < 2 * I_G) { const int up = r >= I_G; if (up) r -= I_G; const int le = r / 128, q = r % 128, kb = q / 8, nb = q % 8; const int n0 = nb * 32; \
            const int drow = (n0 >> 7) * 256 + up * 128 + (n0 & 127); T.N = FF; T.ldk = DM; \
            T.src = (up ? F_w_up : F_w_gate) + (size_t)le * DM * FF + (size_t)(kb * 64) * FF + n0; T.dst = F_WguT + ((size_t)le * 512 + drow) * DM + kb * 64; break; } r -= 2 * I_G; \
        { const int le = r / 128, q = r % 128, kb = q / 32, nb = q % 32; T.N = DM; T.ldk = FF; \
            T.src = F_w_down + (size_t)le * FF * DM + (size_t)(kb * 64) * DM + nb * 32; T.dst = F_WdT + ((size_t)le * DM + nb * 32) * FF + kb * 64; } } while (0)
#define TR_LOAD(T, tv) do { _Pragma("unroll") for (int i = 0; i < 32; ++i) { const int kk = 2 * i + (F.lane >> 5); tv[i] = __builtin_nontemporal_load(T.src + (size_t)kk * T.N + (F.lane & 31)); } } while (0)
#define TR_STORE(T, tv) do { _Pragma("unroll") for (int i = 0; i < 32; ++i) { const int kk = 2 * i + (F.lane >> 5); scr[kk * 33 + (F.lane & 31)] = tv[i]; } \
        LDS_WAIT(); asm volatile("" ::: "memory"); const int c = F.lane & 7; \
        _Pragma("unroll") for (int j = 0; j < 4; ++j) { const int n = (F.lane >> 3) + 8 * j; const LAS float* s = scr + (8 * c) * 33 + n; \
            u32x4 o; o.x = pk2(s[0 * 33], s[1 * 33]); o.y = pk2(s[2 * 33], s[3 * 33]); o.z = pk2(s[4 * 33], s[5 * 33]); o.w = pk2(s[6 * 33], s[7 * 33]); \
            *(u32x4*)(T.dst + (size_t)n * T.ldk + 8 * c) = o; } \
        LDS_WAIT(); asm volatile("" ::: "memory"); } while (0)
    {
        float tva[32], tvb[32]; TItem Ta, Tb; Ta.src = nullptr; Ta.dst = nullptr; Ta.N = 0; Ta.ldk = 0; Tb = Ta;
        int it = F.gw;
        if (it < NITEMS) { TR_DECODE(it, Ta); TR_LOAD(Ta, tva); }
        while (it < NITEMS) {
            const int it1 = it + F.ngw; if (it1 < NITEMS) { TR_DECODE(it1, Tb); TR_LOAD(Tb, tvb); }
            TR_STORE(Ta, tva);
            if (it1 >= NITEMS) break;
            const int it2 = it1 + F.ngw; if (it2 < NITEMS) { TR_DECODE(it2, Ta); TR_LOAD(Ta, tva); }
            TR_STORE(Tb, tvb);
            it = it2;
        }
    }
#undef TR_DECODE
#undef TR_LOAD
#undef TR_STORE
    for (int i = F.blk * NTHR + F.tid; i < NL * 48 * DM; i += F.G * NTHR) { const int l = i / (48 * DM), j = (i / DM) % 48, k = i % DM;
        const float w = (j < 4) ? F_w_group[((size_t)l * DM + k) * 4 + j] : (j < 36 ? F_w_expert[((size_t)l * DM + k) * 32 + (j - 4)] : 0.f);
        const unsigned hi = f2bf(w); const unsigned lo = f2bf(w - bf2f(hi));
        F_WRHL[((size_t)(l * 2 + 0) * 48 + j) * DM + k] = (bf16)hi; F_WRHL[((size_t)(l * 2 + 1) * 48 + j) * DM + k] = (bf16)lo; }
    for (int i = F.blk * 16 + F.tid; F.tid < 16 && i < NL * 16 * 64; i += F.G * 16) {
        const int lg = i / 64; const float are = F_a_re[i], aim = F_a_im[i], dt = __expf(F_log_dt[lg]);
        const float mag = expf(are * dt); float sn, cs; sincosf(aim * dt, &sn, &cs);
        const float abr = mag * cs, abi = mag * sn;
        F_ABAR[i] = (f32x2){abr, abi};
        const float mag64 = expf(64.f * are * dt); float sn64, cs64; sincosf(64.f * aim * dt, &sn64, &cs64);
        F_ABAR64[i] = (f32x2){mag64 * cs64, mag64 * sn64};
        F_PW[((size_t)lg * 65 + 64) * 64 + (i & 63)] = (f32x2){mag64 * cs64, mag64 * sn64};
        const float xr = abr - 1.f, xi = abi, den = are * are + aim * aim;
        const float fr = (xr * are + xi * aim) / den, fi = (xi * are - xr * aim) / den;
        f32x4 brv[4], biv[4];
#pragma unroll
        for (int q4 = 0; q4 < 4; ++q4) { brv[q4] = *(const f32x4*)(F_b_re + (size_t)i * 16 + 4 * q4); biv[q4] = *(const f32x4*)(F_b_im + (size_t)i * 16 + 4 * q4); }
#pragma unroll
        for (int q4 = 0; q4 < 4; ++q4)
#pragma unroll
            for (int r = 0; r < 4; ++r) { const float br = brv[q4][r], bi = biv[q4][r]; F_BBAR[(size_t)i * 16 + 4 * q4 + r] = (f32x2){fr * br - fi * bi, fr * bi + fi * br}; }
    }
    __syncthreads();
    for (int wu = F.blk; wu < NL * 16 * 4; wu += F.G) {
        const int lg = wu >> 2, lag0 = (wu & 3) * 16; const float dt = __expf(F_log_dt[lg]);
        LAS f32x2* pw = (LAS f32x2*)F.lds;
        LAS f32x2* ff = pw + 1024;
        LAS f32x2* cc = ff + 64;
        LAS float* bbr = (LAS float*)(cc + 1024);
        LAS float* bbi = bbr + 1024;
        for (int idx = F.tid; idx < 1024 + 64; idx += NTHR) { const int p = idx & 63; const float are = F_a_re[lg * 64 + p], aim = F_a_im[lg * 64 + p];
            if (idx < 1024) { const float lag = (float)(lag0 + (idx >> 6)); const float pm = expf(lag * are * dt); float sn, cs; sincosf(lag * aim * dt, &sn, &cs); const f32x2 pv = (f32x2){pm * cs, pm * sn}; pw[idx] = pv; F_PW[((size_t)lg * 65 + lag0 + (idx >> 6)) * 64 + p] = pv; }
            else { const float mag = expf(are * dt); float sn, cs; sincosf(aim * dt, &sn, &cs); const float xr0 = mag * cs - 1.f, xi0 = mag * sn, den = are * are + aim * aim;
                ff[p] = (f32x2){(xr0 * are + xi0 * aim) / den, (xi0 * are - xr0 * aim) / den}; } }
        for (int idx = F.tid; idx < 1024; idx += NTHR) cc[idx] = (f32x2){F_c_re[(size_t)lg * 1024 + idx], F_c_im[(size_t)lg * 1024 + idx]};
        __syncthreads();
        for (int idx = F.tid; idx < 1024; idx += NTHR) { const f32x2 fv = ff[idx >> 4]; const float br = F_b_re[(size_t)lg * 1024 + idx], bi = F_b_im[(size_t)lg * 1024 + idx];
            bbr[idx] = fv.x * br - fv.y * bi; bbi[idx] = fv.x * bi + fv.y * br; }
        __syncthreads();
        if (F.tid < 256) { const int c = F.tid & 15, lagi = F.tid >> 4, lag = lag0 + lagi;
            float acc[16];
#pragma unroll
            for (int q = 0; q < 16; ++q) acc[q] = 0.f;
#pragma unroll 4
            for (int p = 0; p < 64; ++p) { const f32x2 pv = pw[lagi * 64 + p], cv = cc[c * 64 + p];
                const float zr = cv.x * pv.x - cv.y * pv.y, zi = cv.x * pv.y + cv.y * pv.x;
                const LAS f32x4* br = (const LAS f32x4*)(bbr + p * 16); const LAS f32x4* bi = (const LAS f32x4*)(bbi + p * 16);
#pragma unroll
                for (int q4 = 0; q4 < 4; ++q4) { const f32x4 r4 = br[q4], i4 = bi[q4];
                    acc[4 * q4] += zr * r4.x - zi * i4.x; acc[4 * q4 + 1] += zr * r4.y - zi * i4.y; acc[4 * q4 + 2] += zr * r4.z - zi * i4.z; acc[4 * q4 + 3] += zr * r4.w - zi * i4.w; } }
            if (lag == 0) {
#pragma unroll
                for (int q = 0; q < 16; ++q) if (q == c) acc[q] += F_ssm_d[lg * 16 + c]; }
            bf16* kp = F_KERNB + (((size_t)lg * 128 + 64 + lag) * 16 + c) * 16;
#pragma unroll
            for (int q8 = 0; q8 < 2; ++q8) { u32x4 o; o.x = pk2(acc[8 * q8], acc[8 * q8 + 1]); o.y = pk2(acc[8 * q8 + 2], acc[8 * q8 + 3]); o.z = pk2(acc[8 * q8 + 4], acc[8 * q8 + 5]); o.w = pk2(acc[8 * q8 + 6], acc[8 * q8 + 7]);
                *(u32x4*)(kp + 8 * q8) = o; }
        } else { bf16* zp = F_KERNB + ((size_t)lg * 128 + lag0) * 256 + (F.tid - 256) * 16;
            *(u32x4*)zp = (u32x4){0u, 0u, 0u, 0u}; *(u32x4*)(zp + 8) = (u32x4){0u, 0u, 0u, 0u}; }
        __syncthreads();
    }
    for (int i = F.blk * NTHR + F.tid; i < SEQ * 32; i += F.G * NTHR) { const int pos = i >> 5, j = i & 31;
        const float inv = powf(10000.0f, -(float)j / 32.0f); const float ang = (float)pos * inv; float sn, cs; sincosf(ang, &sn, &cs); F_ROPE[i] = (f32x2){cs, sn}; }
    __syncthreads();
    {
        LAS float* cond = (LAS float*)F.lds;
        LAS float* red = (LAS float*)(F.lds + 32768);
        for (int i = F.tid; i < NB * DM; i += NTHR) cond[i] = silu_f(F_c[i]);
        __syncthreads();
        constexpr int NITM = NL * 6144 / 96;
        for (int it = F.blk; it < NITM; it += F.G) {
            const int cl = F.tid % 96, ks = F.tid / 96, col = it * 96 + cl, l = col / 6144, j = col % 6144;
            if (ks < 4) {
                float acc[8];
#pragma unroll
                for (int b = 0; b < 8; ++b) acc[b] = 0.f;
                const float* wp = F_w_ada + (size_t)l * DM * 6144 + j + (size_t)(ks * 256) * 6144;
                for (int k0 = 0; k0 < 256; k0 += 16) { float w[16];
#pragma unroll
                    for (int q = 0; q < 16; ++q) w[q] = __builtin_nontemporal_load(wp + (size_t)(k0 + q) * 6144);
#pragma unroll
                    for (int q = 0; q < 16; ++q)
#pragma unroll
                        for (int b = 0; b < 8; ++b) acc[b] += cond[b * DM + ks * 256 + k0 + q] * w[q]; }
#pragma unroll
                for (int b = 0; b < 8; ++b) red[(ks * 96 + cl) * 8 + b] = acc[b];
            }
            __syncthreads();
            if (F.tid < 96) {
#pragma unroll
                for (int b = 0; b < 8; ++b) { const float s = red[(0 * 96 + F.tid) * 8 + b] + red[(1 * 96 + F.tid) * 8 + b] + red[(2 * 96 + F.tid) * 8 + b] + red[(3 * 96 + F.tid) * 8 + b];
                    F_MOD[((size_t)l * NB + b) * 6144 + j] = s + F_b_ada[(size_t)l * 6144 + j]; }
            }
            __syncthreads();
        }
    }
}


template <bool FINAL>
__device__ __forceinline__ void norm1_phase(Frame& F, int l) {
    const bool addmoe = FINAL || l > 0;
    const int lp = FINAL ? NL - 1 : l - 1;
    const int rpw = (NT + F.ngw - 1) / F.ngw;
    for (int j = 0; j < rpw; j += 2) {
        const int rowA = F.gw * rpw + j;
        if (rowA >= NT) break;
        f32x4 v[2][4];
#pragma unroll
        for (int q = 0; q < 2; ++q) { const int row = rowA + q;
            if (!FINAL && l == 0) { const f32x4* xr = (const f32x4*)(F_x + (size_t)row * DM) + F.lane;
#pragma unroll
                for (int i = 0; i < 4; ++i) v[q][i] = xr[64 * i]; }
            else { const u32x2* xr = (const u32x2*)(F_XB + (size_t)row * DM) + F.lane;
#pragma unroll
                for (int i = 0; i < 4; ++i) { const u32x2 w = xr[64 * i]; v[q][i] = (f32x4){bf2f(w.x & 0xffffu), bf2f(w.x >> 16), bf2f(w.y & 0xffffu), bf2f(w.y >> 16)}; } } }
        if (addmoe) {
#pragma unroll
            for (int q = 0; q < 2; ++q) { const int row = rowA + q, b = row / SEQ;
                const f32x4* g2 = (const f32x4*)(F_MOD + ((size_t)lp * NB + b) * 6144 + 5120) + F.lane;
                const u32x2* s0 = (const u32x2*)(F_SLOT + (size_t)row * DM) + F.lane; const u32x2* s1 = (const u32x2*)(F_SLOT + (size_t)NT * DM + (size_t)row * DM) + F.lane;
#pragma unroll
                for (int i = 0; i < 4; ++i) { const u32x2 a = s0[64 * i], c = s1[64 * i]; const f32x4 g = g2[64 * i];
                    v[q][i].x += g.x * (bf2f(a.x & 0xffffu) + bf2f(c.x & 0xffffu)); v[q][i].y += g.y * (bf2f(a.x >> 16) + bf2f(c.x >> 16));
                    v[q][i].z += g.z * (bf2f(a.y & 0xffffu) + bf2f(c.y & 0xffffu)); v[q][i].w += g.w * (bf2f(a.y >> 16) + bf2f(c.y >> 16)); }
                if (!FINAL) { u32x2* xo = (u32x2*)(F_XB + (size_t)row * DM) + F.lane;
#pragma unroll
                    for (int i = 0; i < 4; ++i) { u32x2 w; w.x = pk2(v[q][i].x, v[q][i].y); w.y = pk2(v[q][i].z, v[q][i].w); xo[64 * i] = w; } } }
        }
        float ss[2];
#pragma unroll
        for (int q = 0; q < 2; ++q) { ss[q] = 0.f;
#pragma unroll
            for (int i = 0; i < 4; ++i) ss[q] += (v[q][i].x * v[q][i].x + v[q][i].y * v[q][i].y) + (v[q][i].z * v[q][i].z + v[q][i].w * v[q][i].w); }
#pragma unroll
        for (int o = 1; o < 64; o <<= 1) { ss[0] += __shfl_xor(ss[0], o); ss[1] += __shfl_xor(ss[1], o); }
#pragma unroll
        for (int q = 0; q < 2; ++q) { const int row = rowA + q, b = row / SEQ; const float rstd = 1.0f / sqrtf(ss[q] * (1.0f / DM) + EPS);
            if (FINAL) { const f32x4* g = (const f32x4*)F_final_g + F.lane; f32x4* xo = (f32x4*)(F_OUT + (size_t)row * DM) + F.lane;
#pragma unroll
                for (int i = 0; i < 4; ++i) xo[64 * i] = v[q][i] * rstd * g[64 * i];
            } else { const f32x4* g = (const f32x4*)(F_norm1_g + (size_t)l * DM) + F.lane; const float* modb = F_MOD + ((size_t)l * NB + b) * 6144;
                const f32x4* sh = (const f32x4*)modb + F.lane; const f32x4* sc = (const f32x4*)(modb + 1024) + F.lane; u32x2* ho = (u32x2*)(F_H + (size_t)row * DM) + F.lane;
#pragma unroll
                for (int i = 0; i < 4; ++i) { const f32x4 hv = v[q][i] * rstd * g[64 * i] * (sc[64 * i] + 1.0f) + sh[64 * i]; u32x2 o; o.x = pk2(hv.x, hv.y); o.y = pk2(hv.z, hv.w); ho[64 * i] = o; } } }
    }
}

__device__ __forceinline__ void norm2_router_phase(Frame& F, int l) {
    LAS int* l_ent = (LAS int*)F.lds;
    LAS int* l_exp = l_ent + 256;
    LAS int* l_cnt = l_exp + 256;
    LAS int* l_base = l_cnt + 32;
    LAS float* lgs = (LAS float*)(F.lds + 4096 + F.wave * 3072);
    if (F.tid < 32) l_cnt[F.tid] = 0;
    __syncthreads();
    const int fr = F.lane & 15, fq = F.lane >> 4;
    const int row = F.blk * 128 + F.wave * 16 + fr, b = (F.blk * 128) / SEQ;
    const bf16* xr = F_XB + (size_t)row * DM + fq * 8;
    float ss; { const f32x4 q = *(const f32x4*)(F_SSQ + (size_t)row * 16 + fq * 4); ss = (q.x + q.y) + (q.z + q.w); }
    ss += __shfl_xor(ss, 16); ss += __shfl_xor(ss, 32);
    const float rstd = 1.0f / sqrtf(ss * (1.0f / DM) + EPS);
    const float* gp = F_norm2_g + (size_t)l * DM + fq * 8;
    const float* shp = F_MOD + ((size_t)l * NB + b) * 6144 + 3072 + fq * 8; const float* scp = shp + 1024;
    const bf16* wb = F_WRHL + (size_t)l * 2 * 48 * DM + (size_t)fr * DM + fq * 8;
    bf16* hrow = F_H + (size_t)row * DM + fq * 8;
    f32x4 acc[3];
#pragma unroll
    for (int t = 0; t < 3; ++t) acc[t] = (f32x4){0.f, 0.f, 0.f, 0.f};
    struct RStep { u32x4 xw; f32x4 g0, g1, s0, s1, h0, h1; bf16x8 bh[3], bl[3]; };
#define R_LOAD(S, ks) do { S.xw = xall[ks]; S.g0 = *(const f32x4*)(gp + (ks) * 32); S.g1 = *(const f32x4*)(gp + (ks) * 32 + 4); \
        S.s0 = *(const f32x4*)(scp + (ks) * 32); S.s1 = *(const f32x4*)(scp + (ks) * 32 + 4); S.h0 = *(const f32x4*)(shp + (ks) * 32); S.h1 = *(const f32x4*)(shp + (ks) * 32 + 4); \
        _Pragma("unroll") for (int t = 0; t < 3; ++t) { S.bh[t] = *(const bf16x8*)(wb + (size_t)(t * 16) * DM + (ks) * 32); S.bl[t] = *(const bf16x8*)(wb + (size_t)(48 + t * 16) * DM + (ks) * 32); } } while (0)
#define R_COMP(S, ks) do { \
        const f32x4 a = (f32x4){bf2f(S.xw.x & 0xffffu), bf2f(S.xw.x >> 16), bf2f(S.xw.y & 0xffffu), bf2f(S.xw.y >> 16)}, c = (f32x4){bf2f(S.xw.z & 0xffffu), bf2f(S.xw.z >> 16), bf2f(S.xw.w & 0xffffu), bf2f(S.xw.w >> 16)}; \
        const f32x4 v0 = a * rstd * S.g0 * (S.s0 + 1.0f) + S.h0, v1 = c * rstd * S.g1 * (S.s1 + 1.0f) + S.h1; \
        u32x4 hi; hi.x = pk2(v0.x, v0.y); hi.y = pk2(v0.z, v0.w); hi.z = pk2(v1.x, v1.y); hi.w = pk2(v1.z, v1.w); \
        *(u32x4*)(hrow + (ks) * 32) = hi; \
        u32x4 lo; lo.x = pk2(v0.x - bf2f(hi.x & 0xffffu), v0.y - bf2f(hi.x >> 16)); lo.y = pk2(v0.z - bf2f(hi.y & 0xffffu), v0.w - bf2f(hi.y >> 16)); \
        lo.z = pk2(v1.x - bf2f(hi.z & 0xffffu), v1.y - bf2f(hi.z >> 16)); lo.w = pk2(v1.z - bf2f(hi.w & 0xffffu), v1.w - bf2f(hi.w >> 16)); \
        const bf16x8 ahi = __builtin_bit_cast(bf16x8, hi), alo = __builtin_bit_cast(bf16x8, lo); \
        _Pragma("unroll") for (int t = 0; t < 3; ++t) { \
            acc[t] = __builtin_amdgcn_mfma_f32_16x16x32_bf16(S.bh[t], ahi, acc[t], 0, 0, 0); \
            acc[t] = __builtin_amdgcn_mfma_f32_16x16x32_bf16(S.bh[t], alo, acc[t], 0, 0, 0); \
            acc[t] = __builtin_amdgcn_mfma_f32_16x16x32_bf16(S.bl[t], ahi, acc[t], 0, 0, 0); } } while (0)
    {
        u32x4 xall[32];
#pragma unroll
        for (int ks = 0; ks < 32; ++ks) xall[ks] = *(const u32x4*)(xr + ks * 32);
        RStep SA, SB;
        R_LOAD(SA, 0);
#pragma unroll
        for (int ks = 0; ks < 32; ks += 2) {
            R_LOAD(SB, ks + 1);
            R_COMP(SA, ks);
            if (ks + 2 < 32) R_LOAD(SA, ks + 2);
            R_COMP(SB, ks + 1);
        }
    }
#undef R_LOAD
#undef R_COMP
#pragma unroll
    for (int t = 0; t < 3; ++t)
#pragma unroll
        for (int r = 0; r < 4; ++r) lgs[fr * 48 + t * 16 + 4 * fq + r] = acc[t][r];
    LDS_WAIT(); __builtin_amdgcn_wave_barrier();
    {
        const LAS float* wl = lgs + fr * 48;
        float gl[4];
#pragma unroll
        for (int j = 0; j < 4; ++j) gl[j] = wl[j] + F_b_group[l * 4 + j];
        int gi = 0; float gm = gl[0];
#pragma unroll
        for (int j = 1; j < 4; ++j) if (gl[j] > gm) { gm = gl[j]; gi = j; }
        float gs = 0.f;
#pragma unroll
        for (int j = 0; j < 4; ++j) gs += __expf(gl[j] - gm);
        const float gw = 1.0f / gs;
        float ig[8];
#pragma unroll
        for (int j = 0; j < 8; ++j) ig[j] = wl[4 + gi * 8 + j] + F_b_expert[l * 32 + gi * 8 + j];
        int i0 = 0; float v0 = ig[0];
#pragma unroll
        for (int j = 1; j < 8; ++j) if (ig[j] > v0) { v0 = ig[j]; i0 = j; }
        int i1 = -1; float v1 = -3.0e38f;
#pragma unroll
        for (int j = 0; j < 8; ++j) if (j != i0 && ig[j] > v1) { v1 = ig[j]; i1 = j; }
        const float e1x = __expf(v1 - v0), w0 = gw / (1.0f + e1x), w1 = gw * e1x / (1.0f + e1x);
        if (fq == 0) { F_RW[(size_t)row * 2] = w0; F_RW[(size_t)row * 2 + 1] = w1;
            const int lr = F.wave * 16 + fr; l_ent[lr * 2] = row * 2; l_ent[lr * 2 + 1] = row * 2 + 1; l_exp[lr * 2] = gi * 8 + i0; l_exp[lr * 2 + 1] = gi * 8 + i1; }
    }
    __syncthreads();
    int rank = 0, e = 0;
    if (F.tid < 256) { e = l_exp[F.tid]; rank = atomicAdd((int*)&l_cnt[e], 1); }
    __syncthreads();
    if (F.tid < 32) l_base[F.tid] = (int)atomicAdd(F_ctl + CW_CNT + l * 32 + F.tid, (unsigned)l_cnt[F.tid]);
    __syncthreads();
    if (F.tid < 256) F_LIST[(size_t)e * NT + l_base[e] + rank] = l_ent[F.tid];
    __syncthreads();
}


struct GateOrder {
    int blk; const char* A; const char* Bt;
    __device__ __forceinline__ bool next(int i, pg8::Unit& u) const { if (i != 0 || blk < 64 || blk >= 192) return false; u.pm = blk - 64; u.pn = 10; u.e = 0; u.i = 0; return true; }
    __device__ __forceinline__ const char* a_base(const pg8::Unit& u) const { return A + (size_t)u.pm * (256 * DM * 2); }
    __device__ __forceinline__ const char* b_base(const pg8::Unit& u) const { return Bt + (size_t)u.pn * (256 * DM * 2); }
    __device__ __forceinline__ int row(const pg8::Unit&, int r) const { return r; }
};

constexpr int MOE_LDS = 131072;
constexpr int MOE_MAXU = 8;
struct MoeOrder {
    LAS const int* ud; LAS const int* rows; const char* A; const char* Bt; size_t strideE, tstepA, tstepB; bool gather;
    __device__ __forceinline__ bool next(int i, pg8::Unit& u) const { if (i >= MOE_MAXU || ud[i * 4 + 3] == 0) return false; u.pm = ud[i * 4]; u.pn = ud[i * 4 + 1]; u.e = ud[i * 4 + 2]; u.i = i; return true; }
    __device__ __forceinline__ const char* a_base(const pg8::Unit& u) const { return gather ? A : A + (size_t)u.pm * tstepA; }
    __device__ __forceinline__ const char* b_base(const pg8::Unit& u) const { return Bt + (size_t)u.e * strideE + (size_t)u.pn * tstepB; }
    __device__ __forceinline__ int row(const pg8::Unit& u, int r) const { if (!gather) return r; const int ent = rows[u.i * 256 + r]; return ent >= 0 ? (ent >> 1) : 0; }
};
struct EpiMoe1 {
    static constexpr bool PERM = true;
    bf16* act; const float* rw; LAS const int* rows;
    __device__ __forceinline__ void operator()(const f32x4 (&acc)[2][2][4][2], const pg8::Unit& u, int wr, int wc, int fr, int fq) const {
#pragma unroll
        for (int ai = 0; ai < 2; ++ai)
#pragma unroll
            for (int m = 0; m < 4; ++m) { const int rl = ai * 128 + wr * 64 + m * 16 + fr; const int ent = rows[u.i * 256 + rl]; const float w = ent >= 0 ? rw[ent] : 0.f;
                const f32x4 g0 = acc[ai][0][m][0], g1 = acc[ai][0][m][1], u0 = acc[ai][1][m][0], u1 = acc[ai][1][m][1];
                u32x4 o; o.x = pg8::cvt_pk_bf16(silu_f(g0[0]) * u0[0] * w, silu_f(g0[1]) * u0[1] * w); o.y = pg8::cvt_pk_bf16(silu_f(g0[2]) * u0[2] * w, silu_f(g0[3]) * u0[3] * w);
                o.z = pg8::cvt_pk_bf16(silu_f(g1[0]) * u1[0] * w, silu_f(g1[1]) * u1[1] * w); o.w = pg8::cvt_pk_bf16(silu_f(g1[2]) * u1[2] * w, silu_f(g1[3]) * u1[3] * w);
                *(u32x4*)(act + ((size_t)u.pm * 256 + rl) * FF + u.pn * 128 + wc * 32 + 8 * fq) = o; }
    }
};
struct EpiMoe2 {
    static constexpr bool PERM = true;
    bf16* slot; LAS const int* rows;
    __device__ __forceinline__ void operator()(const f32x4 (&acc)[2][2][4][2], const pg8::Unit& u, int wr, int wc, int fr, int fq) const {
#pragma unroll
        for (int ai = 0; ai < 2; ++ai)
#pragma unroll
            for (int m = 0; m < 4; ++m) { const int rl = ai * 128 + wr * 64 + m * 16 + fr; const int ent = rows[u.i * 256 + rl];
                if (ent >= 0) { bf16* rowp = slot + (size_t)(ent & 1) * NT * DM + (size_t)(ent >> 1) * DM + u.pn * 256 + wc * 32 + 8 * fq;
#pragma unroll
                    for (int bj = 0; bj < 2; ++bj) { const f32x4 v0 = acc[ai][bj][m][0], v1 = acc[ai][bj][m][1];
                        u32x4 w; w.x = pg8::cvt_pk_bf16(v0[0], v0[1]); w.y = pg8::cvt_pk_bf16(v0[2], v0[3]); w.z = pg8::cvt_pk_bf16(v1[0], v1[1]); w.w = pg8::cvt_pk_bf16(v1[2], v1[3]);
                        *(u32x4*)(rowp + bj * 128) = w; } } }
    }
};
struct MoeDeal { int nA, nB, NL, q, ls, nAfull; bool defer; };
__device__ __forceinline__ MoeDeal moe_deal(int tiles, int G) {
    MoeDeal d; d.nA = tiles * 2; d.nB = tiles * 4; d.nAfull = (d.nA / G) * G; d.NL = d.nA - d.nAfull; d.q = (d.nB + 2 * d.NL + G - 1) / G; d.ls = d.q - 3 < 2 ? 2 : d.q - 3;
    d.defer = (G == 256) && d.NL > 0 && d.NL <= 64 && d.q >= 4 && d.nAfull > 0 && d.ls <= MOE_MAXU && d.NL * d.ls <= d.nB && (d.nB - d.NL * d.ls + (G - d.NL) - 1) / (G - d.NL) <= MOE_MAXU; return d;
}
constexpr int CW_MB = 28672;
template <int STAGE>
__device__ __forceinline__ void moe_pg8(Frame& F, int l) {
    LAS int* t_cnt = (LAS int*)(F.lds + MOE_LDS);
    LAS int* t_toff = t_cnt + 32;
    LAS int* ud = t_toff + 36;
    LAS int* rows = ud + 32;
    int tid_m = threadIdx.x; asm volatile("" : "+v"(tid_m));
    __syncthreads();
    if (tid_m == 0) { int to = 0;
        for (int e = 0; e < NE; ++e) { const int c = (int)__hip_atomic_load(F_ctl + CW_CNT + l * 32 + e, __ATOMIC_RELAXED, __HIP_MEMORY_SCOPE_AGENT); t_cnt[e] = c; t_toff[e] = to; to += (c + 255) >> 8; }
        t_toff[NE] = to; }
    __syncthreads();
    const MoeDeal D = moe_deal(t_toff[NE], F.G);
#define MOE_SLOT(i, L, valid, NPN_) do { int rtg = 0, pn = 0, e = 0; \
        if (valid) { rtg = (L) / (NPN_); pn = (L) % (NPN_); for (int q_ = 1; q_ < NE; ++q_) if (t_toff[q_] <= rtg) e = q_; } \
        if (tid_m == 0) { ud[(i) * 4] = rtg; ud[(i) * 4 + 1] = pn; ud[(i) * 4 + 2] = e; ud[(i) * 4 + 3] = (valid) ? 1 : 0; } \
        if (tid_m < 256) { int ent = -1; if (valid) { const int pos = (rtg - t_toff[e]) * 256 + tid_m; if (pos < t_cnt[e]) ent = F_LIST[(size_t)e * NT + pos]; } rows[(i) * 256 + tid_m] = ent; } } while (0)
    MoeOrder S; S.ud = ud; S.rows = rows;
    if (STAGE == 1 || (D.defer && F.blk < D.NL)) {
        const int nlim = D.defer ? D.nAfull : D.nA;
        for (int i = 0; i < MOE_MAXU; ++i) { int L; bool valid;
            if (STAGE == 1) { L = i * F.G + F.blk; valid = L < nlim; } else { L = D.nAfull + F.blk; valid = (i == 0); }
            MOE_SLOT(i, L, valid, 2); }
        __syncthreads();
        S.A = (const char*)F_H; S.Bt = (const char*)(F_WguT + (size_t)l * NE * 512 * DM); S.strideE = (size_t)512 * DM * 2; S.tstepA = 0; S.tstepB = (size_t)256 * DM * 2; S.gather = true;
        EpiMoe1 E{F_ACT, F_RW, rows};
        pg8::gemm_phase<EpiMoe1, MoeOrder, true>(F.lds, DM, DM, DM, S, E);
        if (STAGE == 2) {
            asm volatile("s_waitcnt vmcnt(0)" ::: "memory"); __syncthreads();
            if (tid_m == 0) { unsigned* mb = F_ctl + CW_MB + l * 64;
                __builtin_amdgcn_fence(__ATOMIC_RELEASE, "agent"); asm volatile("s_waitcnt vmcnt(0)" ::: "memory");
                (void)__hip_atomic_fetch_add(mb, 1u, __ATOMIC_RELAXED, __HIP_MEMORY_SCOPE_AGENT);
                unsigned sp = 0; while (__hip_atomic_load(mb, __ATOMIC_RELAXED, __HIP_MEMORY_SCOPE_AGENT) < (unsigned)D.NL) { __builtin_amdgcn_s_sleep(1); if (++sp > (1u << 22)) break; }
                __builtin_amdgcn_fence(__ATOMIC_ACQUIRE, "agent"); asm volatile("s_waitcnt vmcnt(0)" ::: "memory"); }
            __syncthreads();
        }
    }
    if (STAGE == 2) {
        for (int i = 0; i < MOE_MAXU; ++i) { int L; bool valid;
            if (!D.defer) { L = i * F.G + F.blk; valid = L < D.nB; }
            else if (F.blk < D.NL) { L = D.nB - (F.blk + 1) * D.ls + i; valid = i < D.ls; }
            else { L = (F.blk - D.NL) + (F.G - D.NL) * i; valid = L < D.nB - D.NL * D.ls; }
            MOE_SLOT(i, L, valid, 4); }
        __syncthreads();
        S.A = (const char*)F_ACT; S.Bt = (const char*)(F_WdT + (size_t)l * NE * DM * FF); S.strideE = (size_t)DM * FF * 2; S.tstepA = (size_t)256 * FF * 2; S.tstepB = (size_t)256 * FF * 2; S.gather = false;
        EpiMoe2 E{F_SLOT, rows};
        pg8::gemm_phase<EpiMoe2, MoeOrder, false>(F.lds, FF, FF, FF, S, E);
    }
#undef MOE_SLOT
}

__device__ __forceinline__ void s5_build_operands(Frame& F, int l) {
    const int gt = F.blk * NTHR + F.tid, ngt = F.G * NTHR;
    for (int i = gt; i < 16 * 1024 * 16; i += ngt) {
        const int kv = i & 15, row = (i >> 4) & 1023, g = i >> 14, t = row >> 4, c = row & 15, k0 = kv * 8;
        const int lg = l * 16 + g, p0 = k0 & 63;
        const f32x4* pwp = (const f32x4*)(F_PW + ((size_t)lg * 65 + t + 1) * 64 + p0);
        const f32x4* crp = (const f32x4*)(F_c_re + ((size_t)lg * 16 + c) * 64 + p0); const f32x4* cip = (const f32x4*)(F_c_im + ((size_t)lg * 16 + c) * 64 + p0);
        const f32x4 w0 = pwp[0], w1 = pwp[1], w2 = pwp[2], w3 = pwp[3], cr0 = crp[0], cr1 = crp[1], ci0 = cip[0], ci1 = cip[1];
        const float pr[8] = {w0.x, w0.z, w1.x, w1.z, w2.x, w2.z, w3.x, w3.z}, pi[8] = {w0.y, w0.w, w1.y, w1.w, w2.y, w2.w, w3.y, w3.w};
        const float cr[8] = {cr0.x, cr0.y, cr0.z, cr0.w, cr1.x, cr1.y, cr1.z, cr1.w}, ci[8] = {ci0.x, ci0.y, ci0.z, ci0.w, ci1.x, ci1.y, ci1.z, ci1.w};
        float v[8];
#pragma unroll
        for (int q = 0; q < 8; ++q) v[q] = (k0 < 64) ? (cr[q] * pr[q] - ci[q] * pi[q]) : -(cr[q] * pi[q] + ci[q] * pr[q]);
        u32x4 o; o.x = pk2(v[0], v[1]); o.y = pk2(v[2], v[3]); o.z = pk2(v[4], v[5]); o.w = pk2(v[6], v[7]);
        *(u32x4*)(F_TMAT + ((size_t)(g * 1024 + row)) * 128 + k0) = o;
    }
    for (int i = gt; i < 16 * 256 * 128; i += ngt) {
        const int kv = i & 127, n = (i >> 7) & 255, g = i >> 15, s = kv >> 1, c0 = (kv & 1) * 8;
        float v[8];
#pragma unroll
        for (int q = 0; q < 8; ++q) v[q] = 0.f;
        if (n < 128) { const int p = n & 63, lg = l * 16 + g; const f32x2 pv = F_PW[((size_t)lg * 65 + (63 - s)) * 64 + p]; const float pr = pv.x, pi = pv.y;
#pragma unroll
            for (int q = 0; q < 8; ++q) { const f32x2 bb = F_BBAR[((size_t)lg * 64 + p) * 16 + c0 + q]; v[q] = (n < 64) ? (pr * bb.x - pi * bb.y) : (pr * bb.y + pi * bb.x); } }
        u32x4 o; o.x = pk2(v[0], v[1]); o.y = pk2(v[2], v[3]); o.z = pk2(v[4], v[5]); o.w = pk2(v[6], v[7]);
        *(u32x4*)(F_BT1 + ((size_t)(g * 256 + n)) * 1024 + s * 16 + c0) = o;
    }
}
struct GroupOrder {
    int G, c, npn, nunit; const char* A; const char* Bt; size_t strideB, tstepA, tstepB;
    __device__ __forceinline__ bool next(int i, pg8::Unit& u) const { const int L = i * G + c; if (L >= nunit) return false; u.pn = L % npn; u.pm = (L / npn) & 1; u.e = L / (npn * 2); u.i = i; return true; }
    __device__ __forceinline__ const char* a_base(const pg8::Unit& u) const { return A + (size_t)u.e * (U2K * 2) + (size_t)u.pm * tstepA; }
    __device__ __forceinline__ const char* b_base(const pg8::Unit& u) const { return Bt + (size_t)u.e * strideB + (size_t)u.pn * tstepB; }
    __device__ __forceinline__ int row(const pg8::Unit&, int r) const { return r; }
};
struct SplitKOrder {
    int G, c; const char* A; const char* Bt;
    __device__ __forceinline__ bool next(int i, pg8::Unit& u) const { const int L = i * G + c; if (L >= 64) return false; u.pn = L & 1; u.pm = (L >> 1) & 1; u.e = L >> 2; u.i = i; return true; }
    __device__ __forceinline__ const char* a_base(const pg8::Unit& u) const { return A + (size_t)u.e * (U2K * 2) + (size_t)u.pm * ((size_t)256 * U2LD * 2) + (size_t)u.pn * 1024; }
    __device__ __forceinline__ const char* b_base(const pg8::Unit& u) const { return Bt + (size_t)u.e * ((size_t)256 * 1024 * 2) + (size_t)u.pn * 1024; }
    __device__ __forceinline__ int row(const pg8::Unit&, int r) const { return r; }
};
struct ToepOrder {
    int G, c, npn, nunit; const char* A; const char* Kb; const char* Ct; size_t tstepA;
    __device__ __forceinline__ bool next(int i, pg8::Unit& u) const { const int L = i * G + c; if (L >= nunit) return false; u.pn = L % npn; u.pm = (L / npn) & 1; u.e = L / (npn * 2); u.i = i; return true; }
    __device__ __forceinline__ const char* a_base(const pg8::Unit& u) const { return A + (size_t)u.e * (U2K * 2) + (size_t)u.pm * tstepA; }
    __device__ __forceinline__ const char* b_base(const pg8::Unit& u) const { return Kb + (size_t)u.e * (128 * 512) + (size_t)(u.pn * 16 + 61) * 512 + 4096; }
    __device__ __forceinline__ const char* c_base(const pg8::Unit& u) const { return Ct + (size_t)u.e * (1024 * 256) + (size_t)u.pn * (256 * 256); }
    __device__ __forceinline__ int row(const pg8::Unit&, int r) const { return r; }
};
struct EpiS5a {
    static constexpr bool PERM = false;
    float* sendp;
    __device__ __forceinline__ void operator()(const f32x4 (&acc)[2][2][4][2], const pg8::Unit& u, int wr, int wc, int fr, int fq) const {
#pragma unroll
        for (int ai = 0; ai < 2; ++ai)
#pragma unroll
            for (int m = 0; m < 4; ++m) { const int R = u.pm * 256 + ai * 128 + wr * 64 + m * 16 + fr; float* rowp = sendp + (size_t)u.pn * (512 * 16 * 128) + ((size_t)R * 16 + u.e) * 128 + wc * 32 + 4 * fq;
#pragma unroll
                for (int n = 0; n < 2; ++n) *(f32x4*)(rowp + n * 16) = acc[ai][0][m][n]; }
    }
};
struct EpiS5b {
    static constexpr bool PERM = true;
    bf16* yg;
    __device__ __forceinline__ void operator()(const f32x4 (&acc)[2][2][4][2], const pg8::Unit& u, int wr, int wc, int fr, int fq) const {
#pragma unroll
        for (int ai = 0; ai < 2; ++ai)
#pragma unroll
            for (int m = 0; m < 4; ++m) { const int R = u.pm * 256 + ai * 128 + wr * 64 + m * 16 + fr;
#pragma unroll
                for (int bj = 0; bj < 2; ++bj) { const int col0 = u.pn * 256 + bj * 128 + wc * 32 + 8 * fq, t = col0 >> 4, c0 = col0 & 15; const f32x4 v0 = acc[ai][bj][m][0], v1 = acc[ai][bj][m][1];
                    u32x4 w; w.x = pg8::cvt_pk_bf16(gelu_tanh_f(v0[0]), gelu_tanh_f(v0[1])); w.y = pg8::cvt_pk_bf16(gelu_tanh_f(v0[2]), gelu_tanh_f(v0[3]));
                    w.z = pg8::cvt_pk_bf16(gelu_tanh_f(v1[0]), gelu_tanh_f(v1[1])); w.w = pg8::cvt_pk_bf16(gelu_tanh_f(v1[2]), gelu_tanh_f(v1[3]));
                    *(u32x4*)(yg + ((size_t)R * 64 + t) * 256 + u.e * 16 + c0) = w; } }
    }
};
struct EpiGlu {
    static constexpr bool PERM = true;
    const bf16* yg; bf16* mix; const float* bglu;
    __device__ __forceinline__ void operator()(const f32x4 (&acc)[2][2][4][2], const pg8::Unit& u, int wr, int wc, int fr, int fq) const {
#pragma unroll
        for (int ai = 0; ai < 2; ++ai)
#pragma unroll
            for (int m = 0; m < 4; ++m) { const size_t row = (size_t)u.pm * 256 + ai * 128 + wr * 64 + m * 16 + fr;
#pragma unroll
                for (int bj = 0; bj < 2; ++bj) { const int col0 = bj * 128 + wc * 32 + 8 * fq; const u32x4 y = *(const u32x4*)(yg + row * 256 + col0);
                    const f32x4 b0 = *(const f32x4*)(bglu + col0), b1 = *(const f32x4*)(bglu + col0 + 4); const f32x4 v0 = acc[ai][bj][m][0] + b0, v1 = acc[ai][bj][m][1] + b1;
                    u32x4 w; w.x = pg8::cvt_pk_bf16(bf2f(y.x & 0xffffu) * sigmoid_f(v0[0]), bf2f(y.x >> 16) * sigmoid_f(v0[1])); w.y = pg8::cvt_pk_bf16(bf2f(y.y & 0xffffu) * sigmoid_f(v0[2]), bf2f(y.y >> 16) * sigmoid_f(v0[3]));
                    w.z = pg8::cvt_pk_bf16(bf2f(y.z & 0xffffu) * sigmoid_f(v1[0]), bf2f(y.z >> 16) * sigmoid_f(v1[1])); w.w = pg8::cvt_pk_bf16(bf2f(y.w & 0xffffu) * sigmoid_f(v1[2]), bf2f(y.w >> 16) * sigmoid_f(v1[3]));
                    *(u32x4*)(mix + row * DM + 512 + col0) = w; } }
    }
};

__device__ __forceinline__ float ret_log2gamma(int h) { return log2f(1.0f - exp2f(-5.0f - (float)h)); }

template <int NQT> __device__ __forceinline__ void attn_mfma(Frame& F, int l);
__device__ __forceinline__ void attn_coop(Frame& F, int l);
__device__ __forceinline__ void p4_scan_attn(Frame& F, int l) {
    const bool rs = (F.G == 256) && F.tid < 256;
    unsigned t[NCH]; unsigned* p0 = nullptr; float g64 = 0.f;
    if (rs) { const int i = F.blk * 256 + F.tid, b = i >> 13, h = (i >> 11) & 3, de2 = i & 2047; g64 = exp2f(64.f * ret_log2gamma(h));
        p0 = (unsigned*)(F_KVB + (size_t)(b * NCH) * KVST + h * 4096) + de2;
#pragma unroll
        for (int n = 0; n < NCH; ++n) t[n] = p0[(size_t)n * (KVST / 2)]; }
    LAS float* sst = (LAS float*)F.lds;
    { const int i0 = F.blk * 32, b = (i0 >> 10) & 7, g = (i0 >> 6) & 15, pb = i0 & 63;
#pragma unroll
        for (int j = 0; j < 2; ++j) { const int v = F.tid + j * NTHR, n = v >> 4, part = (v >> 3) & 1, q = v & 7; const size_t r = (size_t)(b * NCH + n) * 16 + g;
            const float* sp = F_SENDP + r * 128 + part * 64 + pb + q * 4; const f32x4 a = *(const f32x4*)sp, c = *(const f32x4*)(sp + 512 * 16 * 128);
            *(LAS f32x4*)(sst + (n * 2 + part) * 32 + q * 4) = a + c; } }
    __syncthreads();
    if (F.tid >= NTHR - 32) { const int tl = F.tid - (NTHR - 32), i = F.blk * 32 + tl;
        if (i < NB * 16 * 64) { const int b = i >> 10, g = (i >> 6) & 15, p = i & 63; const f32x2 a64 = F_ABAR64[l * 1024 + (i & 1023)];
            float xr = 0.f, xi = 0.f;
#pragma unroll 8
            for (int n = 0; n < NCH; ++n) { const size_t r = (size_t)(b * NCH + n) * 16 + g; bf16* cp = F_U2X + r * U2K; cp[p] = (bf16)f2bf(xr); cp[64 + p] = (bf16)f2bf(xi);
                const float sr = sst[(n * 2) * 32 + tl], si = sst[(n * 2 + 1) * 32 + tl];
                const float nr = a64.x * xr - a64.y * xi + sr, ni = a64.x * xi + a64.y * xr + si; xr = nr; xi = ni; } } }
    if (rs) { float s0 = 0.f, s1 = 0.f;
#pragma unroll
        for (int n = 0; n < NCH; ++n) { const float v0 = bf2f(t[n] & 0xffffu), v1 = bf2f(t[n] >> 16); p0[(size_t)n * (KVST / 2)] = pk2(s0, s1); s0 = g64 * s0 + v0; s1 = g64 * s1 + v1; } }
    if (F.G != 256)
    for (int i = F.blk * 256 + F.tid; F.tid < 256 && i < NB * 4 * 2048; i += F.G * 256) { const int b = i >> 13, h = (i >> 11) & 3, de2 = i & 2047; const float gg = exp2f(64.f * ret_log2gamma(h));
        unsigned* q0 = (unsigned*)(F_KVB + (size_t)(b * NCH) * KVST + h * 4096) + de2; unsigned tt[NCH];
#pragma unroll
        for (int n = 0; n < NCH; ++n) tt[n] = q0[(size_t)n * (KVST / 2)];
        float s0 = 0.f, s1 = 0.f;
#pragma unroll
        for (int n = 0; n < NCH; ++n) { const float v0 = bf2f(tt[n] & 0xffffu), v1 = bf2f(tt[n] >> 16); q0[(size_t)n * (KVST / 2)] = pk2(s0, s1); s0 = gg * s0 + v0; s1 = gg * s1 + v1; } }
    __syncthreads();
    if (F.G == 256) attn_coop(F, l); else attn_mfma<ATTN_NQT>(F, l);
}


typedef short v4i16_t __attribute__((ext_vector_type(4)));
template <int NQT>
__device__ __forceinline__ void attn_mfma(Frame& F, int l) {
    const int lane = F.lane, fr = lane & 15, fq = lane >> 4;
    LAS unsigned char* vl = F.lds + F.wave * 10240;
    LAS float* bl = (LAS float*)(vl + 9216);
    constexpr int QPW = NQT * 16, TPC = 64 / QPW;
    constexpr float LOG2E = 1.4426950408889634f, SC = 0.125f * LOG2E;
    const int ntask = NB * NCH * 8 * TPC;
    const unsigned vtr0 = (unsigned)((4 * fq + (fr >> 2)) * 144 + (fr & 3) * 8);
    constexpr int WPC = 8 / TPC;
    const bool deal = (F.G == 256);
    const int nstep = deal ? 16 / WPC : (ntask + F.ngw - 1) / F.ngw;
    for (int step = 0; step < nstep; ++step) {
        int sub, h, n, b;
        if (deal) { const int j = F.blk >> 3; b = F.blk & 7; h = j >> 2; n = (j & 3) * 16 + step * WPC + F.wave / TPC; sub = F.wave % TPC; }
        else { const int task = F.gw + step * F.ngw; if (task >= ntask) break; sub = task % TPC; const int u = task / TPC; h = u & 7; n = (u >> 3) & 63; b = u >> 9; }
        const size_t qrow0 = (size_t)b * SEQ + n * 64 + sub * QPW;
        __builtin_amdgcn_wave_barrier();
#pragma unroll
        for (int i = 0; i < 3; ++i) bl[lane + 64 * i] = F_rel_bias[(size_t)(l * 8 + h) * 192 + lane + 64 * i] * LOG2E;
        bf16x8 qf[NQT][2];
#pragma unroll
        for (int qt = 0; qt < NQT; ++qt)
#pragma unroll
            for (int ks = 0; ks < 2; ++ks) qf[qt][ks] = *(const bf16x8*)(F_QKV + (qrow0 + qt * 16 + fr) * INW + C_QA + h * 64 + ks * 32 + fq * 8);
        f32x4 ot[4][NQT]; float lp[NQT];
#pragma unroll
        for (int qt = 0; qt < NQT; ++qt) { lp[qt] = 0.f;
#pragma unroll
            for (int et = 0; et < 4; ++et) ot[et][qt] = (f32x4){0.f, 0.f, 0.f, 0.f}; }
        LDS_WAIT(); __builtin_amdgcn_wave_barrier();
        const float b0 = bl[0];
        const int kc0 = n >= 8 ? n - 8 : 0;
        bf16x8 kf[4][2];
#pragma unroll
        for (int kt = 0; kt < 4; ++kt) { const bf16* kp = F_QKV + ((size_t)b * SEQ + kc0 * 64 + kt * 16 + fr) * INW + C_KA + h * 64 + fq * 8; kf[kt][0] = *(const bf16x8*)kp; kf[kt][1] = *(const bf16x8*)(kp + 32); }
        for (int kc = kc0; kc <= n; ++kc) {
            const size_t krow0 = (size_t)b * SEQ + kc * 64;
            u32x4 vreg[8];
#pragma unroll
            for (int i = 0; i < 8; ++i) vreg[i] = *(const u32x4*)(F_QKV + (krow0 + (lane >> 3) + 8 * i) * INW + C_VA + h * 64 + (lane & 7) * 8);
            bf16x8 kn[4][2];
            { const size_t krow1 = (size_t)b * SEQ + (kc < n ? kc + 1 : n) * 64;
#pragma unroll
                for (int kt = 0; kt < 4; ++kt) { const bf16* kp = F_QKV + (krow1 + kt * 16 + fr) * INW + C_KA + h * 64 + fq * 8; kn[kt][0] = *(const bf16x8*)kp; kn[kt][1] = *(const bf16x8*)(kp + 32); } }
            f32x4 st[4][NQT];
#pragma unroll
            for (int kt = 0; kt < 4; ++kt) {
#pragma unroll
                for (int qt = 0; qt < NQT; ++qt) { f32x4 z = (f32x4){0.f, 0.f, 0.f, 0.f};
                    z = __builtin_amdgcn_mfma_f32_16x16x32_bf16(kf[kt][0], qf[qt][0], z, 0, 0, 0); st[kt][qt] = __builtin_amdgcn_mfma_f32_16x16x32_bf16(kf[kt][1], qf[qt][1], z, 0, 0, 0); } }
            const int dc = kc - n;
            if (dc <= -3) {
#pragma unroll
                for (int kt = 0; kt < 4; ++kt)
#pragma unroll
                    for (int qt = 0; qt < NQT; ++qt) st[kt][qt] = st[kt][qt] * SC + b0;
            } else {
                const int ib = 64 * dc + 128 + 4 * fq - fr + sub * (-QPW);
#pragma unroll
                for (int kt = 0; kt < 4; ++kt)
#pragma unroll
                    for (int qt = 0; qt < NQT; ++qt)
#pragma unroll
                        for (int r = 0; r < 4; ++r) { int idx = ib + 16 * (kt - qt) + r; idx = idx < 0 ? 0 : idx; st[kt][qt][r] = st[kt][qt][r] * SC + bl[idx]; }
            }
#pragma unroll
            for (int qt = 0; qt < NQT; ++qt) { float ps = 0.f;
#pragma unroll
                for (int kt = 0; kt < 4; ++kt)
#pragma unroll
                    for (int r = 0; r < 4; ++r) { const float p = __builtin_amdgcn_exp2f(st[kt][qt][r]); st[kt][qt][r] = p; ps += p; }
                lp[qt] += ps; }
            __builtin_amdgcn_wave_barrier();
#pragma unroll
            for (int i = 0; i < 8; ++i) *(LAS u32x4*)(vl + ((lane >> 3) + 8 * i) * 144 + (lane & 7) * 16) = vreg[i];
            LDS_WAIT(); __builtin_amdgcn_wave_barrier();
#pragma unroll
            for (int s = 0; s < 2; ++s) {
                bf16x8 pf[NQT];
#pragma unroll
                for (int qt = 0; qt < NQT; ++qt) { u32x4 w; w.x = pg8::cvt_pk_bf16(st[2 * s][qt][0], st[2 * s][qt][1]); w.y = pg8::cvt_pk_bf16(st[2 * s][qt][2], st[2 * s][qt][3]);
                    w.z = pg8::cvt_pk_bf16(st[2 * s + 1][qt][0], st[2 * s + 1][qt][1]); w.w = pg8::cvt_pk_bf16(st[2 * s + 1][qt][2], st[2 * s + 1][qt][3]); pf[qt] = __builtin_bit_cast(bf16x8, w); }
#pragma unroll
                for (int et = 0; et < 4; ++et) {
                    const v4i16_t t0 = __builtin_amdgcn_ds_read_tr16_b64_v4i16((LAS v4i16_t*)(vl + vtr0 + (2 * s) * 16 * 144 + et * 32));
                    const v4i16_t t1 = __builtin_amdgcn_ds_read_tr16_b64_v4i16((LAS v4i16_t*)(vl + vtr0 + (2 * s + 1) * 16 * 144 + et * 32));
                    bf16x8 vf; vf[0] = t0[0]; vf[1] = t0[1]; vf[2] = t0[2]; vf[3] = t0[3]; vf[4] = t1[0]; vf[5] = t1[1]; vf[6] = t1[2]; vf[7] = t1[3];
#pragma unroll
                    for (int qt = 0; qt < NQT; ++qt) ot[et][qt] = __builtin_amdgcn_mfma_f32_16x16x32_bf16(vf, pf[qt], ot[et][qt], 0, 0, 0);
                }
            }
#pragma unroll
            for (int kt = 0; kt < 4; ++kt) { kf[kt][0] = kn[kt][0]; kf[kt][1] = kn[kt][1]; }
        }
#pragma unroll
        for (int qt = 0; qt < NQT; ++qt) { float ls = lp[qt]; ls += __shfl_xor(ls, 16); ls += __shfl_xor(ls, 32); const float inv = 1.0f / ls;
            bf16* op = F_MIX + (qrow0 + qt * 16 + fr) * DM + h * 64 + 4 * fq;
#pragma unroll
            for (int et = 0; et < 4; ++et) { const f32x4 o = ot[et][qt] * inv; u32x2 w; w.x = pk2(o.x, o.y); w.y = pk2(o.z, o.w); *(u32x2*)(op + et * 16) = w; } }
    }
}


__device__ __forceinline__ void attn_coop(Frame& F, int l) {
    const int lane = F.lane, fr = lane & 15, fq = lane >> 4, tid = F.tid, wave = F.wave;
    constexpr int PIT = 144, TILE = 64 * PIT, BUF = 2 * TILE;
    LAS unsigned char* base = F.lds;
    LAS float* bl = (LAS float*)(F.lds + 2 * BUF);
    constexpr float LOG2E = 1.4426950408889634f, SC = 0.125f * LOG2E;
    const unsigned vtr0 = (unsigned)((4 * fq + (fr >> 2)) * PIT + (fr & 3) * 8);
    const unsigned kfa = (unsigned)(fr * PIT + fq * 16);
    const int srow = tid >> 3, sch = tid & 7;
    const int b = F.blk & 7, jq = F.blk >> 3, h = jq >> 2, quarter = jq & 3, sub = wave & 1;
    for (int step = 0; step < 4; ++step) {
        const int n0 = quarter * 16 + step * 4, nw = n0 + (wave >> 1);
        const size_t qrow0 = (size_t)b * SEQ + nw * 64 + sub * 32;
        const int kcmin = n0 >= 8 ? n0 - 8 : 0, nit = n0 + 3 - kcmin + 1;
        __syncthreads();
        if (tid < 192) bl[tid] = F_rel_bias[(size_t)(l * 8 + h) * 192 + tid] * LOG2E;
        { const bf16* gp = F_QKV + ((size_t)b * SEQ + kcmin * 64 + srow) * INW + h * 64 + sch * 8;
            const u32x4 kk = *(const u32x4*)(gp + C_KA), vv = *(const u32x4*)(gp + C_VA);
            *(LAS u32x4*)(base + srow * PIT + sch * 16) = kk; *(LAS u32x4*)(base + TILE + srow * PIT + sch * 16) = vv; }
        bf16x8 qf[2][2];
#pragma unroll
        for (int qt = 0; qt < 2; ++qt)
#pragma unroll
            for (int ks = 0; ks < 2; ++ks) qf[qt][ks] = *(const bf16x8*)(F_QKV + (qrow0 + qt * 16 + fr) * INW + C_QA + h * 64 + ks * 32 + fq * 8);
        f32x4 ot[4][2]; float lp[2];
#pragma unroll
        for (int qt = 0; qt < 2; ++qt) { lp[qt] = 0.f;
#pragma unroll
            for (int et = 0; et < 4; ++et) ot[et][qt] = (f32x4){0.f, 0.f, 0.f, 0.f}; }
        __syncthreads();
        const float b0 = bl[0];
        for (int i = 0; i < nit; ++i) {
            const int kc = kcmin + i; const bool more = (i + 1 < nit);
            u32x4 kk, vv;
            if (more) { const bf16* gp = F_QKV + ((size_t)b * SEQ + (kc + 1) * 64 + srow) * INW + h * 64 + sch * 8; kk = *(const u32x4*)(gp + C_KA); vv = *(const u32x4*)(gp + C_VA); }
            LAS unsigned char* kb = base + (i & 1) * BUF; LAS unsigned char* vb = kb + TILE;
            if (kc >= nw - 8 && kc <= nw) {
                f32x4 st[4][2];
#pragma unroll
                for (int kt = 0; kt < 4; ++kt) { const bf16x8 k0 = *(const LAS bf16x8*)(kb + kfa + kt * 16 * PIT), k1 = *(const LAS bf16x8*)(kb + kfa + kt * 16 * PIT + 64);
#pragma unroll
                    for (int qt = 0; qt < 2; ++qt) { f32x4 z = (f32x4){0.f, 0.f, 0.f, 0.f};
                        z = __builtin_amdgcn_mfma_f32_16x16x32_bf16(k0, qf[qt][0], z, 0, 0, 0); st[kt][qt] = __builtin_amdgcn_mfma_f32_16x16x32_bf16(k1, qf[qt][1], z, 0, 0, 0); } }
                const int dc = kc - nw;
                if (dc <= -3) {
#pragma unroll
                    for (int kt = 0; kt < 4; ++kt)
#pragma unroll
                        for (int qt = 0; qt < 2; ++qt) st[kt][qt] = st[kt][qt] * SC + b0;
                } else {
                    const int ib = 64 * dc + 128 + 4 * fq - fr - sub * 32;
#pragma unroll
                    for (int kt = 0; kt < 4; ++kt)
#pragma unroll
                        for (int qt = 0; qt < 2; ++qt)
#pragma unroll
                            for (int r = 0; r < 4; ++r) { int idx = ib + 16 * (kt - qt) + r; idx = idx < 0 ? 0 : idx; st[kt][qt][r] = st[kt][qt][r] * SC + bl[idx]; }
                }
#pragma unroll
                for (int qt = 0; qt < 2; ++qt) { float ps = 0.f;
#pragma unroll
                    for (int kt = 0; kt < 4; ++kt)
#pragma unroll
                        for (int r = 0; r < 4; ++r) { const float p = __builtin_amdgcn_exp2f(st[kt][qt][r]); st[kt][qt][r] = p; ps += p; }
                    lp[qt] += ps; }
#pragma unroll
                for (int s = 0; s < 2; ++s) {
                    bf16x8 pf[2];
#pragma unroll
                    for (int qt = 0; qt < 2; ++qt) { u32x4 w; w.x = pg8::cvt_pk_bf16(st[2 * s][qt][0], st[2 * s][qt][1]); w.y = pg8::cvt_pk_bf16(st[2 * s][qt][2], st[2 * s][qt][3]);
                        w.z = pg8::cvt_pk_bf16(st[2 * s + 1][qt][0], st[2 * s + 1][qt][1]); w.w = pg8::cvt_pk_bf16(st[2 * s + 1][qt][2], st[2 * s + 1][qt][3]); pf[qt] = __builtin_bit_cast(bf16x8, w); }
#pragma unroll
                    for (int et = 0; et < 4; ++et) {
                        const v4i16_t t0 = __builtin_amdgcn_ds_read_tr16_b64_v4i16((LAS v4i16_t*)(vb + vtr0 + (2 * s) * 16 * PIT + et * 32));
                        const v4i16_t t1 = __builtin_amdgcn_ds_read_tr16_b64_v4i16((LAS v4i16_t*)(vb + vtr0 + (2 * s + 1) * 16 * PIT + et * 32));
                        bf16x8 vf; vf[0] = t0[0]; vf[1] = t0[1]; vf[2] = t0[2]; vf[3] = t0[3]; vf[4] = t1[0]; vf[5] = t1[1]; vf[6] = t1[2]; vf[7] = t1[3];
#pragma unroll
                        for (int qt = 0; qt < 2; ++qt) ot[et][qt] = __builtin_amdgcn_mfma_f32_16x16x32_bf16(vf, pf[qt], ot[et][qt], 0, 0, 0);
                    }
                }
            }
            if (more) { LAS unsigned char* nb = base + ((i + 1) & 1) * BUF; *(LAS u32x4*)(nb + srow * PIT + sch * 16) = kk; *(LAS u32x4*)(nb + TILE + srow * PIT + sch * 16) = vv; }
            __syncthreads();
        }
#pragma unroll
        for (int qt = 0; qt < 2; ++qt) { float ls = lp[qt]; ls += __shfl_xor(ls, 16); ls += __shfl_xor(ls, 32); const float inv = 1.0f / ls;
            bf16* op = F_MIX + (qrow0 + qt * 16 + fr) * DM + h * 64 + 4 * fq;
#pragma unroll
            for (int et = 0; et < 4; ++et) { const f32x4 o = ot[et][qt] * inv; u32x2 w; w.x = pk2(o.x, o.y); w.y = pk2(o.z, o.w); *(u32x2*)(op + et * 16) = w; } }
    }
}

__device__ __forceinline__ void unpack8(const u32x4 w, float (&x)[8]) { x[0] = bf2f(w.x & 0xffffu); x[1] = bf2f(w.x >> 16); x[2] = bf2f(w.y & 0xffffu); x[3] = bf2f(w.y >> 16); x[4] = bf2f(w.z & 0xffffu); x[5] = bf2f(w.z >> 16); x[6] = bf2f(w.w & 0xffffu); x[7] = bf2f(w.w >> 16); }
__device__ __forceinline__ u32x4 pack8(const float (&x)[8]) { u32x4 w; w.x = pk2(x[0], x[1]); w.y = pk2(x[2], x[3]); w.z = pk2(x[4], x[5]); w.w = pk2(x[6], x[7]); return w; }
__device__ __forceinline__ void rope8(const u32x4 a, const u32x4 b, const f32x2* cs, float scale, u32x4& o1, u32x4& o2) {
    float x1[8], x2[8], r1[8], r2[8]; unpack8(a, x1); unpack8(b, x2);
    const f32x4* c4 = (const f32x4*)cs;
#pragma unroll
    for (int q = 0; q < 4; ++q) { const f32x4 t = c4[q];
        r1[2 * q] = (x1[2 * q] * t.x - x2[2 * q] * t.y) * scale; r2[2 * q] = (x1[2 * q] * t.y + x2[2 * q] * t.x) * scale;
        r1[2 * q + 1] = (x1[2 * q + 1] * t.z - x2[2 * q + 1] * t.w) * scale; r2[2 * q + 1] = (x1[2 * q + 1] * t.w + x2[2 * q + 1] * t.z) * scale; }
    o1 = pack8(r1); o2 = pack8(r2);
}
__device__ __forceinline__ bf16x8 tr_frag(LAS unsigned char* p0, LAS unsigned char* p1) {
    const v4i16_t t0 = __builtin_amdgcn_ds_read_tr16_b64_v4i16((LAS v4i16_t*)p0), t1 = __builtin_amdgcn_ds_read_tr16_b64_v4i16((LAS v4i16_t*)p1);
    bf16x8 f; f[0] = t0[0]; f[1] = t0[1]; f[2] = t0[2]; f[3] = t0[3]; f[4] = t1[0]; f[5] = t1[1]; f[6] = t1[2]; f[7] = t1[3]; return f;
}
__device__ __forceinline__ void ret_kv_mfma(Frame& F, int l) {
    const int lane = F.lane, fr = lane & 15, fq = lane >> 4;
    constexpr int PIT = 136;
    LAS unsigned char* kt = F.lds + F.wave * (2 * 64 * PIT);
    LAS unsigned char* vt = kt + 64 * PIT;
    const unsigned tr0 = (unsigned)((4 * fq + (fr >> 2)) * PIT + (fr & 3) * 8);
    int u0, ustride, ucnt;
    if (F.G != 256) { u0 = F.gw; ustride = F.ngw; ucnt = (NB * NCH * 4 - u0 + ustride - 1) / ustride; }
    else if (F.blk < 64) { u0 = F.blk * NWAVES + F.wave; ustride = 0; ucnt = 1; }
    else if (F.blk >= 192) { u0 = 512 + (F.blk - 192) * NWAVES + F.wave; ustride = 512; ucnt = 3; }
    else return;
    for (int ui = 0; ui < ucnt; ++ui) { const int u = u0 + ui * ustride;
        const int h = u & 3, n = (u >> 2) & 63, b = u >> 8; const float lg = ret_log2gamma(h);
        const size_t row = (size_t)b * SEQ + n * 64 + lane;
        const bf16* kp = F_QKV + row * INW + C_KR + h * 64; const bf16* vp = F_QKV + row * INW + C_VR + h * 64;
        const f32x2* rp = F_ROPE + (size_t)(n * 64 + lane) * 32;
        const float zs = 0.125f * exp2f(lg * (float)(63 - lane));
        __builtin_amdgcn_wave_barrier();
#pragma unroll
        for (int dq = 0; dq < 4; ++dq) { u32x4 o1, o2; rope8(*(const u32x4*)(kp + dq * 8), *(const u32x4*)(kp + 32 + dq * 8), rp + dq * 8, zs, o1, o2);
            LAS u32x2* w1 = (LAS u32x2*)(kt + lane * PIT + dq * 16); LAS u32x2* w2 = (LAS u32x2*)(kt + lane * PIT + 64 + dq * 16);
            w1[0] = (u32x2){o1.x, o1.y}; w1[1] = (u32x2){o1.z, o1.w}; w2[0] = (u32x2){o2.x, o2.y}; w2[1] = (u32x2){o2.z, o2.w}; }
#pragma unroll
        for (int c = 0; c < 8; ++c) { const u32x4 v = *(const u32x4*)(vp + c * 8); LAS u32x2* w = (LAS u32x2*)(vt + lane * PIT + c * 16); w[0] = (u32x2){v.x, v.y}; w[1] = (u32x2){v.z, v.w}; }
        LDS_WAIT(); __builtin_amdgcn_wave_barrier();
        f32x4 acc[4][4];
#pragma unroll
        for (int i = 0; i < 4; ++i)
#pragma unroll
            for (int j = 0; j < 4; ++j) acc[i][j] = (f32x4){0.f, 0.f, 0.f, 0.f};
#pragma unroll
        for (int s = 0; s < 2; ++s) {
            bf16x8 kf[4];
#pragma unroll
            for (int dt = 0; dt < 4; ++dt) kf[dt] = tr_frag(kt + tr0 + (2 * s) * 16 * PIT + dt * 32, kt + tr0 + (2 * s + 1) * 16 * PIT + dt * 32);
#pragma unroll
            for (int et = 0; et < 4; ++et) { const bf16x8 vf = tr_frag(vt + tr0 + (2 * s) * 16 * PIT + et * 32, vt + tr0 + (2 * s + 1) * 16 * PIT + et * 32);
#pragma unroll
                for (int dt = 0; dt < 4; ++dt) acc[et][dt] = __builtin_amdgcn_mfma_f32_16x16x32_bf16(kf[dt], vf, acc[et][dt], 0, 0, 0); }
        }
        bf16* o = F_KVB + (size_t)(u >> 2) * KVST + (u & 3) * 4096;
#pragma unroll
        for (int et = 0; et < 4; ++et)
#pragma unroll
            for (int dt = 0; dt < 4; ++dt) { u32x2 w; w.x = pk2(acc[et][dt][0], acc[et][dt][1]); w.y = pk2(acc[et][dt][2], acc[et][dt][3]); *(u32x2*)(o + (et * 16 + fr) * 64 + dt * 16 + 4 * fq) = w; }
    }
}
__device__ __forceinline__ void ret_out_mfma(Frame& F, int l) {
    const int lane = F.lane, fr = lane & 15, fq = lane >> 4;
    constexpr int PIT = 144;
    LAS unsigned char* vt = F.lds + F.wave * (64 * PIT);
    const unsigned tr0 = (unsigned)((4 * fq + (fr >> 2)) * PIT + (fr & 3) * 8);
    const int skip = (F.G == 256) ? 128 : 0;
    if (F.blk < skip) return;
    for (int u = (F.blk - skip) * NWAVES + F.wave; u < NB * NCH * 4; u += (F.G - skip) * NWAVES) {
        const int h = u & 3, n = (u >> 2) & 63, b = u >> 8; const float lg = ret_log2gamma(h);
        const size_t row0 = (size_t)b * SEQ + n * 64;
        __builtin_amdgcn_wave_barrier();
#pragma unroll
        for (int i = 0; i < 8; ++i) { const u32x4 v = *(const u32x4*)(F_QKV + (row0 + (lane >> 3) + 8 * i) * INW + C_VR + h * 64 + (lane & 7) * 8); *(LAS u32x4*)(vt + ((lane >> 3) + 8 * i) * PIT + (lane & 7) * 16) = v; }
        bf16x8 kf[4][2];
#pragma unroll
        for (int jt = 0; jt < 4; ++jt) { const int j = jt * 16 + fr; u32x4 o1, o2;
            const bf16* kp = F_QKV + (row0 + j) * INW + C_KR + h * 64 + fq * 8; rope8(*(const u32x4*)kp, *(const u32x4*)(kp + 32), F_ROPE + (size_t)(n * 64 + j) * 32 + fq * 8, 0.125f, o1, o2);
            kf[jt][0] = __builtin_bit_cast(bf16x8, o1); kf[jt][1] = __builtin_bit_cast(bf16x8, o2); }
        LDS_WAIT(); __builtin_amdgcn_wave_barrier();
        const bf16* prev = F_KVB + (size_t)(u >> 2) * KVST + (u & 3) * 4096; const float* gng = F_gn_g + l * 256 + h * 64 + 4 * fq;
        bf16x8 pvf[4][2];
#pragma unroll
        for (int et = 0; et < 4; ++et)
#pragma unroll
            for (int ks = 0; ks < 2; ++ks) pvf[et][ks] = *(const bf16x8*)(prev + (et * 16 + fr) * 64 + ks * 32 + fq * 8);
#pragma unroll 1
        for (int hq = 0; hq < 2; ++hq) {
            bf16x8 qf[2][2];
#pragma unroll
            for (int it = 0; it < 2; ++it) { const int i = (2 * hq + it) * 16 + fr; u32x4 o1, o2;
                const bf16* qp = F_QKV + (row0 + i) * INW + C_QR + h * 64 + fq * 8; rope8(*(const u32x4*)qp, *(const u32x4*)(qp + 32), F_ROPE + (size_t)(n * 64 + i) * 32 + fq * 8, 1.0f, o1, o2);
                qf[it][0] = __builtin_bit_cast(bf16x8, o1); qf[it][1] = __builtin_bit_cast(bf16x8, o2); }
            u32x2 gwv[2][4]; f32x4 gnv[4];
#pragma unroll
            for (int et = 0; et < 4; ++et) { gnv[et] = *(const f32x4*)(gng + et * 16);
#pragma unroll
                for (int it = 0; it < 2; ++it) gwv[it][et] = *(const u32x2*)(F_QKV + (row0 + (2 * hq + it) * 16 + fr) * INW + C_GR + h * 64 + et * 16 + 4 * fq); }
            f32x4 st[4][2];
#pragma unroll
            for (int jt = 0; jt < 4; ++jt)
#pragma unroll
                for (int it = 0; it < 2; ++it) { f32x4 z = (f32x4){0.f, 0.f, 0.f, 0.f}; z = __builtin_amdgcn_mfma_f32_16x16x32_bf16(kf[jt][0], qf[it][0], z, 0, 0, 0); st[jt][it] = __builtin_amdgcn_mfma_f32_16x16x32_bf16(kf[jt][1], qf[it][1], z, 0, 0, 0); }
#pragma unroll
            for (int jt = 0; jt < 4; ++jt)
#pragma unroll
                for (int it = 0; it < 2; ++it)
#pragma unroll
                    for (int r = 0; r < 4; ++r) { const int dd = ((2 * hq + it) * 16 + fr) - (jt * 16 + 4 * fq + r); st[jt][it][r] = dd >= 0 ? st[jt][it][r] * exp2f(lg * (float)dd) : 0.f; }
            f32x4 yi[4][2], yc[4][2];
#pragma unroll
            for (int et = 0; et < 4; ++et)
#pragma unroll
                for (int it = 0; it < 2; ++it) { yi[et][it] = (f32x4){0.f, 0.f, 0.f, 0.f}; yc[et][it] = (f32x4){0.f, 0.f, 0.f, 0.f}; }
#pragma unroll
            for (int s = 0; s < 2; ++s) {
                bf16x8 pf[2];
#pragma unroll
                for (int it = 0; it < 2; ++it) { u32x4 w; w.x = pk2(st[2 * s][it][0], st[2 * s][it][1]); w.y = pk2(st[2 * s][it][2], st[2 * s][it][3]); w.z = pk2(st[2 * s + 1][it][0], st[2 * s + 1][it][1]); w.w = pk2(st[2 * s + 1][it][2], st[2 * s + 1][it][3]); pf[it] = __builtin_bit_cast(bf16x8, w); }
#pragma unroll
                for (int et = 0; et < 4; ++et) { const bf16x8 vf = tr_frag(vt + tr0 + (2 * s) * 16 * PIT + et * 32, vt + tr0 + (2 * s + 1) * 16 * PIT + et * 32);
#pragma unroll
                    for (int it = 0; it < 2; ++it) yi[et][it] = __builtin_amdgcn_mfma_f32_16x16x32_bf16(vf, pf[it], yi[et][it], 0, 0, 0); }
            }
#pragma unroll
            for (int et = 0; et < 4; ++et)
#pragma unroll
                for (int ks = 0; ks < 2; ++ks) {
#pragma unroll
                    for (int it = 0; it < 2; ++it) yc[et][it] = __builtin_amdgcn_mfma_f32_16x16x32_bf16(pvf[et][ks], qf[it][ks], yc[et][it], 0, 0, 0); }
#pragma unroll
            for (int it = 0; it < 2; ++it) { const int i = (2 * hq + it) * 16 + fr; const float xi = exp2f(lg * (float)(i + 1)); float s1 = 0.f;
#pragma unroll
                for (int et = 0; et < 4; ++et) { yi[et][it] = yi[et][it] + yc[et][it] * xi; s1 += (yi[et][it].x + yi[et][it].y) + (yi[et][it].z + yi[et][it].w); }
                s1 += __shfl_xor(s1, 16); s1 += __shfl_xor(s1, 32); const float mu = s1 * (1.0f / 64.0f); float s2 = 0.f;
#pragma unroll
                for (int et = 0; et < 4; ++et) { yi[et][it] = yi[et][it] - mu; s2 += (yi[et][it].x * yi[et][it].x + yi[et][it].y * yi[et][it].y) + (yi[et][it].z * yi[et][it].z + yi[et][it].w * yi[et][it].w); }
                s2 += __shfl_xor(s2, 16); s2 += __shfl_xor(s2, 32); const float rstd = 1.0f / sqrtf(s2 * (1.0f / 64.0f) + EPS);
#pragma unroll
                for (int et = 0; et < 4; ++et) { const int e0 = et * 16 + 4 * fq; const u32x2 gw = gwv[it][et]; const f32x4 gn = gnv[et];
                    const f32x4 y = yi[et][it] * rstd * gn; u32x2 w; w.x = pk2(silu_f(bf2f(gw.x & 0xffffu)) * y.x, silu_f(bf2f(gw.x >> 16)) * y.y); w.y = pk2(silu_f(bf2f(gw.y & 0xffffu)) * y.z, silu_f(bf2f(gw.y >> 16)) * y.w);
                    *(u32x2*)(F_MIX + (row0 + i) * DM + 768 + h * 64 + e0) = w; }
            }
        }
    }
}

struct Args { const float* in[28]; float* out; unsigned char* ws; int ph_lo, ph_hi; };
constexpr int NPHASE = 2 + NL * 10;

__global__ void __launch_bounds__(NTHR, 2) fwd_kernel(Args args) {
    extern __shared__ __attribute__((aligned(16))) unsigned char lds[];
    Frame F;
    F.lds = (LAS unsigned char*)lds;
    F.tid = threadIdx.x; F.lane = F.tid & 63; F.wave = __builtin_amdgcn_readfirstlane(F.tid >> 6); F.blk = blockIdx.x; F.G = gridDim.x;
    F.gw = F.blk * NWAVES + F.wave; F.ngw = F.G * NWAVES;
    F.out0 = args.out; F.ws0 = args.ws; F.wz = 0;
    F.ptab = (LAS unsigned long long*)(F.lds + LDS_BYTES - 64 - 256);
    if (F.tid == 0) {
#pragma unroll
        for (int i = 0; i < 28; ++i) F.ptab[i] = (unsigned long long)args.in[i];
    }
    LAS unsigned* misc = (LAS unsigned*)(F.lds + LDS_BYTES - 64);
    if (F.tid < 16) misc[F.tid] = 0u;
    __syncthreads();
    const int lo = args.ph_lo, hi = args.ph_hi;
    XcdBarrier bar; bar.bar = F_ctl + CW_BAR; bar.x = 0; bar.st = nullptr;
    if (hi - lo > 1) bar = xcd_barrier_post(F_ctl + CW_BAR, (volatile LAS unsigned*)misc);
#ifndef PH_ONLY
#define PH_ONLY -1
#endif
#define PSEL(j) (PH_ONLY < 0 || PH_ONLY == (j))
#define IN(k) (lo <= (k) && (k) < hi)
#define SEAM(k) do { if (IN(k) && IN((k) + 1)) xcd_barrier(bar); { int _t = threadIdx.x; asm volatile("" : "+v"(_t)); F.tid = _t; F.lane = _t & 63; asm volatile("" : "+s"(F.wz)); { unsigned _z = 0; asm volatile("" : "+s"(_z)); F.lds = (LAS unsigned char*)lds + _z; F.ptab = (LAS unsigned long long*)(F.lds + LDS_BYTES - 64 - 256); } asm volatile("" : "+s"(F.gw), "+s"(F.ngw), "+s"(F.blk), "+s"(F.G), "+s"(F.wave)); } } while (0)

#ifndef PROBE_PH
#define PROBE_PH -1
#endif
    volatile LAS unsigned long long* tpw = (volatile LAS unsigned long long*)(F.lds + LDS_BYTES - 32);
#define TPB(j) do { if (PROBE_PH == (j) && F.blk == 0 && F.tid == 0) tpw[1] = __builtin_amdgcn_s_memrealtime(); } while (0)
#define TPE(j) do { if (PROBE_PH == (j) && F.blk == 0 && F.tid == 0) tpw[0] = tpw[0] + (__builtin_amdgcn_s_memrealtime() - tpw[1]); } while (0)
    TPB(10); if (IN(0) && PSEL(10)) { p0_prologue(F); } SEAM(0); TPE(10);
    for (int l = 0; l < NL; ++l) {
        const int p = 1 + 10 * l;
        TPB(0); if (IN(p + 0) && PSEL(0)) { norm1_phase<false>(F, l); s5_build_operands(F, l); } SEAM(p + 0); TPE(0);
        TPB(1); if (IN(p + 1) && PSEL(1)) { pg8::StaticOrder S; S.init(F_H, DM, F_WinT + (size_t)l * INW * DM, DM, NT, (F.G == 256) ? INW - 256 : INW, F.G, F.blk); EpiQKV E{F_QKV, F_U2X};
            pg8::gemm_phase<EpiQKV, pg8::StaticOrder, false>(F.lds, DM, DM, DM, S, E); } SEAM(p + 1); TPE(1);
        TPB(2); if (IN(p + 2) && PSEL(2)) { ret_kv_mfma(F, l); __syncthreads();
            SplitKOrder S; S.G = F.G; S.c = F.blk; S.A = (const char*)(F_U2X + 128); S.Bt = (const char*)F_BT1;
            EpiS5a E{F_SENDP}; pg8::gemm_phase<EpiS5a, SplitKOrder, false>(F.lds, 512, U2LD, 1024, S, E);
            if (F.G == 256) { GateOrder SG; SG.blk = F.blk; SG.A = (const char*)F_H; SG.Bt = (const char*)(F_WinT + (size_t)l * INW * DM); EpiQKV EG{F_QKV, F_U2X};
                pg8::gemm_phase<EpiQKV, GateOrder, false>(F.lds, DM, DM, DM, SG, EG); } } SEAM(p + 2); TPE(2);
        TPB(3); if (IN(p + 3) && PSEL(3)) { p4_scan_attn(F, l); } SEAM(p + 3); TPE(3);
        TPB(4); if (IN(p + 4) && PSEL(4)) { ret_out_mfma(F, l); __syncthreads();
            ToepOrder S; S.G = F.G; S.c = F.blk; S.npn = 4; S.nunit = 128; S.A = (const char*)F_U2X; S.Kb = (const char*)(F_KERNB + (size_t)l * 16 * 128 * 256); S.Ct = (const char*)F_TMAT; S.tstepA = (size_t)256 * U2LD * 2;
            EpiS5b E{F_YG}; const int keff = (F.G == 256) ? 128 + 256 * ((F.blk & 3) + 1) : U2K;
            pg8::gemm_phase<EpiS5b, ToepOrder, false, true>(F.lds, keff, U2LD, 128, S, E); } SEAM(p + 4); TPE(4);
        TPB(5); if (IN(p + 5) && PSEL(5)) { pg8::StaticOrder S; S.init(F_YG, 256, F_WgluT + (size_t)l * 256 * 256, 256, NT, 256, F.G, F.blk); EpiGlu E{F_YG, F_MIX, F_b_glu + l * 256};
            pg8::gemm_phase<EpiGlu, pg8::StaticOrder, false>(F.lds, 256, 256, 256, S, E); } SEAM(p + 5); TPE(5);
        TPB(6); if (IN(p + 6) && PSEL(6)) { pg8::StaticOrder S; S.init(F_MIX, DM, F_WoutT + (size_t)l * DM * DM, DM, NT, DM, F.G, F.blk); EpiRes E{F_x, F_XB, F_MOD + (size_t)l * NB * 6144 + 2048, F_SSQ, l == 0 ? 1 : 0};
            pg8::gemm_phase<EpiRes, pg8::StaticOrder, false>(F.lds, DM, DM, DM, S, E); } SEAM(p + 6); TPE(6);
        TPB(7); if (IN(p + 7) && PSEL(7)) { norm2_router_phase(F, l); } SEAM(p + 7); TPE(7);
        TPB(8); if (IN(p + 8) && PSEL(8)) { moe_pg8<1>(F, l); } SEAM(p + 8); TPE(8);
        TPB(9); if (IN(p + 9) && PSEL(9)) { moe_pg8<2>(F, l); } SEAM(p + 9); TPE(9);
    }
    TPB(11); if (IN(NPHASE - 1) && PSEL(11)) { norm1_phase<true>(F, 0); } TPE(11);
    if (PROBE_PH >= 0 && F.blk == 0 && F.tid == 0) { const unsigned long long t1 = __builtin_amdgcn_s_memrealtime(); const unsigned long long tp_acc = tpw[0]; while (__builtin_amdgcn_s_memrealtime() - t1 < 4ull * tp_acc) __builtin_amdgcn_s_sleep(8); }
#undef IN
#undef SEAM
}

extern "C" void kernel_launch(void* const* d_in, const int* in_sizes, int n_in, void* d_out, int out_size, void* d_ws, size_t ws_size, hipStream_t stream) {
    static int grid = 0;
    if (grid == 0) {
        if (n_in != 28 || in_sizes[0] != NT * DM || out_size != NT * DM || ws_size < WS_END) { fprintf(stderr, "kernel_launch: unexpected shapes / workspace (%d inputs, ws %zu < %zu)\n", n_in, ws_size, (size_t)WS_END); grid = -1; return; }
        int dev = 0, cus = 0;
        if (hipGetDevice(&dev) != hipSuccess || hipDeviceGetAttribute(&cus, hipDeviceAttributeMultiprocessorCount, dev) != hipSuccess) { grid = -1; return; }
        if (hipFuncSetAttribute((const void*)fwd_kernel, hipFuncAttributeMaxDynamicSharedMemorySize, LDS_BYTES) != hipSuccess) { fprintf(stderr, "kernel_launch: hipFuncSetAttribute failed\n"); grid = -1; return; }
        int per_cu = 0;
        if (hipOccupancyMaxActiveBlocksPerMultiprocessor(&per_cu, (const void*)fwd_kernel, NTHR, LDS_BYTES) != hipSuccess || per_cu < 1) { fprintf(stderr, "kernel_launch: occupancy query says %d\n", per_cu); }
        (void)hipGetLastError();
        grid = 256;
        if (cus < 256) { fprintf(stderr, "kernel_launch: device has %d CUs, need 256\n", cus); grid = -1; return; }
    }
    if (grid < 0) return;
    (void)hipMemsetAsync((char*)d_ws + WS_CTL, 0, CTL_BYTES, stream);
    Args a{};
    for (int i = 0; i < 28; ++i) a.in[i] = (const float*)d_in[i];
    a.out = (float*)d_out; a.ws = (unsigned char*)d_ws;
#if MK_MULTI
    for (int ph = 0; ph < NPHASE; ++ph) { a.ph_lo = ph; a.ph_hi = ph + 1; hipLaunchKernelGGL(fwd_kernel, dim3(grid), dim3(NTHR), LDS_BYTES, stream, a); }
#else
    a.ph_lo = 0; a.ph_hi = NPHASE; hipLaunchKernelGGL(fwd_kernel, dim3(grid), dim3(NTHR), LDS_BYTES, stream, a);
#endif
}
```

```cpp
#include <hip/hip_runtime.h>
#include <cstdio>
#include <cstdint>

#define GAS __attribute__((address_space(1)))
#define LAS __attribute__((address_space(3)))
typedef unsigned short bf16;
typedef short bf16x8 __attribute__((ext_vector_type(8)));
typedef float f32x4 __attribute__((ext_vector_type(4)));
typedef float f32x2 __attribute__((ext_vector_type(2)));
typedef unsigned u32x4 __attribute__((ext_vector_type(4)));
typedef unsigned u32x2 __attribute__((ext_vector_type(2)));

#ifndef MK_MULTI
#define MK_MULTI 0
#endif

#ifndef REP_P3
#define REP_P3 1
#endif
#ifndef REP_P5
#define REP_P5 1
#endif
#ifndef REP_AT
#define REP_AT 1
#endif
#ifndef ATTN_NQT
#define ATTN_NQT 2
#endif

constexpr int NL = 4, NB = 8, SEQ = 4096, DM = 1024, NT = NB * SEQ, NCH = 64;
constexpr int INW = 2816;
constexpr int C_QA = 0, C_KA = 512, C_VA = 1024, C_US = 1536, C_QR = 1792, C_KR = 2048, C_VR = 2304, C_GR = 2560;
constexpr int NE = 32, FF = 256;
constexpr float EPS = 1e-6f;
constexpr int NWAVES = 8, NTHR = 512;
constexpr int LDS_BYTES = 147456;

constexpr size_t al256(size_t x) { return (x + 255) & ~(size_t)255; }
constexpr size_t WS_CTL = 0, CTL_BYTES = 1u << 20;
constexpr size_t WS_WIN = CTL_BYTES;
constexpr size_t WS_WOUT = WS_WIN + (size_t)NL * INW * DM * 2;
constexpr size_t WS_WGU = WS_WOUT + (size_t)NL * DM * DM * 2;
constexpr size_t WS_WD = WS_WGU + (size_t)NL * NE * 512 * DM * 2;
constexpr size_t WS_WGLU = WS_WD + (size_t)NL * NE * DM * FF * 2;
constexpr size_t WS_WR = WS_WGLU + (size_t)NL * 256 * 256 * 2;
constexpr size_t WS_MOD = WS_WR + (size_t)NL * 36 * DM * 4;
constexpr size_t WS_ABAR = WS_MOD + (size_t)NL * NB * 6144 * 4;
constexpr size_t WS_ABAR64 = WS_ABAR + (size_t)NL * 16 * 64 * 8;
constexpr size_t WS_BBAR = WS_ABAR64 + (size_t)NL * 16 * 64 * 8;
constexpr size_t WS_ROPE = WS_BBAR + (size_t)NL * 16 * 64 * 16 * 8;
constexpr size_t WS_H = al256(WS_ROPE + (size_t)SEQ * 32 * 8);
constexpr size_t WS_QKV = WS_H + (size_t)NT * DM * 2;
constexpr size_t WS_SLOT = WS_QKV;
constexpr size_t WS_ACT = WS_QKV + (size_t)2 * NT * DM * 2;
constexpr int ACT_ROWS = 2 * NT + NE * 256;
static_assert(WS_ACT + (size_t)ACT_ROWS * FF * 2 <= WS_QKV + (size_t)NT * INW * 2, "overlay fits");
constexpr size_t WS_XB = WS_QKV + (size_t)NT * INW * 2;
constexpr size_t WS_MIX = WS_H;
constexpr size_t WS_YG = WS_XB + (size_t)NT * DM * 2;
constexpr size_t WS_SEND = WS_YG + (size_t)NT * 256 * 2;
constexpr size_t WS_XS = WS_SEND + (size_t)NB * NCH * 16 * 64 * 8;
constexpr size_t WS_KV = WS_XS + (size_t)NB * NCH * 16 * 64 * 8;
constexpr size_t WS_RW = WS_KV + (size_t)NB * NCH * 4 * 4096 * 4;
constexpr size_t WS_LIST = WS_RW + (size_t)NT * 2 * 4;
constexpr size_t WS_WRHL = WS_LIST + (size_t)NE * NT * 4;
constexpr size_t WS_KERN = WS_WRHL + (size_t)NL * 2 * 48 * DM * 2;
constexpr size_t WS_U2X = WS_KERN + (size_t)NL * 16 * 64 * 256 * 4;
constexpr int U2K = 1152, U2LD = 16 * U2K;
constexpr size_t WS_TMAT = WS_U2X + (size_t)512 * U2LD * 2;
constexpr size_t WS_BT1 = WS_TMAT + (size_t)16 * 1024 * U2K * 2;
constexpr size_t WS_SSQ = WS_BT1 + (size_t)16 * 256 * 1024 * 2;
constexpr size_t WS_PW = WS_SSQ + (size_t)NT * 16 * 4;
constexpr size_t WS_END = WS_PW + (size_t)NL * 16 * 65 * 64 * 8;
constexpr int CW_BAR = 4096;
constexpr int CW_CNT = 16384;

__device__ __forceinline__ float bf2f(unsigned v) { return __uint_as_float(v << 16); }
__device__ __forceinline__ unsigned f2bf(float f) { unsigned u = __float_as_uint(f); return (u + 0x7fffu + ((u >> 16) & 1u)) >> 16; }
typedef __bf16 nbf16x2 __attribute__((ext_vector_type(2)));
typedef float nf32x2 __attribute__((ext_vector_type(2)));
__device__ __forceinline__ unsigned pk2(float lo, float hi) { const nf32x2 v = {lo, hi}; const nbf16x2 r = __builtin_convertvector(v, nbf16x2); return __builtin_bit_cast(unsigned, r); }
__device__ __forceinline__ float wave_sum(float v) {
#pragma unroll
    for (int o = 1; o < 64; o <<= 1) v += __shfl_xor(v, o);
    return v;
}
__device__ __forceinline__ float silu_f(float x) { return x * __builtin_amdgcn_rcpf(1.0f + __expf(-x)); }
__device__ __forceinline__ float sigmoid_f(float x) { return __builtin_amdgcn_rcpf(1.0f + __expf(-x)); }
__device__ __forceinline__ float gelu_tanh_f(float y) { const float z = 0.7978845608028654f * (y + 0.044715f * y * y * y); const float t = 1.0f - 2.0f * __builtin_amdgcn_rcpf(__expf(2.0f * z) + 1.0f); return 0.5f * y * (1.0f + t); }
#define LDS_WAIT() asm volatile("s_waitcnt lgkmcnt(0)" ::: "memory")

#define XB_TMO      128
#define XB_XCNT(j)  (256  + 64 * (j))
#define XB_XSUB(j)  (1280 + 64 * (j))
#define XB_XGEN(j)  (2304 + 64 * (j))
#define XB_TOP      3328
#define XB_TOPGEN   3392
#define XCD_BAR_WORDS 3456
#define XB_SPIN_CAP (1u << 22)
__device__ __forceinline__ unsigned xb_ld(unsigned* p)              { return __hip_atomic_load(p, __ATOMIC_RELAXED, __HIP_MEMORY_SCOPE_AGENT); }
__device__ __forceinline__ unsigned xb_add(unsigned* p, unsigned v) { return __hip_atomic_fetch_add(p, v, __ATOMIC_RELAXED, __HIP_MEMORY_SCOPE_AGENT); }
__device__ __forceinline__ unsigned xb_xcc_id() { return (unsigned)__builtin_amdgcn_s_getreg((3 << 11) | 20) & 0xFu; }
#define XB_SPIN(cond, bar) do { unsigned _sp = 0; while (cond) { __builtin_amdgcn_s_sleep(1); \
    if ((++_sp & 255u) == 0u) { if (xb_ld(&(bar)[XB_TMO])) break; if (_sp > XB_SPIN_CAP) { atomicAdd(&(bar)[XB_TMO], 1u); break; } } } } while (0)
struct XcdBarrier { unsigned* bar; unsigned x; volatile LAS unsigned* st; };
__device__ __forceinline__ XcdBarrier xcd_barrier_post(unsigned* bar, volatile LAS unsigned* st) {
    XcdBarrier b; b.bar = bar; b.x = xb_xcc_id(); b.st = st;
    if (threadIdx.x == 0) (void)xb_add(&bar[XB_XCNT(b.x)], 1u);
    return b;
}
__device__ __forceinline__ void xcd_barrier_complete(unsigned* bar, unsigned x, unsigned& nloc, unsigned& nx) {
    const unsigned G = gridDim.x * gridDim.y * gridDim.z;
    unsigned sum, cnt, mine, sp = 0u;
    for (;;) {
        sum = 0u; cnt = 0u; mine = 0u;
#pragma unroll
        for (unsigned j = 0; j < 16; ++j) { const unsigned c = xb_ld(&bar[XB_XCNT(j)]); sum += c; cnt += (c > 0u) ? 1u : 0u; mine = (j == x) ? c : mine; }
        if (sum == G) break;
        __builtin_amdgcn_s_sleep(1);
        if ((++sp & 255u) == 0u) { if (xb_ld(&bar[XB_TMO])) break; if (sp > XB_SPIN_CAP) { atomicAdd(&bar[XB_TMO], 1u); break; } }
    }
    nloc = mine > 0u ? mine : 1u; nx = cnt > 0u ? cnt : 1u;
}
__device__ __forceinline__ void xcd_barrier(const XcdBarrier& b) {
    asm volatile("s_waitcnt vmcnt(0)" ::: "memory");
    __syncthreads();
    if (threadIdx.x == 0) {
        unsigned* bar = b.bar;
        __builtin_amdgcn_s_waitcnt(0);
        unsigned nloc = b.st[0], nx = b.st[1];
        if (nloc == 0u) { xcd_barrier_complete(bar, b.x, nloc, nx); b.st[0] = nloc; b.st[1] = nx; }
        const unsigned old = xb_add(&bar[XB_XSUB(b.x)], 1u);
        const unsigned gen = old / nloc;
        if (old + 1u == (gen + 1u) * nloc) {
            __builtin_amdgcn_fence(__ATOMIC_RELEASE, "agent");
            asm volatile("s_waitcnt vmcnt(0)" ::: "memory");
            const unsigned og = xb_add(&bar[XB_TOP], 1u);
            const unsigned tg = og / nx;
            if (og + 1u == (tg + 1u) * nx) xb_add(&bar[XB_TOPGEN], 1u);
            else XB_SPIN(xb_ld(&bar[XB_TOPGEN]) == tg, bar);
            __builtin_amdgcn_fence(__ATOMIC_ACQUIRE, "agent");
            xb_add(&bar[XB_XGEN(b.x)], 1u);
            asm volatile("s_waitcnt vmcnt(0)" ::: "memory");
        } else {
            XB_SPIN(xb_ld(&bar[XB_XGEN(b.x)]) == gen, bar);
            __builtin_amdgcn_fence(__ATOMIC_ACQUIRE, "agent");
            asm volatile("s_waitcnt vmcnt(0)" ::: "memory");
        }
    }
    __syncthreads();
}

struct Frame {
    LAS unsigned char* lds;
    LAS unsigned long long* ptab;
    int tid, lane, wave, blk, G, gw, ngw;
    float* out0; unsigned char* ws0; size_t wz;
};
#define F_OUT (F.out0 + F.wz)
__device__ __forceinline__ const float* inp_ptr(LAS unsigned long long* t, int k) { const unsigned long long v = t[k];
    const unsigned lo = __builtin_amdgcn_readfirstlane((unsigned)v), hi = __builtin_amdgcn_readfirstlane((unsigned)(v >> 32)); return (const float*)(const GAS float*)(((unsigned long long)hi << 32) | lo); }
#define INP(k) inp_ptr(F.ptab, k)
#define F_x INP(0)
#define F_c INP(1)
#define F_norm1_g INP(2)
#define F_norm2_g INP(3)
#define F_w_ada INP(4)
#define F_b_ada INP(5)
#define F_w_in INP(6)
#define F_rel_bias INP(7)
#define F_a_re INP(8)
#define F_a_im INP(9)
#define F_log_dt INP(10)
#define F_b_re INP(11)
#define F_b_im INP(12)
#define F_c_re INP(13)
#define F_c_im INP(14)
#define F_ssm_d INP(15)
#define F_w_glu INP(16)
#define F_b_glu INP(17)
#define F_gn_g INP(18)
#define F_w_out INP(19)
#define F_w_group INP(20)
#define F_b_group INP(21)
#define F_w_expert INP(22)
#define F_b_expert INP(23)
#define F_w_gate INP(24)
#define F_w_up INP(25)
#define F_w_down INP(26)
#define F_final_g INP(27)
#define F_ctl ((unsigned*)(F.ws0 + F.wz + WS_CTL))
#define F_WinT ((bf16*)(F.ws0 + F.wz + WS_WIN))
#define F_WoutT ((bf16*)(F.ws0 + F.wz + WS_WOUT))
#define F_WguT ((bf16*)(F.ws0 + F.wz + WS_WGU))
#define F_WdT ((bf16*)(F.ws0 + F.wz + WS_WD))
#define F_WgluT ((bf16*)(F.ws0 + F.wz + WS_WGLU))
#define F_WrT ((float*)(F.ws0 + F.wz + WS_WR))
#define F_MOD ((float*)(F.ws0 + F.wz + WS_MOD))
#define F_ABAR ((f32x2*)(F.ws0 + F.wz + WS_ABAR))
#define F_ABAR64 ((f32x2*)(F.ws0 + F.wz + WS_ABAR64))
#define F_BBAR ((f32x2*)(F.ws0 + F.wz + WS_BBAR))
#define F_ROPE ((f32x2*)(F.ws0 + F.wz + WS_ROPE))
#define F_H ((bf16*)(F.ws0 + F.wz + WS_H))
#define F_QKV ((bf16*)(F.ws0 + F.wz + WS_QKV))
#define F_SLOT ((bf16*)(F.ws0 + F.wz + WS_SLOT))
#define F_ACT ((bf16*)(F.ws0 + F.wz + WS_ACT))
#define F_MIX ((bf16*)(F.ws0 + F.wz + WS_MIX))
#define F_YG ((bf16*)(F.ws0 + F.wz + WS_YG))
#define F_SEND ((f32x2*)(F.ws0 + F.wz + WS_SEND))
#define F_XS ((f32x2*)(F.ws0 + F.wz + WS_XS))
#define F_KV ((float*)(F.ws0 + F.wz + WS_KV))
#define F_KVB ((bf16*)(F.ws0 + F.wz + WS_KV))
constexpr int KVST = 4 * 4096 + 128;
#define F_RW ((float*)(F.ws0 + F.wz + WS_RW))
#define F_LIST ((int*)(F.ws0 + F.wz + WS_LIST))
#define F_WRHL ((bf16*)(F.ws0 + F.wz + WS_WRHL))
#define F_KERNB ((bf16*)(F.ws0 + F.wz + WS_KERN))
#define F_U2X ((bf16*)(F.ws0 + F.wz + WS_U2X))
#define F_TMAT ((bf16*)(F.ws0 + F.wz + WS_TMAT))
constexpr size_t CTSZ = (size_t)16 * 1024 * 128, BTSZ = (size_t)16 * 256 * 1024;
#define F_BT1 ((bf16*)(F.ws0 + F.wz + WS_TMAT + 2 * CTSZ * 2))
#define F_SENDP ((float*)(F.ws0 + F.wz + WS_SEND))
#define F_SSQ ((float*)(F.ws0 + F.wz + WS_SSQ))
#define F_PW ((f32x2*)(F.ws0 + F.wz + WS_PW))
#define F_XB ((bf16*)(F.ws0 + F.wz + WS_XB))

namespace pg8 {
constexpr int BM = 256, BK = 64, HALF = 128, HTB = HALF * BK * 2, STAGE_BYTES = 8 * HTB, NXCD = 8, WGM = 8;
__host__ __device__ __forceinline__ int lds_byte(int r, int c) { const int st = (r >> 4) * 2 + (c >> 5), rr = r & 15, cc = c & 31, ob = rr * 64 + cc * 2; return st * 1024 + (ob ^ (((ob >> 9) & 1) << 5)); }
__host__ __device__ __forceinline__ void stage_rc(int b, int& R, int& C) { const int st = b / 1024, sb = b % 1024, swz = sb ^ (((sb >> 9) & 1) << 5); R = (st >> 1) * 16 + swz / 64; C = (st & 1) * 32 + (swz % 64) / 2; }
__host__ __device__ __forceinline__ int perm32(int rho) { const int n = rho >> 4, i = rho & 15; return 8 * (i >> 2) + 4 * n + (i & 3); }
struct Unit { int pm, pn, e, i; };
struct StaticOrder {
    int nM, nN, nwg, G, c; const char* A; const char* Bt; size_t tstepA, tstepB;
    __device__ void init(const bf16* A_, int lda, const bf16* Bt_, int ldb, int M, int N, int G_, int c_) { nM = M / BM; nN = N / BM; nwg = nM * nN; G = G_; c = c_; A = (const char*)A_; Bt = (const char*)Bt_; tstepA = (size_t)BM * lda * 2; tstepB = (size_t)BM * ldb * 2; }
    __device__ bool next(int i, Unit& u) const {
        const long L = (long)i * G + c; if (L >= nwg) return false;
        int wgid = (int)L; { const int q = nwg / NXCD, r = nwg % NXCD, xcd = wgid % NXCD, off = wgid / NXCD; wgid = (xcd < r ? xcd * (q + 1) : r * (q + 1) + (xcd - r) * q) + off; }
        const int nig = WGM * nN, gid = wgid / nig, fm = gid * WGM, gsz = (nM - fm) < WGM ? (nM - fm) : WGM;
        u.pm = fm + ((wgid % nig) % gsz); u.pn = (wgid % nig) / gsz; u.e = 0; u.i = i; return true;
    }
    __device__ __forceinline__ const char* a_base(const Unit& u) const { return A + (size_t)u.pm * tstepA; }
    __device__ __forceinline__ const char* b_base(const Unit& u) const { return Bt + (size_t)u.pn * tstepB; }
    __device__ __forceinline__ int row(const Unit&, int r) const { return r; }
};
__device__ __forceinline__ unsigned cvt_pk_bf16(float lo, float hi) { return pk2(lo, hi); }

template <class Epi, class Sched, bool GATHER, bool TOEP = false>
__device__ __forceinline__ void gemm_phase(LAS unsigned char* lds, const int K, const int lda, const int ldb, const Sched& S, const Epi& E) {
    int tid_ = threadIdx.x; asm volatile("" : "+v"(tid_));
    const int tid = tid_, wid = __builtin_amdgcn_readfirstlane(tid >> 6), lane = tid & 63, wr = wid >> 2, wc = wid & 3, fr = lane & 15, fq = lane >> 4;
    const int nt = K / BK;
    int Rr[2], Cc[2]; unsigned voffB[2], voffC[2];
#pragma unroll
    for (int i = 0; i < 2; ++i) { stage_rc(tid * 16 + i * 8192, Rr[i], Cc[i]); const int Rb = Epi::PERM ? ((Rr[i] & ~31) + perm32(Rr[i] & 31)) : Rr[i]; voffC[i] = (unsigned)(Rb * ldb + Cc[i]) * 2u;
        voffB[i] = TOEP ? (unsigned)(((Rb >> 4) - (Cc[i] >> 4) + 3) * 512 + (Rb & 15) * 32 + (Cc[i] & 15) * 2) : voffC[i]; }
    const size_t kstep = (size_t)(BK * 2);
    const long kstepB = TOEP ? -2048l : (long)(BK * 2);
    const size_t hstepC = (size_t)HALF * ldb * 2;
    const size_t hstepB = TOEP ? (size_t)4096 : hstepC;
    const unsigned ldsw = (unsigned)wid * 1024u;
    const int aoff = lds_byte(wr * 64 + fr, fq * 8), boff = lds_byte(wc * 32 + fr, fq * 8);
#define PG8_SA(b, h) (((b) * 2 + (h)) * HTB)
#define PG8_SB(b, h) ((4 + (b) * 2 + (h)) * HTB)
#define PG8_STAGE(bufoff, gbase, voff) do { _Pragma("unroll") for (int _i = 0; _i < 2; ++_i) \
        __builtin_amdgcn_global_load_lds((const unsigned*)((const char*)(gbase) + (voff)[_i]), (LAS unsigned*)(lds + (bufoff) + ldsw + _i * 8192), 16, 0, 0); } while (0)
#define PG8_STAGE_SEL(bufoff, gbase, h) do { if (GATHER && last) PG8_STAGE(bufoff, gbase, vN[h]); else PG8_STAGE(bufoff, gbase, vA[h]); } while (0)
#define PG8_LDA(dst, b, h) do { _Pragma("unroll") for (int m = 0; m < 4; ++m) _Pragma("unroll") for (int k = 0; k < 2; ++k) dst[m][k] = *(const LAS bf16x8*)(lds + PG8_SA(b, h) + aoff + m * 2048 + k * 1024); } while (0)
#define PG8_LDB(dst, b, h) do { _Pragma("unroll") for (int n = 0; n < 2; ++n) _Pragma("unroll") for (int k = 0; k < 2; ++k) dst[n][k] = *(const LAS bf16x8*)(lds + PG8_SB(b, h) + boff + n * 2048 + k * 1024); } while (0)
#define PG8_MMA(ai, bj, At, Bt) do { __builtin_amdgcn_s_setprio(1); _Pragma("unroll") for (int m = 0; m < 4; ++m) _Pragma("unroll") for (int n = 0; n < 2; ++n) _Pragma("unroll") for (int k = 0; k < 2; ++k) \
        acc[ai][bj][m][n] = __builtin_amdgcn_mfma_f32_16x16x32_bf16(Bt[n][k], At[m][k], acc[ai][bj][m][n], 0, 0, 0); __builtin_amdgcn_s_setprio(0); } while (0)
#define PG8_WAIT_V(n) asm volatile("s_waitcnt vmcnt(" #n ")" ::: "memory")
#define PG8_WAIT_L(n) asm volatile("s_waitcnt lgkmcnt(" #n ")" ::: "memory")
#define PG8_BAR __builtin_amdgcn_s_barrier()
#define PG8_SCHED __builtin_amdgcn_sched_barrier(0)
#define PG8_VOFF(dst, u) do { int _t = tid; if (GATHER) asm volatile("" : "+v"(_t)); _Pragma("unroll") for (int _i = 0; _i < 2; ++_i) { int _R, _C; stage_rc(_t * 16 + _i * 8192, _R, _C); \
        _Pragma("unroll") for (int _h = 0; _h < 2; ++_h) dst[_h][_i] = (unsigned)(S.row(u, _h * HALF + _R) * lda + _C) * 2u; } } while (0)
    Unit cur, nxt; int ui = 0;
    if (!S.next(0, cur)) return;
    f32x4 acc[2][2][4][2];
#pragma unroll
    for (int a = 0; a < 2; ++a)
#pragma unroll
        for (int b = 0; b < 2; ++b)
#pragma unroll
            for (int m = 0; m < 4; ++m)
#pragma unroll
                for (int n = 0; n < 2; ++n) acc[a][b][m][n] = (f32x4){0.f, 0.f, 0.f, 0.f};
    bf16x8 At[4][2], B0[2][2], B1[2][2];
    unsigned vA[2][2];
    PG8_VOFF(vA, cur);
    const char* cA = S.a_base(cur); const char* cB = S.b_base(cur);
    const char* cC = cB; if constexpr (TOEP) cC = S.c_base(cur);
    PG8_STAGE(PG8_SB(0, 0), cC, voffC); PG8_STAGE(PG8_SB(0, 1), cC + hstepC, voffC); PG8_STAGE(PG8_SA(0, 0), cA, vA[0]); PG8_STAGE(PG8_SA(0, 1), cA, vA[1]);
    if (wr == 1) PG8_BAR;
    PG8_WAIT_V(2); PG8_BAR;
    PG8_STAGE(PG8_SB(1, 0), cC + kstep, voffC); PG8_STAGE(PG8_SA(1, 0), cA + kstep, vA[0]); PG8_STAGE(PG8_SB(1, 1), cC + hstepC + kstep, voffC);
    PG8_WAIT_V(6); PG8_BAR;
    for (;;) {
        const bool has_next = S.next(ui + 1, nxt);
        const char* nA = has_next ? S.a_base(nxt) : cA; const char* nB = has_next ? S.b_base(nxt) : cB;
        const char* nC = nB; if constexpr (TOEP) nC = has_next ? S.c_base(nxt) : cC;
        asm volatile(".p2align 8\n\t.fill 8, 4, 0xBF800000" ::: "memory");
#pragma unroll 1
        for (int t = 0; t < nt; t += 2) {
            const bool last = (t == nt - 2);
            const char* a1 = cA + (size_t)(t + 1) * kstep;
            const char* a2 = last ? nA : cA + (size_t)(t + 2) * kstep; const char* b2 = last ? nC : cB + (long)(t + 2) * kstepB;
            const char* a3 = a2 + kstep; const char* b3 = (TOEP && last) ? b2 + kstep : b2 + kstepB;
            PG8_LDB(B0, 0, 0); PG8_LDB(B1, 0, 1); PG8_SCHED; PG8_LDA(At, 0, 0); PG8_STAGE(PG8_SA(1, 1), a1, vA[1]);
            PG8_WAIT_V(8); PG8_WAIT_L(0); PG8_BAR; PG8_MMA(0, 0, At, B0); PG8_MMA(0, 1, At, B1); PG8_BAR; PG8_SCHED;
            if (GATHER && last && has_next) { PG8_VOFF(vA, nxt); }
            PG8_LDA(At, 0, 1);
            if (TOEP && last) { PG8_STAGE(PG8_SB(0, 0), b2, voffC); PG8_STAGE(PG8_SB(0, 1), b2 + hstepC, voffC); } else { PG8_STAGE(PG8_SB(0, 0), b2, voffB); PG8_STAGE(PG8_SB(0, 1), b2 + hstepB, voffB); }
            PG8_STAGE(PG8_SA(0, 0), a2, vA[0]);
            PG8_WAIT_V(8); PG8_WAIT_L(0); PG8_BAR; PG8_MMA(1, 0, At, B0); PG8_MMA(1, 1, At, B1); PG8_BAR; PG8_SCHED;
            PG8_LDB(B0, 1, 0); PG8_LDB(B1, 1, 1); PG8_SCHED; PG8_LDA(At, 1, 0); PG8_STAGE(PG8_SA(0, 1), a2, vA[1]);
            PG8_WAIT_V(8); PG8_WAIT_L(0); PG8_BAR; PG8_MMA(0, 0, At, B0); PG8_MMA(0, 1, At, B1); PG8_BAR; PG8_SCHED;
            PG8_LDA(At, 1, 1);
            if (TOEP && last) { PG8_STAGE(PG8_SB(1, 0), b3, voffC); PG8_STAGE(PG8_SB(1, 1), b3 + hstepC, voffC); } else { PG8_STAGE(PG8_SB(1, 0), b3, voffB); PG8_STAGE(PG8_SB(1, 1), b3 + hstepB, voffB); }
            PG8_STAGE(PG8_SA(1, 0), a3, vA[0]);
            PG8_WAIT_V(8); PG8_WAIT_L(0); PG8_BAR; PG8_MMA(1, 0, At, B0); PG8_MMA(1, 1, At, B1); PG8_BAR; PG8_SCHED;
        }
        if (wr == 0) PG8_BAR;
        { int fr_e = fr, fq_e = fq; asm volatile("" : "+v"(fr_e), "+v"(fq_e)); E(acc, cur, wr, wc, fr_e, fq_e); }
        if (!has_next) break;
#pragma unroll
        for (int a = 0; a < 2; ++a)
#pragma unroll
            for (int b = 0; b < 2; ++b)
#pragma unroll
                for (int m = 0; m < 4; ++m)
#pragma unroll
                    for (int n = 0; n < 2; ++n) acc[a][b][m][n] = (f32x4){0.f, 0.f, 0.f, 0.f};
        cur = nxt; cA = nA; cB = nB; cC = nC; ++ui;
        if (wr == 1) PG8_BAR;
    }
    PG8_WAIT_V(0);
    PG8_BAR;
#undef PG8_SA
#undef PG8_SB
#undef PG8_STAGE
#undef PG8_STAGE_SEL
#undef PG8_LDA
#undef PG8_LDB
#undef PG8_MMA
#undef PG8_WAIT_V
#undef PG8_WAIT_L
#undef PG8_BAR
#undef PG8_SCHED
#undef PG8_VOFF
}
}

struct EpiQKV {
    static constexpr bool PERM = true;
    bf16* O; bf16* U2;
    __device__ __forceinline__ void operator()(const f32x4 (&acc)[2][2][4][2], const pg8::Unit& u, int wr, int wc, int fr, int fq) const {
        const int row0 = u.pm * 256 + wr * 64 + fr, col0 = u.pn * 256 + wc * 32 + 8 * fq;
#pragma unroll
        for (int ai = 0; ai < 2; ++ai)
#pragma unroll
            for (int m = 0; m < 4; ++m) { const int row = row0 + ai * 128 + m * 16; bf16* rowp = O + (size_t)row * INW + col0;
#pragma unroll
                for (int bj = 0; bj < 2; ++bj) { const f32x4 v0 = acc[ai][bj][m][0], v1 = acc[ai][bj][m][1];
                    u32x4 w; w.x = pg8::cvt_pk_bf16(v0[0], v0[1]); w.y = pg8::cvt_pk_bf16(v0[2], v0[3]); w.z = pg8::cvt_pk_bf16(v1[0], v1[1]); w.w = pg8::cvt_pk_bf16(v1[2], v1[3]);
                    if (u.pn == 6) { const int cu = bj * 128 + wc * 32 + 8 * fq;
                        *(u32x4*)(U2 + ((size_t)(row >> 6) * 16 + (cu >> 4)) * U2K + 128 + (row & 63) * 16 + (cu & 15)) = w; }
                    else *(u32x4*)(rowp + bj * 128) = w; } }
    }
};
struct EpiRes {
    static constexpr bool PERM = true;
    const float* x0; bf16* xb; const float* g1l; float* ssq; int first;
    __device__ __forceinline__ void operator()(const f32x4 (&acc)[2][2][4][2], const pg8::Unit& u, int wr, int wc, int fr, int fq) const {
        const int row0 = u.pm * 256 + wr * 64 + fr, col0 = u.pn * 256 + wc * 32 + 8 * fq;
        const float* g1 = g1l + (size_t)((u.pm * 256) / SEQ) * 6144 + col0;
        f32x4 gv[2][2];
#pragma unroll
        for (int bj = 0; bj < 2; ++bj)
#pragma unroll
            for (int n = 0; n < 2; ++n) gv[bj][n] = *(const f32x4*)(g1 + bj * 128 + n * 4);
        if (!first) {
#pragma unroll
            for (int ai = 0; ai < 2; ++ai) {
                u32x4 xw[4][2];
#pragma unroll
                for (int m = 0; m < 4; ++m)
#pragma unroll
                    for (int bj = 0; bj < 2; ++bj) xw[m][bj] = *(const u32x4*)(xb + (size_t)(row0 + ai * 128 + m * 16) * DM + col0 + bj * 128);
#pragma unroll
                for (int m = 0; m < 4; ++m) { const int row = row0 + ai * 128 + m * 16; const size_t off = (size_t)row * DM + col0; float sq = 0.f;
#pragma unroll
                    for (int bj = 0; bj < 2; ++bj) { const u32x4 w0 = xw[m][bj];
                        const f32x4 x0v = (f32x4){bf2f(w0.x & 0xffffu), bf2f(w0.x >> 16), bf2f(w0.y & 0xffffu), bf2f(w0.y >> 16)}, x1v = (f32x4){bf2f(w0.z & 0xffffu), bf2f(w0.z >> 16), bf2f(w0.w & 0xffffu), bf2f(w0.w >> 16)};
                        const f32x4 o0 = x0v + gv[bj][0] * acc[ai][bj][m][0], o1 = x1v + gv[bj][1] * acc[ai][bj][m][1];
                        u32x4 w; w.x = pk2(o0[0], o0[1]); w.y = pk2(o0[2], o0[3]); w.z = pk2(o1[0], o1[1]); w.w = pk2(o1[2], o1[3]);
                        *(u32x4*)(xb + off + bj * 128) = w;
                        sq += (o0.x * o0.x + o0.y * o0.y) + (o0.z * o0.z + o0.w * o0.w) + (o1.x * o1.x + o1.y * o1.y) + (o1.z * o1.z + o1.w * o1.w); }
                    sq += __shfl_xor(sq, 16); sq += __shfl_xor(sq, 32);
                    if (fq == 0) ssq[(size_t)row * 16 + u.pn * 4 + wc] = sq; }
                asm volatile("" ::: "memory");
            }
            return;
        }
#pragma unroll
        for (int ai = 0; ai < 2; ++ai)
#pragma unroll
            for (int m = 0; m < 4; ++m) { const int row = row0 + ai * 128 + m * 16; const size_t off = (size_t)row * DM + col0; float sq = 0.f;
#pragma unroll
                for (int bj = 0; bj < 2; ++bj) { f32x4 x0v, x1v;
                    if (first) { x0v = *(const f32x4*)(x0 + off + bj * 128); x1v = *(const f32x4*)(x0 + off + bj * 128 + 4); }
                    else { const u32x4 w = *(const u32x4*)(xb + off + bj * 128); x0v = (f32x4){bf2f(w.x & 0xffffu), bf2f(w.x >> 16), bf2f(w.y & 0xffffu), bf2f(w.y >> 16)}; x1v = (f32x4){bf2f(w.z & 0xffffu), bf2f(w.z >> 16), bf2f(w.w & 0xffffu), bf2f(w.w >> 16)}; }
                    const f32x4 o0 = x0v + gv[bj][0] * acc[ai][bj][m][0], o1 = x1v + gv[bj][1] * acc[ai][bj][m][1];
                    u32x4 w; w.x = pg8::cvt_pk_bf16(o0[0], o0[1]); w.y = pg8::cvt_pk_bf16(o0[2], o0[3]); w.z = pg8::cvt_pk_bf16(o1[0], o1[1]); w.w = pg8::cvt_pk_bf16(o1[2], o1[3]);
                    *(u32x4*)(xb + off + bj * 128) = w;
                    sq += (o0.x * o0.x + o0.y * o0.y) + (o0.z * o0.z + o0.w * o0.w) + (o1.x * o1.x + o1.y * o1.y) + (o1.z * o1.z + o1.w * o1.w); }
                sq += __shfl_xor(sq, 16); sq += __shfl_xor(sq, 32);
                if (fq == 0) ssq[(size_t)row * 16 + u.pn * 4 + wc] = sq;
                asm volatile("" ::: "memory"); }
    }
};

constexpr int TR_NPL = 16 * 88 + 16 * 32 + 32 + 3 * NE * 128;
constexpr int TR_S2 = 1024, TR_S4 = TR_S2 + 32 * 184, TR_SLOT = TR_S4 + 2048;
__device__ __forceinline__ void tr_items(Frame& F, const int l, const int j0, const int j1, const int w, const int nw) {
    LAS float* scr = (LAS float*)(F.lds + F.wave * 16384);
    constexpr int I_IN = NL * 16 * 88, I_OUT = NL * 16 * 32, I_GLU = NL * 4 * 8, I_G = NL * NE * 16 * 8, I_D = NL * NE * 4 * 32;
#define TR_FLAT(j) ((j) < 1408 ? l * 1408 + (j) : (j) < 1920 ? I_IN + l * 512 + ((j) - 1408) : (j) < 1952 ? I_IN + I_OUT + l * 32 + ((j) - 1920) : \
        (j) < 1952 + NE * 128 ? I_IN + I_OUT + I_GLU + l * (NE * 128) + ((j) - 1952) : (j) < 1952 + 2 * NE * 128 ? I_IN + I_OUT + I_GLU + I_G + l * (NE * 128) + ((j) - 1952 - NE * 128) : \
        I_IN + I_OUT + I_GLU + 2 * I_G + l * (NE * 128) + ((j) - 1952 - 2 * NE * 128))
    struct TItem { const float* src; bf16* dst; int N, ldk; };
#define TR_DECODE(itv, T) do { int r = (itv); \
        if (r < I_IN) { const int l = r / (16 * 88), q = r % (16 * 88), kb = q / 88, nb = q % 88; T.N = INW; T.ldk = DM; \
            T.src = F_w_in + (size_t)l * DM * INW + (size_t)(kb * 64) * INW + nb * 32; T.dst = F_WinT + ((size_t)l * INW + nb * 32) * DM + kb * 64; break; } r -= I_IN; \
        if (r < I_OUT) { const int l = r / (16 * 32), q = r % (16 * 32), kb = q / 32, nb = q % 32; T.N = DM; T.ldk = DM; \
            T.src = F_w_out + (size_t)l * DM * DM + (size_t)(kb * 64) * DM + nb * 32; T.dst = F_WoutT + ((size_t)l * DM + nb * 32) * DM + kb * 64; break; } r -= I_OUT; \
        if (r < I_GLU) { const int l = r / 32, q = r % 32, kb = q / 8, nb = q % 8; T.N = 256; T.ldk = 256; \
            T.src = F_w_glu + (size_t)l * 256 * 256 + (size_t)(kb * 64) * 256 + nb * 32; T.dst = F_WgluT + ((size_t)l * 256 + nb * 32) * 256 + kb * 64; break; } r -= I_GLU; \
        if (r < 2 * I_G) { const int up = r >= I_G; if (up) r -= I_G; const int le = r / 128, q = r % 128, kb = q / 8, nb = q % 8; const int n0 = nb * 32; \
            const int drow = (n0 >> 7) * 256 + up * 128 + (n0 & 127); T.N = FF; T.ldk = DM; \
            T.src = (up ? F_w_up : F_w_gate) + (size_t)le * DM * FF + (size_t)(kb * 64) * FF + n0; T.dst = F_WguT + ((size_t)le * 512 + drow) * DM + kb * 64; break; } r -= 2 * I_G; \
        { const int le = r / 128, q = r % 128, kb = q / 32, nb = q % 32; T.N = DM; T.ldk = FF; \
            T.src = F_w_down + (size_t)le * FF * DM + (size_t)(kb * 64) * DM + nb * 32; T.dst = F_WdT + ((size_t)le * DM + nb * 32) * FF + kb * 64; } } while (0)
#define TR_LOAD(T, tv) do { _Pragma("unroll") for (int i = 0; i < 32; ++i) { const int kk = 2 * i + (F.lane >> 5); tv[i] = __builtin_nontemporal_load(T.src + (size_t)kk * T.N + (F.lane & 31)); } } while (0)
#define TR_STORE(T, tv) do { _Pragma("unroll") for (int i = 0; i < 32; ++i) { const int kk = 2 * i + (F.lane >> 5); scr[kk * 33 + (F.lane & 31)] = tv[i]; } \
        LDS_WAIT(); asm volatile("" ::: "memory"); const int c = F.lane & 7; \
        _Pragma("unroll") for (int j = 0; j < 4; ++j) { const int n = (F.lane >> 3) + 8 * j; const LAS float* s = scr + (8 * c) * 33 + n; \
            u32x4 o; o.x = pk2(s[0 * 33], s[1 * 33]); o.y = pk2(s[2 * 33], s[3 * 33]); o.z = pk2(s[4 * 33], s[5 * 33]); o.w = pk2(s[6 * 33], s[7 * 33]); \
            *(u32x4*)(T.dst + (size_t)n * T.ldk + 8 * c) = o; } \
        LDS_WAIT(); asm volatile("" ::: "memory"); } while (0)
    {
        float tva[32], tvb[32]; TItem Ta, Tb; Ta.src = nullptr; Ta.dst = nullptr; Ta.N = 0; Ta.ldk = 0; Tb = Ta;
        int it = j0 + w;
        if (it < j1) { TR_DECODE(TR_FLAT(it), Ta); TR_LOAD(Ta, tva); }
        while (it < j1) {
            const int it1 = it + nw; if (it1 < j1) { TR_DECODE(TR_FLAT(it1), Tb); TR_LOAD(Tb, tvb); }
            TR_STORE(Ta, tva);
            if (it1 >= j1) break;
            const int it2 = it1 + nw; if (it2 < j1) { TR_DECODE(TR_FLAT(it2), Ta); TR_LOAD(Ta, tva); }
            TR_STORE(Tb, tvb);
            it = it2;
        }
    }
#undef TR_FLAT
#undef TR_DECODE
#undef TR_LOAD
#undef TR_STORE
}

__device__ __forceinline__ void p0_prologue(Frame& F) {
    for (int l = 0; l < NL; ++l) tr_items(F, l, (F.G == 256 && l > 0) ? TR_SLOT : 0, TR_NPL, F.gw, F.ngw);
    for (int i = F.blk * NTHR + F.tid; i < NL * 48 * DM; i += F.G * NTHR) { const int l = i / (48 * DM), j = (i / DM) % 48, k = i % DM;
        const float w = (j < 4) ? F_w_group[((size_t)l * DM + k) * 4 + j] : (j < 36 ? F_w_expert[((size_t)l * DM + k) * 32 + (j - 4)] : 0.f);
        const unsigned hi = f2bf(w); const unsigned lo = f2bf(w - bf2f(hi));
        F_WRHL[((size_t)(l * 2 + 0) * 48 + j) * DM + k] = (bf16)hi; F_WRHL[((size_t)(l * 2 + 1) * 48 + j) * DM + k] = (bf16)lo; }
    for (int i = F.blk * 16 + F.tid; F.tid < 16 && i < NL * 16 * 64; i += F.G * 16) {
        const int lg = i / 64; const float are = F_a_re[i], aim = F_a_im[i], dt = __expf(F_log_dt[lg]);
        const float mag = expf(are * dt); float sn, cs; sincosf(aim * dt, &sn, &cs);
        const float abr = mag * cs, abi = mag * sn;
        F_ABAR[i] = (f32x2){abr, abi};
        const float mag64 = expf(64.f * are * dt); float sn64, cs64; sincosf(64.f * aim * dt, &sn64, &cs64);
        F_ABAR64[i] = (f32x2){mag64 * cs64, mag64 * sn64};
        F_PW[((size_t)lg * 65 + 64) * 64 + (i & 63)] = (f32x2){mag64 * cs64, mag64 * sn64};
        const float xr = abr - 1.f, xi = abi, den = are * are + aim * aim;
        const float fr = (xr * are + xi * aim) / den, fi = (xi * are - xr * aim) / den;
        f32x4 brv[4], biv[4];
#pragma unroll
        for (int q4 = 0; q4 < 4; ++q4) { brv[q4] = *(const f32x4*)(F_b_re + (size_t)i * 16 + 4 * q4); biv[q4] = *(const f32x4*)(F_b_im + (size_t)i * 16 + 4 * q4); }
#pragma unroll
        for (int q4 = 0; q4 < 4; ++q4)
#pragma unroll
            for (int r = 0; r < 4; ++r) { const float br = brv[q4][r], bi = biv[q4][r]; F_BBAR[(size_t)i * 16 + 4 * q4 + r] = (f32x2){fr * br - fi * bi, fr * bi + fi * br}; }
    }
    __syncthreads();
    for (int wu = F.blk; wu < NL * 16 * 4; wu += F.G) {
        const int lg = wu >> 2, lag0 = (wu & 3) * 16; const float dt = __expf(F_log_dt[lg]);
        LAS f32x2* pw = (LAS f32x2*)F.lds;
        LAS f32x2* ff = pw + 1024;
        LAS f32x2* cc = ff + 64;
        LAS float* bbr = (LAS float*)(cc + 1024);
        LAS float* bbi = bbr + 1024;
        for (int idx = F.tid; idx < 1024 + 64; idx += NTHR) { const int p = idx & 63; const float are = F_a_re[lg * 64 + p], aim = F_a_im[lg * 64 + p];
            if (idx < 1024) { const float lag = (float)(lag0 + (idx >> 6)); const float pm = expf(lag * are * dt); float sn, cs; sincosf(lag * aim * dt, &sn, &cs); const f32x2 pv = (f32x2){pm * cs, pm * sn}; pw[idx] = pv; F_PW[((size_t)lg * 65 + lag0 + (idx >> 6)) * 64 + p] = pv; }
            else { const float mag = expf(are * dt); float sn, cs; sincosf(aim * dt, &sn, &cs); const float xr0 = mag * cs - 1.f, xi0 = mag * sn, den = are * are + aim * aim;
                ff[p] = (f32x2){(xr0 * are + xi0 * aim) / den, (xi0 * are - xr0 * aim) / den}; } }
        for (int idx = F.tid; idx < 1024; idx += NTHR) cc[idx] = (f32x2){F_c_re[(size_t)lg * 1024 + idx], F_c_im[(size_t)lg * 1024 + idx]};
        __syncthreads();
        for (int idx = F.tid; idx < 1024; idx += NTHR) { const f32x2 fv = ff[idx >> 4]; const float br = F_b_re[(size_t)lg * 1024 + idx], bi = F_b_im[(size_t)lg * 1024 + idx];
            bbr[idx] = fv.x * br - fv.y * bi; bbi[idx] = fv.x * bi + fv.y * br; }
        __syncthreads();
        if (F.tid < 256) { const int c = F.tid & 15, lagi = F.tid >> 4, lag = lag0 + lagi;
            float acc[16];
#pragma unroll
            for (int q = 0; q < 16; ++q) acc[q] = 0.f;
#pragma unroll 4
            for (int p = 0; p < 64; ++p) { const f32x2 pv = pw[lagi * 64 + p], cv = cc[c * 64 + p];
                const float zr = cv.x * pv.x - cv.y * pv.y, zi = cv.x * pv.y + cv.y * pv.x;
                const LAS f32x4* br = (const LAS f32x4*)(bbr + p * 16); const LAS f32x4* bi = (const LAS f32x4*)(bbi + p * 16);
#pragma unroll
                for (int q4 = 0; q4 < 4; ++q4) { const f32x4 r4 = br[q4], i4 = bi[q4];
                    acc[4 * q4] += zr * r4.x - zi * i4.x; acc[4 * q4 + 1] += zr * r4.y - zi * i4.y; acc[4 * q4 + 2] += zr * r4.z - zi * i4.z; acc[4 * q4 + 3] += zr * r4.w - zi * i4.w; } }
            if (lag == 0) {
#pragma unroll
                for (int q = 0; q < 16; ++q) if (q == c) acc[q] += F_ssm_d[lg * 16 + c]; }
            bf16* kp = F_KERNB + (((size_t)lg * 128 + 64 + lag) * 16 + c) * 16;
#pragma unroll
            for (int q8 = 0; q8 < 2; ++q8) { u32x4 o; o.x = pk2(acc[8 * q8], acc[8 * q8 + 1]); o.y = pk2(acc[8 * q8 + 2], acc[8 * q8 + 3]); o.z = pk2(acc[8 * q8 + 4], acc[8 * q8 + 5]); o.w = pk2(acc[8 * q8 + 6], acc[8 * q8 + 7]);
                *(u32x4*)(kp + 8 * q8) = o; }
        } else { bf16* zp = F_KERNB + ((size_t)lg * 128 + lag0) * 256 + (F.tid - 256) * 16;
            *(u32x4*)zp = (u32x4){0u, 0u, 0u, 0u}; *(u32x4*)(zp + 8) = (u32x4){0u, 0u, 0u, 0u}; }
        __syncthreads();
    }
    for (int i = F.blk * NTHR + F.tid; i < SEQ * 32; i += F.G * NTHR) { const int pos = i >> 5, j = i & 31;
        const float inv = powf(10000.0f, -(float)j / 32.0f); const float ang = (float)pos * inv; float sn, cs; sincosf(ang, &sn, &cs); F_ROPE[i] = (f32x2){cs, sn}; }
    __syncthreads();
    {
        LAS float* cond = (LAS float*)F.lds;
        LAS float* red = (LAS float*)(F.lds + 32768);
        for (int i = F.tid; i < NB * DM; i += NTHR) cond[i] = silu_f(F_c[i]);
        __syncthreads();
        constexpr int NITM = NL * 6144 / 96;
        for (int it = F.blk; it < NITM; it += F.G) {
            const int cl = F.tid % 96, ks = F.tid / 96, col = it * 96 + cl, l = col / 6144, j = col % 6144;
            if (ks < 4) {
                float acc[8];
#pragma unroll
                for (int b = 0; b < 8; ++b) acc[b] = 0.f;
                const float* wp = F_w_ada + (size_t)l * DM * 6144 + j + (size_t)(ks * 256) * 6144;
                for (int k0 = 0; k0 < 256; k0 += 16) { float w[16];
#pragma unroll
                    for (int q = 0; q < 16; ++q) w[q] = __builtin_nontemporal_load(wp + (size_t)(k0 + q) * 6144);
#pragma unroll
                    for (int q = 0; q < 16; ++q)
#pragma unroll
                        for (int b = 0; b < 8; ++b) acc[b] += cond[b * DM + ks * 256 + k0 + q] * w[q]; }
#pragma unroll
                for (int b = 0; b < 8; ++b) red[(ks * 96 + cl) * 8 + b] = acc[b];
            }
            __syncthreads();
            if (F.tid < 96) {
#pragma unroll
                for (int b = 0; b < 8; ++b) { const float s = red[(0 * 96 + F.tid) * 8 + b] + red[(1 * 96 + F.tid) * 8 + b] + red[(2 * 96 + F.tid) * 8 + b] + red[(3 * 96 + F.tid) * 8 + b];
                    F_MOD[((size_t)l * NB + b) * 6144 + j] = s + F_b_ada[(size_t)l * 6144 + j]; }
            }
            __syncthreads();
        }
    }
}


template <bool FINAL>
__device__ __forceinline__ void norm1_phase(Frame& F, int l) {
    const bool addmoe = FINAL || l > 0;
    const int lp = FINAL ? NL - 1 : l - 1;
    const int rpw = (NT + F.ngw - 1) / F.ngw;
    const bool oneb = (SEQ % rpw) == 0;
    const int bw = (F.gw * rpw) / SEQ;
    f32x4 g2v[4], gsv[4], shv[4];
#pragma unroll
    for (int i = 0; i < 4; ++i) { g2v[i] = (f32x4){0.f, 0.f, 0.f, 0.f}; gsv[i] = g2v[i]; shv[i] = g2v[i]; }
    if (oneb && F.gw * rpw < NT) {
        if (addmoe) { const f32x4* g2 = (const f32x4*)(F_MOD + ((size_t)lp * NB + bw) * 6144 + 5120) + F.lane;
#pragma unroll
            for (int i = 0; i < 4; ++i) g2v[i] = g2[64 * i]; }
        if (FINAL) { const f32x4* g = (const f32x4*)F_final_g + F.lane;
#pragma unroll
            for (int i = 0; i < 4; ++i) gsv[i] = g[64 * i];
        } else { const f32x4* g = (const f32x4*)(F_norm1_g + (size_t)l * DM) + F.lane; const float* modb = F_MOD + ((size_t)l * NB + bw) * 6144;
            const f32x4* sh = (const f32x4*)modb + F.lane; const f32x4* sc = (const f32x4*)(modb + 1024) + F.lane;
#pragma unroll
            for (int i = 0; i < 4; ++i) { gsv[i] = g[64 * i] * (sc[64 * i] + 1.0f); shv[i] = sh[64 * i]; } }
    }
    constexpr int NR = 4;
    for (int j = 0; j < rpw; j += NR) {
        const int rowA = F.gw * rpw + j;
        if (rowA >= NT) break;
        f32x4 v[NR][4];
#pragma unroll
        for (int q = 0; q < NR; ++q) { const int row = rowA + q;
            if (!FINAL && l == 0) { const f32x4* xr = (const f32x4*)(F_x + (size_t)row * DM) + F.lane;
#pragma unroll
                for (int i = 0; i < 4; ++i) v[q][i] = xr[64 * i]; }
            else { const u32x2* xr = (const u32x2*)(F_XB + (size_t)row * DM) + F.lane;
#pragma unroll
                for (int i = 0; i < 4; ++i) { const u32x2 w = xr[64 * i]; v[q][i] = (f32x4){bf2f(w.x & 0xffffu), bf2f(w.x >> 16), bf2f(w.y & 0xffffu), bf2f(w.y >> 16)}; } } }
        if (addmoe) {
#pragma unroll
            for (int q = 0; q < NR; ++q) { const int row = rowA + q, b = row / SEQ;
                const f32x4* g2 = (const f32x4*)(F_MOD + ((size_t)lp * NB + b) * 6144 + 5120) + F.lane;
                const u32x2* s0 = (const u32x2*)(F_SLOT + (size_t)row * DM) + F.lane; const u32x2* s1 = (const u32x2*)(F_SLOT + (size_t)NT * DM + (size_t)row * DM) + F.lane;
#pragma unroll
                for (int i = 0; i < 4; ++i) { const u32x2 a = s0[64 * i], c = s1[64 * i]; const f32x4 g = oneb ? g2v[i] : g2[64 * i];
                    v[q][i].x += g.x * (bf2f(a.x & 0xffffu) + bf2f(c.x & 0xffffu)); v[q][i].y += g.y * (bf2f(a.x >> 16) + bf2f(c.x >> 16));
                    v[q][i].z += g.z * (bf2f(a.y & 0xffffu) + bf2f(c.y & 0xffffu)); v[q][i].w += g.w * (bf2f(a.y >> 16) + bf2f(c.y >> 16)); }
                if (!FINAL) { u32x2* xo = (u32x2*)(F_XB + (size_t)row * DM) + F.lane;
#pragma unroll
                    for (int i = 0; i < 4; ++i) { u32x2 w; w.x = pk2(v[q][i].x, v[q][i].y); w.y = pk2(v[q][i].z, v[q][i].w); xo[64 * i] = w; } } }
        }
        float ss[NR];
#pragma unroll
        for (int q = 0; q < NR; ++q) { ss[q] = 0.f;
#pragma unroll
            for (int i = 0; i < 4; ++i) ss[q] += (v[q][i].x * v[q][i].x + v[q][i].y * v[q][i].y) + (v[q][i].z * v[q][i].z + v[q][i].w * v[q][i].w); }
#pragma unroll
        for (int o = 1; o < 64; o <<= 1) {
#pragma unroll
            for (int q = 0; q < NR; ++q) ss[q] += __shfl_xor(ss[q], o); }
#pragma unroll
        for (int q = 0; q < NR; ++q) { const int row = rowA + q, b = row / SEQ; const float rstd = 1.0f / sqrtf(ss[q] * (1.0f / DM) + EPS);
            if (FINAL) { const f32x4* g = (const f32x4*)F_final_g + F.lane; f32x4* xo = (f32x4*)(F_OUT + (size_t)row * DM) + F.lane;
#pragma unroll
                for (int i = 0; i < 4; ++i) xo[64 * i] = v[q][i] * rstd * (oneb ? gsv[i] : g[64 * i]);
            } else { const f32x4* g = (const f32x4*)(F_norm1_g + (size_t)l * DM) + F.lane; const float* modb = F_MOD + ((size_t)l * NB + b) * 6144;
                const f32x4* sh = (const f32x4*)modb + F.lane; const f32x4* sc = (const f32x4*)(modb + 1024) + F.lane; u32x2* ho = (u32x2*)(F_H + (size_t)row * DM) + F.lane;
#pragma unroll
                for (int i = 0; i < 4; ++i) { const f32x4 hv = oneb ? v[q][i] * rstd * gsv[i] + shv[i] : v[q][i] * rstd * g[64 * i] * (sc[64 * i] + 1.0f) + sh[64 * i]; u32x2 o; o.x = pk2(hv.x, hv.y); o.y = pk2(hv.z, hv.w); ho[64 * i] = o; } } }
    }
}

__device__ __forceinline__ void norm2_router_phase(Frame& F, int l) {
    LAS int* l_ent = (LAS int*)F.lds;
    LAS int* l_exp = l_ent + 256;
    LAS int* l_cnt = l_exp + 256;
    LAS int* l_base = l_cnt + 32;
    LAS float* lgs = (LAS float*)(F.lds + 4096 + F.wave * 3072);
    if (F.tid < 32) l_cnt[F.tid] = 0;
    const int fr = F.lane & 15, fq = F.lane >> 4;
    const int row = F.blk * 128 + F.wave * 16 + fr, b = (F.blk * 128) / SEQ;
    LAS float* gsl = (LAS float*)(F.lds + 4096 + NWAVES * 3072);
    { const float* shb = F_MOD + ((size_t)l * NB + b) * 6144 + 3072;
        for (int i = F.tid; i < DM; i += NTHR) { gsl[i] = F_norm2_g[(size_t)l * DM + i] * (shb[1024 + i] + 1.0f); gsl[DM + i] = shb[i]; } }
    __syncthreads();
    const bf16* xr = F_XB + (size_t)row * DM + fq * 8;
    float ss; { const f32x4 q = *(const f32x4*)(F_SSQ + (size_t)row * 16 + fq * 4); ss = (q.x + q.y) + (q.z + q.w); }
    ss += __shfl_xor(ss, 16); ss += __shfl_xor(ss, 32);
    const float rstd = 1.0f / sqrtf(ss * (1.0f / DM) + EPS);
    const LAS float* gp = gsl + fq * 8; const LAS float* shp = gsl + DM + fq * 8;
    const bf16* wb = F_WRHL + (size_t)l * 2 * 48 * DM + (size_t)fr * DM + fq * 8;
    bf16* hrow = F_H + (size_t)row * DM + fq * 8;
    f32x4 acc[3];
#pragma unroll
    for (int t = 0; t < 3; ++t) acc[t] = (f32x4){0.f, 0.f, 0.f, 0.f};
    struct RStep { u32x4 xw; f32x4 g0, g1, h0, h1; bf16x8 bh[3], bl[3]; };
#define R_LOAD(S, ks) do { S.xw = xall[ks]; S.g0 = *(const LAS f32x4*)(gp + (ks) * 32); S.g1 = *(const LAS f32x4*)(gp + (ks) * 32 + 4); \
        S.h0 = *(const LAS f32x4*)(shp + (ks) * 32); S.h1 = *(const LAS f32x4*)(shp + (ks) * 32 + 4); \
        _Pragma("unroll") for (int t = 0; t < 3; ++t) { S.bh[t] = *(const bf16x8*)(wb + (size_t)(t * 16) * DM + (ks) * 32); S.bl[t] = *(const bf16x8*)(wb + (size_t)(48 + t * 16) * DM + (ks) * 32); } } while (0)
#define R_COMP(S, ks) do { \
        const f32x4 a = (f32x4){bf2f(S.xw.x & 0xffffu), bf2f(S.xw.x >> 16), bf2f(S.xw.y & 0xffffu), bf2f(S.xw.y >> 16)}, c = (f32x4){bf2f(S.xw.z & 0xffffu), bf2f(S.xw.z >> 16), bf2f(S.xw.w & 0xffffu), bf2f(S.xw.w >> 16)}; \
        const f32x4 v0 = a * rstd * S.g0 + S.h0, v1 = c * rstd * S.g1 + S.h1; \
        u32x4 hi; hi.x = pk2(v0.x, v0.y); hi.y = pk2(v0.z, v0.w); hi.z = pk2(v1.x, v1.y); hi.w = pk2(v1.z, v1.w); \
        *(u32x4*)(hrow + (ks) * 32) = hi; \
        u32x4 lo; lo.x = pk2(v0.x - bf2f(hi.x & 0xffffu), v0.y - bf2f(hi.x >> 16)); lo.y = pk2(v0.z - bf2f(hi.y & 0xffffu), v0.w - bf2f(hi.y >> 16)); \
        lo.z = pk2(v1.x - bf2f(hi.z & 0xffffu), v1.y - bf2f(hi.z >> 16)); lo.w = pk2(v1.z - bf2f(hi.w & 0xffffu), v1.w - bf2f(hi.w >> 16)); \
        const bf16x8 ahi = __builtin_bit_cast(bf16x8, hi), alo = __builtin_bit_cast(bf16x8, lo); \
        _Pragma("unroll") for (int t = 0; t < 3; ++t) { \
            acc[t] = __builtin_amdgcn_mfma_f32_16x16x32_bf16(S.bh[t], ahi, acc[t], 0, 0, 0); \
            acc[t] = __builtin_amdgcn_mfma_f32_16x16x32_bf16(S.bh[t], alo, acc[t], 0, 0, 0); \
            acc[t] = __builtin_amdgcn_mfma_f32_16x16x32_bf16(S.bl[t], ahi, acc[t], 0, 0, 0); } } while (0)
    {
        u32x4 xall[32];
#pragma unroll
        for (int ks = 0; ks < 32; ++ks) xall[ks] = *(const u32x4*)(xr + ks * 32);
        RStep SA, SB;
        R_LOAD(SA, 0);
#pragma unroll
        for (int ks = 0; ks < 32; ks += 2) {
            R_LOAD(SB, ks + 1);
            R_COMP(SA, ks);
            if (ks + 2 < 32) R_LOAD(SA, ks + 2);
            R_COMP(SB, ks + 1);
        }
    }
#undef R_LOAD
#undef R_COMP
#pragma unroll
    for (int t = 0; t < 3; ++t)
#pragma unroll
        for (int r = 0; r < 4; ++r) lgs[fr * 48 + t * 16 + 4 * fq + r] = acc[t][r];
    LDS_WAIT(); __builtin_amdgcn_wave_barrier();
    {
        const LAS float* wl = lgs + fr * 48;
        float gl[4];
#pragma unroll
        for (int j = 0; j < 4; ++j) gl[j] = wl[j] + F_b_group[l * 4 + j];
        int gi = 0; float gm = gl[0];
#pragma unroll
        for (int j = 1; j < 4; ++j) if (gl[j] > gm) { gm = gl[j]; gi = j; }
        float gs = 0.f;
#pragma unroll
        for (int j = 0; j < 4; ++j) gs += __expf(gl[j] - gm);
        const float gw = 1.0f / gs;
        float ig[8];
#pragma unroll
        for (int j = 0; j < 8; ++j) ig[j] = wl[4 + gi * 8 + j] + F_b_expert[l * 32 + gi * 8 + j];
        int i0 = 0; float v0 = ig[0];
#pragma unroll
        for (int j = 1; j < 8; ++j) if (ig[j] > v0) { v0 = ig[j]; i0 = j; }
        int i1 = -1; float v1 = -3.0e38f;
#pragma unroll
        for (int j = 0; j < 8; ++j) if (j != i0 && ig[j] > v1) { v1 = ig[j]; i1 = j; }
        const float e1x = __expf(v1 - v0), w0 = gw / (1.0f + e1x), w1 = gw * e1x / (1.0f + e1x);
        if (fq == 0) { F_RW[(size_t)row * 2] = w0; F_RW[(size_t)row * 2 + 1] = w1;
            const int lr = F.wave * 16 + fr; l_ent[lr * 2] = row * 2; l_ent[lr * 2 + 1] = row * 2 + 1; l_exp[lr * 2] = gi * 8 + i0; l_exp[lr * 2 + 1] = gi * 8 + i1; }
    }
    __syncthreads();
    int rank = 0, e = 0;
    if (F.tid < 256) { e = l_exp[F.tid]; rank = atomicAdd((int*)&l_cnt[e], 1); }
    __syncthreads();
    if (F.tid < 32) l_base[F.tid] = (int)atomicAdd(F_ctl + CW_CNT + l * 32 + F.tid, (unsigned)l_cnt[F.tid]);
    __syncthreads();
    if (F.tid < 256) F_LIST[(size_t)e * NT + l_base[e] + rank] = l_ent[F.tid];
    __syncthreads();
}


struct GateOrder {
    int blk; const char* A; const char* Bt;
    __device__ __forceinline__ bool next(int i, pg8::Unit& u) const { if (i != 0 || blk < 64 || blk >= 192) return false; u.pm = blk - 64; u.pn = 10; u.e = 0; u.i = 0; return true; }
    __device__ __forceinline__ const char* a_base(const pg8::Unit& u) const { return A + (size_t)u.pm * (256 * DM * 2); }
    __device__ __forceinline__ const char* b_base(const pg8::Unit& u) const { return Bt + (size_t)u.pn * (256 * DM * 2); }
    __device__ __forceinline__ int row(const pg8::Unit&, int r) const { return r; }
};

constexpr int MOE_LDS = 131072;
constexpr int MOE_MAXU = 8;
struct MoeOrder {
    LAS const int* ud; LAS const int* rows; const char* A; const char* Bt; size_t strideE, tstepA, tstepB; bool gather;
    __device__ __forceinline__ bool next(int i, pg8::Unit& u) const { if (i >= MOE_MAXU || ud[i * 4 + 3] == 0) return false; u.pm = ud[i * 4]; u.pn = ud[i * 4 + 1]; u.e = ud[i * 4 + 2]; u.i = i; return true; }
    __device__ __forceinline__ const char* a_base(const pg8::Unit& u) const { return gather ? A : A + (size_t)u.pm * tstepA; }
    __device__ __forceinline__ const char* b_base(const pg8::Unit& u) const { return Bt + (size_t)u.e * strideE + (size_t)u.pn * tstepB; }
    __device__ __forceinline__ int row(const pg8::Unit& u, int r) const { if (!gather) return r; const int ent = rows[u.i * 256 + r]; return ent >= 0 ? (ent >> 1) : 0; }
};
struct EpiMoe1 {
    static constexpr bool PERM = true;
    bf16* act; const float* rw; LAS const int* rows;
    __device__ __forceinline__ void operator()(const f32x4 (&acc)[2][2][4][2], const pg8::Unit& u, int wr, int wc, int fr, int fq) const {
        float wv[2][4];
#pragma unroll
        for (int ai = 0; ai < 2; ++ai)
#pragma unroll
            for (int m = 0; m < 4; ++m) { const int ent = rows[u.i * 256 + ai * 128 + wr * 64 + m * 16 + fr]; wv[ai][m] = ent >= 0 ? rw[ent] : 0.f; }
#pragma unroll
        for (int ai = 0; ai < 2; ++ai)
#pragma unroll
            for (int m = 0; m < 4; ++m) { const int rl = ai * 128 + wr * 64 + m * 16 + fr; const float w = wv[ai][m];
                const f32x4 g0 = acc[ai][0][m][0], g1 = acc[ai][0][m][1], u0 = acc[ai][1][m][0], u1 = acc[ai][1][m][1];
                u32x4 o; o.x = pg8::cvt_pk_bf16(silu_f(g0[0]) * u0[0] * w, silu_f(g0[1]) * u0[1] * w); o.y = pg8::cvt_pk_bf16(silu_f(g0[2]) * u0[2] * w, silu_f(g0[3]) * u0[3] * w);
                o.z = pg8::cvt_pk_bf16(silu_f(g1[0]) * u1[0] * w, silu_f(g1[1]) * u1[1] * w); o.w = pg8::cvt_pk_bf16(silu_f(g1[2]) * u1[2] * w, silu_f(g1[3]) * u1[3] * w);
                *(u32x4*)(act + ((size_t)u.pm * 256 + rl) * FF + u.pn * 128 + wc * 32 + 8 * fq) = o; }
    }
};
struct EpiMoe2 {
    static constexpr bool PERM = true;
    bf16* slot; LAS const int* rows;
    __device__ __forceinline__ void operator()(const f32x4 (&acc)[2][2][4][2], const pg8::Unit& u, int wr, int wc, int fr, int fq) const {
#pragma unroll
        for (int ai = 0; ai < 2; ++ai)
#pragma unroll
            for (int m = 0; m < 4; ++m) { const int rl = ai * 128 + wr * 64 + m * 16 + fr; const int ent = rows[u.i * 256 + rl];
                if (ent >= 0) { bf16* rowp = slot + (size_t)(ent & 1) * NT * DM + (size_t)(ent >> 1) * DM + u.pn * 256 + wc * 32 + 8 * fq;
#pragma unroll
                    for (int bj = 0; bj < 2; ++bj) { const f32x4 v0 = acc[ai][bj][m][0], v1 = acc[ai][bj][m][1];
                        u32x4 w; w.x = pg8::cvt_pk_bf16(v0[0], v0[1]); w.y = pg8::cvt_pk_bf16(v0[2], v0[3]); w.z = pg8::cvt_pk_bf16(v1[0], v1[1]); w.w = pg8::cvt_pk_bf16(v1[2], v1[3]);
                        *(u32x4*)(rowp + bj * 128) = w; } } }
    }
};
struct MoeDeal { int nA, nB, NL, q, ls, nAfull; bool defer; };
__device__ __forceinline__ MoeDeal moe_deal(int tiles, int G) {
    MoeDeal d; d.nA = tiles * 2; d.nB = tiles * 4; d.nAfull = (d.nA / G) * G; d.NL = d.nA - d.nAfull; d.q = (d.nB + 2 * d.NL + G - 1) / G; d.ls = d.q - 3 < 2 ? 2 : d.q - 3;
    d.defer = (G == 256) && d.NL > 0 && d.NL <= 64 && d.q >= 4 && d.nAfull > 0 && d.ls <= MOE_MAXU && d.NL * d.ls <= d.nB && (d.nB - d.NL * d.ls + (G - d.NL) - 1) / (G - d.NL) <= MOE_MAXU; return d;
}
constexpr int CW_MB = 28672;
template <int STAGE>
__device__ __forceinline__ void moe_pg8(Frame& F, int l) {
    LAS int* t_cnt = (LAS int*)(F.lds + MOE_LDS);
    LAS int* t_toff = t_cnt + 32;
    LAS int* ud = t_toff + 36;
    LAS int* rows = ud + 32;
    int tid_m = threadIdx.x; asm volatile("" : "+v"(tid_m));
    __syncthreads();
    if (tid_m < NE) t_cnt[tid_m] = (int)__hip_atomic_load(F_ctl + CW_CNT + l * 32 + tid_m, __ATOMIC_RELAXED, __HIP_MEMORY_SCOPE_AGENT);
    __syncthreads();
    if (tid_m == 0) { int to = 0;
        for (int e = 0; e < NE; ++e) { t_toff[e] = to; to += (t_cnt[e] + 255) >> 8; }
        t_toff[NE] = to; }
    __syncthreads();
    const MoeDeal D = moe_deal(t_toff[NE], F.G);
#define MOE_SLOT(i, L, valid, NPN_) do { int rtg = 0, pn = 0, e = 0; \
        if (valid) { rtg = (L) / (NPN_); pn = (L) % (NPN_); for (int q_ = 1; q_ < NE; ++q_) if (t_toff[q_] <= rtg) e = q_; } \
        if (tid_m == 0) { ud[(i) * 4] = rtg; ud[(i) * 4 + 1] = pn; ud[(i) * 4 + 2] = e; ud[(i) * 4 + 3] = (valid) ? 1 : 0; } \
        if (tid_m < 256) { int ent = -1; if (valid) { const int pos = (rtg - t_toff[e]) * 256 + tid_m; if (pos < t_cnt[e]) ent = F_LIST[(size_t)e * NT + pos]; } rows[(i) * 256 + tid_m] = ent; } } while (0)
    MoeOrder S; S.ud = ud; S.rows = rows;
    if (STAGE == 1 || (D.defer && F.blk < D.NL)) {
        const int nlim = D.defer ? D.nAfull : D.nA;
        for (int i = 0; i < MOE_MAXU; ++i) { int L; bool valid;
            if (STAGE == 1) { L = i * F.G + F.blk; valid = L < nlim; } else { L = D.nAfull + F.blk; valid = (i == 0); }
            MOE_SLOT(i, L, valid, 2); }
        __syncthreads();
        S.A = (const char*)F_H; S.Bt = (const char*)(F_WguT + (size_t)l * NE * 512 * DM); S.strideE = (size_t)512 * DM * 2; S.tstepA = 0; S.tstepB = (size_t)256 * DM * 2; S.gather = true;
        EpiMoe1 E{F_ACT, F_RW, rows};
        pg8::gemm_phase<EpiMoe1, MoeOrder, true>(F.lds, DM, DM, DM, S, E);
        if (STAGE == 2) {
            asm volatile("s_waitcnt vmcnt(0)" ::: "memory"); __syncthreads();
            if (tid_m == 0) { unsigned* mb = F_ctl + CW_MB + l * 64;
                __builtin_amdgcn_fence(__ATOMIC_RELEASE, "agent"); asm volatile("s_waitcnt vmcnt(0)" ::: "memory");
                (void)__hip_atomic_fetch_add(mb, 1u, __ATOMIC_RELAXED, __HIP_MEMORY_SCOPE_AGENT);
                unsigned sp = 0; while (__hip_atomic_load(mb, __ATOMIC_RELAXED, __HIP_MEMORY_SCOPE_AGENT) < (unsigned)D.NL) { __builtin_amdgcn_s_sleep(1); if (++sp > (1u << 22)) break; }
                __builtin_amdgcn_fence(__ATOMIC_ACQUIRE, "agent"); asm volatile("s_waitcnt vmcnt(0)" ::: "memory"); }
            __syncthreads();
        }
    }
    if (STAGE == 2) {
        for (int i = 0; i < MOE_MAXU; ++i) { int L; bool valid;
            if (!D.defer) { L = i * F.G + F.blk; valid = L < D.nB; }
            else if (F.blk < D.NL) { L = D.nB - (F.blk + 1) * D.ls + i; valid = i < D.ls; }
            else { L = (F.blk - D.NL) + (F.G - D.NL) * i; valid = L < D.nB - D.NL * D.ls; }
            MOE_SLOT(i, L, valid, 4); }
        __syncthreads();
        S.A = (const char*)F_ACT; S.Bt = (const char*)(F_WdT + (size_t)l * NE * DM * FF); S.strideE = (size_t)DM * FF * 2; S.tstepA = (size_t)256 * FF * 2; S.tstepB = (size_t)256 * FF * 2; S.gather = false;
        EpiMoe2 E{F_SLOT, rows};
        pg8::gemm_phase<EpiMoe2, MoeOrder, false>(F.lds, FF, FF, FF, S, E);
    }
#undef MOE_SLOT
}

__device__ __forceinline__ void s5_build_operands(Frame& F, int l, int blk0, int nblk) {
    if (F.blk < blk0 || F.blk >= blk0 + nblk) return;
    const int gt = (F.blk - blk0) * NTHR + F.tid, ngt = nblk * NTHR;
    bf16* ctb = F_TMAT + (size_t)(l & 1) * CTSZ; bf16* btb = F_BT1 + (size_t)(l & 1) * BTSZ;
    for (int i = gt; i < 16 * 1024 * 16; i += ngt) {
        const int kv = i & 15, row = (i >> 4) & 1023, g = i >> 14, t = row >> 4, c = row & 15, k0 = kv * 8;
        const int lg = l * 16 + g, p0 = k0 & 63;
        const f32x4* pwp = (const f32x4*)(F_PW + ((size_t)lg * 65 + t + 1) * 64 + p0);
        const f32x4* crp = (const f32x4*)(F_c_re + ((size_t)lg * 16 + c) * 64 + p0); const f32x4* cip = (const f32x4*)(F_c_im + ((size_t)lg * 16 + c) * 64 + p0);
        const f32x4 w0 = pwp[0], w1 = pwp[1], w2 = pwp[2], w3 = pwp[3], cr0 = crp[0], cr1 = crp[1], ci0 = cip[0], ci1 = cip[1];
        const float pr[8] = {w0.x, w0.z, w1.x, w1.z, w2.x, w2.z, w3.x, w3.z}, pi[8] = {w0.y, w0.w, w1.y, w1.w, w2.y, w2.w, w3.y, w3.w};
        const float cr[8] = {cr0.x, cr0.y, cr0.z, cr0.w, cr1.x, cr1.y, cr1.z, cr1.w}, ci[8] = {ci0.x, ci0.y, ci0.z, ci0.w, ci1.x, ci1.y, ci1.z, ci1.w};
        float v[8];
#pragma unroll
        for (int q = 0; q < 8; ++q) v[q] = (k0 < 64) ? (cr[q] * pr[q] - ci[q] * pi[q]) : -(cr[q] * pi[q] + ci[q] * pr[q]);
        u32x4 o; o.x = pk2(v[0], v[1]); o.y = pk2(v[2], v[3]); o.z = pk2(v[4], v[5]); o.w = pk2(v[6], v[7]);
        *(u32x4*)(ctb + ((size_t)(g * 1024 + row)) * 128 + k0) = o;
    }
    for (int i = gt; i < 16 * 256 * 128; i += ngt) {
        const int kv = i & 127, n = (i >> 7) & 255, g = i >> 15, s = kv >> 1, c0 = (kv & 1) * 8;
        float v[8];
#pragma unroll
        for (int q = 0; q < 8; ++q) v[q] = 0.f;
        if (n < 128) { const int p = n & 63, lg = l * 16 + g; const f32x2 pv = F_PW[((size_t)lg * 65 + (63 - s)) * 64 + p]; const float pr = pv.x, pi = pv.y;
#pragma unroll
            for (int q = 0; q < 8; ++q) { const f32x2 bb = F_BBAR[((size_t)lg * 64 + p) * 16 + c0 + q]; v[q] = (n < 64) ? (pr * bb.x - pi * bb.y) : (pr * bb.y + pi * bb.x); } }
        u32x4 o; o.x = pk2(v[0], v[1]); o.y = pk2(v[2], v[3]); o.z = pk2(v[4], v[5]); o.w = pk2(v[6], v[7]);
        *(u32x4*)(btb + ((size_t)(g * 256 + n)) * 1024 + s * 16 + c0) = o;
    }
}
struct GroupOrder {
    int G, c, npn, nunit; const char* A; const char* Bt; size_t strideB, tstepA, tstepB;
    __device__ __forceinline__ bool next(int i, pg8::Unit& u) const { const int L = i * G + c; if (L >= nunit) return false; u.pn = L % npn; u.pm = (L / npn) & 1; u.e = L / (npn * 2); u.i = i; return true; }
    __device__ __forceinline__ const char* a_base(const pg8::Unit& u) const { return A + (size_t)u.e * (U2K * 2) + (size_t)u.pm * tstepA; }
    __device__ __forceinline__ const char* b_base(const pg8::Unit& u) const { return Bt + (size_t)u.e * strideB + (size_t)u.pn * tstepB; }
    __device__ __forceinline__ int row(const pg8::Unit&, int r) const { return r; }
};
struct SplitKOrder {
    int G, c; const char* A; const char* Bt;
    __device__ __forceinline__ bool next(int i, pg8::Unit& u) const { const int L = i * G + c; if (L >= 64) return false; u.pn = L & 1; u.pm = (L >> 1) & 1; u.e = L >> 2; u.i = i; return true; }
    __device__ __forceinline__ const char* a_base(const pg8::Unit& u) const { return A + (size_t)u.e * (U2K * 2) + (size_t)u.pm * ((size_t)256 * U2LD * 2) + (size_t)u.pn * 1024; }
    __device__ __forceinline__ const char* b_base(const pg8::Unit& u) const { return Bt + (size_t)u.e * ((size_t)256 * 1024 * 2) + (size_t)u.pn * 1024; }
    __device__ __forceinline__ int row(const pg8::Unit&, int r) const { return r; }
};
struct ToepOrder {
    int G, c, npn, nunit; const char* A; const char* Kb; const char* Ct; size_t tstepA;
    __device__ __forceinline__ bool next(int i, pg8::Unit& u) const { const int L = i * G + c; if (L >= nunit) return false; u.pn = L % npn; u.pm = (L / npn) & 1; u.e = L / (npn * 2); u.i = i; return true; }
    __device__ __forceinline__ const char* a_base(const pg8::Unit& u) const { return A + (size_t)u.e * (U2K * 2) + (size_t)u.pm * tstepA; }
    __device__ __forceinline__ const char* b_base(const pg8::Unit& u) const { return Kb + (size_t)u.e * (128 * 512) + (size_t)(u.pn * 16 + 61) * 512 + 4096; }
    __device__ __forceinline__ const char* c_base(const pg8::Unit& u) const { return Ct + (size_t)u.e * (1024 * 256) + (size_t)u.pn * (256 * 256); }
    __device__ __forceinline__ int row(const pg8::Unit&, int r) const { return r; }
};
struct EpiS5a {
    static constexpr bool PERM = false;
    float* sendp;
    __device__ __forceinline__ void operator()(const f32x4 (&acc)[2][2][4][2], const pg8::Unit& u, int wr, int wc, int fr, int fq) const {
#pragma unroll
        for (int ai = 0; ai < 2; ++ai)
#pragma unroll
            for (int m = 0; m < 4; ++m) { const int R = u.pm * 256 + ai * 128 + wr * 64 + m * 16 + fr; float* rowp = sendp + (size_t)u.pn * (512 * 16 * 128) + ((size_t)R * 16 + u.e) * 128 + wc * 32 + 4 * fq;
#pragma unroll
                for (int n = 0; n < 2; ++n) *(f32x4*)(rowp + n * 16) = acc[ai][0][m][n]; }
    }
};
struct EpiS5b {
    static constexpr bool PERM = true;
    bf16* yg;
    __device__ __forceinline__ void operator()(const f32x4 (&acc)[2][2][4][2], const pg8::Unit& u, int wr, int wc, int fr, int fq) const {
#pragma unroll
        for (int ai = 0; ai < 2; ++ai)
#pragma unroll
            for (int m = 0; m < 4; ++m) { const int R = u.pm * 256 + ai * 128 + wr * 64 + m * 16 + fr;
#pragma unroll
                for (int bj = 0; bj < 2; ++bj) { const int col0 = u.pn * 256 + bj * 128 + wc * 32 + 8 * fq, t = col0 >> 4, c0 = col0 & 15; const f32x4 v0 = acc[ai][bj][m][0], v1 = acc[ai][bj][m][1];
                    u32x4 w; w.x = pg8::cvt_pk_bf16(gelu_tanh_f(v0[0]), gelu_tanh_f(v0[1])); w.y = pg8::cvt_pk_bf16(gelu_tanh_f(v0[2]), gelu_tanh_f(v0[3]));
                    w.z = pg8::cvt_pk_bf16(gelu_tanh_f(v1[0]), gelu_tanh_f(v1[1])); w.w = pg8::cvt_pk_bf16(gelu_tanh_f(v1[2]), gelu_tanh_f(v1[3]));
                    *(u32x4*)(yg + ((size_t)R * 64 + t) * 256 + u.e * 16 + c0) = w; } }
    }
};
struct EpiGlu {
    static constexpr bool PERM = true;
    const bf16* yg; bf16* mix; const float* bglu;
    __device__ __forceinline__ void operator()(const f32x4 (&acc)[2][2][4][2], const pg8::Unit& u, int wr, int wc, int fr, int fq) const {
        f32x4 bv[2][2];
#pragma unroll
        for (int bj = 0; bj < 2; ++bj) { const int col0 = bj * 128 + wc * 32 + 8 * fq; bv[bj][0] = *(const f32x4*)(bglu + col0); bv[bj][1] = *(const f32x4*)(bglu + col0 + 4); }
#pragma unroll
        for (int ai = 0; ai < 2; ++ai) {
            u32x4 yv[4][2];
#pragma unroll
            for (int m = 0; m < 4; ++m)
#pragma unroll
                for (int bj = 0; bj < 2; ++bj) yv[m][bj] = *(const u32x4*)(yg + ((size_t)u.pm * 256 + ai * 128 + wr * 64 + m * 16 + fr) * 256 + bj * 128 + wc * 32 + 8 * fq);
#pragma unroll
            for (int m = 0; m < 4; ++m) { const size_t row = (size_t)u.pm * 256 + ai * 128 + wr * 64 + m * 16 + fr;
#pragma unroll
                for (int bj = 0; bj < 2; ++bj) { const int col0 = bj * 128 + wc * 32 + 8 * fq; const u32x4 y = yv[m][bj];
                    const f32x4 v0 = acc[ai][bj][m][0] + bv[bj][0], v1 = acc[ai][bj][m][1] + bv[bj][1];
                    u32x4 w; w.x = pg8::cvt_pk_bf16(bf2f(y.x & 0xffffu) * sigmoid_f(v0[0]), bf2f(y.x >> 16) * sigmoid_f(v0[1])); w.y = pg8::cvt_pk_bf16(bf2f(y.y & 0xffffu) * sigmoid_f(v0[2]), bf2f(y.y >> 16) * sigmoid_f(v0[3]));
                    w.z = pg8::cvt_pk_bf16(bf2f(y.z & 0xffffu) * sigmoid_f(v1[0]), bf2f(y.z >> 16) * sigmoid_f(v1[1])); w.w = pg8::cvt_pk_bf16(bf2f(y.w & 0xffffu) * sigmoid_f(v1[2]), bf2f(y.w >> 16) * sigmoid_f(v1[3]));
                    *(u32x4*)(mix + row * DM + 512 + col0) = w; } }
            asm volatile("" ::: "memory");
        }
    }
};

__device__ __forceinline__ float ret_log2gamma(int h) { return log2f(1.0f - exp2f(-5.0f - (float)h)); }

template <int NQT> __device__ __forceinline__ void attn_mfma(Frame& F, int l);
__device__ __forceinline__ void attn_coop(Frame& F, int l);
__device__ __forceinline__ void scans_by_quarter0(Frame& F, int l) {
    const int qb = (F.blk >> 5) * 8 + (F.blk & 7);
    LAS float* sst = (LAS float*)F.lds;
    const int i0 = qb * 128, sb = i0 >> 10, g0 = (i0 >> 6) & 15;
#pragma unroll
    for (int j = 0; j < 8; ++j) { const int v = F.tid + j * NTHR, n = v >> 6, gsel = (v >> 5) & 1, part = (v >> 4) & 1, q = v & 15; const size_t r = (size_t)(sb * NCH + n) * 16 + g0 + gsel;
        const float* sp = F_SENDP + r * 128 + part * 64 + q * 4; const f32x4 a = *(const f32x4*)sp, c = *(const f32x4*)(sp + 512 * 16 * 128);
        *(LAS f32x4*)(sst + (n * 2 + part) * 128 + gsel * 64 + q * 4) = a + c; }
    asm volatile("" ::: "memory");
#pragma unroll 1
    for (int ps = 0; ps < 2; ++ps) { const int i = qb * 1024 + ps * NTHR + F.tid, b = i >> 13, h = (i >> 11) & 3, de2 = i & 2047; const float ga = exp2f(64.f * ret_log2gamma(h));
        unsigned* pa = (unsigned*)(F_KVB + (size_t)(b * NCH) * KVST + h * 4096) + de2; unsigned ta[NCH];
#pragma unroll
        for (int n = 0; n < NCH; ++n) ta[n] = pa[(size_t)n * (KVST / 2)];
        float s0 = 0.f, s1 = 0.f;
#pragma unroll
        for (int n = 0; n < NCH; ++n) { const float v0 = bf2f(ta[n] & 0xffffu), v1 = bf2f(ta[n] >> 16); pa[(size_t)n * (KVST / 2)] = pk2(s0, s1); s0 = ga * s0 + v0; s1 = ga * s1 + v1; } }
    __syncthreads();
    if (F.tid >= NTHR - 128) { const int tl = F.tid - (NTHR - 128), i = i0 + tl, g = (i >> 6) & 15, p = i & 63; const f32x2 a64 = F_ABAR64[l * 1024 + (i & 1023)];
        float xr = 0.f, xi = 0.f;
#pragma unroll 8
        for (int n = 0; n < NCH; ++n) { const size_t r = (size_t)(sb * NCH + n) * 16 + g; bf16* cp = F_U2X + r * U2K; cp[p] = (bf16)f2bf(xr); cp[64 + p] = (bf16)f2bf(xi);
            const float sr = sst[(n * 2) * 128 + tl], si = sst[(n * 2 + 1) * 128 + tl];
            const float nr = a64.x * xr - a64.y * xi + sr, ni = a64.x * xi + a64.y * xr + si; xr = nr; xi = ni; } }
}
__device__ __forceinline__ void p4_scan_attn(Frame& F, int l) {
    if (F.G == 256) { attn_coop(F, l); if (((F.blk >> 3) & 3) == 0) { __syncthreads(); scans_by_quarter0(F, l); } return; }
    const bool rs = (F.G == 256) && F.tid < 256;
    unsigned t[NCH]; unsigned* p0 = nullptr; float g64 = 0.f;
    if (rs) { const int i = F.blk * 256 + F.tid, b = i >> 13, h = (i >> 11) & 3, de2 = i & 2047; g64 = exp2f(64.f * ret_log2gamma(h));
        p0 = (unsigned*)(F_KVB + (size_t)(b * NCH) * KVST + h * 4096) + de2;
#pragma unroll
        for (int n = 0; n < NCH; ++n) t[n] = p0[(size_t)n * (KVST / 2)]; }
    LAS float* sst = (LAS float*)F.lds;
    { const int i0 = F.blk * 32, b = (i0 >> 10) & 7, g = (i0 >> 6) & 15, pb = i0 & 63;
#pragma unroll
        for (int j = 0; j < 2; ++j) { const int v = F.tid + j * NTHR, n = v >> 4, part = (v >> 3) & 1, q = v & 7; const size_t r = (size_t)(b * NCH + n) * 16 + g;
            const float* sp = F_SENDP + r * 128 + part * 64 + pb + q * 4; const f32x4 a = *(const f32x4*)sp, c = *(const f32x4*)(sp + 512 * 16 * 128);
            *(LAS f32x4*)(sst + (n * 2 + part) * 32 + q * 4) = a + c; } }
    __syncthreads();
    if (F.tid >= NTHR - 32) { const int tl = F.tid - (NTHR - 32), i = F.blk * 32 + tl;
        if (i < NB * 16 * 64) { const int b = i >> 10, g = (i >> 6) & 15, p = i & 63; const f32x2 a64 = F_ABAR64[l * 1024 + (i & 1023)];
            float xr = 0.f, xi = 0.f;
#pragma unroll 8
            for (int n = 0; n < NCH; ++n) { const size_t r = (size_t)(b * NCH + n) * 16 + g; bf16* cp = F_U2X + r * U2K; cp[p] = (bf16)f2bf(xr); cp[64 + p] = (bf16)f2bf(xi);
                const float sr = sst[(n * 2) * 32 + tl], si = sst[(n * 2 + 1) * 32 + tl];
                const float nr = a64.x * xr - a64.y * xi + sr, ni = a64.x * xi + a64.y * xr + si; xr = nr; xi = ni; } } }
    if (rs) { float s0 = 0.f, s1 = 0.f;
#pragma unroll
        for (int n = 0; n < NCH; ++n) { const float v0 = bf2f(t[n] & 0xffffu), v1 = bf2f(t[n] >> 16); p0[(size_t)n * (KVST / 2)] = pk2(s0, s1); s0 = g64 * s0 + v0; s1 = g64 * s1 + v1; } }
    if (F.G != 256)
    for (int i = F.blk * 256 + F.tid; F.tid < 256 && i < NB * 4 * 2048; i += F.G * 256) { const int b = i >> 13, h = (i >> 11) & 3, de2 = i & 2047; const float gg = exp2f(64.f * ret_log2gamma(h));
        unsigned* q0 = (unsigned*)(F_KVB + (size_t)(b * NCH) * KVST + h * 4096) + de2; unsigned tt[NCH];
#pragma unroll
        for (int n = 0; n < NCH; ++n) tt[n] = q0[(size_t)n * (KVST / 2)];
        float s0 = 0.f, s1 = 0.f;
#pragma unroll
        for (int n = 0; n < NCH; ++n) { const float v0 = bf2f(tt[n] & 0xffffu), v1 = bf2f(tt[n] >> 16); q0[(size_t)n * (KVST / 2)] = pk2(s0, s1); s0 = gg * s0 + v0; s1 = gg * s1 + v1; } }
    __syncthreads();
    if (F.G == 256) attn_coop(F, l); else attn_mfma<ATTN_NQT>(F, l);
}


typedef short v4i16_t __attribute__((ext_vector_type(4)));
template <int NQT>
__device__ __forceinline__ void attn_mfma(Frame& F, int l) {
    const int lane = F.lane, fr = lane & 15, fq = lane >> 4;
    LAS unsigned char* vl = F.lds + F.wave * 10240;
    LAS float* bl = (LAS float*)(vl + 9216);
    constexpr int QPW = NQT * 16, TPC = 64 / QPW;
    constexpr float LOG2E = 1.4426950408889634f, SC = 0.125f * LOG2E;
    const int ntask = NB * NCH * 8 * TPC;
    const unsigned vtr0 = (unsigned)((4 * fq + (fr >> 2)) * 144 + (fr & 3) * 8);
    constexpr int WPC = 8 / TPC;
    const bool deal = (F.G == 256);
    const int nstep = deal ? 16 / WPC : (ntask + F.ngw - 1) / F.ngw;
    for (int step = 0; step < nstep; ++step) {
        int sub, h, n, b;
        if (deal) { const int j = F.blk >> 3; b = F.blk & 7; h = j >> 2; n = (j & 3) * 16 + step * WPC + F.wave / TPC; sub = F.wave % TPC; }
        else { const int task = F.gw + step * F.ngw; if (task >= ntask) break; sub = task % TPC; const int u = task / TPC; h = u & 7; n = (u >> 3) & 63; b = u >> 9; }
        const size_t qrow0 = (size_t)b * SEQ + n * 64 + sub * QPW;
        __builtin_amdgcn_wave_barrier();
#pragma unroll
        for (int i = 0; i < 3; ++i) bl[lane + 64 * i] = F_rel_bias[(size_t)(l * 8 + h) * 192 + lane + 64 * i] * LOG2E;
        bf16x8 qf[NQT][2];
#pragma unroll
        for (int qt = 0; qt < NQT; ++qt)
#pragma unroll
            for (int ks = 0; ks < 2; ++ks) qf[qt][ks] = *(const bf16x8*)(F_QKV + (qrow0 + qt * 16 + fr) * INW + C_QA + h * 64 + ks * 32 + fq * 8);
        f32x4 ot[4][NQT]; float lp[NQT];
#pragma unroll
        for (int qt = 0; qt < NQT; ++qt) { lp[qt] = 0.f;
#pragma unroll
            for (int et = 0; et < 4; ++et) ot[et][qt] = (f32x4){0.f, 0.f, 0.f, 0.f}; }
        LDS_WAIT(); __builtin_amdgcn_wave_barrier();
        const float b0 = bl[0];
        const int kc0 = n >= 8 ? n - 8 : 0;
        bf16x8 kf[4][2];
#pragma unroll
        for (int kt = 0; kt < 4; ++kt) { const bf16* kp = F_QKV + ((size_t)b * SEQ + kc0 * 64 + kt * 16 + fr) * INW + C_KA + h * 64 + fq * 8; kf[kt][0] = *(const bf16x8*)kp; kf[kt][1] = *(const bf16x8*)(kp + 32); }
        for (int kc = kc0; kc <= n; ++kc) {
            const size_t krow0 = (size_t)b * SEQ + kc * 64;
            u32x4 vreg[8];
#pragma unroll
            for (int i = 0; i < 8; ++i) vreg[i] = *(const u32x4*)(F_QKV + (krow0 + (lane >> 3) + 8 * i) * INW + C_VA + h * 64 + (lane & 7) * 8);
            bf16x8 kn[4][2];
            { const size_t krow1 = (size_t)b * SEQ + (kc < n ? kc + 1 : n) * 64;
#pragma unroll
                for (int kt = 0; kt < 4; ++kt) { const bf16* kp = F_QKV + (krow1 + kt * 16 + fr) * INW + C_KA + h * 64 + fq * 8; kn[kt][0] = *(const bf16x8*)kp; kn[kt][1] = *(const bf16x8*)(kp + 32); } }
            f32x4 st[4][NQT];
#pragma unroll
            for (int kt = 0; kt < 4; ++kt) {
#pragma unroll
                for (int qt = 0; qt < NQT; ++qt) { f32x4 z = (f32x4){0.f, 0.f, 0.f, 0.f};
                    z = __builtin_amdgcn_mfma_f32_16x16x32_bf16(kf[kt][0], qf[qt][0], z, 0, 0, 0); st[kt][qt] = __builtin_amdgcn_mfma_f32_16x16x32_bf16(kf[kt][1], qf[qt][1], z, 0, 0, 0); } }
            const int dc = kc - n;
            if (dc <= -3) {
#pragma unroll
                for (int kt = 0; kt < 4; ++kt)
#pragma unroll
                    for (int qt = 0; qt < NQT; ++qt) st[kt][qt] = st[kt][qt] * SC + b0;
            } else {
                const int ib = 64 * dc + 128 + 4 * fq - fr + sub * (-QPW);
#pragma unroll
                for (int kt = 0; kt < 4; ++kt)
#pragma unroll
                    for (int qt = 0; qt < NQT; ++qt)
#pragma unroll
                        for (int r = 0; r < 4; ++r) { int idx = ib + 16 * (kt - qt) + r; idx = idx < 0 ? 0 : idx; st[kt][qt][r] = st[kt][qt][r] * SC + bl[idx]; }
            }
#pragma unroll
            for (int qt = 0; qt < NQT; ++qt) { float ps = 0.f;
#pragma unroll
                for (int kt = 0; kt < 4; ++kt)
#pragma unroll
                    for (int r = 0; r < 4; ++r) { const float p = __builtin_amdgcn_exp2f(st[kt][qt][r]); st[kt][qt][r] = p; ps += p; }
                lp[qt] += ps; }
            __builtin_amdgcn_wave_barrier();
#pragma unroll
            for (int i = 0; i < 8; ++i) *(LAS u32x4*)(vl + ((lane >> 3) + 8 * i) * 144 + (lane & 7) * 16) = vreg[i];
            LDS_WAIT(); __builtin_amdgcn_wave_barrier();
#pragma unroll
            for (int s = 0; s < 2; ++s) {
                bf16x8 pf[NQT];
#pragma unroll
                for (int qt = 0; qt < NQT; ++qt) { u32x4 w; w.x = pg8::cvt_pk_bf16(st[2 * s][qt][0], st[2 * s][qt][1]); w.y = pg8::cvt_pk_bf16(st[2 * s][qt][2], st[2 * s][qt][3]);
                    w.z = pg8::cvt_pk_bf16(st[2 * s + 1][qt][0], st[2 * s + 1][qt][1]); w.w = pg8::cvt_pk_bf16(st[2 * s + 1][qt][2], st[2 * s + 1][qt][3]); pf[qt] = __builtin_bit_cast(bf16x8, w); }
#pragma unroll
                for (int et = 0; et < 4; ++et) {
                    const v4i16_t t0 = __builtin_amdgcn_ds_read_tr16_b64_v4i16((LAS v4i16_t*)(vl + vtr0 + (2 * s) * 16 * 144 + et * 32));
                    const v4i16_t t1 = __builtin_amdgcn_ds_read_tr16_b64_v4i16((LAS v4i16_t*)(vl + vtr0 + (2 * s + 1) * 16 * 144 + et * 32));
                    bf16x8 vf; vf[0] = t0[0]; vf[1] = t0[1]; vf[2] = t0[2]; vf[3] = t0[3]; vf[4] = t1[0]; vf[5] = t1[1]; vf[6] = t1[2]; vf[7] = t1[3];
#pragma unroll
                    for (int qt = 0; qt < NQT; ++qt) ot[et][qt] = __builtin_amdgcn_mfma_f32_16x16x32_bf16(vf, pf[qt], ot[et][qt], 0, 0, 0);
                }
            }
#pragma unroll
            for (int kt = 0; kt < 4; ++kt) { kf[kt][0] = kn[kt][0]; kf[kt][1] = kn[kt][1]; }
        }
#pragma unroll
        for (int qt = 0; qt < NQT; ++qt) { float ls = lp[qt]; ls += __shfl_xor(ls, 16); ls += __shfl_xor(ls, 32); const float inv = 1.0f / ls;
            bf16* op = F_MIX + (qrow0 + qt * 16 + fr) * DM + h * 64 + 4 * fq;
#pragma unroll
            for (int et = 0; et < 4; ++et) { const f32x4 o = ot[et][qt] * inv; u32x2 w; w.x = pk2(o.x, o.y); w.y = pk2(o.z, o.w); *(u32x2*)(op + et * 16) = w; } }
    }
}


__device__ __forceinline__ void attn_coop(Frame& F, int l) {
    const int lane = F.lane, fr = lane & 15, fq = lane >> 4, tid = F.tid, wave = F.wave;
    constexpr int PIT = 144, TILE = 64 * PIT, BUF = 2 * TILE;
    LAS unsigned char* base = F.lds;
    LAS float* bl = (LAS float*)(F.lds + 2 * BUF);
    constexpr float LOG2E = 1.4426950408889634f, SC = 0.125f * LOG2E;
    const unsigned vtr0 = (unsigned)((4 * fq + (fr >> 2)) * PIT + (fr & 3) * 8);
    const unsigned kfa = (unsigned)(fr * PIT + fq * 16);
    const int srow = tid >> 3, sch = tid & 7;
    const int b = F.blk & 7, jq = F.blk >> 3, h = jq >> 2, quarter = jq & 3, sub = wave & 1;
    for (int step = 0; step < 4; ++step) {
        const int n0 = quarter * 16 + step * 4, nw = n0 + (wave >> 1);
        const size_t qrow0 = (size_t)b * SEQ + nw * 64 + sub * 32;
        const int kcmin = n0 >= 8 ? n0 - 8 : 0, nit = n0 + 3 - kcmin + 1;
        __syncthreads();
        if (tid < 192) bl[tid] = F_rel_bias[(size_t)(l * 8 + h) * 192 + tid] * LOG2E;
        { const bf16* gp = F_QKV + ((size_t)b * SEQ + kcmin * 64 + srow) * INW + h * 64 + sch * 8;
            const u32x4 kk = *(const u32x4*)(gp + C_KA), vv = *(const u32x4*)(gp + C_VA);
            *(LAS u32x4*)(base + srow * PIT + sch * 16) = kk; *(LAS u32x4*)(base + TILE + srow * PIT + sch * 16) = vv; }
        bf16x8 qf[2][2];
#pragma unroll
        for (int qt = 0; qt < 2; ++qt)
#pragma unroll
            for (int ks = 0; ks < 2; ++ks) qf[qt][ks] = *(const bf16x8*)(F_QKV + (qrow0 + qt * 16 + fr) * INW + C_QA + h * 64 + ks * 32 + fq * 8);
        f32x4 ot[4][2]; float lp[2];
#pragma unroll
        for (int qt = 0; qt < 2; ++qt) { lp[qt] = 0.f;
#pragma unroll
            for (int et = 0; et < 4; ++et) ot[et][qt] = (f32x4){0.f, 0.f, 0.f, 0.f}; }
        __syncthreads();
        const float b0 = bl[0];
        for (int i = 0; i < nit; ++i) {
            const int kc = kcmin + i; const bool more = (i + 1 < nit);
            u32x4 kk, vv;
            if (more) { const bf16* gp = F_QKV + ((size_t)b * SEQ + (kc + 1) * 64 + srow) * INW + h * 64 + sch * 8; kk = *(const u32x4*)(gp + C_KA); vv = *(const u32x4*)(gp + C_VA); }
            LAS unsigned char* kb = base + (i & 1) * BUF; LAS unsigned char* vb = kb + TILE;
            if (kc >= nw - 8 && kc <= nw) {
                f32x4 st[4][2];
#pragma unroll
                for (int kt = 0; kt < 4; ++kt) { const bf16x8 k0 = *(const LAS bf16x8*)(kb + kfa + kt * 16 * PIT), k1 = *(const LAS bf16x8*)(kb + kfa + kt * 16 * PIT + 64);
#pragma unroll
                    for (int qt = 0; qt < 2; ++qt) { f32x4 z = (f32x4){0.f, 0.f, 0.f, 0.f};
                        z = __builtin_amdgcn_mfma_f32_16x16x32_bf16(k0, qf[qt][0], z, 0, 0, 0); st[kt][qt] = __builtin_amdgcn_mfma_f32_16x16x32_bf16(k1, qf[qt][1], z, 0, 0, 0); } }
                const int dc = kc - nw;
                if (dc <= -3) {
#pragma unroll
                    for (int kt = 0; kt < 4; ++kt)
#pragma unroll
                        for (int qt = 0; qt < 2; ++qt) st[kt][qt] = st[kt][qt] * SC + b0;
                } else {
                    const int ib = 64 * dc + 128 + 4 * fq - fr - sub * 32;
#pragma unroll
                    for (int kt = 0; kt < 4; ++kt)
#pragma unroll
                        for (int qt = 0; qt < 2; ++qt)
#pragma unroll
                            for (int r = 0; r < 4; ++r) { int idx = ib + 16 * (kt - qt) + r; idx = idx < 0 ? 0 : idx; st[kt][qt][r] = st[kt][qt][r] * SC + bl[idx]; }
                }
#pragma unroll
                for (int qt = 0; qt < 2; ++qt) { float ps = 0.f;
#pragma unroll
                    for (int kt = 0; kt < 4; ++kt)
#pragma unroll
                        for (int r = 0; r < 4; ++r) { const float p = __builtin_amdgcn_exp2f(st[kt][qt][r]); st[kt][qt][r] = p; ps += p; }
                    lp[qt] += ps; }
#pragma unroll
                for (int s = 0; s < 2; ++s) {
                    bf16x8 pf[2];
#pragma unroll
                    for (int qt = 0; qt < 2; ++qt) { u32x4 w; w.x = pg8::cvt_pk_bf16(st[2 * s][qt][0], st[2 * s][qt][1]); w.y = pg8::cvt_pk_bf16(st[2 * s][qt][2], st[2 * s][qt][3]);
                        w.z = pg8::cvt_pk_bf16(st[2 * s + 1][qt][0], st[2 * s + 1][qt][1]); w.w = pg8::cvt_pk_bf16(st[2 * s + 1][qt][2], st[2 * s + 1][qt][3]); pf[qt] = __builtin_bit_cast(bf16x8, w); }
#pragma unroll
                    for (int et = 0; et < 4; ++et) {
                        const v4i16_t t0 = __builtin_amdgcn_ds_read_tr16_b64_v4i16((LAS v4i16_t*)(vb + vtr0 + (2 * s) * 16 * PIT + et * 32));
                        const v4i16_t t1 = __builtin_amdgcn_ds_read_tr16_b64_v4i16((LAS v4i16_t*)(vb + vtr0 + (2 * s + 1) * 16 * PIT + et * 32));
                        bf16x8 vf; vf[0] = t0[0]; vf[1] = t0[1]; vf[2] = t0[2]; vf[3] = t0[3]; vf[4] = t1[0]; vf[5] = t1[1]; vf[6] = t1[2]; vf[7] = t1[3];
#pragma unroll
                        for (int qt = 0; qt < 2; ++qt) ot[et][qt] = __builtin_amdgcn_mfma_f32_16x16x32_bf16(vf, pf[qt], ot[et][qt], 0, 0, 0);
                    }
                }
            }
            if (more) { LAS unsigned char* nb = base + ((i + 1) & 1) * BUF; *(LAS u32x4*)(nb + srow * PIT + sch * 16) = kk; *(LAS u32x4*)(nb + TILE + srow * PIT + sch * 16) = vv; }
            __syncthreads();
        }
#pragma unroll
        for (int qt = 0; qt < 2; ++qt) { float ls = lp[qt]; ls += __shfl_xor(ls, 16); ls += __shfl_xor(ls, 32); const float inv = 1.0f / ls;
            bf16* op = F_MIX + (qrow0 + qt * 16 + fr) * DM + h * 64 + 4 * fq;
#pragma unroll
            for (int et = 0; et < 4; ++et) { const f32x4 o = ot[et][qt] * inv; u32x2 w; w.x = pk2(o.x, o.y); w.y = pk2(o.z, o.w); *(u32x2*)(op + et * 16) = w; } }
    }
}

__device__ __forceinline__ void unpack8(const u32x4 w, float (&x)[8]) { x[0] = bf2f(w.x & 0xffffu); x[1] = bf2f(w.x >> 16); x[2] = bf2f(w.y & 0xffffu); x[3] = bf2f(w.y >> 16); x[4] = bf2f(w.z & 0xffffu); x[5] = bf2f(w.z >> 16); x[6] = bf2f(w.w & 0xffffu); x[7] = bf2f(w.w >> 16); }
__device__ __forceinline__ u32x4 pack8(const float (&x)[8]) { u32x4 w; w.x = pk2(x[0], x[1]); w.y = pk2(x[2], x[3]); w.z = pk2(x[4], x[5]); w.w = pk2(x[6], x[7]); return w; }
__device__ __forceinline__ void rope8(const u32x4 a, const u32x4 b, const f32x2* cs, float scale, u32x4& o1, u32x4& o2) {
    float x1[8], x2[8], r1[8], r2[8]; unpack8(a, x1); unpack8(b, x2);
    const f32x4* c4 = (const f32x4*)cs;
#pragma unroll
    for (int q = 0; q < 4; ++q) { const f32x4 t = c4[q];
        r1[2 * q] = (x1[2 * q] * t.x - x2[2 * q] * t.y) * scale; r2[2 * q] = (x1[2 * q] * t.y + x2[2 * q] * t.x) * scale;
        r1[2 * q + 1] = (x1[2 * q + 1] * t.z - x2[2 * q + 1] * t.w) * scale; r2[2 * q + 1] = (x1[2 * q + 1] * t.w + x2[2 * q + 1] * t.z) * scale; }
    o1 = pack8(r1); o2 = pack8(r2);
}
__device__ __forceinline__ bf16x8 tr_frag(LAS unsigned char* p0, LAS unsigned char* p1) {
    const v4i16_t t0 = __builtin_amdgcn_ds_read_tr16_b64_v4i16((LAS v4i16_t*)p0), t1 = __builtin_amdgcn_ds_read_tr16_b64_v4i16((LAS v4i16_t*)p1);
    bf16x8 f; f[0] = t0[0]; f[1] = t0[1]; f[2] = t0[2]; f[3] = t0[3]; f[4] = t1[0]; f[5] = t1[1]; f[6] = t1[2]; f[7] = t1[3]; return f;
}
__device__ __forceinline__ void ret_kv_mfma(Frame& F, int l) {
    const int lane = F.lane, fr = lane & 15, fq = lane >> 4;
    constexpr int PIT = 136;
    LAS unsigned char* kt = F.lds + F.wave * (2 * 64 * PIT);
    LAS unsigned char* vt = kt + 64 * PIT;
    const unsigned tr0 = (unsigned)((4 * fq + (fr >> 2)) * PIT + (fr & 3) * 8);
    int u0, ustride, ucnt;
    if (F.G != 256) { u0 = F.gw; ustride = F.ngw; ucnt = (NB * NCH * 4 - u0 + ustride - 1) / ustride; }
    else if (F.blk < 64) { u0 = F.blk * NWAVES + F.wave; ustride = 0; ucnt = 1; }
    else if (F.blk >= 192) { u0 = 512 + (F.blk - 192) * NWAVES + F.wave; ustride = 512; ucnt = 3; }
    else return;
    for (int ui = 0; ui < ucnt; ++ui) { const int u = u0 + ui * ustride;
        const int h = u & 3, n = (u >> 2) & 63, b = u >> 8; const float lg = ret_log2gamma(h);
        const size_t row = (size_t)b * SEQ + n * 64 + lane;
        const bf16* kp = F_QKV + row * INW + C_KR + h * 64; const bf16* vp = F_QKV + row * INW + C_VR + h * 64;
        const f32x2* rp = F_ROPE + (size_t)(n * 64 + lane) * 32;
        const float zs = 0.125f * exp2f(lg * (float)(63 - lane));
        __builtin_amdgcn_wave_barrier();
#pragma unroll
        for (int dq = 0; dq < 4; ++dq) { u32x4 o1, o2; rope8(*(const u32x4*)(kp + dq * 8), *(const u32x4*)(kp + 32 + dq * 8), rp + dq * 8, zs, o1, o2);
            LAS u32x2* w1 = (LAS u32x2*)(kt + lane * PIT + dq * 16); LAS u32x2* w2 = (LAS u32x2*)(kt + lane * PIT + 64 + dq * 16);
            w1[0] = (u32x2){o1.x, o1.y}; w1[1] = (u32x2){o1.z, o1.w}; w2[0] = (u32x2){o2.x, o2.y}; w2[1] = (u32x2){o2.z, o2.w}; }
#pragma unroll
        for (int c = 0; c < 8; ++c) { const u32x4 v = *(const u32x4*)(vp + c * 8); LAS u32x2* w = (LAS u32x2*)(vt + lane * PIT + c * 16); w[0] = (u32x2){v.x, v.y}; w[1] = (u32x2){v.z, v.w}; }
        LDS_WAIT(); __builtin_amdgcn_wave_barrier();
        f32x4 acc[4][4];
#pragma unroll
        for (int i = 0; i < 4; ++i)
#pragma unroll
            for (int j = 0; j < 4; ++j) acc[i][j] = (f32x4){0.f, 0.f, 0.f, 0.f};
#pragma unroll
        for (int s = 0; s < 2; ++s) {
            bf16x8 kf[4];
#pragma unroll
            for (int dt = 0; dt < 4; ++dt) kf[dt] = tr_frag(kt + tr0 + (2 * s) * 16 * PIT + dt * 32, kt + tr0 + (2 * s + 1) * 16 * PIT + dt * 32);
#pragma unroll
            for (int et = 0; et < 4; ++et) { const bf16x8 vf = tr_frag(vt + tr0 + (2 * s) * 16 * PIT + et * 32, vt + tr0 + (2 * s + 1) * 16 * PIT + et * 32);
#pragma unroll
                for (int dt = 0; dt < 4; ++dt) acc[et][dt] = __builtin_amdgcn_mfma_f32_16x16x32_bf16(kf[dt], vf, acc[et][dt], 0, 0, 0); }
        }
        bf16* o = F_KVB + (size_t)(u >> 2) * KVST + (u & 3) * 4096;
#pragma unroll
        for (int et = 0; et < 4; ++et)
#pragma unroll
            for (int dt = 0; dt < 4; ++dt) { u32x2 w; w.x = pk2(acc[et][dt][0], acc[et][dt][1]); w.y = pk2(acc[et][dt][2], acc[et][dt][3]); *(u32x2*)(o + (et * 16 + fr) * 64 + dt * 16 + 4 * fq) = w; }
    }
}
__device__ __forceinline__ void ret_out_mfma(Frame& F, int l) {
    const int lane = F.lane, fr = lane & 15, fq = lane >> 4;
    constexpr int PIT = 144;
    LAS unsigned char* vt = F.lds + F.wave * (64 * PIT);
    const unsigned tr0 = (unsigned)((4 * fq + (fr >> 2)) * PIT + (fr & 3) * 8);
    const int skip = (F.G == 256) ? 128 : 0;
    if (F.blk < skip) return;
    for (int u = (F.blk - skip) * NWAVES + F.wave; u < NB * NCH * 4; u += (F.G - skip) * NWAVES) {
        const int h = u & 3, n = (u >> 2) & 63, b = u >> 8; const float lg = ret_log2gamma(h);
        const size_t row0 = (size_t)b * SEQ + n * 64;
        __builtin_amdgcn_wave_barrier();
#pragma unroll
        for (int i = 0; i < 8; ++i) { const u32x4 v = *(const u32x4*)(F_QKV + (row0 + (lane >> 3) + 8 * i) * INW + C_VR + h * 64 + (lane & 7) * 8); *(LAS u32x4*)(vt + ((lane >> 3) + 8 * i) * PIT + (lane & 7) * 16) = v; }
        bf16x8 kf[4][2];
#pragma unroll
        for (int jt = 0; jt < 4; ++jt) { const int j = jt * 16 + fr; u32x4 o1, o2;
            const bf16* kp = F_QKV + (row0 + j) * INW + C_KR + h * 64 + fq * 8; rope8(*(const u32x4*)kp, *(const u32x4*)(kp + 32), F_ROPE + (size_t)(n * 64 + j) * 32 + fq * 8, 0.125f, o1, o2);
            kf[jt][0] = __builtin_bit_cast(bf16x8, o1); kf[jt][1] = __builtin_bit_cast(bf16x8, o2); }
        LDS_WAIT(); __builtin_amdgcn_wave_barrier();
        const bf16* prev = F_KVB + (size_t)(u >> 2) * KVST + (u & 3) * 4096; const float* gng = F_gn_g + l * 256 + h * 64 + 4 * fq;
        bf16x8 pvf[4][2];
#pragma unroll
        for (int et = 0; et < 4; ++et)
#pragma unroll
            for (int ks = 0; ks < 2; ++ks) pvf[et][ks] = *(const bf16x8*)(prev + (et * 16 + fr) * 64 + ks * 32 + fq * 8);
        u32x4 qra[2], qrb[2];
#pragma unroll
        for (int it = 0; it < 2; ++it) { const bf16* qp = F_QKV + (row0 + it * 16 + fr) * INW + C_QR + h * 64 + fq * 8; qra[it] = *(const u32x4*)qp; qrb[it] = *(const u32x4*)(qp + 32); }
#pragma unroll 1
        for (int hq = 0; hq < 2; ++hq) {
            bf16x8 qf[2][2];
            u32x4 qna[2], qnb[2];
            if (hq == 0) {
#pragma unroll
                for (int it = 0; it < 2; ++it) { const bf16* qp = F_QKV + (row0 + (2 + it) * 16 + fr) * INW + C_QR + h * 64 + fq * 8; qna[it] = *(const u32x4*)qp; qnb[it] = *(const u32x4*)(qp + 32); } }
            else {
#pragma unroll
                for (int it = 0; it < 2; ++it) { qna[it] = qra[it]; qnb[it] = qrb[it]; } }
#pragma unroll
            for (int it = 0; it < 2; ++it) { const int i = (2 * hq + it) * 16 + fr; u32x4 o1, o2;
                rope8(qra[it], qrb[it], F_ROPE + (size_t)(n * 64 + i) * 32 + fq * 8, 1.0f, o1, o2);
                qf[it][0] = __builtin_bit_cast(bf16x8, o1); qf[it][1] = __builtin_bit_cast(bf16x8, o2); }
            u32x2 gwv[2][4]; f32x4 gnv[4];
#pragma unroll
            for (int et = 0; et < 4; ++et) { gnv[et] = *(const f32x4*)(gng + et * 16);
#pragma unroll
                for (int it = 0; it < 2; ++it) gwv[it][et] = *(const u32x2*)(F_QKV + (row0 + (2 * hq + it) * 16 + fr) * INW + C_GR + h * 64 + et * 16 + 4 * fq); }
            f32x4 st[4][2];
#pragma unroll
            for (int jt = 0; jt < 2; ++jt)
#pragma unroll
                for (int it = 0; it < 2; ++it) { f32x4 z = (f32x4){0.f, 0.f, 0.f, 0.f}; z = __builtin_amdgcn_mfma_f32_16x16x32_bf16(kf[jt][0], qf[it][0], z, 0, 0, 0); st[jt][it] = __builtin_amdgcn_mfma_f32_16x16x32_bf16(kf[jt][1], qf[it][1], z, 0, 0, 0); }
            if (hq) {
#pragma unroll
                for (int jt = 2; jt < 4; ++jt)
#pragma unroll
                    for (int it = 0; it < 2; ++it) { f32x4 z = (f32x4){0.f, 0.f, 0.f, 0.f}; z = __builtin_amdgcn_mfma_f32_16x16x32_bf16(kf[jt][0], qf[it][0], z, 0, 0, 0); st[jt][it] = __builtin_amdgcn_mfma_f32_16x16x32_bf16(kf[jt][1], qf[it][1], z, 0, 0, 0); }
#pragma unroll
                for (int jt = 2; jt < 4; ++jt)
#pragma unroll
                    for (int it = 0; it < 2; ++it)
#pragma unroll
                        for (int r = 0; r < 4; ++r) { const int dd = ((2 + it) * 16 + fr) - (jt * 16 + 4 * fq + r); st[jt][it][r] = dd >= 0 ? st[jt][it][r] * __builtin_amdgcn_exp2f(lg * (float)dd) : 0.f; }
            } else {
#pragma unroll
                for (int jt = 2; jt < 4; ++jt)
#pragma unroll
                    for (int it = 0; it < 2; ++it) st[jt][it] = (f32x4){0.f, 0.f, 0.f, 0.f};
            }
#pragma unroll
            for (int jt = 0; jt < 2; ++jt)
#pragma unroll
                for (int it = 0; it < 2; ++it)
#pragma unroll
                    for (int r = 0; r < 4; ++r) { const int dd = ((2 * hq + it) * 16 + fr) - (jt * 16 + 4 * fq + r); st[jt][it][r] = dd >= 0 ? st[jt][it][r] * __builtin_amdgcn_exp2f(lg * (float)dd) : 0.f; }
            f32x4 yi[4][2], yc[4][2];
#pragma unroll
            for (int et = 0; et < 4; ++et)
#pragma unroll
                for (int it = 0; it < 2; ++it) { yi[et][it] = (f32x4){0.f, 0.f, 0.f, 0.f}; yc[et][it] = (f32x4){0.f, 0.f, 0.f, 0.f}; }
#pragma unroll
            for (int s = 0; s < 2; ++s) {
                if (s == 1 && hq == 0) continue;
                bf16x8 pf[2];
#pragma unroll
                for (int it = 0; it < 2; ++it) { u32x4 w; w.x = pk2(st[2 * s][it][0], st[2 * s][it][1]); w.y = pk2(st[2 * s][it][2], st[2 * s][it][3]); w.z = pk2(st[2 * s + 1][it][0], st[2 * s + 1][it][1]); w.w = pk2(st[2 * s + 1][it][2], st[2 * s + 1][it][3]); pf[it] = __builtin_bit_cast(bf16x8, w); }
#pragma unroll
                for (int et = 0; et < 4; ++et) { const bf16x8 vf = tr_frag(vt + tr0 + (2 * s) * 16 * PIT + et * 32, vt + tr0 + (2 * s + 1) * 16 * PIT + et * 32);
#pragma unroll
                    for (int it = 0; it < 2; ++it) yi[et][it] = __builtin_amdgcn_mfma_f32_16x16x32_bf16(vf, pf[it], yi[et][it], 0, 0, 0); }
            }
#pragma unroll
            for (int et = 0; et < 4; ++et)
#pragma unroll
                for (int ks = 0; ks < 2; ++ks) {
#pragma unroll
                    for (int it = 0; it < 2; ++it) yc[et][it] = __builtin_amdgcn_mfma_f32_16x16x32_bf16(pvf[et][ks], qf[it][ks], yc[et][it], 0, 0, 0); }
#pragma unroll
            for (int it = 0; it < 2; ++it) { const int i = (2 * hq + it) * 16 + fr; const float xi = __builtin_amdgcn_exp2f(lg * (float)(i + 1)); float s1 = 0.f;
#pragma unroll
                for (int et = 0; et < 4; ++et) { yi[et][it] = yi[et][it] + yc[et][it] * xi; s1 += (yi[et][it].x + yi[et][it].y) + (yi[et][it].z + yi[et][it].w); }
                s1 += __shfl_xor(s1, 16); s1 += __shfl_xor(s1, 32); const float mu = s1 * (1.0f / 64.0f); float s2 = 0.f;
#pragma unroll
                for (int et = 0; et < 4; ++et) { yi[et][it] = yi[et][it] - mu; s2 += (yi[et][it].x * yi[et][it].x + yi[et][it].y * yi[et][it].y) + (yi[et][it].z * yi[et][it].z + yi[et][it].w * yi[et][it].w); }
                s2 += __shfl_xor(s2, 16); s2 += __shfl_xor(s2, 32); const float rstd = 1.0f / sqrtf(s2 * (1.0f / 64.0f) + EPS);
#pragma unroll
                for (int et = 0; et < 4; ++et) { const int e0 = et * 16 + 4 * fq; const u32x2 gw = gwv[it][et]; const f32x4 gn = gnv[et];
                    const f32x4 y = yi[et][it] * rstd * gn; u32x2 w; w.x = pk2(silu_f(bf2f(gw.x & 0xffffu)) * y.x, silu_f(bf2f(gw.x >> 16)) * y.y); w.y = pk2(silu_f(bf2f(gw.y & 0xffffu)) * y.z, silu_f(bf2f(gw.y >> 16)) * y.w);
                    *(u32x2*)(F_MIX + (row0 + i) * DM + 768 + h * 64 + e0) = w; }
            }
#pragma unroll
            for (int it = 0; it < 2; ++it) { qra[it] = qna[it]; qrb[it] = qnb[it]; }
        }
    }
}

struct Args { const float* in[28]; float* out; unsigned char* ws; int ph_lo, ph_hi; };
constexpr int NPHASE = 2 + NL * 10;

__global__ void __launch_bounds__(NTHR, 2) fwd_kernel(Args args) {
    extern __shared__ __attribute__((aligned(16))) unsigned char lds[];
    Frame F;
    F.lds = (LAS unsigned char*)lds;
    F.tid = threadIdx.x; F.lane = F.tid & 63; F.wave = __builtin_amdgcn_readfirstlane(F.tid >> 6); F.blk = blockIdx.x; F.G = gridDim.x;
    F.gw = F.blk * NWAVES + F.wave; F.ngw = F.G * NWAVES;
    F.out0 = args.out; F.ws0 = args.ws; F.wz = 0;
    F.ptab = (LAS unsigned long long*)(F.lds + LDS_BYTES - 64 - 256);
    if (F.tid == 0) {
#pragma unroll
        for (int i = 0; i < 28; ++i) F.ptab[i] = (unsigned long long)args.in[i];
    }
    LAS unsigned* misc = (LAS unsigned*)(F.lds + LDS_BYTES - 64);
    if (F.tid < 16) misc[F.tid] = 0u;
    __syncthreads();
    const int lo = args.ph_lo, hi = args.ph_hi;
    XcdBarrier bar; bar.bar = F_ctl + CW_BAR; bar.x = 0; bar.st = nullptr;
    if (hi - lo > 1) bar = xcd_barrier_post(F_ctl + CW_BAR, (volatile LAS unsigned*)misc);
#ifndef PH_ONLY
#define PH_ONLY -1
#endif
#define PSEL(j) (PH_ONLY < 0 || PH_ONLY == (j))
#define IN(k) (lo <= (k) && (k) < hi)
#define SEAM(k) do { if (IN(k) && IN((k) + 1)) xcd_barrier(bar); { int _t = threadIdx.x; asm volatile("" : "+v"(_t)); F.tid = _t; F.lane = _t & 63; asm volatile("" : "+s"(F.wz)); { unsigned _z = 0; asm volatile("" : "+s"(_z)); F.lds = (LAS unsigned char*)lds + _z; F.ptab = (LAS unsigned long long*)(F.lds + LDS_BYTES - 64 - 256); } asm volatile("" : "+s"(F.gw), "+s"(F.ngw), "+s"(F.blk), "+s"(F.G), "+s"(F.wave)); } } while (0)

#ifndef PROBE_PH
#define PROBE_PH -1
#endif
    volatile LAS unsigned long long* tpw = (volatile LAS unsigned long long*)(F.lds + LDS_BYTES - 32);
#define TPB(j) do { if (PROBE_PH == (j) && F.blk == 0 && F.tid == 0) tpw[1] = __builtin_amdgcn_s_memrealtime(); } while (0)
#define TPE(j) do { if (PROBE_PH == (j) && F.blk == 0 && F.tid == 0) tpw[0] = tpw[0] + (__builtin_amdgcn_s_memrealtime() - tpw[1]); } while (0)
    TPB(10); if (IN(0) && PSEL(10)) { p0_prologue(F); } SEAM(0); TPE(10);
    for (int l = 0; l < NL; ++l) {
        const int p = 1 + 10 * l;
        TPB(0); if (IN(p + 0) && PSEL(0)) { norm1_phase<false>(F, l); if (l == 0) s5_build_operands(F, 0, 0, F.G); } SEAM(p + 0); TPE(0);
        TPB(1); if (IN(p + 1) && PSEL(1)) { pg8::StaticOrder S; S.init(F_H, DM, F_WinT + (size_t)l * INW * DM, DM, NT, (F.G == 256) ? INW - 256 : INW, F.G, F.blk); EpiQKV E{F_QKV, F_U2X};
            pg8::gemm_phase<EpiQKV, pg8::StaticOrder, false>(F.lds, DM, DM, DM, S, E); } SEAM(p + 1); TPE(1);
        TPB(2); if (IN(p + 2) && PSEL(2)) { ret_kv_mfma(F, l); __syncthreads();
            SplitKOrder S; S.G = F.G; S.c = F.blk; S.A = (const char*)(F_U2X + 128); S.Bt = (const char*)(F_BT1 + (size_t)(l & 1) * BTSZ);
            EpiS5a E{F_SENDP}; pg8::gemm_phase<EpiS5a, SplitKOrder, false>(F.lds, 512, U2LD, 1024, S, E);
            if (F.G == 256) { GateOrder SG; SG.blk = F.blk; SG.A = (const char*)F_H; SG.Bt = (const char*)(F_WinT + (size_t)l * INW * DM); EpiQKV EG{F_QKV, F_U2X};
                pg8::gemm_phase<EpiQKV, GateOrder, false>(F.lds, DM, DM, DM, SG, EG);
                if (l + 1 < NL && F.blk >= 192) { __syncthreads(); tr_items(F, l + 1, 0, TR_S2, (F.blk - 192) * NWAVES + F.wave, 512); } } } SEAM(p + 2); TPE(2);
        TPB(3); if (IN(p + 3) && PSEL(3)) { p4_scan_attn(F, l); } SEAM(p + 3); TPE(3);
        TPB(4); if (IN(p + 4) && PSEL(4)) { ret_out_mfma(F, l); __syncthreads();
            ToepOrder S; S.G = F.G; S.c = F.blk; S.npn = 4; S.nunit = 128; S.A = (const char*)F_U2X; S.Kb = (const char*)(F_KERNB + (size_t)l * 16 * 128 * 256); S.Ct = (const char*)(F_TMAT + (size_t)(l & 1) * CTSZ); S.tstepA = (size_t)256 * U2LD * 2;
            EpiS5b E{F_YG}; const int keff = (F.G == 256) ? 128 + 256 * ((F.blk & 3) + 1) : U2K;
            pg8::gemm_phase<EpiS5b, ToepOrder, false, true>(F.lds, keff, U2LD, 128, S, E);
            if (F.G == 256 && l + 1 < NL && F.blk < 128) { const int pnb = F.blk & 3, js = TR_S2 + (F.blk >> 2) * 184 + (pnb == 0 ? 0 : pnb == 1 ? 72 : pnb == 2 ? 128 : 168), jc = pnb == 0 ? 72 : pnb == 1 ? 56 : pnb == 2 ? 40 : 16;
                __syncthreads(); tr_items(F, l + 1, js, js + jc, F.wave, NWAVES); } } SEAM(p + 4); TPE(4);
        TPB(5); if (IN(p + 5) && PSEL(5)) { pg8::StaticOrder S; S.init(F_YG, 256, F_WgluT + (size_t)l * 256 * 256, 256, NT, 256, F.G, F.blk); EpiGlu E{F_YG, F_MIX, F_b_glu + l * 256};
            pg8::gemm_phase<EpiGlu, pg8::StaticOrder, false>(F.lds, 256, 256, 256, S, E);
            if (l + 1 < NL) { if (F.G == 256) { s5_build_operands(F, l + 1, 128, 128); if (F.blk >= 128) { __syncthreads(); tr_items(F, l + 1, TR_S4, TR_SLOT, (F.blk - 128) * NWAVES + F.wave, 1024); } } else s5_build_operands(F, l + 1, 0, F.G); } } SEAM(p + 5); TPE(5);
        TPB(6); if (IN(p + 6) && PSEL(6)) { pg8::StaticOrder S; S.init(F_MIX, DM, F_WoutT + (size_t)l * DM * DM, DM, NT, DM, F.G, F.blk); EpiRes E{F_x, F_XB, F_MOD + (size_t)l * NB * 6144 + 2048, F_SSQ, l == 0 ? 1 : 0};
            pg8::gemm_phase<EpiRes, pg8::StaticOrder, false>(F.lds, DM, DM, DM, S, E); } SEAM(p + 6); TPE(6);
        TPB(7); if (IN(p + 7) && PSEL(7)) { norm2_router_phase(F, l); } SEAM(p + 7); TPE(7);
        TPB(8); if (IN(p + 8) && PSEL(8)) { moe_pg8<1>(F, l); } SEAM(p + 8); TPE(8);
        TPB(9); if (IN(p + 9) && PSEL(9)) { moe_pg8<2>(F, l); } SEAM(p + 9); TPE(9);
    }
    TPB(11); if (IN(NPHASE - 1) && PSEL(11)) { norm1_phase<true>(F, 0); } TPE(11);
    if (PROBE_PH >= 0 && F.blk == 0 && F.tid == 0) { const unsigned long long t1 = __builtin_amdgcn_s_memrealtime(); const unsigned long long tp_acc = tpw[0]; while (__builtin_amdgcn_s_memrealtime() - t1 < 4ull * tp_acc) __builtin_amdgcn_s_sleep(8); }
#undef IN
#undef SEAM
}

extern "C" void kernel_launch(void* const* d_in, const int* in_sizes, int n_in, void* d_out, int out_size, void* d_ws, size_t ws_size, hipStream_t stream) {
    static int grid = 0;
    if (grid == 0) {
        if (n_in != 28 || in_sizes[0] != NT * DM || out_size != NT * DM || ws_size < WS_END) { fprintf(stderr, "kernel_launch: unexpected shapes / workspace (%d inputs, ws %zu < %zu)\n", n_in, ws_size, (size_t)WS_END); grid = -1; return; }
        int dev = 0, cus = 0;
        if (hipGetDevice(&dev) != hipSuccess || hipDeviceGetAttribute(&cus, hipDeviceAttributeMultiprocessorCount, dev) != hipSuccess) { grid = -1; return; }
        if (hipFuncSetAttribute((const void*)fwd_kernel, hipFuncAttributeMaxDynamicSharedMemorySize, LDS_BYTES) != hipSuccess) { fprintf(stderr, "kernel_launch: hipFuncSetAttribute failed\n"); grid = -1; return; }
        int per_cu = 0;
        if (hipOccupancyMaxActiveBlocksPerMultiprocessor(&per_cu, (const void*)fwd_kernel, NTHR, LDS_BYTES) != hipSuccess || per_cu < 1) { fprintf(stderr, "kernel_launch: occupancy query says %d\n", per_cu); }
        (void)hipGetLastError();
        grid = 256;
        if (cus < 256) { fprintf(stderr, "kernel_launch: device has %d CUs, need 256\n", cus); grid = -1; return; }
    }
    if (grid < 0) return;
    (void)hipMemsetAsync((char*)d_ws + WS_CTL, 0, CTL_BYTES, stream);
    Args a{};
    for (int i = 0; i < 28; ++i) a.in[i] = (const float*)d_in[i];
    a.out = (float*)d_out; a.ws = (unsigned char*)d_ws;
#if MK_MULTI
    for (int ph = 0; ph < NPHASE; ++ph) { a.ph_lo = ph; a.ph_hi = ph + 1; hipLaunchKernelGGL(fwd_kernel, dim3(grid), dim3(NTHR), LDS_BYTES, stream, a); }
#else
    a.ph_lo = 0; a.ph_hi = NPHASE; hipLaunchKernelGGL(fwd_kernel, dim3(grid), dim3(NTHR), LDS_BYTES, stream, a);
#endif
}
```
